# Optimizing an MI355X kernel written in HIP

```python
import math
import jax
import jax.numpy as jnp
from jax import lax
import numpy as np

D_MODEL = 1024
BATCH = 4
SEQ = 4096
DEPTH = 2

D_INNER = 2 * D_MODEL
N_BRANCH = 4
BRANCH_W = D_INNER // N_BRANCH
HGRN_HEADS = 4
RET_HEADS = 4
RET_DECAY_EXP0 = 5.0
ROPE_BASE = 10000.0
SSM_HEAD_DIM = 64
SSM_HEADS = BRANCH_W // SSM_HEAD_DIM
SSM_GROUPS = 2
SSM_STATE = 128
SSM_CONV = 4
SSM_CONV_CH = BRANCH_W + 2 * SSM_GROUPS * SSM_STATE
SSM_DT_MIN = 0.001
SSM_DT_MAX = 0.1
GLA_HEADS = 4
GLA_KEY_W = BRANCH_W // 2
GLA_LOWRANK = 16
GLA_GATE_TEMP = 16.0
CHUNK = 64
EPS = 1e-6
IN_SPLITS = (
    BRANCH_W, BRANCH_W, BRANCH_W, BRANCH_W,
    BRANCH_W, BRANCH_W, BRANCH_W, BRANCH_W,
    BRANCH_W, SSM_CONV_CH, SSM_HEADS,
    GLA_KEY_W, GLA_KEY_W, BRANCH_W, BRANCH_W, GLA_LOWRANK,
)
IN_PROJ_W = 8 * BRANCH_W + BRANCH_W + SSM_CONV_CH + SSM_HEADS + 2 * GLA_KEY_W + 2 * BRANCH_W + GLA_LOWRANK

kernel_name = 'hybrid_parallel_heads_decoder'


def rmsnorm(x, g):
    xf = x.astype(jnp.float32)
    y = xf * lax.rsqrt(jnp.mean(xf * xf, axis=-1, keepdims=True) + EPS)
    return (y * g.astype(jnp.float32)).astype(x.dtype)


def group_rmsnorm(y, g, n_groups):
    b, l, w = y.shape
    yf = y.astype(jnp.float32).reshape(b, l, n_groups, w // n_groups)
    yf = yf * lax.rsqrt(jnp.mean(yf * yf, axis=-1, keepdims=True) + EPS)
    return (yf.reshape(b, l, w) * g.astype(jnp.float32)).astype(y.dtype)


def to_heads(t, n_heads):
    b, l, w = t.shape
    return t.reshape(b, l, n_heads, w // n_heads).transpose(0, 2, 1, 3)


def from_heads(t):
    b, h, l, d = t.shape
    return t.transpose(0, 2, 1, 3).reshape(b, l, h * d)


def to_chunks(t):
    b, h, l = t.shape[:3]
    return jnp.moveaxis(t.reshape(b, h, l // CHUNK, CHUNK, *t.shape[3:]), 2, 0)


def from_chunks(t):
    n, b, h, c, d = t.shape
    return jnp.moveaxis(t, 0, 2).reshape(b, h, n * c, d)


def chunked_scalar_decay(q, k, v, log_a):
    out_dtype = v.dtype
    q, k, v, log_a = (t.astype(jnp.float32) for t in (q, k, v, log_a))
    b, h, _, dk = q.shape
    dv = v.shape[-1]
    causal = jnp.tril(jnp.ones((CHUNK, CHUNK), dtype=bool))

    def step(state, inp):
        qc, kc, vc, ac = inp
        cum = jnp.cumsum(ac, axis=-1)
        rel = jnp.where(causal, cum[..., :, None] - cum[..., None, :], -jnp.inf)
        scores = jnp.einsum('bhtd,bhsd->bhts', qc, kc) * jnp.exp(rel)
        o = (jnp.einsum('bhts,bhsv->bhtv', scores, vc)
             + jnp.einsum('bhtd,bhdv->bhtv', qc * jnp.exp(cum)[..., None], state))
        k_to_end = kc * jnp.exp(cum[..., -1:] - cum)[..., None]
        state = (state * jnp.exp(cum[..., -1])[..., None, None]
                 + jnp.einsum('bhsd,bhsv->bhdv', k_to_end, vc))
        return state, o

    state0 = jnp.zeros((b, h, dk, dv), jnp.float32)
    _, o = lax.scan(step, state0, (to_chunks(q), to_chunks(k), to_chunks(v), to_chunks(log_a)))
    return from_chunks(o).astype(out_dtype)


def chunked_vector_decay(q, k, v, log_f):
    out_dtype = v.dtype
    q, k, v, log_f = (t.astype(jnp.float32) for t in (q, k, v, log_f))
    b, h, _, dk = q.shape
    dv = v.shape[-1]
    causal = jnp.tril(jnp.ones((CHUNK, CHUNK), dtype=bool))[..., None]

    def step(state, inp):
        qc, kc, vc, fc = inp
        cum = jnp.cumsum(fc, axis=-2)
        rel = jnp.where(causal, cum[..., :, None, :] - cum[..., None, :, :], -jnp.inf)
        scores = jnp.einsum('bhtd,bhsd,bhtsd->bhts', qc, kc, jnp.exp(rel))
        o = (jnp.einsum('bhts,bhsv->bhtv', scores, vc)
             + jnp.einsum('bhtd,bhdv->bhtv', qc * jnp.exp(cum), state))
        k_to_end = kc * jnp.exp(cum[..., -1:, :] - cum)
        state = (state * jnp.exp(cum[..., -1, :])[..., None]
                 + jnp.einsum('bhsd,bhsv->bhdv', k_to_end, vc))
        return state, o

    state0 = jnp.zeros((b, h, dk, dv), jnp.float32)
    _, o = lax.scan(step, state0, (to_chunks(q), to_chunks(k), to_chunks(v), to_chunks(log_f)))
    return from_chunks(o).astype(out_dtype)


def causal_depthwise_conv(u, w, bias):
    y = lax.conv_general_dilated(
        u, w[:, None, :].astype(u.dtype), window_strides=(1,),
        padding=[(SSM_CONV - 1, 0)], dimension_numbers=('NWC', 'WIO', 'NWC'),
        feature_group_count=u.shape[-1])
    return y + bias.astype(u.dtype)


def rotary(t):
    d = t.shape[-1]
    l = t.shape[2]
    inv_freq = ROPE_BASE ** (-jnp.arange(0, d, 2, dtype=jnp.float32) / d)
    ang = jnp.arange(l, dtype=jnp.float32)[:, None] * inv_freq[None, :]
    cos, sin = jnp.cos(ang), jnp.sin(ang)
    tf = t.astype(jnp.float32)
    t1, t2 = tf[..., : d // 2], tf[..., d // 2:]
    return jnp.concatenate([t1 * cos - t2 * sin, t1 * sin + t2 * cos], axis=-1).astype(t.dtype)


def hgrn2_branch(q_in, f_in, i_in, g_in, lower_bound, onorm_g):
    q = to_heads(jax.nn.silu(q_in), HGRN_HEADS)
    lb = lower_bound.astype(jnp.float32)
    log_f = jnp.logaddexp(jnp.log(lb), jnp.log1p(-lb) + jax.nn.log_sigmoid(f_in.astype(jnp.float32)))
    k = -jnp.expm1(log_f)
    o = chunked_vector_decay(q, to_heads(k, HGRN_HEADS), to_heads(i_in, HGRN_HEADS),
                             to_heads(log_f, HGRN_HEADS))
    return group_rmsnorm(from_heads(o), onorm_g, HGRN_HEADS) * jax.nn.silu(g_in)


def retention_branch(q_in, k_in, v_in, g_in, onorm_g):
    dk = BRANCH_W // RET_HEADS
    q = rotary(to_heads(q_in, RET_HEADS))
    k = rotary(to_heads(k_in, RET_HEADS)) * (dk ** -0.5)
    b, _, l, _ = q.shape
    log_gamma = jnp.log1p(-jnp.exp2(-(RET_DECAY_EXP0 + jnp.arange(RET_HEADS, dtype=jnp.float32))))
    log_a = jnp.broadcast_to(log_gamma[None, :, None], (b, RET_HEADS, l))
    o = chunked_scalar_decay(q, k, to_heads(v_in, RET_HEADS), log_a)
    return group_rmsnorm(from_heads(o), onorm_g, RET_HEADS) * jax.nn.silu(g_in)


def ssd_branch(z_in, xbc_in, dt_in, conv_w, conv_b, dt_bias, a_log, d_skip, norm_g):
    xbc = jax.nn.silu(causal_depthwise_conv(xbc_in, conv_w, conv_b))
    xs, bmat, cmat = jnp.split(xbc, [BRANCH_W, BRANCH_W + SSM_GROUPS * SSM_STATE], axis=-1)
    b, l, _ = xs.shape
    heads_per_group = SSM_HEADS // SSM_GROUPS

    def group_to_heads(m):
        m = m.reshape(b, l, SSM_GROUPS, SSM_STATE).transpose(0, 2, 1, 3)
        return jnp.repeat(m, heads_per_group, axis=1)

    dt = jax.nn.softplus(dt_in.astype(jnp.float32) + dt_bias.astype(jnp.float32)).transpose(0, 2, 1)
    a = -jnp.exp(a_log.astype(jnp.float32))
    xh = to_heads(xs, SSM_HEADS).astype(jnp.float32)
    y = chunked_scalar_decay(group_to_heads(cmat), group_to_heads(bmat),
                             xh * dt[..., None], dt * a[None, :, None])
    y = y + d_skip.astype(jnp.float32)[None, :, None, None] * xh
    y = from_heads(y).astype(z_in.dtype) * jax.nn.silu(z_in)
    return group_rmsnorm(y, norm_g, SSM_GROUPS)


def gla_branch(q_in, k_in, v_in, g_in, lr_in, w_gk2, b_gk2, onorm_g):
    dk = GLA_KEY_W // GLA_HEADS
    gk = jnp.einsum('blr,rk->blk', lr_in, w_gk2) + b_gk2
    log_f = jax.nn.log_sigmoid(gk.astype(jnp.float32)) / GLA_GATE_TEMP
    q = to_heads(q_in, GLA_HEADS) * (dk ** -0.5)
    o = chunked_vector_decay(q, to_heads(k_in, GLA_HEADS), to_heads(v_in, GLA_HEADS),
                             to_heads(log_f, GLA_HEADS))
    return group_rmsnorm(from_heads(o), onorm_g, GLA_HEADS) * jax.nn.silu(g_in)


def setup_inputs(seed: int = 0) -> dict:
    key = jax.random.key(seed)
    ks = jax.random.split(key, 20)
    f32 = jnp.float32

    def nrm(k, shape, scale):
        return scale * jax.random.normal(k, shape, f32)

    def gain(k, shape):
        return 1.0 + 0.01 * jax.random.normal(k, shape, f32)

    dt = jnp.exp(jax.random.uniform(ks[11], (DEPTH, SSM_HEADS), f32,
                                    math.log(SSM_DT_MIN), math.log(SSM_DT_MAX)))
    return {
        'x': jax.random.normal(ks[0], (BATCH, SEQ, D_MODEL), f32),
        'c': jax.random.normal(ks[1], (BATCH, D_MODEL), f32),
        'w_ada': nrm(ks[2], (DEPTH, D_MODEL, 3 * D_MODEL), 0.5 * D_MODEL ** -0.5),
        'b_ada': nrm(ks[3], (DEPTH, 3 * D_MODEL), 0.01),
        'norm_g': gain(ks[4], (DEPTH, D_MODEL)),
        'w_in': nrm(ks[5], (DEPTH, D_MODEL, IN_PROJ_W), D_MODEL ** -0.5),
        'hgrn_lb_logits': nrm(ks[6], (DEPTH, BRANCH_W), 0.1),
        'hgrn_onorm_g': gain(ks[7], (DEPTH, BRANCH_W)),
        'ret_onorm_g': gain(ks[8], (DEPTH, BRANCH_W)),
        'ssm_conv_w': nrm(ks[9], (DEPTH, SSM_CONV, SSM_CONV_CH), SSM_CONV ** -0.5),
        'ssm_conv_b': nrm(ks[10], (DEPTH, SSM_CONV_CH), 0.01),
        'ssm_dt_bias': dt + jnp.log(-jnp.expm1(-dt)),
        'ssm_a_log': jnp.log(jax.random.uniform(ks[12], (DEPTH, SSM_HEADS), f32, 1.0, 16.0)),
        'ssm_d': gain(ks[13], (DEPTH, SSM_HEADS)),
        'ssm_norm_g': gain(ks[14], (DEPTH, BRANCH_W)),
        'gla_w_gk2': nrm(ks[15], (DEPTH, GLA_LOWRANK, GLA_KEY_W), GLA_LOWRANK ** -0.5),
        'gla_b_gk2': nrm(ks[16], (DEPTH, GLA_KEY_W), 0.01),
        'gla_onorm_g': gain(ks[17], (DEPTH, BRANCH_W)),
        'w_out': nrm(ks[18], (DEPTH, D_INNER, D_MODEL), D_INNER ** -0.5),
        'final_g': gain(ks[19], (D_MODEL,)),
    }


def reference(x, c, w_ada, b_ada, norm_g, w_in, hgrn_lb_logits, hgrn_onorm_g, ret_onorm_g,
              ssm_conv_w, ssm_conv_b, ssm_dt_bias, ssm_a_log, ssm_d, ssm_norm_g,
              gla_w_gk2, gla_b_gk2, gla_onorm_g, w_out, final_g):
    c_act = jax.nn.silu(c)
    lb_cum = jnp.cumsum(jax.nn.softmax(hgrn_lb_logits.astype(jnp.float32), axis=0), axis=0)
    lower_bounds = lb_cum - lb_cum[0]
    split_at = [int(s) for s in np.cumsum(IN_SPLITS)[:-1]]
    for layer in range(DEPTH):
        mod = c_act @ w_ada[layer] + b_ada[layer]
        shift, scale, gate = jnp.split(mod[:, None, :], 3, axis=-1)
        h = rmsnorm(x, norm_g[layer]) * (1.0 + scale) + shift
        proj = jnp.einsum('bld,de->ble', h, w_in[layer])
        (aq, af, ai, ag, rq, rk, rv, rg, mz, mxbc, mdt,
         gq, gk, gv, gg, glr) = jnp.split(proj, split_at, axis=-1)
        y_a = hgrn2_branch(aq, af, ai, ag, lower_bounds[layer], hgrn_onorm_g[layer])
        y_b = retention_branch(rq, rk, rv, rg, ret_onorm_g[layer])
        y_c = ssd_branch(mz, mxbc, mdt, ssm_conv_w[layer], ssm_conv_b[layer], ssm_dt_bias[layer],
                         ssm_a_log[layer], ssm_d[layer], ssm_norm_g[layer])
        y_d = gla_branch(gq, gk, gv, gg, glr, gla_w_gk2[layer], gla_b_gk2[layer], gla_onorm_g[layer])
        y = jnp.concatenate([y_a, y_b, y_c, y_d], axis=-1)
        x = x + gate * jnp.einsum('ble,ed->bld', y, w_out[layer])
    return rmsnorm(x, final_g)
```

```cpp
#include <hip/hip_runtime.h>
#include <hip/hip_cooperative_groups.h>
#include <cstdio>
namespace cg = cooperative_groups;

#define LAS __attribute__((address_space(3)))
typedef unsigned short bf16_t;
typedef short bf16x8 __attribute__((ext_vector_type(8)));
typedef float f32x4 __attribute__((ext_vector_type(4)));
typedef float f32x16 __attribute__((ext_vector_type(16)));
typedef unsigned u32x4 __attribute__((ext_vector_type(4)));
typedef unsigned u32x2 __attribute__((ext_vector_type(2)));

constexpr int NB = 4, SEQ = 4096, DM = 1024, DEPTH = 2, DI = 2048;
constexpr int NIN = 7192, LDP = 7424;
constexpr int HROWS = 8192;
constexpr int NTHR = 512;
constexpr float EPS = 1e-6f;
constexpr int C_AQ = 0, C_AF = 512, C_AI = 1024, C_AG = 1536, C_RQ = 2048, C_RK = 2560, C_RV = 3072, C_RG = 3584,
              C_MZ = 4096, C_XBC = 4608, C_DT = 5632, C_GQ = 5640, C_GK = 5896, C_GV = 6152, C_GG = 6664, C_LR = 7176;
constexpr int ST_PER_BC = 229376;
constexpr size_t WS_WIN = 0;
constexpr size_t WS_WOUT = WS_WIN + 2ull * LDP * DM * 2;
constexpr size_t WS_MOD = WS_WOUT + 2ull * DM * DI * 2;
constexpr size_t WS_ROPE = WS_MOD + 2ull * 4 * 3072 * 4;
constexpr size_t WS_DEC = WS_ROPE + 4096ull * 64 * 8;
constexpr size_t WS_HY = WS_DEC + 128ull * 1024 * 4;
constexpr size_t WS_PROJ = WS_HY + (size_t)HROWS * DI * 2;
constexpr size_t WS_ST = WS_PROJ + (size_t)HROWS * LDP * 2;
constexpr size_t WS_END = WS_ST + 128ull * ST_PER_BC * 2;
constexpr int L_QI = 0, L_KI = 17408, L_VT = 34816, L_BIG = 71680, L_SM = 141312;
constexpr int SM_CUM = 0, SM_DT = 256, SM_SEG = 512, SM_REF = 1536, SM_CLAST = 1664, SM_RSS = 1792;
constexpr int LDS_BYTES = L_SM + (1792 + 512) * 4;

__device__ __forceinline__ float bf2f(bf16_t v) { return __uint_as_float(((unsigned)v) << 16); }
__device__ __forceinline__ bf16_t f2bf(float f) { unsigned u = __float_as_uint(f); u += 0x7FFFu + ((u >> 16) & 1u); return (bf16_t)(u >> 16); }
__device__ __forceinline__ unsigned pk2(float lo, float hi) { unsigned r; asm("v_cvt_pk_bf16_f32 %0, %1, %2" : "=v"(r) : "v"(lo), "v"(hi)); return r; }
__device__ __forceinline__ int opaque_tid() { int t = threadIdx.x; asm volatile("" : "+v"(t)); return t; }
__device__ __forceinline__ float silu_f(float x) { return x / (1.f + __expf(-x)); }
__device__ __forceinline__ float softplus_f(float x) { return fmaxf(x, 0.f) + __logf(1.f + __expf(-fabsf(x))); }
__device__ __forceinline__ float logsig_f(float x) { return fminf(x, 0.f) - __logf(1.f + __expf(-fabsf(x))); }

namespace pg8 {
constexpr int BM = 256, BK = 64, HALF = 128, HTB = HALF * BK * 2, STAGE_BYTES = 8 * HTB, NXCD = 8, WGM = 8;
__device__ __forceinline__ int lds_byte(int r, int c) { const int st = (r >> 4) * 2 + (c >> 5), rr = r & 15, cc = c & 31, ob = rr * 64 + cc * 2; return st * 1024 + (ob ^ (((ob >> 9) & 1) << 5)); }
__device__ __forceinline__ void stage_rc(int b, int& R, int& C) { const int st = b / 1024, sb = b % 1024, swz = sb ^ (((sb >> 9) & 1) << 5); R = (st >> 1) * 16 + swz / 64; C = (st & 1) * 32 + (swz % 64) / 2; }
__device__ __forceinline__ int perm32(int rho) { const int n = rho >> 4, i = rho & 15; return 8 * (i >> 2) + 4 * n + (i & 3); }
struct Unit { int pm, pn; };
struct Gemm { const bf16_t* A; const bf16_t* Bt; int M, N, K; };
struct StaticOrder {
    int nM, nN, nwg, G, c;
    __device__ void init(int M, int N, int G_, int c_) { nM = M / BM; nN = N / BM; nwg = nM * nN; G = G_; c = c_; }
    __device__ bool next(int i, Unit& u) const {
        const long L = (long)i * G + c; if (L >= nwg) return false;
        int wgid = (int)L; { const int q = nwg / NXCD, r = nwg % NXCD, xcd = wgid % NXCD, off = wgid / NXCD; wgid = (xcd < r ? xcd * (q + 1) : r * (q + 1) + (xcd - r) * q) + off; }
        const int nig = WGM * nN, gid = wgid / nig, fm = gid * WGM, gsz = (nM - fm) < WGM ? (nM - fm) : WGM;
        u.pm = fm + ((wgid % nig) % gsz); u.pn = (wgid % nig) / gsz; return true;
    }
};
struct EpiProj {
    static constexpr bool PERM = true;
    bf16_t* O; int ldc;
    __device__ __forceinline__ void operator()(const f32x4 (&acc)[2][2][4][2], const Unit& u, int wr, int wc, int fr, int fq) const {
        const int row0 = u.pm * BM + wr * 64 + fr, col0 = u.pn * BM + wc * 32 + 8 * fq;
#pragma unroll
        for (int ai = 0; ai < 2; ++ai)
#pragma unroll
            for (int m = 0; m < 4; ++m) { bf16_t* rowp = O + (size_t)(row0 + ai * HALF + m * 16) * ldc + col0;
#pragma unroll
                for (int bj = 0; bj < 2; ++bj) { const f32x4 v0 = acc[ai][bj][m][0], v1 = acc[ai][bj][m][1];
                    u32x4 w; w.x = pk2(v0[0], v0[1]); w.y = pk2(v0[2], v0[3]); w.z = pk2(v1[0], v1[1]); w.w = pk2(v1[2], v1[3]);
                    *(u32x4*)(rowp + bj * HALF) = w; } }
    }
};
struct EpiRes {
    static constexpr bool PERM = false;
    const float* xin; float* xout; const float* gate;
    __device__ __forceinline__ void operator()(const f32x4 (&acc)[2][2][4][2], const Unit& u, int wr, int wc, int fr, int fq) const {
        const int row0 = u.pm * BM + wr * 64 + fr, col0 = u.pn * BM + wc * 32 + 4 * fq;
        const float* gp = gate + (size_t)(u.pm >> 4) * 3072 + col0;
        f32x4 gv[2][2];
#pragma unroll
        for (int bj = 0; bj < 2; ++bj)
#pragma unroll
            for (int n = 0; n < 2; ++n) gv[bj][n] = *(const f32x4*)(gp + bj * HALF + n * 16);
#pragma unroll
        for (int ai = 0; ai < 2; ++ai)
#pragma unroll
            for (int m = 0; m < 4; ++m) { const size_t ro = (size_t)(row0 + ai * HALF + m * 16) * DM + col0;
#pragma unroll
                for (int bj = 0; bj < 2; ++bj)
#pragma unroll
                    for (int n = 0; n < 2; ++n) { const f32x4 xi = *(const f32x4*)(xin + ro + bj * HALF + n * 16);
                        *(f32x4*)(xout + ro + bj * HALF + n * 16) = xi + gv[bj][n] * acc[ai][bj][m][n]; } }
    }
};

template <class Epi, class Sched>
__device__ __forceinline__ void gemm_phase(LAS unsigned char* lds, const Gemm g, const Sched& S, const Epi& E) {
    const int tid = opaque_tid(), wid = __builtin_amdgcn_readfirstlane(tid >> 6), lane = tid & 63, wr = wid >> 2, wc = wid & 3, fr = lane & 15, fq = lane >> 4;
    const int K = g.K, nt = K / BK;
    unsigned voffA[2], voffB[2];
#pragma unroll
    for (int i = 0; i < 2; ++i) { int R, C; stage_rc(tid * 16 + i * 8192, R, C); const int Rb = Epi::PERM ? ((R & ~31) + perm32(R & 31)) : R;
        voffA[i] = (unsigned)(R * K + C) * 2u; voffB[i] = (unsigned)(Rb * K + C) * 2u; }
    const size_t kstep = (size_t)(BK * 2);
    const size_t hstep = (size_t)HALF * K * 2;
    const size_t tstep = 2 * hstep;
    const unsigned ldsw = (unsigned)wid * 1024u;
    const int aoff = lds_byte(wr * 64 + fr, fq * 8), boff = lds_byte(wc * 32 + fr, fq * 8);
#define PG8_SA(b, h) (((b) * 2 + (h)) * HTB)
#define PG8_SB(b, h) ((4 + (b) * 2 + (h)) * HTB)
#define PG8_STAGE(bufoff, gbase, voff) do { _Pragma("unroll") for (int _i = 0; _i < 2; ++_i) \
        __builtin_amdgcn_global_load_lds((const unsigned*)((const char*)(gbase) + (voff)[_i]), (LAS unsigned*)(lds + (bufoff) + ldsw + _i * 8192), 16, 0, 0); } while (0)
#define PG8_LDA(dst, b, h) do { _Pragma("unroll") for (int m = 0; m < 4; ++m) _Pragma("unroll") for (int k = 0; k < 2; ++k) dst[m][k] = *(const LAS bf16x8*)(lds + PG8_SA(b, h) + aoff + m * 2048 + k * 1024); } while (0)
#define PG8_LDB(dst, b, h) do { _Pragma("unroll") for (int n = 0; n < 2; ++n) _Pragma("unroll") for (int k = 0; k < 2; ++k) dst[n][k] = *(const LAS bf16x8*)(lds + PG8_SB(b, h) + boff + n * 2048 + k * 1024); } while (0)
#define PG8_MMA(ai, bj, At, Bt) do { __builtin_amdgcn_s_setprio(1); _Pragma("unroll") for (int m = 0; m < 4; ++m) _Pragma("unroll") for (int n = 0; n < 2; ++n) _Pragma("unroll") for (int k = 0; k < 2; ++k) \
        acc[ai][bj][m][n] = __builtin_amdgcn_mfma_f32_16x16x32_bf16(Bt[n][k], At[m][k], acc[ai][bj][m][n], 0, 0, 0); __builtin_amdgcn_s_setprio(0); } while (0)
#define PG8_WAIT_V(n) asm volatile("s_waitcnt vmcnt(" #n ")" ::: "memory")
#define PG8_WAIT_L(n) asm volatile("s_waitcnt lgkmcnt(" #n ")" ::: "memory")
#define PG8_BAR __builtin_amdgcn_s_barrier()
#define PG8_SCHED __builtin_amdgcn_sched_barrier(0)
    Unit cur, nxt; int ui = 0;
    if (!S.next(0, cur)) return;
    f32x4 acc[2][2][4][2];
#pragma unroll
    for (int a = 0; a < 2; ++a)
#pragma unroll
        for (int b = 0; b < 2; ++b)
#pragma unroll
            for (int m = 0; m < 4; ++m)
#pragma unroll
                for (int n = 0; n < 2; ++n) acc[a][b][m][n] = (f32x4){0.f, 0.f, 0.f, 0.f};
    bf16x8 At[4][2], B0[2][2], B1[2][2];
    const char* cA = (const char*)g.A + (size_t)cur.pm * tstep; const char* cB = (const char*)g.Bt + (size_t)cur.pn * tstep;
    PG8_STAGE(PG8_SB(0, 0), cB, voffB); PG8_STAGE(PG8_SA(0, 0), cA, voffA); PG8_STAGE(PG8_SB(0, 1), cB + hstep, voffB); PG8_STAGE(PG8_SA(0, 1), cA + hstep, voffA);
    if (wr == 1) PG8_BAR;
    PG8_WAIT_V(4); PG8_BAR;
    PG8_STAGE(PG8_SB(1, 0), cB + kstep, voffB); PG8_STAGE(PG8_SA(1, 0), cA + kstep, voffA); PG8_STAGE(PG8_SB(1, 1), cB + hstep + kstep, voffB);
    PG8_WAIT_V(6); PG8_BAR;
    for (;;) {
        const bool has_next = S.next(ui + 1, nxt);
        const char* nA = has_next ? (const char*)g.A + (size_t)nxt.pm * tstep : cA; const char* nB = has_next ? (const char*)g.Bt + (size_t)nxt.pn * tstep : cB;
        for (int t = 0; t < nt; t += 2) {
            const bool last = (t == nt - 2);
            const char* a1 = cA + (size_t)(t + 1) * kstep;
            const char* a2 = last ? nA : cA + (size_t)(t + 2) * kstep; const char* b2 = last ? nB : cB + (size_t)(t + 2) * kstep;
            const char* a3 = a2 + kstep; const char* b3 = b2 + kstep;
            PG8_LDB(B0, 0, 0); PG8_SCHED; PG8_LDA(At, 0, 0); PG8_STAGE(PG8_SA(1, 1), a1 + hstep, voffA);
            PG8_WAIT_L(8); PG8_BAR; PG8_WAIT_L(0); PG8_MMA(0, 0, At, B0); PG8_BAR; PG8_SCHED;
            PG8_LDB(B1, 0, 1); PG8_STAGE(PG8_SB(0, 0), b2, voffB);
            PG8_BAR; PG8_WAIT_L(0); PG8_MMA(0, 1, At, B1); PG8_BAR;
            PG8_LDA(At, 0, 1); PG8_STAGE(PG8_SA(0, 0), a2, voffA);
            PG8_BAR; PG8_WAIT_L(0); PG8_MMA(1, 0, At, B0); PG8_BAR; PG8_SCHED;
            PG8_STAGE(PG8_SB(0, 1), b2 + hstep, voffB);
            PG8_WAIT_V(6); PG8_BAR; PG8_MMA(1, 1, At, B1); PG8_BAR;
            PG8_LDB(B0, 1, 0); PG8_SCHED; PG8_LDA(At, 1, 0); PG8_STAGE(PG8_SA(0, 1), a2 + hstep, voffA);
            PG8_WAIT_L(8); PG8_BAR; PG8_WAIT_L(0); PG8_MMA(0, 0, At, B0); PG8_BAR; PG8_SCHED;
            PG8_LDB(B1, 1, 1); PG8_STAGE(PG8_SB(1, 0), b3, voffB);
            PG8_BAR; PG8_WAIT_L(0); PG8_MMA(0, 1, At, B1); PG8_BAR;
            PG8_LDA(At, 1, 1); PG8_STAGE(PG8_SA(1, 0), a3, voffA);
            PG8_BAR; PG8_WAIT_L(0); PG8_MMA(1, 0, At, B0); PG8_BAR; PG8_SCHED;
            PG8_STAGE(PG8_SB(1, 1), b3 + hstep, voffB);
            PG8_WAIT_V(6); PG8_BAR; PG8_MMA(1, 1, At, B1); PG8_BAR;
        }
        E(acc, cur, wr, wc, fr, fq);
        if (!has_next) break;
#pragma unroll
        for (int a = 0; a < 2; ++a)
#pragma unroll
            for (int b = 0; b < 2; ++b)
#pragma unroll
                for (int m = 0; m < 4; ++m)
#pragma unroll
                    for (int n = 0; n < 2; ++n) acc[a][b][m][n] = (f32x4){0.f, 0.f, 0.f, 0.f};
        cur = nxt; cA = nA; cB = nB; ++ui;
    }
    PG8_WAIT_V(0);
    if (wr == 0) PG8_BAR;
    PG8_BAR;
#undef PG8_SA
#undef PG8_SB
#undef PG8_STAGE
#undef PG8_LDA
#undef PG8_LDB
#undef PG8_MMA
#undef PG8_WAIT_V
#undef PG8_WAIT_L
#undef PG8_BAR
#undef PG8_SCHED
}
}

struct Args {
    const float* x; const float* c; const float* w_ada; const float* b_ada; const float* norm_g; const float* w_in;
    const float* lb_logits; const float* hgrn_g; const float* ret_g; const float* conv_w; const float* conv_b;
    const float* dt_bias; const float* a_log; const float* dskip; const float* ssm_g; const float* w_gk2; const float* b_gk2;
    const float* gla_g; const float* w_out; const float* final_g;
    float* out; unsigned char* ws;
};

__device__ __forceinline__ void transpose_cvt(const float* __restrict__ src, int K, int N, bf16_t* __restrict__ dst, int Npad, LAS unsigned char* lds, int gid, int gstride) {
    LAS float* T = (LAS float*)lds;
    const int tid = opaque_tid(), ntk = K / 64, ntn = Npad / 64;
    for (int tile = gid; tile < ntk * ntn; tile += gstride) {
        const int tk = tile % ntk, tn = tile / ntk;
#pragma unroll
        for (int i = 0; i < 8; ++i) { const int kk = (tid >> 6) + 8 * i, nn = tid & 63, n = tn * 64 + nn;
            T[kk * 65 + nn] = (n < N) ? src[(size_t)(tk * 64 + kk) * N + n] : 0.f; }
        __syncthreads();
#pragma unroll
        for (int i = 0; i < 4; ++i) { const int nn = (tid >> 5) + 16 * i, kk = (tid & 31) * 2;
            *(unsigned*)(dst + (size_t)(tn * 64 + nn) * K + tk * 64 + kk) = pk2(T[kk * 65 + nn], T[(kk + 1) * 65 + nn]); }
        __syncthreads();
    }
}

__device__ __forceinline__ void phase_prep(const Args& a, LAS unsigned char* lds) {
    const int tid = opaque_tid(), G = gridDim.x, bid = blockIdx.x;
    unsigned char* ws = a.ws;
    for (int l = 0; l < DEPTH; ++l) {
        transpose_cvt(a.w_in + (size_t)l * DM * NIN, DM, NIN, (bf16_t*)(ws + WS_WIN) + (size_t)l * LDP * DM, LDP, lds, bid, G);
        transpose_cvt(a.w_out + (size_t)l * DI * DM, DI, DM, (bf16_t*)(ws + WS_WOUT) + (size_t)l * DM * DI, DM, lds, (bid + 128) % G, G);
    }
    {
        LAS float* R = (LAS float*)lds;
        float* mod = (float*)(ws + WS_MOD);
        const int jj = tid & 63, ks = tid >> 6;
        for (int item = bid; item < DEPTH * 48; item += G) {
            const int l = item / 48, j = (item % 48) * 64 + jj;
            float s0 = 0.f, s1 = 0.f, s2 = 0.f, s3 = 0.f;
            const float* w = a.w_ada + (size_t)l * DM * 3072 + j;
            for (int k = ks * 128; k < ks * 128 + 128; ++k) { const float wv = w[(size_t)k * 3072];
                s0 += silu_f(a.c[k]) * wv; s1 += silu_f(a.c[DM + k]) * wv; s2 += silu_f(a.c[2 * DM + k]) * wv; s3 += silu_f(a.c[3 * DM + k]) * wv; }
            R[(ks * 4 + 0) * 64 + jj] = s0; R[(ks * 4 + 1) * 64 + jj] = s1; R[(ks * 4 + 2) * 64 + jj] = s2; R[(ks * 4 + 3) * 64 + jj] = s3;
            __syncthreads();
            if (tid < 256) { const int b = tid >> 6; float s = a.b_ada[l * 3072 + j];
#pragma unroll
                for (int q = 0; q < 8; ++q) s += R[(q * 4 + b) * 64 + jj];
                mod[(size_t)(l * 4 + b) * 3072 + j] = s; }
            __syncthreads();
        }
    }
    {
        float2* rope = (float2*)(ws + WS_ROPE);
        for (int i = bid * NTHR + tid; i < 4096 * 64; i += G * NTHR) {
            const int pos = i >> 6, j = i & 63;
            const float invf = powf(10000.f, -(float)(2 * j) / 128.f);
            const float ang = (float)pos * invf;
            const float k = rintf(ang * 0.15915494309189535f);
            float r = fmaf(-k, 6.2831854820251465f, ang); r = fmaf(-k, -1.7484555e-07f, r);
            rope[i] = make_float2(__cosf(r), __sinf(r));
        }
    }
}

__device__ __forceinline__ void phase_norm(const float* __restrict__ xin  , const float* __restrict__ g, const float* __restrict__ mod  ,
                                           int half, bf16_t* __restrict__ hout) {
    const int tid = opaque_tid(), lane = tid & 63, wid = tid >> 6;
    const int gw = blockIdx.x * 8 + wid, nw = gridDim.x * 8;
    for (int row = gw; row < HROWS; row += nw) {
        const float* xr = xin + (size_t)row * DM;
        f32x4 v[4]; float ss = 0.f;
#pragma unroll
        for (int i = 0; i < 4; ++i) { v[i] = *(const f32x4*)(xr + i * 256 + lane * 4); ss += v[i][0] * v[i][0] + v[i][1] * v[i][1] + v[i][2] * v[i][2] + v[i][3] * v[i][3]; }
#pragma unroll
        for (int o = 32; o > 0; o >>= 1) ss += __shfl_xor(ss, o);
        const float rinv = rsqrtf(ss * (1.f / DM) + EPS);
        const float* mb = mod + (size_t)(half * 2 + (row >> 12)) * 3072;
#pragma unroll
        for (int i = 0; i < 4; ++i) { const int col = i * 256 + lane * 4;
            const f32x4 gg = *(const f32x4*)(g + col), sh = *(const f32x4*)(mb + col), sc = *(const f32x4*)(mb + 1024 + col);
            float o0 = v[i][0] * rinv * gg[0] * (1.f + sc[0]) + sh[0], o1 = v[i][1] * rinv * gg[1] * (1.f + sc[1]) + sh[1];
            float o2 = v[i][2] * rinv * gg[2] * (1.f + sc[2]) + sh[2], o3 = v[i][3] * rinv * gg[3] * (1.f + sc[3]) + sh[3];
            u32x2 w; w.x = pk2(o0, o1); w.y = pk2(o2, o3);
            *(u32x2*)(hout + (size_t)row * DM + col) = w; }
    }
}
__device__ __forceinline__ void phase_final(float* __restrict__ xio  , const float* __restrict__ g) {
    const int tid = opaque_tid(), lane = tid & 63, wid = tid >> 6;
    const int gw = blockIdx.x * 8 + wid, nw = gridDim.x * 8;
    for (int row = gw; row < HROWS; row += nw) {
        float* xr = xio + (size_t)row * DM;
        f32x4 v[4]; float ss = 0.f;
#pragma unroll
        for (int i = 0; i < 4; ++i) { v[i] = *(const f32x4*)(xr + i * 256 + lane * 4); ss += v[i][0] * v[i][0] + v[i][1] * v[i][1] + v[i][2] * v[i][2] + v[i][3] * v[i][3]; }
#pragma unroll
        for (int o = 32; o > 0; o >>= 1) ss += __shfl_xor(ss, o);
        const float rinv = rsqrtf(ss * (1.f / DM) + EPS);
#pragma unroll
        for (int i = 0; i < 4; ++i) { const int col = i * 256 + lane * 4; const f32x4 gg = *(const f32x4*)(g + col);
            *(f32x4*)(xr + col) = v[i] * rinv * gg; }
    }
}

struct MixP {
    const bf16_t* proj; bf16_t* st; float* dec; bf16_t* y; const float2* rope;
    const float* lbl; const float* hgrn_g; const float* ret_g; const float* conv_w; const float* conv_b; const float* dt_bias; const float* a_log;
    const float* dskip; const float* ssm_g; const float* w2; const float* b2; const float* gla_g; int layer;
};

__device__ __forceinline__ bf16x8 frag(LAS unsigned char* lds, int off, int ld, int r0, int ks, int lane) {
    return *(const LAS bf16x8*)(lds + off + (((r0 + (lane & 31)) * ld + 16 * ks + 8 * (lane >> 5)) << 1));
}
__device__ __forceinline__ int rowmap(int r, int lane) { return (r & 3) + 8 * (r >> 2) + 4 * (lane >> 5); }

__device__ __forceinline__ void conv16(const MixP& p, const bf16_t* P, int chunk, int chan, int seg, float (&out)[16]) {
    const float w0 = p.conv_w[chan], w1 = p.conv_w[1024 + chan], w2 = p.conv_w[2048 + chan], w3 = p.conv_w[3072 + chan], cb = p.conv_b[chan];
    float u[19];
#pragma unroll
    for (int k = 0; k < 19; ++k) { const int tt = seg * 16 - 3 + k; const bool valid = (chunk > 0) || (tt >= 0);
        u[k] = valid ? bf2f(P[(ptrdiff_t)tt * LDP + C_XBC + chan]) : 0.f; }
#pragma unroll
    for (int i = 0; i < 16; ++i) out[i] = silu_f(cb + w0 * u[i] + w1 * u[i + 1] + w2 * u[i + 2] + w3 * u[i + 3]);
}
__device__ __forceinline__ void store16(LAS unsigned char* lds, int byteoff, const float (&v)[16]) {
    u32x4 a, b; a.x = pk2(v[0], v[1]); a.y = pk2(v[2], v[3]); a.z = pk2(v[4], v[5]); a.w = pk2(v[6], v[7]);
    b.x = pk2(v[8], v[9]); b.y = pk2(v[10], v[11]); b.z = pk2(v[12], v[13]); b.w = pk2(v[14], v[15]);
    *(LAS u32x4*)(lds + byteoff) = a; *(LAS u32x4*)(lds + byteoff + 16) = b;
}
__device__ __forceinline__ void store8(LAS unsigned char* lds, int byteoff, const float (&v)[8]) {
    u32x4 a; a.x = pk2(v[0], v[1]); a.y = pk2(v[2], v[3]); a.z = pk2(v[4], v[5]); a.w = pk2(v[6], v[7]);
    *(LAS u32x4*)(lds + byteoff) = a;
}

template <int BR, int PASS>
__device__ __forceinline__ void mixer_unit(const MixP& p, LAS unsigned char* lds, int bc, int hu  ) {
    constexpr int DK = (BR == 3) ? 64 : 128, LDK = DK + 8, NH = (BR == 2) ? 4 : 1, DV = (BR == 2) ? 256 : 128, NT = DV / 128;
    constexpr bool VEC = (BR == 0 || BR == 3);
    const int tid = opaque_tid(), lane = tid & 63, wid = __builtin_amdgcn_readfirstlane(tid >> 6);
    const int chunk = bc & 63;
    const bf16_t* P = p.proj + (size_t)bc * 64 * LDP;
    LAS float* SM = (LAS float*)(lds + L_SM);
    LAS bf16_t* QI = (LAS bf16_t*)(lds + L_QI); LAS bf16_t* KI = (LAS bf16_t*)(lds + L_KI); LAS bf16_t* VT = (LAS bf16_t*)(lds + L_VT);
    const int st_off = (BR == 0) ? hu * 16384 : (BR == 1) ? 65536 + hu * 16384 : (BR == 2) ? 131072 + hu * 32768 : 196608 + hu * 8192;
    bf16_t* stg = p.st + (size_t)bc * ST_PER_BC + st_off;

    if constexpr (BR == 0) {
        const int d = tid & 127, seg = tid >> 7, cc = hu * 128 + d;
        float lb = 0.f;
        if (p.layer == 1) lb = 1.f / (1.f + __expf(p.lbl[cc] - p.lbl[512 + cc]));
        const bf16_t* pr = P + (size_t)(seg * 16) * LDP;
        float cs[16], kk[16]; float run = 0.f;
#pragma unroll
        for (int i = 0; i < 16; ++i) { const float av = fmaxf(bf2f(pr[(size_t)i * LDP + C_AF + cc]), -60.f); const float e = __expf(-av), sg = 1.f / (1.f + e);
            const float f = lb + (1.f - lb) * sg; run += __logf(f); cs[i] = run; kk[i] = (1.f - lb) * e * sg; }
        SM[SM_SEG + seg * 128 + d] = run;
        __syncthreads();
        const float t0 = SM[SM_SEG + d], t1 = SM[SM_SEG + 128 + d], t2 = SM[SM_SEG + 256 + d], t3 = SM[SM_SEG + 384 + d];
        const float off = (seg == 0) ? 0.f : (seg == 1) ? t0 : (seg == 2) ? t0 + t1 : t0 + t1 + t2;
        const float ref = t0 + t1, clast = ref + t2 + t3;
        if (seg == 0) { SM[SM_REF + d] = ref; SM[SM_CLAST + d] = clast; }
        float kv[16];
#pragma unroll
        for (int i = 0; i < 16; ++i) { const float c = off + cs[i]; kv[i] = kk[i] * __expf(ref - c);
            if constexpr (PASS == 3) { KI[(seg * 16 + i) * LDK + d] = f2bf(kv[i]);
                const float q = bf2f(pr[(size_t)i * LDP + C_AQ + cc]); QI[(seg * 16 + i) * LDK + d] = f2bf(silu_f(q) * __expf(c - ref)); } }
        if constexpr (PASS == 1) store16(lds, L_BIG + (d * 72 + seg * 16) * 2, kv);
        bf16_t vv[16];
#pragma unroll
        for (int i = 0; i < 16; ++i) vv[i] = pr[(size_t)i * LDP + C_AI + cc];
        u32x4 a, b; a.x = vv[0] | (vv[1] << 16); a.y = vv[2] | (vv[3] << 16); a.z = vv[4] | (vv[5] << 16); a.w = vv[6] | (vv[7] << 16);
        b.x = vv[8] | (vv[9] << 16); b.y = vv[10] | (vv[11] << 16); b.z = vv[12] | (vv[13] << 16); b.w = vv[14] | (vv[15] << 16);
        *(LAS u32x4*)(lds + L_VT + (d * 72 + seg * 16) * 2) = a; *(LAS u32x4*)(lds + L_VT + (d * 72 + seg * 16) * 2 + 16) = b;
    }
    if constexpr (BR == 1) {
        const int j = tid & 63, seg = tid >> 6;
        const float lg = log1pf(-exp2f(-(5.f + (float)hu)));
        float k1[8], k2[8];
#pragma unroll
        for (int i = 0; i < 8; ++i) { const int t = seg * 8 + i; const float2 cssn = p.rope[(chunk * 64 + t) * 64 + j];
            const bf16_t* pr = P + (size_t)t * LDP + hu * 128 + j;
            const float ka = bf2f(pr[C_RK]) * 0.08838834764831845f, kb = bf2f(pr[C_RK + 64]) * 0.08838834764831845f;
            k1[i] = ka * cssn.x - kb * cssn.y; k2[i] = ka * cssn.y + kb * cssn.x;
            if constexpr (PASS == 3) { const float qa = bf2f(pr[C_RQ]), qb = bf2f(pr[C_RQ + 64]);
                QI[t * LDK + j] = f2bf(qa * cssn.x - qb * cssn.y); QI[t * LDK + j + 64] = f2bf(qa * cssn.y + qb * cssn.x);
                KI[t * LDK + j] = f2bf(k1[i]); KI[t * LDK + j + 64] = f2bf(k2[i]); } }
        if constexpr (PASS == 1) { store8(lds, L_BIG + (j * 72 + seg * 8) * 2, k1); store8(lds, L_BIG + ((j + 64) * 72 + seg * 8) * 2, k2); }
        if (tid < 64) { SM[SM_CUM + tid] = (float)(tid + 1) * lg; SM[SM_DT + tid] = 1.f; }
        const int v = tid & 127, s4 = tid >> 7; float vv[16];
#pragma unroll
        for (int i = 0; i < 16; ++i) { const int s = s4 * 16 + i; float x = bf2f(P[(size_t)s * LDP + C_RV + hu * 128 + v]);
            if constexpr (PASS == 1) x *= __expf((float)(63 - s) * lg);
            vv[i] = x; }
        store16(lds, L_VT + (v * 72 + s4 * 16) * 2, vv);
    }
    if constexpr (BR == 2) {
        if (tid < 64) {
#pragma unroll
            for (int hh = 0; hh < 4; ++hh) { const int head = hu * 4 + hh;
                const float dt = softplus_f(bf2f(P[(size_t)tid * LDP + C_DT + head]) + p.dt_bias[head]);
                float la = -dt * __expf(p.a_log[head]);
#pragma unroll
                for (int o = 1; o < 64; o <<= 1) { const float yv = __shfl_up(la, o); if (tid >= o) la += yv; }
                SM[SM_CUM + hh * 64 + tid] = la; SM[SM_DT + hh * 64 + tid] = dt; }
        }
        { const int n = tid & 127, seg = tid >> 7; float o[16];
          conv16(p, P, chunk, 512 + hu * 128 + n, seg, o);
          if constexpr (PASS == 3) {
#pragma unroll
              for (int i = 0; i < 16; ++i) KI[(seg * 16 + i) * LDK + n] = f2bf(o[i]);
              conv16(p, P, chunk, 768 + hu * 128 + n, seg, o);
#pragma unroll
              for (int i = 0; i < 16; ++i) QI[(seg * 16 + i) * LDK + n] = f2bf(o[i]);
          } else store16(lds, L_BIG + (n * 72 + seg * 16) * 2, o);
        }
        if constexpr (PASS == 1) __syncthreads();
        { const int v = tid & 255, s2 = tid >> 8, hh = v >> 6;
#pragma unroll
          for (int r = 0; r < 2; ++r) { const int seg = s2 * 2 + r; float o[16];
              conv16(p, P, chunk, hu * 256 + v, seg, o);
              if constexpr (PASS == 1) { const float cl = SM[SM_CUM + hh * 64 + 63];
#pragma unroll
                  for (int i = 0; i < 16; ++i) { const int s = seg * 16 + i; o[i] *= __expf(cl - SM[SM_CUM + hh * 64 + s]) * SM[SM_DT + hh * 64 + s]; } }
              store16(lds, L_VT + (v * 72 + seg * 16) * 2, o); }
        }
    }
    if constexpr (BR == 3) {
        const int d = tid & 63, seg = tid >> 6, cc = hu * 64 + d;
        float w2r[16];
#pragma unroll
        for (int r = 0; r < 16; ++r) w2r[r] = p.w2[r * 256 + cc];
        const float bb = p.b2[cc];
        float cs[8]; float run = 0.f;
#pragma unroll
        for (int i = 0; i < 8; ++i) { const int t = seg * 8 + i; const bf16x8* lp = (const bf16x8*)(P + (size_t)t * LDP + C_LR);
            const bf16x8 l0 = lp[0], l1 = lp[1]; float gk = bb;
#pragma unroll
            for (int r = 0; r < 8; ++r) { gk += w2r[r] * bf2f((bf16_t)l0[r]); gk += w2r[8 + r] * bf2f((bf16_t)l1[r]); }
            run += logsig_f(gk) * (1.f / 16.f); cs[i] = run; }
        SM[SM_SEG + seg * 64 + d] = run;
        __syncthreads();
        float off = 0.f, ref = 0.f, clast = 0.f;
#pragma unroll
        for (int s = 0; s < 8; ++s) { const float tv = SM[SM_SEG + s * 64 + d]; if (s < seg) off += tv; if (s < 4) ref += tv; clast += tv; }
        if (seg == 0) { SM[SM_REF + d] = ref; SM[SM_CLAST + d] = clast; }
        float kv[8];
#pragma unroll
        for (int i = 0; i < 8; ++i) { const int t = seg * 8 + i; const float c = off + cs[i];
            kv[i] = bf2f(P[(size_t)t * LDP + C_GK + cc]) * __expf(ref - c);
            if constexpr (PASS == 3) { KI[t * LDK + d] = f2bf(kv[i]); QI[t * LDK + d] = f2bf(bf2f(P[(size_t)t * LDP + C_GQ + cc]) * 0.125f * __expf(c - ref)); } }
        if constexpr (PASS == 1) store8(lds, L_BIG + (d * 72 + seg * 8) * 2, kv);
        const int v = tid & 127, s4 = tid >> 7; bf16_t vv[16];
#pragma unroll
        for (int i = 0; i < 16; ++i) vv[i] = P[(size_t)(s4 * 16 + i) * LDP + C_GV + hu * 128 + v];
        u32x4 a, b; a.x = vv[0] | (vv[1] << 16); a.y = vv[2] | (vv[3] << 16); a.z = vv[4] | (vv[5] << 16); a.w = vv[6] | (vv[7] << 16);
        b.x = vv[8] | (vv[9] << 16); b.y = vv[10] | (vv[11] << 16); b.z = vv[12] | (vv[13] << 16); b.w = vv[14] | (vv[15] << 16);
        *(LAS u32x4*)(lds + L_VT + (v * 72 + s4 * 16) * 2) = a; *(LAS u32x4*)(lds + L_VT + (v * 72 + s4 * 16) * 2 + 16) = b;
    }
    __syncthreads();

    if constexpr (PASS == 1) {
        constexpr int NTN = DV / 32, NTILES = (DK / 32) * NTN;
#pragma unroll
        for (int i = 0; i < NTILES / 8; ++i) {
            const int ti = wid + 8 * i, tm = ti / NTN, tn = ti % NTN;
            f32x16 acc;
#pragma unroll
            for (int r = 0; r < 16; ++r) acc[r] = 0.f;
#pragma unroll
            for (int ks = 0; ks < 4; ++ks) acc = __builtin_amdgcn_mfma_f32_32x32x16_bf16(frag(lds, L_BIG, 72, tm * 32, ks, lane), frag(lds, L_VT, 72, tn * 32, ks, lane), acc, 0, 0, 0);
            const int v = tn * 32 + (lane & 31);
#pragma unroll
            for (int rg = 0; rg < 4; ++rg) { const int d0 = tm * 32 + 8 * rg + 4 * (lane >> 5);
                float o[4];
#pragma unroll
                for (int q = 0; q < 4; ++q) { o[q] = acc[rg * 4 + q]; if constexpr (VEC) o[q] *= __expf(SM[SM_CLAST + d0 + q] - SM[SM_REF + d0 + q]); }
                u32x2 w; w.x = pk2(o[0], o[1]); w.y = pk2(o[2], o[3]);
                *(u32x2*)(stg + (size_t)v * DK + d0) = w; }
        }
        float* dec = p.dec + (size_t)bc * 1024;
        if constexpr (BR == 0) { if (tid < 128) dec[hu * 128 + tid] = __expf(SM[SM_CLAST + tid]); }
        if constexpr (BR == 3) { if (tid < 64) dec[512 + hu * 64 + tid] = __expf(SM[SM_CLAST + tid]); }
        if constexpr (BR == 2) { if (tid < 4) dec[768 + hu * 4 + tid] = __expf(SM[SM_CUM + tid * 64 + 63]); }
        __syncthreads();
    } else {
        {
            constexpr int NVEC = DV * DK / 8, VPR = DK / 8;
            for (int vi = tid; vi < NVEC; vi += NTHR) { const int v = vi / VPR, d0 = (vi % VPR) * 8;
                u32x4 raw = *(const u32x4*)(stg + (size_t)vi * 8);
                if constexpr (VEC) { unsigned w[4] = {raw.x, raw.y, raw.z, raw.w};
#pragma unroll
                    for (int q = 0; q < 4; ++q) { const float lo = __uint_as_float(w[q] << 16) * __expf(SM[SM_REF + d0 + 2 * q]), hi = __uint_as_float(w[q] & 0xffff0000u) * __expf(SM[SM_REF + d0 + 2 * q + 1]);
                        w[q] = pk2(lo, hi); }
                    raw.x = w[0]; raw.y = w[1]; raw.z = w[2]; raw.w = w[3]; }
                *(LAS u32x4*)(lds + L_BIG + (v * LDK + d0) * 2) = raw; }
        }
        __syncthreads();
        const int tm = wid >> 2, tnb = wid & 3;
        f32x16 acc[NT];
#pragma unroll
        for (int nt = 0; nt < NT; ++nt)
#pragma unroll
            for (int r = 0; r < 16; ++r) acc[nt][r] = 0.f;
#pragma unroll
        for (int ks = 0; ks < DK / 16; ++ks) { const bf16x8 af = frag(lds, L_QI, LDK, tm * 32, ks, lane);
#pragma unroll
            for (int nt = 0; nt < NT; ++nt) acc[nt] = __builtin_amdgcn_mfma_f32_32x32x16_bf16(af, frag(lds, L_BIG, LDK, (tnb + 4 * nt) * 32, ks, lane), acc[nt], 0, 0, 0); }
        if constexpr (!VEC) {
#pragma unroll
            for (int nt = 0; nt < NT; ++nt) { const int hh = (NH == 1) ? 0 : ((tnb + 4 * nt) >> 1);
#pragma unroll
                for (int r = 0; r < 16; ++r) acc[nt][r] *= __expf(SM[SM_CUM + hh * 64 + tm * 32 + rowmap(r, lane)]); }
        }
        f32x16 sc;
#pragma unroll
        for (int r = 0; r < 16; ++r) sc[r] = 0.f;
        const int stm = wid >> 1, stn = wid & 1;
        if (wid < 4) {
#pragma unroll
            for (int ks = 0; ks < DK / 16; ++ks) sc = __builtin_amdgcn_mfma_f32_32x32x16_bf16(frag(lds, L_QI, LDK, stm * 32, ks, lane), frag(lds, L_KI, LDK, stn * 32, ks, lane), sc, 0, 0, 0);
        }
        __syncthreads();
        if (wid < 4) {
            const int s = stn * 32 + (lane & 31);
#pragma unroll
            for (int hh = 0; hh < NH; ++hh) {
                float cums = 0.f, dts = 1.f;
                if constexpr (!VEC) { cums = SM[SM_CUM + hh * 64 + s]; dts = SM[SM_DT + hh * 64 + s]; }
#pragma unroll
                for (int r = 0; r < 16; ++r) { const int t = stm * 32 + rowmap(r, lane);
                    float val = sc[r];
                    if constexpr (!VEC) { const float ex = (s <= t) ? SM[SM_CUM + hh * 64 + t] - cums : 0.f; val *= __expf(ex) * dts; }
                    val = (s <= t) ? val : 0.f;
                    *(LAS bf16_t*)(lds + L_BIG + ((hh * 64 + t) * 72 + s) * 2) = f2bf(val); }
            }
        }
        __syncthreads();
#pragma unroll
        for (int nt = 0; nt < NT; ++nt) { const int hh = (NH == 1) ? 0 : ((tnb + 4 * nt) >> 1);
#pragma unroll
            for (int ks = 0; ks < 4; ++ks) acc[nt] = __builtin_amdgcn_mfma_f32_32x32x16_bf16(frag(lds, L_BIG + hh * 9216, 72, tm * 32, ks, lane), frag(lds, L_VT, 72, (tnb + 4 * nt) * 32, ks, lane), acc[nt], 0, 0, 0); }
        constexpr int NCT = DV / 32;
        const int gcol = (BR == 0) ? C_AG + hu * 128 : (BR == 1) ? C_RG + hu * 128 : (BR == 2) ? C_MZ + hu * 256 : C_GG + hu * 128;
        const int ycol = (BR == 0) ? hu * 128 : (BR == 1) ? 512 + hu * 128 : (BR == 2) ? 1024 + hu * 256 : 1536 + hu * 128;
        const float* gain = (BR == 0) ? p.hgrn_g + hu * 128 : (BR == 1) ? p.ret_g + hu * 128 : (BR == 2) ? p.ssm_g + hu * 256 : p.gla_g + hu * 128;
#pragma unroll
        for (int nt = 0; nt < NT; ++nt) { const int ct = tnb + 4 * nt, v = ct * 32 + (lane & 31);
            float dsk = 0.f; if constexpr (BR == 2) dsk = p.dskip[hu * 4 + (ct >> 1)];
#pragma unroll
            for (int r = 0; r < 16; ++r) { const int t = tm * 32 + rowmap(r, lane);
                float val = acc[nt][r];
                if constexpr (BR == 2) { val = (val + dsk * bf2f(VT[v * 72 + t])) * silu_f(bf2f(P[(size_t)t * LDP + gcol + v])); acc[nt][r] = val; }
                float sq = val * val;
#pragma unroll
                for (int o = 16; o > 0; o >>= 1) sq += __shfl_xor(sq, o);
                if ((lane & 31) == 0) SM[SM_RSS + ct * 64 + t] = sq; }
        }
        __syncthreads();
#pragma unroll
        for (int nt = 0; nt < NT; ++nt) { const int ct = tnb + 4 * nt, v = ct * 32 + (lane & 31);
            const float gn = gain[v];
#pragma unroll
            for (int r = 0; r < 16; ++r) { const int t = tm * 32 + rowmap(r, lane);
                float tot = 0.f;
#pragma unroll
                for (int q = 0; q < NCT; ++q) tot += SM[SM_RSS + q * 64 + t];
                float o = acc[nt][r] * rsqrtf(tot * (1.f / DV) + EPS) * gn;
                if constexpr (BR != 2) o *= silu_f(bf2f(P[(size_t)t * LDP + gcol + v]));
                p.y[(size_t)(bc * 64 + t) * DI + ycol + v] = f2bf(o); }
        }
        __syncthreads();
    }
}

template <int PASS>
__device__ __forceinline__ void phase_mixer(const MixP& p, LAS unsigned char* lds) {
#pragma unroll 1
    for (int i = blockIdx.x; i < 128 * 14; i += gridDim.x) {
        const int bc = i / 14, u = i % 14;
        if (u < 4) mixer_unit<0, PASS>(p, lds, bc, u);
        else if (u < 8) mixer_unit<1, PASS>(p, lds, bc, u - 4);
        else if (u < 10) mixer_unit<2, PASS>(p, lds, bc, u - 8);
        else mixer_unit<3, PASS>(p, lds, bc, u - 10);
    }
}

__device__ __forceinline__ void phase_scan(bf16_t* st, const float* dec) {
    const int gt = blockIdx.x * NTHR + opaque_tid();
    constexpr int VPB = ST_PER_BC / 4;
    if (gt >= 2 * VPB) return;
    const int bl = gt / VPB, e0 = (gt % VPB) * 4;
    int mode, didx = 0; float cfac = 0.f;
    if (e0 < 65536) { mode = 0; didx = (e0 >> 14) * 128 + (e0 & 127); }
    else if (e0 < 131072) { mode = 1; const int h = (e0 - 65536) >> 14; cfac = __expf(64.f * log1pf(-exp2f(-(5.f + (float)h)))); }
    else if (e0 < 196608) { mode = 2; const int r = e0 - 131072; didx = 768 + (r >> 15) * 4 + (((r & 32767) >> 7) >> 6); }
    else { mode = 0; const int r = e0 - 196608; didx = 512 + (r >> 13) * 64 + (r & 63); }
    float s0 = 0.f, s1 = 0.f, s2 = 0.f, s3 = 0.f;
    bf16_t* ptr = st + (size_t)bl * 64 * ST_PER_BC + e0;
    const float* dp = dec + (size_t)bl * 64 * 1024 + didx;
#pragma unroll 4
    for (int c = 0; c < 64; ++c) {
        const u32x2 hv = *(const u32x2*)(ptr + (size_t)c * ST_PER_BC);
        float d0, d1, d2, d3;
        if (mode == 0) { const f32x4 dv = *(const f32x4*)(dp + (size_t)c * 1024); d0 = dv[0]; d1 = dv[1]; d2 = dv[2]; d3 = dv[3]; }
        else if (mode == 1) { d0 = d1 = d2 = d3 = cfac; }
        else { d0 = d1 = d2 = d3 = dp[(size_t)c * 1024]; }
        u32x2 w; w.x = pk2(s0, s1); w.y = pk2(s2, s3);
        *(u32x2*)(ptr + (size_t)c * ST_PER_BC) = w;
        s0 = s0 * d0 + __uint_as_float(hv.x << 16); s1 = s1 * d1 + __uint_as_float(hv.x & 0xffff0000u);
        s2 = s2 * d2 + __uint_as_float(hv.y << 16); s3 = s3 * d3 + __uint_as_float(hv.y & 0xffff0000u);
    }
}

__global__ void __launch_bounds__(NTHR, 2) fwd_megakernel(Args a) {
    extern __shared__ __attribute__((aligned(16))) unsigned char shm[];
    LAS unsigned char* lds = (LAS unsigned char*)shm;
    cg::grid_group grid = cg::this_grid();
    unsigned char* ws = a.ws;
    const int G = gridDim.x;

    phase_prep(a, lds);
    grid.sync();

    bf16_t* hbuf = (bf16_t*)(ws + WS_HY); bf16_t* ybuf = (bf16_t*)(ws + WS_HY);
    bf16_t* proj = (bf16_t*)(ws + WS_PROJ); bf16_t* st = (bf16_t*)(ws + WS_ST); float* dec = (float*)(ws + WS_DEC);
    const float* mod = (const float*)(ws + WS_MOD);

#pragma unroll 1
    for (int half = 0; half < 2; ++half) {
        const size_t xoff = (size_t)half * HROWS * DM;
#pragma unroll 1
        for (int l = 0; l < DEPTH; ++l) {
            const float* xin = (l == 0) ? a.x + xoff : a.out + xoff;
            const float* modl = mod + (size_t)l * 4 * 3072;
            phase_norm(xin, a.norm_g + l * DM, modl, half, hbuf);
            grid.sync();
            {
                pg8::Gemm g{hbuf, (const bf16_t*)(ws + WS_WIN) + (size_t)l * LDP * DM, HROWS, LDP, DM};
                pg8::StaticOrder S; S.init(HROWS, LDP, G, (int)blockIdx.x);
                pg8::EpiProj E{proj, LDP};
                pg8::gemm_phase<pg8::EpiProj, pg8::StaticOrder>(lds, g, S, E);
            }
            grid.sync();
            MixP p;
            p.proj = proj; p.st = st; p.dec = dec; p.y = ybuf; p.rope = (const float2*)(ws + WS_ROPE);
            p.lbl = a.lb_logits; p.hgrn_g = a.hgrn_g + l * 512; p.ret_g = a.ret_g + l * 512; p.conv_w = a.conv_w + l * 4096; p.conv_b = a.conv_b + l * 1024;
            p.dt_bias = a.dt_bias + l * 8; p.a_log = a.a_log + l * 8; p.dskip = a.dskip + l * 8; p.ssm_g = a.ssm_g + l * 512;
            p.w2 = a.w_gk2 + l * 16 * 256; p.b2 = a.b_gk2 + l * 256; p.gla_g = a.gla_g + l * 512; p.layer = l;
            phase_mixer<1>(p, lds);
            grid.sync();
            phase_scan(st, dec);
            grid.sync();
            phase_mixer<3>(p, lds);
            grid.sync();
            {
                pg8::Gemm g{ybuf, (const bf16_t*)(ws + WS_WOUT) + (size_t)l * DM * DI, HROWS, DM, DI};
                pg8::StaticOrder S; S.init(HROWS, DM, G, (int)blockIdx.x);
                pg8::EpiRes E{xin, a.out + xoff, modl + (size_t)(half * 2) * 3072 + 2048};
                pg8::gemm_phase<pg8::EpiRes, pg8::StaticOrder>(lds, g, S, E);
            }
            grid.sync();
        }
        phase_final(a.out + xoff, a.final_g);
    }
}

extern "C" void kernel_launch(void* const* d_in, const int* in_sizes, int n_in, void* d_out, int out_size, void* d_ws, size_t ws_size, hipStream_t stream) {
    static int grid = 0;
    if (grid == 0) {
        if (n_in != 20 || ws_size < WS_END) { fprintf(stderr, "kernel_launch: unexpected n_in %d / ws_size %zu (need %zu)\n", n_in, ws_size, (size_t)WS_END); grid = -1; return; }
        int dev = 0, cus = 0, per_cu = 0;
        hipGetDevice(&dev);
        hipDeviceGetAttribute(&cus, hipDeviceAttributeMultiprocessorCount, dev);
        if (hipFuncSetAttribute((const void*)fwd_megakernel, hipFuncAttributeMaxDynamicSharedMemorySize, LDS_BYTES) != hipSuccess) { fprintf(stderr, "kernel_launch: hipFuncSetAttribute failed\n"); grid = -1; return; }
        hipOccupancyMaxActiveBlocksPerMultiprocessor(&per_cu, (const void*)fwd_megakernel, NTHR, LDS_BYTES);
        if (per_cu < 1) { fprintf(stderr, "kernel_launch: occupancy query says %d blocks per CU\n", per_cu); per_cu = 1; }
        (void)hipGetLastError();
        grid = cus * per_cu;
    }
    if (grid < 0) return;
    Args a{};
    const float** f = (const float**)&a;
    for (int i = 0; i < 20; ++i) f[i] = (const float*)d_in[i];
    a.out = (float*)d_out; a.ws = (unsigned char*)d_ws;
    void* args[] = {&a};
    hipError_t e = hipLaunchCooperativeKernel((const void*)fwd_megakernel, dim3(grid), dim3(NTHR), args, LDS_BYTES, stream);
    if (e != hipSuccess) fprintf(stderr, "cooperative launch failed: %s (grid %d)\n", hipGetErrorString(e), grid);
}
```

```cpp
#include <hip/hip_runtime.h>
#include <hip/hip_cooperative_groups.h>
#include <cstdio>
namespace cg = cooperative_groups;

#define LAS __attribute__((address_space(3)))
typedef unsigned short bf16_t;
typedef short bf16x8 __attribute__((ext_vector_type(8)));
typedef float f32x4 __attribute__((ext_vector_type(4)));
typedef float f32x16 __attribute__((ext_vector_type(16)));
typedef unsigned u32x4 __attribute__((ext_vector_type(4)));
typedef unsigned u32x2 __attribute__((ext_vector_type(2)));

#ifndef REP_PREP
#define REP_PREP 1
#endif
#ifndef REP_NORM
#define REP_NORM 1
#endif
#ifndef REP_G1
#define REP_G1 1
#endif
#ifndef REP_M12
#define REP_M12 1
#endif
#ifndef REP_M3
#define REP_M3 1
#endif
#ifndef REP_G2
#define REP_G2 1
#endif
constexpr int NB = 4, SEQ = 4096, DM = 1024, DEPTH = 2, DI = 2048;
constexpr int NIN = 7192, LDP = 7424;
constexpr int HROWS = 8192;
constexpr int NTHR = 512;
constexpr float EPS = 1e-6f;
constexpr int C_AQ = 0, C_AF = 512, C_AI = 1024, C_AG = 1536, C_RQ = 2048, C_RK = 2560, C_RV = 3072, C_RG = 3584,
              C_MZ = 4096, C_XBC = 4608, C_DT = 5632, C_GQ = 5640, C_GK = 5896, C_GV = 6152, C_GG = 6664, C_LR = 7176;
constexpr int ST_PER_BC = 229376;
constexpr size_t WS_WIN = 0;
constexpr size_t WS_WOUT = WS_WIN + 2ull * LDP * DM * 2;
constexpr size_t WS_MOD = WS_WOUT + 2ull * DM * DI * 2;
constexpr size_t WS_ROPE = WS_MOD + 2ull * 4 * 3072 * 4;
constexpr size_t WS_DEC = WS_ROPE + 4096ull * 64 * 8;
constexpr size_t WS_HY = WS_DEC + 128ull * 1024 * 4;
constexpr size_t WS_PROJ = WS_HY + (size_t)HROWS * DI * 2;
constexpr size_t WS_ST = WS_PROJ + (size_t)HROWS * LDP * 2;
constexpr size_t WS_END = WS_ST + 128ull * ST_PER_BC * 2;
constexpr int L_QI = 0, L_KI = 17408, L_VT = 34816, L_BIG = 71680, L_SM = 141312;
constexpr int SM_CUM = 0, SM_DT = 256, SM_SEG = 512, SM_REF = 1536, SM_CLAST = 1664, SM_RSS = 1792;
constexpr int LDS_BYTES = L_SM + (1792 + 512) * 4;

__device__ __forceinline__ float bf2f(bf16_t v) { return __uint_as_float(((unsigned)v) << 16); }
__device__ __forceinline__ bf16_t f2bf(float f) { unsigned u = __float_as_uint(f); u += 0x7FFFu + ((u >> 16) & 1u); return (bf16_t)(u >> 16); }
__device__ __forceinline__ unsigned pk2(float lo, float hi) { unsigned r; asm("v_cvt_pk_bf16_f32 %0, %1, %2" : "=v"(r) : "v"(lo), "v"(hi)); return r; }
__device__ __forceinline__ int opaque_tid() { int t = threadIdx.x; asm volatile("" : "+v"(t)); return t; }
__device__ __forceinline__ float silu_f(float x) { return x / (1.f + __expf(-x)); }
__device__ __forceinline__ float softplus_f(float x) { return fmaxf(x, 0.f) + __logf(1.f + __expf(-fabsf(x))); }
__device__ __forceinline__ float logsig_f(float x) { return fminf(x, 0.f) - __logf(1.f + __expf(-fabsf(x))); }

namespace pg8 {
constexpr int BM = 256, BK = 64, HALF = 128, HTB = HALF * BK * 2, STAGE_BYTES = 8 * HTB, NXCD = 8, WGM = 8;
__device__ __forceinline__ int lds_byte(int r, int c) { const int st = (r >> 4) * 2 + (c >> 5), rr = r & 15, cc = c & 31, ob = rr * 64 + cc * 2; return st * 1024 + (ob ^ (((ob >> 9) & 1) << 5)); }
__device__ __forceinline__ void stage_rc(int b, int& R, int& C) { const int st = b / 1024, sb = b % 1024, swz = sb ^ (((sb >> 9) & 1) << 5); R = (st >> 1) * 16 + swz / 64; C = (st & 1) * 32 + (swz % 64) / 2; }
__device__ __forceinline__ int perm32(int rho) { const int n = rho >> 4, i = rho & 15; return 8 * (i >> 2) + 4 * n + (i & 3); }
struct Unit { int pm, pn; };
struct Gemm { const bf16_t* A; const bf16_t* Bt; int M, N, K; };
struct StaticOrder {
    int nM, nN, nwg, G, c;
    __device__ void init(int M, int N, int G_, int c_) { nM = M / BM; nN = N / BM; nwg = nM * nN; G = G_; c = c_; }
    __device__ bool next(int i, Unit& u) const {
        const long L = (long)i * G + c; if (L >= nwg) return false;
        int wgid = (int)L; { const int q = nwg / NXCD, r = nwg % NXCD, xcd = wgid % NXCD, off = wgid / NXCD; wgid = (xcd < r ? xcd * (q + 1) : r * (q + 1) + (xcd - r) * q) + off; }
        const int nig = WGM * nN, gid = wgid / nig, fm = gid * WGM, gsz = (nM - fm) < WGM ? (nM - fm) : WGM;
        u.pm = fm + ((wgid % nig) % gsz); u.pn = (wgid % nig) / gsz; return true;
    }
};
struct EpiProj {
    static constexpr bool PERM = true;
    bf16_t* O; int ldc;
    __device__ __forceinline__ void operator()(const f32x4 (&acc)[2][2][4][2], const Unit& u, int wr, int wc, int fr, int fq) const {
        const int row0 = u.pm * BM + wr * 64 + fr, col0 = u.pn * BM + wc * 32 + 8 * fq;
#pragma unroll
        for (int ai = 0; ai < 2; ++ai)
#pragma unroll
            for (int m = 0; m < 4; ++m) { bf16_t* rowp = O + (size_t)(row0 + ai * HALF + m * 16) * ldc + col0;
#pragma unroll
                for (int bj = 0; bj < 2; ++bj) { const f32x4 v0 = acc[ai][bj][m][0], v1 = acc[ai][bj][m][1];
                    u32x4 w; w.x = pk2(v0[0], v0[1]); w.y = pk2(v0[2], v0[3]); w.z = pk2(v1[0], v1[1]); w.w = pk2(v1[2], v1[3]);
                    *(u32x4*)(rowp + bj * HALF) = w; } }
    }
};
struct EpiRes {
    static constexpr bool PERM = false;
    const float* xin; float* xout; const float* gate;
    __device__ __forceinline__ void operator()(const f32x4 (&acc)[2][2][4][2], const Unit& u, int wr, int wc, int fr, int fq) const {
        const int row0 = u.pm * BM + wr * 64 + fr, col0 = u.pn * BM + wc * 32 + 4 * fq;
        const float* gp = gate + (size_t)(u.pm >> 4) * 3072 + col0;
        f32x4 gv[2][2];
#pragma unroll
        for (int bj = 0; bj < 2; ++bj)
#pragma unroll
            for (int n = 0; n < 2; ++n) gv[bj][n] = *(const f32x4*)(gp + bj * HALF + n * 16);
#pragma unroll
        for (int am = 0; am < 4; ++am) {
            const int ai = am >> 1, m0 = (am & 1) * 2;
            f32x4 xi[2][2][2];
#pragma unroll
            for (int m = 0; m < 2; ++m)
#pragma unroll
                for (int bj = 0; bj < 2; ++bj)
#pragma unroll
                    for (int n = 0; n < 2; ++n) xi[m][bj][n] = *(const f32x4*)(xin + (size_t)(row0 + ai * HALF + (m0 + m) * 16) * DM + col0 + bj * HALF + n * 16);
            __builtin_amdgcn_sched_barrier(0);
#pragma unroll
            for (int m = 0; m < 2; ++m)
#pragma unroll
                for (int bj = 0; bj < 2; ++bj)
#pragma unroll
                    for (int n = 0; n < 2; ++n) *(f32x4*)(xout + (size_t)(row0 + ai * HALF + (m0 + m) * 16) * DM + col0 + bj * HALF + n * 16) = xi[m][bj][n] + gv[bj][n] * acc[ai][bj][m0 + m][n];
        }
    }
};

template <class Epi, class Sched>
__device__ __forceinline__ void gemm_phase(LAS unsigned char* lds, const Gemm g, const Sched& S, const Epi& E) {
    const int tid = opaque_tid(), wid = __builtin_amdgcn_readfirstlane(tid >> 6), lane = tid & 63, wr = wid >> 2, wc = wid & 3, fr = lane & 15, fq = lane >> 4;
    const int K = g.K, nt = K / BK;
    unsigned voffA[2], voffB[2];
#pragma unroll
    for (int i = 0; i < 2; ++i) { int R, C; stage_rc(tid * 16 + i * 8192, R, C); const int Rb = Epi::PERM ? ((R & ~31) + perm32(R & 31)) : R;
        voffA[i] = (unsigned)(R * K + C) * 2u; voffB[i] = (unsigned)(Rb * K + C) * 2u; }
    const size_t kstep = (size_t)(BK * 2);
    const size_t hstep = (size_t)HALF * K * 2;
    const size_t tstep = 2 * hstep;
    const unsigned ldsw = (unsigned)wid * 1024u;
    const int aoff = lds_byte(wr * 64 + fr, fq * 8), boff = lds_byte(wc * 32 + fr, fq * 8);
#define PG8_SA(b, h) (((b) * 2 + (h)) * HTB)
#define PG8_SB(b, h) ((4 + (b) * 2 + (h)) * HTB)
#define PG8_STAGE(bufoff, gbase, voff) do { _Pragma("unroll") for (int _i = 0; _i < 2; ++_i) \
        __builtin_amdgcn_global_load_lds((const unsigned*)((const char*)(gbase) + (voff)[_i]), (LAS unsigned*)(lds + (bufoff) + ldsw + _i * 8192), 16, 0, 0); } while (0)
#define PG8_LDA(dst, b, h) do { _Pragma("unroll") for (int m = 0; m < 4; ++m) _Pragma("unroll") for (int k = 0; k < 2; ++k) dst[m][k] = *(const LAS bf16x8*)(lds + PG8_SA(b, h) + aoff + m * 2048 + k * 1024); } while (0)
#define PG8_LDB(dst, b, h) do { _Pragma("unroll") for (int n = 0; n < 2; ++n) _Pragma("unroll") for (int k = 0; k < 2; ++k) dst[n][k] = *(const LAS bf16x8*)(lds + PG8_SB(b, h) + boff + n * 2048 + k * 1024); } while (0)
#define PG8_MMA(ai, bj, At, Bt) do { __builtin_amdgcn_s_setprio(1); _Pragma("unroll") for (int m = 0; m < 4; ++m) _Pragma("unroll") for (int n = 0; n < 2; ++n) _Pragma("unroll") for (int k = 0; k < 2; ++k) \
        acc[ai][bj][m][n] = __builtin_amdgcn_mfma_f32_16x16x32_bf16(Bt[n][k], At[m][k], acc[ai][bj][m][n], 0, 0, 0); __builtin_amdgcn_s_setprio(0); } while (0)
#define PG8_WAIT_V(n) asm volatile("s_waitcnt vmcnt(" #n ")" ::: "memory")
#define PG8_WAIT_L(n) asm volatile("s_waitcnt lgkmcnt(" #n ")" ::: "memory")
#define PG8_BAR __builtin_amdgcn_s_barrier()
#define PG8_SCHED __builtin_amdgcn_sched_barrier(0)
    Unit cur, nxt; int ui = 0;
    if (!S.next(0, cur)) return;
    f32x4 acc[2][2][4][2];
#pragma unroll
    for (int a = 0; a < 2; ++a)
#pragma unroll
        for (int b = 0; b < 2; ++b)
#pragma unroll
            for (int m = 0; m < 4; ++m)
#pragma unroll
                for (int n = 0; n < 2; ++n) acc[a][b][m][n] = (f32x4){0.f, 0.f, 0.f, 0.f};
    bf16x8 At[4][2], B0[2][2], B1[2][2];
    const char* cA = (const char*)g.A + (size_t)cur.pm * tstep; const char* cB = (const char*)g.Bt + (size_t)cur.pn * tstep;
    PG8_STAGE(PG8_SB(0, 0), cB, voffB); PG8_STAGE(PG8_SA(0, 0), cA, voffA); PG8_STAGE(PG8_SB(0, 1), cB + hstep, voffB); PG8_STAGE(PG8_SA(0, 1), cA + hstep, voffA);
    if (wr == 1) PG8_BAR;
    PG8_WAIT_V(4); PG8_BAR;
    PG8_STAGE(PG8_SB(1, 0), cB + kstep, voffB); PG8_STAGE(PG8_SA(1, 0), cA + kstep, voffA); PG8_STAGE(PG8_SB(1, 1), cB + hstep + kstep, voffB);
    PG8_WAIT_V(6); PG8_BAR;
    for (;;) {
        const bool has_next = S.next(ui + 1, nxt);
        const char* nA = has_next ? (const char*)g.A + (size_t)nxt.pm * tstep : cA; const char* nB = has_next ? (const char*)g.Bt + (size_t)nxt.pn * tstep : cB;
        for (int t = 0; t < nt; t += 2) {
            const bool last = (t == nt - 2);
            const char* a1 = cA + (size_t)(t + 1) * kstep;
            const char* a2 = last ? nA : cA + (size_t)(t + 2) * kstep; const char* b2 = last ? nB : cB + (size_t)(t + 2) * kstep;
            const char* a3 = a2 + kstep; const char* b3 = b2 + kstep;
            PG8_LDB(B0, 0, 0); PG8_SCHED; PG8_LDA(At, 0, 0); PG8_STAGE(PG8_SA(1, 1), a1 + hstep, voffA);
            PG8_WAIT_L(8); PG8_BAR; PG8_WAIT_L(0); PG8_MMA(0, 0, At, B0); PG8_BAR; PG8_SCHED;
            PG8_LDB(B1, 0, 1); PG8_STAGE(PG8_SB(0, 0), b2, voffB);
            PG8_BAR; PG8_WAIT_L(0); PG8_MMA(0, 1, At, B1); PG8_BAR;
            PG8_LDA(At, 0, 1); PG8_STAGE(PG8_SA(0, 0), a2, voffA);
            PG8_BAR; PG8_WAIT_L(0); PG8_MMA(1, 0, At, B0); PG8_BAR; PG8_SCHED;
            PG8_STAGE(PG8_SB(0, 1), b2 + hstep, voffB);
            PG8_WAIT_V(6); PG8_BAR; PG8_MMA(1, 1, At, B1); PG8_BAR;
            PG8_LDB(B0, 1, 0); PG8_SCHED; PG8_LDA(At, 1, 0); PG8_STAGE(PG8_SA(0, 1), a2 + hstep, voffA);
            PG8_WAIT_L(8); PG8_BAR; PG8_WAIT_L(0); PG8_MMA(0, 0, At, B0); PG8_BAR; PG8_SCHED;
            PG8_LDB(B1, 1, 1); PG8_STAGE(PG8_SB(1, 0), b3, voffB);
            PG8_BAR; PG8_WAIT_L(0); PG8_MMA(0, 1, At, B1); PG8_BAR;
            PG8_LDA(At, 1, 1); PG8_STAGE(PG8_SA(1, 0), a3, voffA);
            PG8_BAR; PG8_WAIT_L(0); PG8_MMA(1, 0, At, B0); PG8_BAR; PG8_SCHED;
            PG8_STAGE(PG8_SB(1, 1), b3 + hstep, voffB);
            PG8_WAIT_V(6); PG8_BAR; PG8_MMA(1, 1, At, B1); PG8_BAR;
        }
        E(acc, cur, wr, wc, fr, fq);
        if (!has_next) break;
#pragma unroll
        for (int a = 0; a < 2; ++a)
#pragma unroll
            for (int b = 0; b < 2; ++b)
#pragma unroll
                for (int m = 0; m < 4; ++m)
#pragma unroll
                    for (int n = 0; n < 2; ++n) acc[a][b][m][n] = (f32x4){0.f, 0.f, 0.f, 0.f};
        cur = nxt; cA = nA; cB = nB; ++ui;
    }
    PG8_WAIT_V(0);
    if (wr == 0) PG8_BAR;
    PG8_BAR;
#undef PG8_SA
#undef PG8_SB
#undef PG8_STAGE
#undef PG8_LDA
#undef PG8_LDB
#undef PG8_MMA
#undef PG8_WAIT_V
#undef PG8_WAIT_L
#undef PG8_BAR
#undef PG8_SCHED
}
}

struct Args {
    const float* x; const float* c; const float* w_ada; const float* b_ada; const float* norm_g; const float* w_in;
    const float* lb_logits; const float* hgrn_g; const float* ret_g; const float* conv_w; const float* conv_b;
    const float* dt_bias; const float* a_log; const float* dskip; const float* ssm_g; const float* w_gk2; const float* b_gk2;
    const float* gla_g; const float* w_out; const float* final_g;
    float* out; unsigned char* ws;
};

__device__ __forceinline__ void transpose_cvt(const float* __restrict__ src, int K, int N, bf16_t* __restrict__ dst, int Npad, LAS unsigned char* lds, int gid, int gstride) {
    LAS float* T = (LAS float*)lds;
    const int tid = opaque_tid(), ntk = K / 64, ntn = Npad / 64;
    for (int tile = gid; tile < ntk * ntn; tile += gstride) {
        const int tk = tile % ntk, tn = tile / ntk;
#pragma unroll
        for (int i = 0; i < 8; ++i) { const int kk = (tid >> 6) + 8 * i, nn = tid & 63, n = tn * 64 + nn;
            T[kk * 65 + nn] = (n < N) ? src[(size_t)(tk * 64 + kk) * N + n] : 0.f; }
        __syncthreads();
#pragma unroll
        for (int i = 0; i < 4; ++i) { const int nn = (tid >> 5) + 16 * i, kk = (tid & 31) * 2;
            *(unsigned*)(dst + (size_t)(tn * 64 + nn) * K + tk * 64 + kk) = pk2(T[kk * 65 + nn], T[(kk + 1) * 65 + nn]); }
        __syncthreads();
    }
}

__device__ __forceinline__ void phase_prep(const Args& a, LAS unsigned char* lds) {
    const int tid = opaque_tid(), G = gridDim.x, bid = blockIdx.x;
    unsigned char* ws = a.ws;
    for (int l = 0; l < DEPTH; ++l) {
        transpose_cvt(a.w_in + (size_t)l * DM * NIN, DM, NIN, (bf16_t*)(ws + WS_WIN) + (size_t)l * LDP * DM, LDP, lds, bid, G);
        transpose_cvt(a.w_out + (size_t)l * DI * DM, DI, DM, (bf16_t*)(ws + WS_WOUT) + (size_t)l * DM * DI, DM, lds, (bid + 128) % G, G);
    }
    {
        LAS float* R = (LAS float*)lds;
        float* mod = (float*)(ws + WS_MOD);
        const int jj = tid & 63, ks = tid >> 6;
        for (int item = bid; item < DEPTH * 48; item += G) {
            const int l = item / 48, j = (item % 48) * 64 + jj;
            float s0 = 0.f, s1 = 0.f, s2 = 0.f, s3 = 0.f;
            const float* w = a.w_ada + (size_t)l * DM * 3072 + j;
            for (int k = ks * 128; k < ks * 128 + 128; ++k) { const float wv = w[(size_t)k * 3072];
                s0 += silu_f(a.c[k]) * wv; s1 += silu_f(a.c[DM + k]) * wv; s2 += silu_f(a.c[2 * DM + k]) * wv; s3 += silu_f(a.c[3 * DM + k]) * wv; }
            R[(ks * 4 + 0) * 64 + jj] = s0; R[(ks * 4 + 1) * 64 + jj] = s1; R[(ks * 4 + 2) * 64 + jj] = s2; R[(ks * 4 + 3) * 64 + jj] = s3;
            __syncthreads();
            if (tid < 256) { const int b = tid >> 6; float s = a.b_ada[l * 3072 + j];
#pragma unroll
                for (int q = 0; q < 8; ++q) s += R[(q * 4 + b) * 64 + jj];
                mod[(size_t)(l * 4 + b) * 3072 + j] = s; }
            __syncthreads();
        }
    }
    {
        float2* rope = (float2*)(ws + WS_ROPE);
        for (int i = bid * NTHR + tid; i < 4096 * 64; i += G * NTHR) {
            const int pos = i >> 6, j = i & 63;
            const float invf = powf(10000.f, -(float)(2 * j) / 128.f);
            const float ang = (float)pos * invf;
            const float k = rintf(ang * 0.15915494309189535f);
            float r = fmaf(-k, 6.2831854820251465f, ang); r = fmaf(-k, -1.7484555e-07f, r);
            rope[i] = make_float2(__cosf(r), __sinf(r));
        }
    }
}

__device__ __forceinline__ void phase_norm(const float* __restrict__ xin  , const float* __restrict__ g, const float* __restrict__ mod  ,
                                           int half, bf16_t* __restrict__ hout) {
    const int tid = opaque_tid(), lane = tid & 63, wid = tid >> 6;
    const int gw = blockIdx.x * 8 + wid, nw = gridDim.x * 8;
    for (int row = gw; row < HROWS; row += nw) {
        const float* xr = xin + (size_t)row * DM;
        f32x4 v[4]; float ss = 0.f;
#pragma unroll
        for (int i = 0; i < 4; ++i) { v[i] = *(const f32x4*)(xr + i * 256 + lane * 4); ss += v[i][0] * v[i][0] + v[i][1] * v[i][1] + v[i][2] * v[i][2] + v[i][3] * v[i][3]; }
#pragma unroll
        for (int o = 32; o > 0; o >>= 1) ss += __shfl_xor(ss, o);
        const float rinv = rsqrtf(ss * (1.f / DM) + EPS);
        const float* mb = mod + (size_t)(half * 2 + (row >> 12)) * 3072;
#pragma unroll
        for (int i = 0; i < 4; ++i) { const int col = i * 256 + lane * 4;
            const f32x4 gg = *(const f32x4*)(g + col), sh = *(const f32x4*)(mb + col), sc = *(const f32x4*)(mb + 1024 + col);
            float o0 = v[i][0] * rinv * gg[0] * (1.f + sc[0]) + sh[0], o1 = v[i][1] * rinv * gg[1] * (1.f + sc[1]) + sh[1];
            float o2 = v[i][2] * rinv * gg[2] * (1.f + sc[2]) + sh[2], o3 = v[i][3] * rinv * gg[3] * (1.f + sc[3]) + sh[3];
            u32x2 w; w.x = pk2(o0, o1); w.y = pk2(o2, o3);
            *(u32x2*)(hout + (size_t)row * DM + col) = w; }
    }
}
__device__ __forceinline__ void phase_final(float* __restrict__ xio  , const float* __restrict__ g) {
    const int tid = opaque_tid(), lane = tid & 63, wid = tid >> 6;
    const int gw = blockIdx.x * 8 + wid, nw = gridDim.x * 8;
    for (int row = gw; row < HROWS; row += nw) {
        float* xr = xio + (size_t)row * DM;
        f32x4 v[4]; float ss = 0.f;
#pragma unroll
        for (int i = 0; i < 4; ++i) { v[i] = *(const f32x4*)(xr + i * 256 + lane * 4); ss += v[i][0] * v[i][0] + v[i][1] * v[i][1] + v[i][2] * v[i][2] + v[i][3] * v[i][3]; }
#pragma unroll
        for (int o = 32; o > 0; o >>= 1) ss += __shfl_xor(ss, o);
        const float rinv = rsqrtf(ss * (1.f / DM) + EPS);
#pragma unroll
        for (int i = 0; i < 4; ++i) { const int col = i * 256 + lane * 4; const f32x4 gg = *(const f32x4*)(g + col);
            *(f32x4*)(xr + col) = v[i] * rinv * gg; }
    }
}

struct MixP {
    const bf16_t* proj; bf16_t* st; float* dec; bf16_t* y; const float2* rope;
    const float* lbl; const float* hgrn_g; const float* ret_g; const float* conv_w; const float* conv_b; const float* dt_bias; const float* a_log;
    const float* dskip; const float* ssm_g; const float* w2; const float* b2; const float* gla_g; int layer;
};

__device__ __forceinline__ bf16x8 frag(LAS unsigned char* lds, int off, int ld, int r0, int ks, int lane) {
    return *(const LAS bf16x8*)(lds + off + (((r0 + (lane & 31)) * ld + 16 * ks + 8 * (lane >> 5)) << 1));
}
__device__ __forceinline__ int rowmap(int r, int lane) { return (r & 3) + 8 * (r >> 2) + 4 * (lane >> 5); }

__device__ __forceinline__ void conv16_old(const MixP& p, const bf16_t* P, int chunk, int chan, int seg, float (&out)[16]) {
    const float w0 = p.conv_w[chan], w1 = p.conv_w[1024 + chan], w2 = p.conv_w[2048 + chan], w3 = p.conv_w[3072 + chan], cb = p.conv_b[chan];
    float u[19];
#pragma unroll
    for (int k = 0; k < 19; ++k) { const int tt = seg * 16 - 3 + k; const bool valid = (chunk > 0) || (tt >= 0);
        u[k] = valid ? bf2f(P[(ptrdiff_t)tt * LDP + C_XBC + chan]) : 0.f; }
#pragma unroll
    for (int i = 0; i < 16; ++i) out[i] = silu_f(cb + w0 * u[i] + w1 * u[i + 1] + w2 * u[i + 2] + w3 * u[i + 3]);
}
__device__ __forceinline__ void conv16(const MixP& p, LAS unsigned char* lds, int off, int ncols, int col, int chan, int seg, float (&out)[16]) {
    const float w0 = p.conv_w[chan], w1 = p.conv_w[1024 + chan], w2 = p.conv_w[2048 + chan], w3 = p.conv_w[3072 + chan], cb = p.conv_b[chan];
    const LAS bf16_t* rp = (const LAS bf16_t*)(lds + off) + seg * 16 * ncols + col;
    float u[19];
#pragma unroll
    for (int k = 0; k < 19; ++k) u[k] = bf2f(rp[k * ncols]);
#pragma unroll
    for (int i = 0; i < 16; ++i) out[i] = silu_f(cb + w0 * u[i] + w1 * u[i + 1] + w2 * u[i + 2] + w3 * u[i + 3]);
}
template <int NCOLS, int NROWS> struct Stg { static constexpr int VPR = NCOLS / 8, NV = NROWS * VPR, NIT = (NV + NTHR - 1) / NTHR; };
template <int NCOLS, int NROWS>
__device__ __forceinline__ void stg_load(const bf16_t* src, int tid, int zrows, u32x4 (&r)[Stg<NCOLS, NROWS>::NIT]) {
    using S = Stg<NCOLS, NROWS>;
#pragma unroll
    for (int j = 0; j < S::NIT; ++j) { const int vi = tid + NTHR * j, row = vi / S::VPR, cv = vi % S::VPR;
        const bool ok = (vi < S::NV) && (row >= zrows);
        r[j] = ok ? *(const u32x4*)(src + (ptrdiff_t)row * LDP + cv * 8) : (u32x4){0u, 0u, 0u, 0u}; }
}
template <int NCOLS, int NROWS>
__device__ __forceinline__ void stg_store(LAS unsigned char* lds, int off, int tid, const u32x4 (&r)[Stg<NCOLS, NROWS>::NIT]) {
    using S = Stg<NCOLS, NROWS>;
#pragma unroll
    for (int j = 0; j < S::NIT; ++j) { const int vi = tid + NTHR * j; if (vi < S::NV) *(LAS u32x4*)(lds + off + vi * 16) = r[j]; }
}
__device__ __forceinline__ void store16(LAS unsigned char* lds, int byteoff, const float (&v)[16]) {
    u32x4 a, b; a.x = pk2(v[0], v[1]); a.y = pk2(v[2], v[3]); a.z = pk2(v[4], v[5]); a.w = pk2(v[6], v[7]);
    b.x = pk2(v[8], v[9]); b.y = pk2(v[10], v[11]); b.z = pk2(v[12], v[13]); b.w = pk2(v[14], v[15]);
    *(LAS u32x4*)(lds + byteoff) = a; *(LAS u32x4*)(lds + byteoff + 16) = b;
}
__device__ __forceinline__ void store8(LAS unsigned char* lds, int byteoff, const float (&v)[8]) {
    u32x4 a; a.x = pk2(v[0], v[1]); a.y = pk2(v[2], v[3]); a.z = pk2(v[4], v[5]); a.w = pk2(v[6], v[7]);
    *(LAS u32x4*)(lds + byteoff) = a;
}

template <int BR, int PASS>
__device__ __forceinline__ void mixer_unit(const MixP& p, LAS unsigned char* lds, int bc, int hu  ) {
    constexpr int DK = (BR == 3) ? 64 : 128, LDK = DK + 8, NH = (BR == 2) ? 4 : 1, DV = (BR == 2) ? 256 : 128, NT = DV / 128;
    constexpr bool VEC = (BR == 0 || BR == 3);
    const int tid = opaque_tid(), lane = tid & 63, wid = __builtin_amdgcn_readfirstlane(tid >> 6);
    const int chunk = bc & 63;
    const bf16_t* P = p.proj + (size_t)bc * 64 * LDP;
    LAS float* SM = (LAS float*)(lds + L_SM);
    LAS bf16_t* QI = (LAS bf16_t*)(lds + L_QI); LAS bf16_t* KI = (LAS bf16_t*)(lds + L_KI); LAS bf16_t* VT = (LAS bf16_t*)(lds + L_VT);
    const int st_off = (BR == 0) ? hu * 16384 : (BR == 1) ? 65536 + hu * 16384 : (BR == 2) ? 131072 + hu * 32768 : 196608 + hu * 8192;
    bf16_t* stg = p.st + (size_t)bc * ST_PER_BC + st_off;

    if constexpr (BR == 0) {
        constexpr int RQ = L_BIG, RF = (PASS == 3) ? L_BIG + 16384 : L_QI, RV = (PASS == 3) ? L_BIG + 32768 : L_QI + 16384;
        {
            u32x4 rf[2], rv[2], rq[2];
            stg_load<128, 64>(P + C_AF + hu * 128, tid, 0, rf); stg_load<128, 64>(P + C_AI + hu * 128, tid, 0, rv);
            if constexpr (PASS == 3) stg_load<128, 64>(P + C_AQ + hu * 128, tid, 0, rq);
            __builtin_amdgcn_sched_barrier(0);
            stg_store<128, 64>(lds, RF, tid, rf); stg_store<128, 64>(lds, RV, tid, rv);
            if constexpr (PASS == 3) stg_store<128, 64>(lds, RQ, tid, rq);
        }
        const int d = tid & 127, seg = tid >> 7, cc = hu * 128 + d;
        float lb = 0.f;
        if (p.layer == 1) lb = 1.f / (1.f + __expf(p.lbl[cc] - p.lbl[512 + cc]));
        __syncthreads();
        const LAS bf16_t* rF = (const LAS bf16_t*)(lds + RF) + seg * 16 * 128 + d;
        const LAS bf16_t* rQ = (const LAS bf16_t*)(lds + RQ) + seg * 16 * 128 + d;
        const LAS bf16_t* rV = (const LAS bf16_t*)(lds + RV) + seg * 16 * 128 + d;
        float cs[16], kk[16]; float run = 0.f;
#pragma unroll
        for (int i = 0; i < 16; ++i) { const float av = fmaxf(bf2f(rF[i * 128]), -60.f); const float e = __expf(-av), sg = 1.f / (1.f + e);
            const float f = lb + (1.f - lb) * sg; run += __logf(f); cs[i] = run; kk[i] = (1.f - lb) * e * sg; }
        SM[SM_SEG + seg * 128 + d] = run;
        __syncthreads();
        const float t0 = SM[SM_SEG + d], t1 = SM[SM_SEG + 128 + d], t2 = SM[SM_SEG + 256 + d], t3 = SM[SM_SEG + 384 + d];
        const float off = (seg == 0) ? 0.f : (seg == 1) ? t0 : (seg == 2) ? t0 + t1 : t0 + t1 + t2;
        const float ref = t0 + t1, clast = ref + t2 + t3;
        if (seg == 0) { SM[SM_REF + d] = ref; SM[SM_CLAST + d] = clast; }
        float kv[16];
#pragma unroll
        for (int i = 0; i < 16; ++i) { const float c = off + cs[i]; kv[i] = kk[i] * __expf(ref - c);
            if constexpr (PASS == 3) { KI[(seg * 16 + i) * LDK + d] = f2bf(kv[i]);
                const float q = bf2f(rQ[i * 128]); QI[(seg * 16 + i) * LDK + d] = f2bf(silu_f(q) * __expf(c - ref)); } }
        if constexpr (PASS == 1) store16(lds, L_BIG + (d * 72 + seg * 16) * 2, kv);
        unsigned vv[16];
#pragma unroll
        for (int i = 0; i < 16; ++i) vv[i] = rV[i * 128];
        u32x4 a, b; a.x = vv[0] | (vv[1] << 16); a.y = vv[2] | (vv[3] << 16); a.z = vv[4] | (vv[5] << 16); a.w = vv[6] | (vv[7] << 16);
        b.x = vv[8] | (vv[9] << 16); b.y = vv[10] | (vv[11] << 16); b.z = vv[12] | (vv[13] << 16); b.w = vv[14] | (vv[15] << 16);
        *(LAS u32x4*)(lds + L_VT + (d * 72 + seg * 16) * 2) = a; *(LAS u32x4*)(lds + L_VT + (d * 72 + seg * 16) * 2 + 16) = b;
    }
    if constexpr (BR == 1) {
        constexpr int RQ = L_BIG, RK = (PASS == 3) ? L_BIG + 16384 : L_QI, RV = (PASS == 3) ? L_BIG + 32768 : L_QI + 16384;
        const int j = tid & 63, seg = tid >> 6;
        float2 cssn[8];
        {
            u32x4 rk[2], rv[2], rq[2];
            stg_load<128, 64>(P + C_RK + hu * 128, tid, 0, rk); stg_load<128, 64>(P + C_RV + hu * 128, tid, 0, rv);
            if constexpr (PASS == 3) stg_load<128, 64>(P + C_RQ + hu * 128, tid, 0, rq);
#pragma unroll
            for (int i = 0; i < 8; ++i) cssn[i] = p.rope[(chunk * 64 + seg * 8 + i) * 64 + j];
            __builtin_amdgcn_sched_barrier(0);
            stg_store<128, 64>(lds, RK, tid, rk); stg_store<128, 64>(lds, RV, tid, rv);
            if constexpr (PASS == 3) stg_store<128, 64>(lds, RQ, tid, rq);
        }
        const float lg = log1pf(-exp2f(-(5.f + (float)hu)));
        if (tid < 64) { SM[SM_CUM + tid] = (float)(tid + 1) * lg; SM[SM_DT + tid] = 1.f; }
        __syncthreads();
        float k1[8], k2[8];
#pragma unroll
        for (int i = 0; i < 8; ++i) { const int t = seg * 8 + i;
            const LAS bf16_t* rk = (const LAS bf16_t*)(lds + RK) + t * 128 + j;
            const float ka = bf2f(rk[0]) * 0.08838834764831845f, kb = bf2f(rk[64]) * 0.08838834764831845f;
            k1[i] = ka * cssn[i].x - kb * cssn[i].y; k2[i] = ka * cssn[i].y + kb * cssn[i].x;
            if constexpr (PASS == 3) { const LAS bf16_t* rq = (const LAS bf16_t*)(lds + RQ) + t * 128 + j;
                const float qa = bf2f(rq[0]), qb = bf2f(rq[64]);
                QI[t * LDK + j] = f2bf(qa * cssn[i].x - qb * cssn[i].y); QI[t * LDK + j + 64] = f2bf(qa * cssn[i].y + qb * cssn[i].x);
                KI[t * LDK + j] = f2bf(k1[i]); KI[t * LDK + j + 64] = f2bf(k2[i]); } }
        if constexpr (PASS == 1) { store8(lds, L_BIG + (j * 72 + seg * 8) * 2, k1); store8(lds, L_BIG + ((j + 64) * 72 + seg * 8) * 2, k2); }
        const int v = tid & 127, s4 = tid >> 7; float vv[16];
#pragma unroll
        for (int i = 0; i < 16; ++i) { const int s = s4 * 16 + i; float x = bf2f(((const LAS bf16_t*)(lds + RV))[s * 128 + v]);
            if constexpr (PASS == 1) x *= __expf((float)(63 - s) * lg);
            vv[i] = x; }
        store16(lds, L_VT + (v * 72 + s4 * 16) * 2, vv);
    }
    if constexpr (BR == 2 && PASS == 1) {
        if (tid < 64) {
#pragma unroll
            for (int hh = 0; hh < 4; ++hh) { const int head = hu * 4 + hh;
                const float dt = softplus_f(bf2f(P[(size_t)tid * LDP + C_DT + head]) + p.dt_bias[head]);
                float la = -dt * __expf(p.a_log[head]);
#pragma unroll
                for (int o = 1; o < 64; o <<= 1) { const float yv = __shfl_up(la, o); if (tid >= o) la += yv; }
                SM[SM_CUM + hh * 64 + tid] = la; SM[SM_DT + hh * 64 + tid] = dt; }
        }
        { const int n = tid & 127, seg = tid >> 7; float o[16];
          conv16_old(p, P, chunk, 512 + hu * 128 + n, seg, o);
          if constexpr (PASS == 3) {
#pragma unroll
              for (int i = 0; i < 16; ++i) KI[(seg * 16 + i) * LDK + n] = f2bf(o[i]);
              conv16_old(p, P, chunk, 768 + hu * 128 + n, seg, o);
#pragma unroll
              for (int i = 0; i < 16; ++i) QI[(seg * 16 + i) * LDK + n] = f2bf(o[i]);
          } else store16(lds, L_BIG + (n * 72 + seg * 16) * 2, o);
        }
        if constexpr (PASS == 1) __syncthreads();
        { const int v = tid & 255, s2 = tid >> 8, hh = v >> 6;
#pragma unroll
          for (int r = 0; r < 2; ++r) { const int seg = s2 * 2 + r; float o[16];
              conv16_old(p, P, chunk, hu * 256 + v, seg, o);
              if constexpr (PASS == 1) { const float cl = SM[SM_CUM + hh * 64 + 63];
#pragma unroll
                  for (int i = 0; i < 16; ++i) { const int s = seg * 16 + i; o[i] *= __expf(cl - SM[SM_CUM + hh * 64 + s]) * SM[SM_DT + hh * 64 + s]; } }
              store16(lds, L_VT + (v * 72 + seg * 16) * 2, o); }
        }
    }
    if constexpr (BR == 2 && PASS == 3) {
        constexpr int RB = (PASS == 3) ? L_BIG : L_QI, RC = L_BIG + 17152, RX = (PASS == 3) ? L_BIG + 34304 : L_BIG + 18432;
        const int zr = (chunk == 0) ? 3 : 0;
        const bf16_t* P3 = P - 3 * (ptrdiff_t)LDP + C_XBC;
        float dtr[4] = {0.f, 0.f, 0.f, 0.f};
        {
            u32x4 rb[3], rx[5], rc[3];
            stg_load<128, 67>(P3 + 512 + hu * 128, tid, zr, rb); stg_load<256, 67>(P3 + hu * 256, tid, zr, rx);
            if constexpr (PASS == 3) stg_load<128, 67>(P3 + 768 + hu * 128, tid, zr, rc);
            if (tid < 64) {
#pragma unroll
                for (int hh = 0; hh < 4; ++hh) dtr[hh] = bf2f(P[(size_t)tid * LDP + C_DT + hu * 4 + hh]);
            }
            __builtin_amdgcn_sched_barrier(0);
            stg_store<128, 67>(lds, RB, tid, rb); stg_store<256, 67>(lds, RX, tid, rx);
            if constexpr (PASS == 3) stg_store<128, 67>(lds, RC, tid, rc);
        }
        if (tid < 64) {
#pragma unroll
            for (int hh = 0; hh < 4; ++hh) { const int head = hu * 4 + hh;
                const float dt = softplus_f(dtr[hh] + p.dt_bias[head]);
                float la = -dt * __expf(p.a_log[head]);
#pragma unroll
                for (int o = 1; o < 64; o <<= 1) { const float yv = __shfl_up(la, o); if (tid >= o) la += yv; }
                SM[SM_CUM + hh * 64 + tid] = la; SM[SM_DT + hh * 64 + tid] = dt; }
        }
        __syncthreads();
        { const int n = tid & 127, seg = tid >> 7; float o[16];
          conv16(p, lds, RB, 128, n, 512 + hu * 128 + n, seg, o);
          if constexpr (PASS == 3) {
#pragma unroll
              for (int i = 0; i < 16; ++i) KI[(seg * 16 + i) * LDK + n] = f2bf(o[i]);
              conv16(p, lds, RC, 128, n, 768 + hu * 128 + n, seg, o);
#pragma unroll
              for (int i = 0; i < 16; ++i) QI[(seg * 16 + i) * LDK + n] = f2bf(o[i]);
          } else store16(lds, L_BIG + (n * 72 + seg * 16) * 2, o);
        }
        { const int v = tid & 255, s2 = tid >> 8, hh = v >> 6;
#pragma unroll
          for (int r = 0; r < 2; ++r) { const int seg = s2 * 2 + r; float o[16];
              conv16(p, lds, RX, 256, v, hu * 256 + v, seg, o);
              if constexpr (PASS == 1) { const float cl = SM[SM_CUM + hh * 64 + 63];
#pragma unroll
                  for (int i = 0; i < 16; ++i) { const int s = seg * 16 + i; o[i] *= __expf(cl - SM[SM_CUM + hh * 64 + s]) * SM[SM_DT + hh * 64 + s]; } }
              store16(lds, L_VT + (v * 72 + seg * 16) * 2, o); }
        }
    }
    if constexpr (BR == 3) {
        constexpr int RQ = L_BIG, RK = (PASS == 3) ? L_BIG + 8192 : L_QI, RV = (PASS == 3) ? L_BIG + 16384 : L_QI + 8192, RL = (PASS == 3) ? L_BIG + 32768 : L_QI + 24576;
        const int d = tid & 63, seg = tid >> 6, cc = hu * 64 + d;
        float w2r[16];
        {
            u32x4 rk[1], rv[2], rl[1], rq[1];
            stg_load<64, 64>(P + C_GK + hu * 64, tid, 0, rk); stg_load<128, 64>(P + C_GV + hu * 128, tid, 0, rv); stg_load<16, 64>(P + C_LR, tid, 0, rl);
            if constexpr (PASS == 3) stg_load<64, 64>(P + C_GQ + hu * 64, tid, 0, rq);
#pragma unroll
            for (int r = 0; r < 16; ++r) w2r[r] = p.w2[r * 256 + cc];
            __builtin_amdgcn_sched_barrier(0);
            stg_store<64, 64>(lds, RK, tid, rk); stg_store<128, 64>(lds, RV, tid, rv); stg_store<16, 64>(lds, RL, tid, rl);
            if constexpr (PASS == 3) stg_store<64, 64>(lds, RQ, tid, rq);
        }
        const float bb = p.b2[cc];
        __syncthreads();
        float cs[8]; float run = 0.f;
#pragma unroll
        for (int i = 0; i < 8; ++i) { const int t = seg * 8 + i; const LAS bf16x8* lp = (const LAS bf16x8*)(lds + RL + t * 32);
            const bf16x8 l0 = lp[0], l1 = lp[1]; float gk = bb;
#pragma unroll
            for (int r = 0; r < 8; ++r) { gk += w2r[r] * bf2f((bf16_t)l0[r]); gk += w2r[8 + r] * bf2f((bf16_t)l1[r]); }
            run += logsig_f(gk) * (1.f / 16.f); cs[i] = run; }
        SM[SM_SEG + seg * 64 + d] = run;
        __syncthreads();
        float off = 0.f, ref = 0.f, clast = 0.f;
#pragma unroll
        for (int s = 0; s < 8; ++s) { const float tv = SM[SM_SEG + s * 64 + d]; if (s < seg) off += tv; if (s < 4) ref += tv; clast += tv; }
        if (seg == 0) { SM[SM_REF + d] = ref; SM[SM_CLAST + d] = clast; }
        float kv[8];
#pragma unroll
        for (int i = 0; i < 8; ++i) { const int t = seg * 8 + i; const float c = off + cs[i];
            kv[i] = bf2f(((const LAS bf16_t*)(lds + RK))[t * 64 + d]) * __expf(ref - c);
            if constexpr (PASS == 3) { KI[t * LDK + d] = f2bf(kv[i]); QI[t * LDK + d] = f2bf(bf2f(((const LAS bf16_t*)(lds + RQ))[t * 64 + d]) * 0.125f * __expf(c - ref)); } }
        if constexpr (PASS == 1) store8(lds, L_BIG + (d * 72 + seg * 8) * 2, kv);
        const int v = tid & 127, s4 = tid >> 7; unsigned vv[16];
#pragma unroll
        for (int i = 0; i < 16; ++i) vv[i] = ((const LAS bf16_t*)(lds + RV))[(s4 * 16 + i) * 128 + v];
        u32x4 a, b; a.x = vv[0] | (vv[1] << 16); a.y = vv[2] | (vv[3] << 16); a.z = vv[4] | (vv[5] << 16); a.w = vv[6] | (vv[7] << 16);
        b.x = vv[8] | (vv[9] << 16); b.y = vv[10] | (vv[11] << 16); b.z = vv[12] | (vv[13] << 16); b.w = vv[14] | (vv[15] << 16);
        *(LAS u32x4*)(lds + L_VT + (v * 72 + s4 * 16) * 2) = a; *(LAS u32x4*)(lds + L_VT + (v * 72 + s4 * 16) * 2 + 16) = b;
    }
    __syncthreads();

    if constexpr (PASS == 1) {
        constexpr int NTN = DV / 32, NTILES = (DK / 32) * NTN;
#pragma unroll
        for (int i = 0; i < NTILES / 8; ++i) {
            const int ti = wid + 8 * i, tm = ti / NTN, tn = ti % NTN;
            f32x16 acc;
#pragma unroll
            for (int r = 0; r < 16; ++r) acc[r] = 0.f;
#pragma unroll
            for (int ks = 0; ks < 4; ++ks) acc = __builtin_amdgcn_mfma_f32_32x32x16_bf16(frag(lds, L_BIG, 72, tm * 32, ks, lane), frag(lds, L_VT, 72, tn * 32, ks, lane), acc, 0, 0, 0);
            const int v = tn * 32 + (lane & 31);
#pragma unroll
            for (int rg = 0; rg < 4; ++rg) { const int d0 = tm * 32 + 8 * rg + 4 * (lane >> 5);
                float o[4];
#pragma unroll
                for (int q = 0; q < 4; ++q) { o[q] = acc[rg * 4 + q]; if constexpr (VEC) o[q] *= __expf(SM[SM_CLAST + d0 + q] - SM[SM_REF + d0 + q]); }
                u32x2 w; w.x = pk2(o[0], o[1]); w.y = pk2(o[2], o[3]);
                *(u32x2*)(stg + (size_t)v * DK + d0) = w; }
        }
        float* dec = p.dec + (size_t)bc * 1024;
        if constexpr (BR == 0) { if (tid < 128) dec[hu * 128 + tid] = __expf(SM[SM_CLAST + tid]); }
        if constexpr (BR == 3) { if (tid < 64) dec[512 + hu * 64 + tid] = __expf(SM[SM_CLAST + tid]); }
        if constexpr (BR == 2) { if (tid < 4) dec[768 + hu * 4 + tid] = __expf(SM[SM_CUM + tid * 64 + 63]); }
        __syncthreads();
    } else {
        constexpr int NCT = DV / 32;
        const int gcol = (BR == 0) ? C_AG + hu * 128 : (BR == 1) ? C_RG + hu * 128 : (BR == 2) ? C_MZ + hu * 256 : C_GG + hu * 128;
        bf16_t gt[NT][16];
#pragma unroll
        for (int nt = 0; nt < NT; ++nt)
#pragma unroll
            for (int r = 0; r < 16; ++r) gt[nt][r] = P[(size_t)((wid >> 2) * 32 + rowmap(r, lane)) * LDP + gcol + ((wid & 3) + 4 * nt) * 32 + (lane & 31)];
        __builtin_amdgcn_sched_barrier(0);
        {
            constexpr int NVEC = DV * DK / 8, VPR = DK / 8;
            for (int vi = tid; vi < NVEC; vi += NTHR) { const int v = vi / VPR, d0 = (vi % VPR) * 8;
                u32x4 raw = *(const u32x4*)(stg + (size_t)vi * 8);
                if constexpr (VEC) { unsigned w[4] = {raw.x, raw.y, raw.z, raw.w};
#pragma unroll
                    for (int q = 0; q < 4; ++q) { const float lo = __uint_as_float(w[q] << 16) * __expf(SM[SM_REF + d0 + 2 * q]), hi = __uint_as_float(w[q] & 0xffff0000u) * __expf(SM[SM_REF + d0 + 2 * q + 1]);
                        w[q] = pk2(lo, hi); }
                    raw.x = w[0]; raw.y = w[1]; raw.z = w[2]; raw.w = w[3]; }
                *(LAS u32x4*)(lds + L_BIG + (v * LDK + d0) * 2) = raw; }
        }
        __syncthreads();
        const int tm = wid >> 2, tnb = wid & 3;
        f32x16 acc[NT];
#pragma unroll
        for (int nt = 0; nt < NT; ++nt)
#pragma unroll
            for (int r = 0; r < 16; ++r) acc[nt][r] = 0.f;
#pragma unroll
        for (int ks = 0; ks < DK / 16; ++ks) { const bf16x8 af = frag(lds, L_QI, LDK, tm * 32, ks, lane);
#pragma unroll
            for (int nt = 0; nt < NT; ++nt) acc[nt] = __builtin_amdgcn_mfma_f32_32x32x16_bf16(af, frag(lds, L_BIG, LDK, (tnb + 4 * nt) * 32, ks, lane), acc[nt], 0, 0, 0); }
        if constexpr (!VEC) {
#pragma unroll
            for (int nt = 0; nt < NT; ++nt) { const int hh = (NH == 1) ? 0 : ((tnb + 4 * nt) >> 1);
#pragma unroll
                for (int r = 0; r < 16; ++r) acc[nt][r] *= __expf(SM[SM_CUM + hh * 64 + tm * 32 + rowmap(r, lane)]); }
        }
        f32x16 sc;
#pragma unroll
        for (int r = 0; r < 16; ++r) sc[r] = 0.f;
        const int stm = wid >> 1, stn = wid & 1;
        if (wid < 4) {
#pragma unroll
            for (int ks = 0; ks < DK / 16; ++ks) sc = __builtin_amdgcn_mfma_f32_32x32x16_bf16(frag(lds, L_QI, LDK, stm * 32, ks, lane), frag(lds, L_KI, LDK, stn * 32, ks, lane), sc, 0, 0, 0);
        }
        __syncthreads();
        if (wid < 4) {
            const int s = stn * 32 + (lane & 31);
#pragma unroll
            for (int hh = 0; hh < NH; ++hh) {
                float cums = 0.f, dts = 1.f;
                if constexpr (!VEC) { cums = SM[SM_CUM + hh * 64 + s]; dts = SM[SM_DT + hh * 64 + s]; }
#pragma unroll
                for (int r = 0; r < 16; ++r) { const int t = stm * 32 + rowmap(r, lane);
                    float val = sc[r];
                    if constexpr (!VEC) { const float ex = (s <= t) ? SM[SM_CUM + hh * 64 + t] - cums : 0.f; val *= __expf(ex) * dts; }
                    val = (s <= t) ? val : 0.f;
                    *(LAS bf16_t*)(lds + L_BIG + ((hh * 64 + t) * 72 + s) * 2) = f2bf(val); }
            }
        }
        __syncthreads();
#pragma unroll
        for (int nt = 0; nt < NT; ++nt) { const int hh = (NH == 1) ? 0 : ((tnb + 4 * nt) >> 1);
#pragma unroll
            for (int ks = 0; ks < 4; ++ks) acc[nt] = __builtin_amdgcn_mfma_f32_32x32x16_bf16(frag(lds, L_BIG + hh * 9216, 72, tm * 32, ks, lane), frag(lds, L_VT, 72, (tnb + 4 * nt) * 32, ks, lane), acc[nt], 0, 0, 0); }
        const int ycol = (BR == 0) ? hu * 128 : (BR == 1) ? 512 + hu * 128 : (BR == 2) ? 1024 + hu * 256 : 1536 + hu * 128;
        const float* gain = (BR == 0) ? p.hgrn_g + hu * 128 : (BR == 1) ? p.ret_g + hu * 128 : (BR == 2) ? p.ssm_g + hu * 256 : p.gla_g + hu * 128;
#pragma unroll
        for (int nt = 0; nt < NT; ++nt) { const int ct = tnb + 4 * nt, v = ct * 32 + (lane & 31);
            float dsk = 0.f; if constexpr (BR == 2) dsk = p.dskip[hu * 4 + (ct >> 1)];
#pragma unroll
            for (int r = 0; r < 16; ++r) { const int t = tm * 32 + rowmap(r, lane);
                float val = acc[nt][r];
                if constexpr (BR == 2) { val = (val + dsk * bf2f(VT[v * 72 + t])) * silu_f(bf2f(gt[nt][r])); acc[nt][r] = val; }
                float sq = val * val;
#pragma unroll
                for (int o = 16; o > 0; o >>= 1) sq += __shfl_xor(sq, o);
                if ((lane & 31) == 0) SM[SM_RSS + ct * 64 + t] = sq; }
        }
        __syncthreads();
#pragma unroll
        for (int nt = 0; nt < NT; ++nt) { const int ct = tnb + 4 * nt, v = ct * 32 + (lane & 31);
            const float gn = gain[v];
#pragma unroll
            for (int r = 0; r < 16; ++r) { const int t = tm * 32 + rowmap(r, lane);
                float tot = 0.f;
#pragma unroll
                for (int q = 0; q < NCT; ++q) tot += SM[SM_RSS + q * 64 + t];
                float o = acc[nt][r] * rsqrtf(tot * (1.f / DV) + EPS) * gn;
                if constexpr (BR != 2) o *= silu_f(bf2f(gt[nt][r]));
                p.y[(size_t)(bc * 64 + t) * DI + ycol + v] = f2bf(o); }
        }
        __syncthreads();
    }
}

template <int PASS>
__device__ __forceinline__ void phase_mixer(const MixP& p, LAS unsigned char* lds) {
#pragma unroll 1
    for (int i = blockIdx.x; i < 128 * 14; i += gridDim.x) {
        const int bc = i / 14, u = i % 14;
        if (u < 4) mixer_unit<0, PASS>(p, lds, bc, u);
        else if (u < 8) mixer_unit<1, PASS>(p, lds, bc, u - 4);
        else if (u < 10) mixer_unit<2, PASS>(p, lds, bc, u - 8);
        else mixer_unit<3, PASS>(p, lds, bc, u - 10);
    }
}

__device__ __forceinline__ void phase_scan(bf16_t* st, const float* dec) {
    const int gt = blockIdx.x * NTHR + opaque_tid();
    constexpr int VPB = ST_PER_BC / 4;
    if (gt >= 2 * VPB) return;
    const int bl = gt / VPB, e0 = (gt % VPB) * 4;
    int mode, didx = 0; float cfac = 0.f;
    if (e0 < 65536) { mode = 0; didx = (e0 >> 14) * 128 + (e0 & 127); }
    else if (e0 < 131072) { mode = 1; const int h = (e0 - 65536) >> 14; cfac = __expf(64.f * log1pf(-exp2f(-(5.f + (float)h)))); }
    else if (e0 < 196608) { mode = 2; const int r = e0 - 131072; didx = 768 + (r >> 15) * 4 + (((r & 32767) >> 7) >> 6); }
    else { mode = 0; const int r = e0 - 196608; didx = 512 + (r >> 13) * 64 + (r & 63); }
    float s0 = 0.f, s1 = 0.f, s2 = 0.f, s3 = 0.f;
    bf16_t* ptr = st + (size_t)bl * 64 * ST_PER_BC + e0;
    const float* dp = dec + (size_t)bl * 64 * 1024 + didx;
#pragma unroll 4
    for (int c = 0; c < 64; ++c) {
        const u32x2 hv = *(const u32x2*)(ptr + (size_t)c * ST_PER_BC);
        float d0, d1, d2, d3;
        if (mode == 0) { const f32x4 dv = *(const f32x4*)(dp + (size_t)c * 1024); d0 = dv[0]; d1 = dv[1]; d2 = dv[2]; d3 = dv[3]; }
        else if (mode == 1) { d0 = d1 = d2 = d3 = cfac; }
        else { d0 = d1 = d2 = d3 = dp[(size_t)c * 1024]; }
        u32x2 w; w.x = pk2(s0, s1); w.y = pk2(s2, s3);
        *(u32x2*)(ptr + (size_t)c * ST_PER_BC) = w;
        s0 = s0 * d0 + __uint_as_float(hv.x << 16); s1 = s1 * d1 + __uint_as_float(hv.x & 0xffff0000u);
        s2 = s2 * d2 + __uint_as_float(hv.y << 16); s3 = s3 * d3 + __uint_as_float(hv.y & 0xffff0000u);
    }
}

__global__ void __launch_bounds__(NTHR, 2) fwd_megakernel(Args a) {
    extern __shared__ __attribute__((aligned(16))) unsigned char shm[];
    LAS unsigned char* lds = (LAS unsigned char*)shm;
    cg::grid_group grid = cg::this_grid();
    unsigned char* ws = a.ws;
    const int G = gridDim.x;

    for (int rep = 0; rep < REP_PREP; ++rep) { phase_prep(a, lds); grid.sync(); }

    bf16_t* hbuf = (bf16_t*)(ws + WS_HY); bf16_t* ybuf = (bf16_t*)(ws + WS_HY);
    bf16_t* proj = (bf16_t*)(ws + WS_PROJ); bf16_t* st = (bf16_t*)(ws + WS_ST); float* dec = (float*)(ws + WS_DEC);
    const float* mod = (const float*)(ws + WS_MOD);

#pragma unroll 1
    for (int half = 0; half < 2; ++half) {
        const size_t xoff = (size_t)half * HROWS * DM;
#pragma unroll 1
        for (int l = 0; l < DEPTH; ++l) {
            const float* xin = (l == 0) ? a.x + xoff : a.out + xoff;
            const float* modl = mod + (size_t)l * 4 * 3072;
            for (int rep = 0; rep < REP_NORM; ++rep) { phase_norm(xin, a.norm_g + l * DM, modl, half, hbuf); grid.sync(); }
            for (int rep = 0; rep < REP_G1; ++rep) {
                pg8::Gemm g{hbuf, (const bf16_t*)(ws + WS_WIN) + (size_t)l * LDP * DM, HROWS, LDP, DM};
                pg8::StaticOrder S; S.init(HROWS, LDP, G, (int)blockIdx.x);
                pg8::EpiProj E{proj, LDP};
                pg8::gemm_phase<pg8::EpiProj, pg8::StaticOrder>(lds, g, S, E);
                grid.sync();
            }
            MixP p;
            p.proj = proj; p.st = st; p.dec = dec; p.y = ybuf; p.rope = (const float2*)(ws + WS_ROPE);
            p.lbl = a.lb_logits; p.hgrn_g = a.hgrn_g + l * 512; p.ret_g = a.ret_g + l * 512; p.conv_w = a.conv_w + l * 4096; p.conv_b = a.conv_b + l * 1024;
            p.dt_bias = a.dt_bias + l * 8; p.a_log = a.a_log + l * 8; p.dskip = a.dskip + l * 8; p.ssm_g = a.ssm_g + l * 512;
            p.w2 = a.w_gk2 + l * 16 * 256; p.b2 = a.b_gk2 + l * 256; p.gla_g = a.gla_g + l * 512; p.layer = l;
            for (int rep = 0; rep < REP_M12; ++rep) { phase_mixer<1>(p, lds); grid.sync(); phase_scan(st, dec); grid.sync(); }
            for (int rep = 0; rep < REP_M3; ++rep) { phase_mixer<3>(p, lds); grid.sync(); }
            for (int rep = 0; rep < ((l == 0) ? REP_G2 : 1); ++rep) {
                pg8::Gemm g{ybuf, (const bf16_t*)(ws + WS_WOUT) + (size_t)l * DM * DI, HROWS, DM, DI};
                pg8::StaticOrder S; S.init(HROWS, DM, G, (int)blockIdx.x);
                pg8::EpiRes E{xin, a.out + xoff, modl + (size_t)(half * 2) * 3072 + 2048};
                pg8::gemm_phase<pg8::EpiRes, pg8::StaticOrder>(lds, g, S, E);
                grid.sync();
            }
        }
        phase_final(a.out + xoff, a.final_g);
    }
}

extern "C" void kernel_launch(void* const* d_in, const int* in_sizes, int n_in, void* d_out, int out_size, void* d_ws, size_t ws_size, hipStream_t stream) {
    static int grid = 0;
    if (grid == 0) {
        if (n_in != 20 || ws_size < WS_END) { fprintf(stderr, "kernel_launch: unexpected n_in %d / ws_size %zu (need %zu)\n", n_in, ws_size, (size_t)WS_END); grid = -1; return; }
        int dev = 0, cus = 0, per_cu = 0;
        hipGetDevice(&dev);
        hipDeviceGetAttribute(&cus, hipDeviceAttributeMultiprocessorCount, dev);
        if (hipFuncSetAttribute((const void*)fwd_megakernel, hipFuncAttributeMaxDynamicSharedMemorySize, LDS_BYTES) != hipSuccess) { fprintf(stderr, "kernel_launch: hipFuncSetAttribute failed\n"); grid = -1; return; }
        hipOccupancyMaxActiveBlocksPerMultiprocessor(&per_cu, (const void*)fwd_megakernel, NTHR, LDS_BYTES);
        if (per_cu < 1) { fprintf(stderr, "kernel_launch: occupancy query says %d blocks per CU\n", per_cu); per_cu = 1; }
        (void)hipGetLastError();
        grid = cus * per_cu;
    }
    if (grid < 0) return;
    Args a{};
    const float** f = (const float**)&a;
    for (int i = 0; i < 20; ++i) f[i] = (const float*)d_in[i];
    a.out = (float*)d_out; a.ws = (unsigned char*)d_ws;
    void* args[] = {&a};
    hipError_t e = hipLaunchCooperativeKernel((const void*)fwd_megakernel, dim3(grid), dim3(NTHR), args, LDS_BYTES, stream);
    if (e != hipSuccess) fprintf(stderr, "cooperative launch failed: %s (grid %d)\n", hipGetErrorString(e), grid);
}
```

```cpp
#include <hip/hip_runtime.h>
#include <hip/hip_cooperative_groups.h>
#include <cstdio>
namespace cg = cooperative_groups;

#define LAS __attribute__((address_space(3)))
typedef unsigned short bf16_t;
typedef short bf16x8 __attribute__((ext_vector_type(8)));
typedef float f32x4 __attribute__((ext_vector_type(4)));
typedef float f32x16 __attribute__((ext_vector_type(16)));
typedef unsigned u32x4 __attribute__((ext_vector_type(4)));
typedef unsigned u32x2 __attribute__((ext_vector_type(2)));

#ifndef REP_PREP
#define REP_PREP 1
#endif
#ifndef REP_NORM
#define REP_NORM 1
#endif
#ifndef REP_G1
#define REP_G1 1
#endif
#ifndef REP_M12
#define REP_M12 1
#endif
#ifndef REP_M3
#define REP_M3 1
#endif
#ifndef REP_G2
#define REP_G2 1
#endif
constexpr int NB = 4, SEQ = 4096, DM = 1024, DEPTH = 2, DI = 2048;
constexpr int NIN = 7192, LDP = 7424;
constexpr int HROWS = 8192;
constexpr int NTHR = 512;
constexpr float EPS = 1e-6f;
constexpr int C_AQ = 0, C_AF = 512, C_AI = 1024, C_AG = 1536, C_RQ = 2048, C_RK = 2560, C_RV = 3072, C_RG = 3584,
              C_MZ = 4096, C_XBC = 4608, C_DT = 5632, C_GQ = 5640, C_GK = 5896, C_GV = 6152, C_GG = 6664, C_LR = 7176;
constexpr int ST_PER_BC = 229376;
constexpr size_t WS_WIN = 0;
constexpr size_t WS_WOUT = WS_WIN + 2ull * LDP * DM * 2;
constexpr size_t WS_MOD = WS_WOUT + 2ull * DM * DI * 2;
constexpr size_t WS_ROPE = WS_MOD + 2ull * 4 * 3072 * 4;
constexpr size_t WS_DEC = WS_ROPE + 4096ull * 64 * 8;
constexpr size_t WS_HY = WS_DEC + 128ull * 1024 * 4;
constexpr size_t WS_PROJ = WS_HY + (size_t)HROWS * DI * 2;
constexpr size_t WS_ST = WS_PROJ + (size_t)HROWS * LDP * 2;
constexpr size_t WS_END = WS_ST + 128ull * ST_PER_BC * 2;
constexpr int L_QI = 0, L_KI = 17408, L_VT = 34816, L_BIG = 71680, L_SM = 141312;
constexpr int SM_CUM = 0, SM_DT = 256, SM_SEG = 512, SM_REF = 1536, SM_CLAST = 1664, SM_RSS = 1792;
constexpr int LDS_BYTES = L_SM + (1792 + 512) * 4;

__device__ __forceinline__ float bf2f(bf16_t v) { return __uint_as_float(((unsigned)v) << 16); }
__device__ __forceinline__ bf16_t f2bf(float f) { unsigned u = __float_as_uint(f); u += 0x7FFFu + ((u >> 16) & 1u); return (bf16_t)(u >> 16); }
typedef float f32x2_t __attribute__((ext_vector_type(2)));
typedef __bf16 bf16x2_t __attribute__((ext_vector_type(2)));
__device__ __forceinline__ unsigned pk2(float lo, float hi) { f32x2_t v = {lo, hi}; bf16x2_t b = __builtin_convertvector(v, bf16x2_t); return __builtin_bit_cast(unsigned, b); }
__device__ __forceinline__ int opaque_tid() { int t = threadIdx.x; asm volatile("" : "+v"(t)); return t; }
__device__ __forceinline__ float silu_f(float x) { return x * __builtin_amdgcn_rcpf(1.f + __expf(-x)); }
__device__ __forceinline__ float softplus_f(float x) { return fmaxf(x, 0.f) + __logf(1.f + __expf(-fabsf(x))); }
__device__ __forceinline__ float logsig_f(float x) { return fminf(x, 0.f) - __logf(1.f + __expf(-fabsf(x))); }

namespace pg8 {
constexpr int BM = 256, BK = 64, HALF = 128, HTB = HALF * BK * 2, STAGE_BYTES = 8 * HTB, NXCD = 8, WGM = 8;
__device__ __forceinline__ int lds_byte(int r, int c) { const int st = (r >> 4) * 2 + (c >> 5), rr = r & 15, cc = c & 31, ob = rr * 64 + cc * 2; return st * 1024 + (ob ^ (((ob >> 9) & 1) << 5)); }
__device__ __forceinline__ void stage_rc(int b, int& R, int& C) { const int st = b / 1024, sb = b % 1024, swz = sb ^ (((sb >> 9) & 1) << 5); R = (st >> 1) * 16 + swz / 64; C = (st & 1) * 32 + (swz % 64) / 2; }
__device__ __forceinline__ int perm32(int rho) { const int n = rho >> 4, i = rho & 15; return 8 * (i >> 2) + 4 * n + (i & 3); }
struct Unit { int pm, pn; };
struct Gemm { const bf16_t* A; const bf16_t* Bt; int M, N, K; };
struct StaticOrder {
    int nM, nN, nwg, G, c;
    __device__ void init(int M, int N, int G_, int c_) { nM = M / BM; nN = N / BM; nwg = nM * nN; G = G_; c = c_; }
    __device__ bool next(int i, Unit& u) const {
        const long L = (long)i * G + c; if (L >= nwg) return false;
        int wgid = (int)L; { const int q = nwg / NXCD, r = nwg % NXCD, xcd = wgid % NXCD, off = wgid / NXCD; wgid = (xcd < r ? xcd * (q + 1) : r * (q + 1) + (xcd - r) * q) + off; }
        const int nig = WGM * nN, gid = wgid / nig, fm = gid * WGM, gsz = (nM - fm) < WGM ? (nM - fm) : WGM;
        u.pm = fm + ((wgid % nig) % gsz); u.pn = (wgid % nig) / gsz; return true;
    }
};
struct EpiProj {
    static constexpr bool PERM = true;
    bf16_t* O; int ldc;
    __device__ __forceinline__ void operator()(const f32x4 (&acc)[2][2][4][2], const Unit& u, int wr, int wc, int fr, int fq) const {
        const int row0 = u.pm * BM + wr * 64 + fr, col0 = u.pn * BM + wc * 32 + 8 * fq;
#pragma unroll
        for (int ai = 0; ai < 2; ++ai)
#pragma unroll
            for (int m = 0; m < 4; ++m) { bf16_t* rowp = O + (size_t)(row0 + ai * HALF + m * 16) * ldc + col0;
#pragma unroll
                for (int bj = 0; bj < 2; ++bj) { const f32x4 v0 = acc[ai][bj][m][0], v1 = acc[ai][bj][m][1];
                    u32x4 w; w.x = pk2(v0[0], v0[1]); w.y = pk2(v0[2], v0[3]); w.z = pk2(v1[0], v1[1]); w.w = pk2(v1[2], v1[3]);
                    *(u32x4*)(rowp + bj * HALF) = w; } }
    }
};
struct EpiRes {
    static constexpr bool PERM = false;
    const float* xin; float* xout; const float* gate;
    __device__ __forceinline__ void operator()(const f32x4 (&acc)[2][2][4][2], const Unit& u, int wr, int wc, int fr, int fq) const {
        const int row0 = u.pm * BM + wr * 64 + fr, col0 = u.pn * BM + wc * 32 + 4 * fq;
        const float* gp = gate + (size_t)(u.pm >> 4) * 3072 + col0;
        f32x4 gv[2][2];
#pragma unroll
        for (int bj = 0; bj < 2; ++bj)
#pragma unroll
            for (int n = 0; n < 2; ++n) gv[bj][n] = *(const f32x4*)(gp + bj * HALF + n * 16);
#pragma unroll
        for (int am = 0; am < 4; ++am) {
            const int ai = am >> 1, m0 = (am & 1) * 2;
            f32x4 xi[2][2][2];
#pragma unroll
            for (int m = 0; m < 2; ++m)
#pragma unroll
                for (int bj = 0; bj < 2; ++bj)
#pragma unroll
                    for (int n = 0; n < 2; ++n) xi[m][bj][n] = *(const f32x4*)(xin + (size_t)(row0 + ai * HALF + (m0 + m) * 16) * DM + col0 + bj * HALF + n * 16);
            __builtin_amdgcn_sched_barrier(0);
#pragma unroll
            for (int m = 0; m < 2; ++m)
#pragma unroll
                for (int bj = 0; bj < 2; ++bj)
#pragma unroll
                    for (int n = 0; n < 2; ++n) *(f32x4*)(xout + (size_t)(row0 + ai * HALF + (m0 + m) * 16) * DM + col0 + bj * HALF + n * 16) = xi[m][bj][n] + gv[bj][n] * acc[ai][bj][m0 + m][n];
        }
    }
};

template <class Epi, class Sched>
__device__ __forceinline__ void gemm_phase(LAS unsigned char* lds, const Gemm g, const Sched& S, const Epi& E) {
    const int tid = opaque_tid(), wid = __builtin_amdgcn_readfirstlane(tid >> 6), lane = tid & 63, wr = wid >> 2, wc = wid & 3, fr = lane & 15, fq = lane >> 4;
    const int K = g.K, nt = K / BK;
    unsigned voffA[2], voffB[2];
#pragma unroll
    for (int i = 0; i < 2; ++i) { int R, C; stage_rc(tid * 16 + i * 8192, R, C); const int Rb = Epi::PERM ? ((R & ~31) + perm32(R & 31)) : R;
        voffA[i] = (unsigned)(R * K + C) * 2u; voffB[i] = (unsigned)(Rb * K + C) * 2u; }
    const size_t kstep = (size_t)(BK * 2);
    const size_t hstep = (size_t)HALF * K * 2;
    const size_t tstep = 2 * hstep;
    const unsigned ldsw = (unsigned)wid * 1024u;
    const int aoff = lds_byte(wr * 64 + fr, fq * 8), boff = lds_byte(wc * 32 + fr, fq * 8);
#define PG8_SA(b, h) (((b) * 2 + (h)) * HTB)
#define PG8_SB(b, h) ((4 + (b) * 2 + (h)) * HTB)
#define PG8_STAGE(bufoff, gbase, voff) do { _Pragma("unroll") for (int _i = 0; _i < 2; ++_i) \
        __builtin_amdgcn_global_load_lds((const unsigned*)((const char*)(gbase) + (voff)[_i]), (LAS unsigned*)(lds + (bufoff) + ldsw + _i * 8192), 16, 0, 0); } while (0)
#define PG8_LDA(dst, b, h) do { _Pragma("unroll") for (int m = 0; m < 4; ++m) _Pragma("unroll") for (int k = 0; k < 2; ++k) dst[m][k] = *(const LAS bf16x8*)(lds + PG8_SA(b, h) + aoff + m * 2048 + k * 1024); } while (0)
#define PG8_LDB(dst, b, h) do { _Pragma("unroll") for (int n = 0; n < 2; ++n) _Pragma("unroll") for (int k = 0; k < 2; ++k) dst[n][k] = *(const LAS bf16x8*)(lds + PG8_SB(b, h) + boff + n * 2048 + k * 1024); } while (0)
#define PG8_MMA(ai, bj, At, Bt) do { __builtin_amdgcn_s_setprio(1); _Pragma("unroll") for (int m = 0; m < 4; ++m) _Pragma("unroll") for (int n = 0; n < 2; ++n) _Pragma("unroll") for (int k = 0; k < 2; ++k) \
        acc[ai][bj][m][n] = __builtin_amdgcn_mfma_f32_16x16x32_bf16(Bt[n][k], At[m][k], acc[ai][bj][m][n], 0, 0, 0); __builtin_amdgcn_s_setprio(0); } while (0)
#define PG8_WAIT_V(n) asm volatile("s_waitcnt vmcnt(" #n ")" ::: "memory")
#define PG8_WAIT_L(n) asm volatile("s_waitcnt lgkmcnt(" #n ")" ::: "memory")
#define PG8_BAR __builtin_amdgcn_s_barrier()
#define PG8_SCHED __builtin_amdgcn_sched_barrier(0)
    Unit cur, nxt; int ui = 0;
    if (!S.next(0, cur)) return;
    f32x4 acc[2][2][4][2];
#pragma unroll
    for (int a = 0; a < 2; ++a)
#pragma unroll
        for (int b = 0; b < 2; ++b)
#pragma unroll
            for (int m = 0; m < 4; ++m)
#pragma unroll
                for (int n = 0; n < 2; ++n) acc[a][b][m][n] = (f32x4){0.f, 0.f, 0.f, 0.f};
    bf16x8 At[4][2], B0[2][2], B1[2][2];
    const char* cA = (const char*)g.A + (size_t)cur.pm * tstep; const char* cB = (const char*)g.Bt + (size_t)cur.pn * tstep;
    PG8_STAGE(PG8_SB(0, 0), cB, voffB); PG8_STAGE(PG8_SA(0, 0), cA, voffA); PG8_STAGE(PG8_SB(0, 1), cB + hstep, voffB); PG8_STAGE(PG8_SA(0, 1), cA + hstep, voffA);
    if (wr == 1) PG8_BAR;
    PG8_WAIT_V(4); PG8_BAR;
    PG8_STAGE(PG8_SB(1, 0), cB + kstep, voffB); PG8_STAGE(PG8_SA(1, 0), cA + kstep, voffA); PG8_STAGE(PG8_SB(1, 1), cB + hstep + kstep, voffB);
    PG8_WAIT_V(6); PG8_BAR;
    for (;;) {
        const bool has_next = S.next(ui + 1, nxt);
        const char* nA = has_next ? (const char*)g.A + (size_t)nxt.pm * tstep : cA; const char* nB = has_next ? (const char*)g.Bt + (size_t)nxt.pn * tstep : cB;
        for (int t = 0; t < nt; t += 2) {
            const bool last = (t == nt - 2);
            const char* a1 = cA + (size_t)(t + 1) * kstep;
            const char* a2 = last ? nA : cA + (size_t)(t + 2) * kstep; const char* b2 = last ? nB : cB + (size_t)(t + 2) * kstep;
            const char* a3 = a2 + kstep; const char* b3 = b2 + kstep;
            PG8_LDB(B0, 0, 0); PG8_SCHED; PG8_LDA(At, 0, 0); PG8_STAGE(PG8_SA(1, 1), a1 + hstep, voffA);
            PG8_WAIT_L(8); PG8_BAR; PG8_WAIT_L(0); PG8_MMA(0, 0, At, B0); PG8_BAR; PG8_SCHED;
            PG8_LDB(B1, 0, 1); PG8_STAGE(PG8_SB(0, 0), b2, voffB);
            PG8_BAR; PG8_WAIT_L(0); PG8_MMA(0, 1, At, B1); PG8_BAR;
            PG8_LDA(At, 0, 1); PG8_STAGE(PG8_SA(0, 0), a2, voffA);
            PG8_BAR; PG8_WAIT_L(0); PG8_MMA(1, 0, At, B0); PG8_BAR; PG8_SCHED;
            PG8_STAGE(PG8_SB(0, 1), b2 + hstep, voffB);
            PG8_WAIT_V(6); PG8_BAR; PG8_MMA(1, 1, At, B1); PG8_BAR;
            PG8_LDB(B0, 1, 0); PG8_SCHED; PG8_LDA(At, 1, 0); PG8_STAGE(PG8_SA(0, 1), a2 + hstep, voffA);
            PG8_WAIT_L(8); PG8_BAR; PG8_WAIT_L(0); PG8_MMA(0, 0, At, B0); PG8_BAR; PG8_SCHED;
            PG8_LDB(B1, 1, 1); PG8_STAGE(PG8_SB(1, 0), b3, voffB);
            PG8_BAR; PG8_WAIT_L(0); PG8_MMA(0, 1, At, B1); PG8_BAR;
            PG8_LDA(At, 1, 1); PG8_STAGE(PG8_SA(1, 0), a3, voffA);
            PG8_BAR; PG8_WAIT_L(0); PG8_MMA(1, 0, At, B0); PG8_BAR; PG8_SCHED;
            PG8_STAGE(PG8_SB(1, 1), b3 + hstep, voffB);
            PG8_WAIT_V(6); PG8_BAR; PG8_MMA(1, 1, At, B1); PG8_BAR;
        }
        E(acc, cur, wr, wc, fr, fq);
        if (!has_next) break;
#pragma unroll
        for (int a = 0; a < 2; ++a)
#pragma unroll
            for (int b = 0; b < 2; ++b)
#pragma unroll
                for (int m = 0; m < 4; ++m)
#pragma unroll
                    for (int n = 0; n < 2; ++n) acc[a][b][m][n] = (f32x4){0.f, 0.f, 0.f, 0.f};
        cur = nxt; cA = nA; cB = nB; ++ui;
    }
    PG8_WAIT_V(0);
    if (wr == 0) PG8_BAR;
    PG8_BAR;
#undef PG8_SA
#undef PG8_SB
#undef PG8_STAGE
#undef PG8_LDA
#undef PG8_LDB
#undef PG8_MMA
#undef PG8_WAIT_V
#undef PG8_WAIT_L
#undef PG8_BAR
#undef PG8_SCHED
}
}

struct Args {
    const float* x; const float* c; const float* w_ada; const float* b_ada; const float* norm_g; const float* w_in;
    const float* lb_logits; const float* hgrn_g; const float* ret_g; const float* conv_w; const float* conv_b;
    const float* dt_bias; const float* a_log; const float* dskip; const float* ssm_g; const float* w_gk2; const float* b_gk2;
    const float* gla_g; const float* w_out; const float* final_g;
    float* out; unsigned char* ws;
};

__device__ __forceinline__ void transpose_cvt(const float* __restrict__ src, int K, int N, bf16_t* __restrict__ dst, int Npad, LAS unsigned char* lds, int gid, int gstride) {
    LAS float* T = (LAS float*)lds;
    const int tid = opaque_tid(), ntk = K / 64, ntn = Npad / 64;
    for (int tile = gid; tile < ntk * ntn; tile += gstride) {
        const int tk = tile % ntk, tn = tile / ntk;
#pragma unroll
        for (int i = 0; i < 8; ++i) { const int kk = (tid >> 6) + 8 * i, nn = tid & 63, n = tn * 64 + nn;
            T[kk * 65 + nn] = (n < N) ? src[(size_t)(tk * 64 + kk) * N + n] : 0.f; }
        __syncthreads();
#pragma unroll
        for (int i = 0; i < 4; ++i) { const int nn = (tid >> 5) + 16 * i, kk = (tid & 31) * 2;
            *(unsigned*)(dst + (size_t)(tn * 64 + nn) * K + tk * 64 + kk) = pk2(T[kk * 65 + nn], T[(kk + 1) * 65 + nn]); }
        __syncthreads();
    }
}

__device__ __forceinline__ void phase_prep(const Args& a, LAS unsigned char* lds) {
    const int tid = opaque_tid(), G = gridDim.x, bid = blockIdx.x;
    unsigned char* ws = a.ws;
    for (int l = 0; l < DEPTH; ++l) {
        transpose_cvt(a.w_in + (size_t)l * DM * NIN, DM, NIN, (bf16_t*)(ws + WS_WIN) + (size_t)l * LDP * DM, LDP, lds, bid, G);
        transpose_cvt(a.w_out + (size_t)l * DI * DM, DI, DM, (bf16_t*)(ws + WS_WOUT) + (size_t)l * DM * DI, DM, lds, (bid + 128) % G, G);
    }
    {
        LAS float* R = (LAS float*)lds;
        float* mod = (float*)(ws + WS_MOD);
        const int jj = tid & 63, ks = tid >> 6;
        for (int item = bid; item < DEPTH * 48; item += G) {
            const int l = item / 48, j = (item % 48) * 64 + jj;
            float s0 = 0.f, s1 = 0.f, s2 = 0.f, s3 = 0.f;
            const float* w = a.w_ada + (size_t)l * DM * 3072 + j;
            for (int k = ks * 128; k < ks * 128 + 128; ++k) { const float wv = w[(size_t)k * 3072];
                s0 += silu_f(a.c[k]) * wv; s1 += silu_f(a.c[DM + k]) * wv; s2 += silu_f(a.c[2 * DM + k]) * wv; s3 += silu_f(a.c[3 * DM + k]) * wv; }
            R[(ks * 4 + 0) * 64 + jj] = s0; R[(ks * 4 + 1) * 64 + jj] = s1; R[(ks * 4 + 2) * 64 + jj] = s2; R[(ks * 4 + 3) * 64 + jj] = s3;
            __syncthreads();
            if (tid < 256) { const int b = tid >> 6; float s = a.b_ada[l * 3072 + j];
#pragma unroll
                for (int q = 0; q < 8; ++q) s += R[(q * 4 + b) * 64 + jj];
                mod[(size_t)(l * 4 + b) * 3072 + j] = s; }
            __syncthreads();
        }
    }
    {
        float2* rope = (float2*)(ws + WS_ROPE);
        for (int i = bid * NTHR + tid; i < 4096 * 64; i += G * NTHR) {
            const int pos = i >> 6, j = i & 63;
            const float invf = powf(10000.f, -(float)(2 * j) / 128.f);
            const float ang = (float)pos * invf;
            const float k = rintf(ang * 0.15915494309189535f);
            float r = fmaf(-k, 6.2831854820251465f, ang); r = fmaf(-k, -1.7484555e-07f, r);
            rope[i] = make_float2(__cosf(r), __sinf(r));
        }
    }
}

__device__ __forceinline__ void phase_norm(const float* __restrict__ xin  , const float* __restrict__ g, const float* __restrict__ mod  ,
                                           int half, bf16_t* __restrict__ hout) {
    const int tid = opaque_tid(), lane = tid & 63, wid = tid >> 6;
    const int gw = blockIdx.x * 8 + wid, nw = gridDim.x * 8;
    for (int row = gw; row < HROWS; row += nw) {
        const float* xr = xin + (size_t)row * DM;
        f32x4 v[4]; float ss = 0.f;
#pragma unroll
        for (int i = 0; i < 4; ++i) { v[i] = *(const f32x4*)(xr + i * 256 + lane * 4); ss += v[i][0] * v[i][0] + v[i][1] * v[i][1] + v[i][2] * v[i][2] + v[i][3] * v[i][3]; }
#pragma unroll
        for (int o = 32; o > 0; o >>= 1) ss += __shfl_xor(ss, o);
        const float rinv = rsqrtf(ss * (1.f / DM) + EPS);
        const float* mb = mod + (size_t)(half * 2 + (row >> 12)) * 3072;
#pragma unroll
        for (int i = 0; i < 4; ++i) { const int col = i * 256 + lane * 4;
            const f32x4 gg = *(const f32x4*)(g + col), sh = *(const f32x4*)(mb + col), sc = *(const f32x4*)(mb + 1024 + col);
            float o0 = v[i][0] * rinv * gg[0] * (1.f + sc[0]) + sh[0], o1 = v[i][1] * rinv * gg[1] * (1.f + sc[1]) + sh[1];
            float o2 = v[i][2] * rinv * gg[2] * (1.f + sc[2]) + sh[2], o3 = v[i][3] * rinv * gg[3] * (1.f + sc[3]) + sh[3];
            u32x2 w; w.x = pk2(o0, o1); w.y = pk2(o2, o3);
            *(u32x2*)(hout + (size_t)row * DM + col) = w; }
    }
}
__device__ __forceinline__ void phase_final(float* __restrict__ xio  , const float* __restrict__ g) {
    const int tid = opaque_tid(), lane = tid & 63, wid = tid >> 6;
    const int gw = blockIdx.x * 8 + wid, nw = gridDim.x * 8;
    for (int row = gw; row < HROWS; row += nw) {
        float* xr = xio + (size_t)row * DM;
        f32x4 v[4]; float ss = 0.f;
#pragma unroll
        for (int i = 0; i < 4; ++i) { v[i] = *(const f32x4*)(xr + i * 256 + lane * 4); ss += v[i][0] * v[i][0] + v[i][1] * v[i][1] + v[i][2] * v[i][2] + v[i][3] * v[i][3]; }
#pragma unroll
        for (int o = 32; o > 0; o >>= 1) ss += __shfl_xor(ss, o);
        const float rinv = rsqrtf(ss * (1.f / DM) + EPS);
#pragma unroll
        for (int i = 0; i < 4; ++i) { const int col = i * 256 + lane * 4; const f32x4 gg = *(const f32x4*)(g + col);
            *(f32x4*)(xr + col) = v[i] * rinv * gg; }
    }
}

struct MixP {
    const bf16_t* proj; bf16_t* st; float* dec; bf16_t* y; const float2* rope;
    const float* lbl; const float* hgrn_g; const float* ret_g; const float* conv_w; const float* conv_b; const float* dt_bias; const float* a_log;
    const float* dskip; const float* ssm_g; const float* w2; const float* b2; const float* gla_g; int layer;
};

__device__ __forceinline__ bf16x8 frag(LAS unsigned char* lds, int off, int ld, int r0, int ks, int lane) {
    return *(const LAS bf16x8*)(lds + off + (((r0 + (lane & 31)) * ld + 16 * ks + 8 * (lane >> 5)) << 1));
}
__device__ __forceinline__ int rowmap(int r, int lane) { return (r & 3) + 8 * (r >> 2) + 4 * (lane >> 5); }

__device__ __forceinline__ void conv16(const MixP& p, LAS unsigned char* lds, int off, int ncols, int col, int chan, int seg, float (&out)[16]) {
    const float w0 = p.conv_w[chan], w1 = p.conv_w[1024 + chan], w2 = p.conv_w[2048 + chan], w3 = p.conv_w[3072 + chan], cb = p.conv_b[chan];
    const LAS bf16_t* rp = (const LAS bf16_t*)(lds + off) + seg * 16 * ncols + col;
    float u[19];
#pragma unroll
    for (int k = 0; k < 19; ++k) u[k] = bf2f(rp[k * ncols]);
#pragma unroll
    for (int i = 0; i < 16; ++i) out[i] = silu_f(cb + w0 * u[i] + w1 * u[i + 1] + w2 * u[i + 2] + w3 * u[i + 3]);
}
template <int NCOLS, int NROWS> struct Stg { static constexpr int VPR = NCOLS / 8, NV = NROWS * VPR, NIT = (NV + NTHR - 1) / NTHR; };
template <int NCOLS, int NROWS>
__device__ __forceinline__ void stg_load(const bf16_t* src, int tid, int zrows, u32x4 (&r)[Stg<NCOLS, NROWS>::NIT]) {
    using S = Stg<NCOLS, NROWS>;
#pragma unroll
    for (int j = 0; j < S::NIT; ++j) { const int vi = tid + NTHR * j, row = vi / S::VPR, cv = vi % S::VPR;
        const bool ok = (vi < S::NV) && (row >= zrows);
        r[j] = ok ? *(const u32x4*)(src + (ptrdiff_t)row * LDP + cv * 8) : (u32x4){0u, 0u, 0u, 0u}; }
}
template <int NCOLS, int NROWS>
__device__ __forceinline__ void stg_store(LAS unsigned char* lds, int off, int tid, const u32x4 (&r)[Stg<NCOLS, NROWS>::NIT]) {
    using S = Stg<NCOLS, NROWS>;
#pragma unroll
    for (int j = 0; j < S::NIT; ++j) { const int vi = tid + NTHR * j; if (vi < S::NV) *(LAS u32x4*)(lds + off + vi * 16) = r[j]; }
}
__device__ __forceinline__ void store16(LAS unsigned char* lds, int byteoff, const float (&v)[16]) {
    u32x4 a, b; a.x = pk2(v[0], v[1]); a.y = pk2(v[2], v[3]); a.z = pk2(v[4], v[5]); a.w = pk2(v[6], v[7]);
    b.x = pk2(v[8], v[9]); b.y = pk2(v[10], v[11]); b.z = pk2(v[12], v[13]); b.w = pk2(v[14], v[15]);
    *(LAS u32x4*)(lds + byteoff) = a; *(LAS u32x4*)(lds + byteoff + 16) = b;
}
__device__ __forceinline__ void store8(LAS unsigned char* lds, int byteoff, const float (&v)[8]) {
    u32x4 a; a.x = pk2(v[0], v[1]); a.y = pk2(v[2], v[3]); a.z = pk2(v[4], v[5]); a.w = pk2(v[6], v[7]);
    *(LAS u32x4*)(lds + byteoff) = a;
}

template <int BR, int PASS>
__device__ __forceinline__ void mixer_unit(const MixP& p, LAS unsigned char* lds, int bc, int hu  ) {
    constexpr int DK = (BR == 3) ? 64 : 128, LDK = DK + 8, NH = (BR == 2) ? 4 : 1, DV = (BR == 2) ? 256 : 128, NT = DV / 128;
    constexpr bool VEC = (BR == 0 || BR == 3);
    const int tid = opaque_tid(), lane = tid & 63, wid = __builtin_amdgcn_readfirstlane(tid >> 6);
    const int chunk = bc & 63;
    const bf16_t* P = p.proj + (size_t)bc * 64 * LDP;
    LAS float* SM = (LAS float*)(lds + L_SM);
    LAS bf16_t* QI = (LAS bf16_t*)(lds + L_QI); LAS bf16_t* KI = (LAS bf16_t*)(lds + L_KI); LAS bf16_t* VT = (LAS bf16_t*)(lds + L_VT);
    const int st_off = (BR == 0) ? hu * 16384 : (BR == 1) ? 65536 + hu * 16384 : (BR == 2) ? 131072 + hu * 32768 : 196608 + hu * 8192;
    bf16_t* stg = p.st + (size_t)bc * ST_PER_BC + st_off;

    if constexpr (BR == 0) {
        constexpr int RQ = L_BIG, RF = (PASS == 3) ? L_BIG + 16384 : L_QI, RV = (PASS == 3) ? L_BIG + 32768 : L_QI + 16384;
        {
            u32x4 rf[2], rv[2], rq[2];
            stg_load<128, 64>(P + C_AF + hu * 128, tid, 0, rf); stg_load<128, 64>(P + C_AI + hu * 128, tid, 0, rv);
            if constexpr (PASS == 3) stg_load<128, 64>(P + C_AQ + hu * 128, tid, 0, rq);
            __builtin_amdgcn_sched_barrier(0);
            stg_store<128, 64>(lds, RF, tid, rf); stg_store<128, 64>(lds, RV, tid, rv);
            if constexpr (PASS == 3) stg_store<128, 64>(lds, RQ, tid, rq);
        }
        const int d = tid & 127, seg = tid >> 7, cc = hu * 128 + d;
        float lb = 0.f;
        if (p.layer == 1) lb = 1.f / (1.f + __expf(p.lbl[cc] - p.lbl[512 + cc]));
        __syncthreads();
        const LAS bf16_t* rF = (const LAS bf16_t*)(lds + RF) + seg * 16 * 128 + d;
        const LAS bf16_t* rQ = (const LAS bf16_t*)(lds + RQ) + seg * 16 * 128 + d;
        const LAS bf16_t* rV = (const LAS bf16_t*)(lds + RV) + seg * 16 * 128 + d;
        float cs[16], kk[16]; float run = 0.f;
#pragma unroll
        for (int i = 0; i < 16; ++i) { const float av = fmaxf(bf2f(rF[i * 128]), -60.f); const float e = __expf(-av), sg = __builtin_amdgcn_rcpf(1.f + e);
            const float f = lb + (1.f - lb) * sg; run += __logf(f); cs[i] = run; kk[i] = (1.f - lb) * e * sg; }
        SM[SM_SEG + seg * 128 + d] = run;
        __syncthreads();
        const float t0 = SM[SM_SEG + d], t1 = SM[SM_SEG + 128 + d], t2 = SM[SM_SEG + 256 + d], t3 = SM[SM_SEG + 384 + d];
        const float off = (seg == 0) ? 0.f : (seg == 1) ? t0 : (seg == 2) ? t0 + t1 : t0 + t1 + t2;
        const float ref = t0 + t1, clast = ref + t2 + t3;
        if (seg == 0) { SM[SM_REF + d] = ref; SM[SM_CLAST + d] = clast; }
        float kv[16];
#pragma unroll
        for (int i = 0; i < 16; ++i) { const float c = off + cs[i]; kv[i] = kk[i] * __expf(ref - c);
            if constexpr (PASS == 3) { KI[(seg * 16 + i) * LDK + d] = f2bf(kv[i]);
                const float q = bf2f(rQ[i * 128]); QI[(seg * 16 + i) * LDK + d] = f2bf(silu_f(q) * __expf(c - ref)); } }
        if constexpr (PASS == 1) store16(lds, L_BIG + (d * 72 + seg * 16) * 2, kv);
        unsigned vv[16];
#pragma unroll
        for (int i = 0; i < 16; ++i) vv[i] = rV[i * 128];
        u32x4 a, b; a.x = vv[0] | (vv[1] << 16); a.y = vv[2] | (vv[3] << 16); a.z = vv[4] | (vv[5] << 16); a.w = vv[6] | (vv[7] << 16);
        b.x = vv[8] | (vv[9] << 16); b.y = vv[10] | (vv[11] << 16); b.z = vv[12] | (vv[13] << 16); b.w = vv[14] | (vv[15] << 16);
        *(LAS u32x4*)(lds + L_VT + (d * 72 + seg * 16) * 2) = a; *(LAS u32x4*)(lds + L_VT + (d * 72 + seg * 16) * 2 + 16) = b;
    }
    if constexpr (BR == 1) {
        constexpr int RQ = L_BIG, RK = (PASS == 3) ? L_BIG + 16384 : L_QI, RV = (PASS == 3) ? L_BIG + 32768 : L_QI + 16384;
        const int j = tid & 63, seg = tid >> 6;
        float2 cssn[8];
        {
            u32x4 rk[2], rv[2], rq[2];
            stg_load<128, 64>(P + C_RK + hu * 128, tid, 0, rk); stg_load<128, 64>(P + C_RV + hu * 128, tid, 0, rv);
            if constexpr (PASS == 3) stg_load<128, 64>(P + C_RQ + hu * 128, tid, 0, rq);
#pragma unroll
            for (int i = 0; i < 8; ++i) cssn[i] = p.rope[(chunk * 64 + seg * 8 + i) * 64 + j];
            __builtin_amdgcn_sched_barrier(0);
            stg_store<128, 64>(lds, RK, tid, rk); stg_store<128, 64>(lds, RV, tid, rv);
            if constexpr (PASS == 3) stg_store<128, 64>(lds, RQ, tid, rq);
        }
        const float lg = log1pf(-exp2f(-(5.f + (float)hu)));
        if (tid < 64) { SM[SM_CUM + tid] = (float)(tid + 1) * lg; SM[SM_DT + tid] = 1.f; }
        __syncthreads();
        float k1[8], k2[8];
#pragma unroll
        for (int i = 0; i < 8; ++i) { const int t = seg * 8 + i;
            const LAS bf16_t* rk = (const LAS bf16_t*)(lds + RK) + t * 128 + j;
            const float ka = bf2f(rk[0]) * 0.08838834764831845f, kb = bf2f(rk[64]) * 0.08838834764831845f;
            k1[i] = ka * cssn[i].x - kb * cssn[i].y; k2[i] = ka * cssn[i].y + kb * cssn[i].x;
            if constexpr (PASS == 3) { const LAS bf16_t* rq = (const LAS bf16_t*)(lds + RQ) + t * 128 + j;
                const float qa = bf2f(rq[0]), qb = bf2f(rq[64]);
                QI[t * LDK + j] = f2bf(qa * cssn[i].x - qb * cssn[i].y); QI[t * LDK + j + 64] = f2bf(qa * cssn[i].y + qb * cssn[i].x);
                KI[t * LDK + j] = f2bf(k1[i]); KI[t * LDK + j + 64] = f2bf(k2[i]); } }
        if constexpr (PASS == 1) { store8(lds, L_BIG + (j * 72 + seg * 8) * 2, k1); store8(lds, L_BIG + ((j + 64) * 72 + seg * 8) * 2, k2); }
        const int v = tid & 127, s4 = tid >> 7; float vv[16];
#pragma unroll
        for (int i = 0; i < 16; ++i) { const int s = s4 * 16 + i; float x = bf2f(((const LAS bf16_t*)(lds + RV))[s * 128 + v]);
            if constexpr (PASS == 1) x *= __expf((float)(63 - s) * lg);
            vv[i] = x; }
        store16(lds, L_VT + (v * 72 + s4 * 16) * 2, vv);
    }
    if constexpr (BR == 2) {
        constexpr int RB = (PASS == 3) ? L_BIG : L_QI, RC = L_BIG + 17152, RX = (PASS == 3) ? L_BIG + 34304 : L_BIG + 18432;
        const int zr = (chunk == 0) ? 3 : 0;
        const bf16_t* P3 = P - 3 * (ptrdiff_t)LDP + C_XBC;
        float dtr[4] = {0.f, 0.f, 0.f, 0.f};
        {
            u32x4 rb[3], rx[5], rc[3];
            stg_load<128, 67>(P3 + 512 + hu * 128, tid, zr, rb); stg_load<256, 67>(P3 + hu * 256, tid, zr, rx);
            if constexpr (PASS == 3) stg_load<128, 67>(P3 + 768 + hu * 128, tid, zr, rc);
            if (tid < 64) {
#pragma unroll
                for (int hh = 0; hh < 4; ++hh) dtr[hh] = bf2f(P[(size_t)tid * LDP + C_DT + hu * 4 + hh]);
            }
            __builtin_amdgcn_sched_barrier(0);
            stg_store<128, 67>(lds, RB, tid, rb); stg_store<256, 67>(lds, RX, tid, rx);
            if constexpr (PASS == 3) stg_store<128, 67>(lds, RC, tid, rc);
        }
        if (tid < 64) {
#pragma unroll
            for (int hh = 0; hh < 4; ++hh) { const int head = hu * 4 + hh;
                const float dt = softplus_f(dtr[hh] + p.dt_bias[head]);
                float la = -dt * __expf(p.a_log[head]);
#pragma unroll
                for (int o = 1; o < 64; o <<= 1) { const float yv = __shfl_up(la, o); if (tid >= o) la += yv; }
                SM[SM_CUM + hh * 64 + tid] = la; SM[SM_DT + hh * 64 + tid] = dt; }
        }
        __syncthreads();
        { const int n = tid & 127, seg = tid >> 7; float o[16];
          conv16(p, lds, RB, 128, n, 512 + hu * 128 + n, seg, o);
          if constexpr (PASS == 3) {
#pragma unroll
              for (int i = 0; i < 16; ++i) KI[(seg * 16 + i) * LDK + n] = f2bf(o[i]);
              conv16(p, lds, RC, 128, n, 768 + hu * 128 + n, seg, o);
#pragma unroll
              for (int i = 0; i < 16; ++i) QI[(seg * 16 + i) * LDK + n] = f2bf(o[i]);
          } else store16(lds, L_BIG + (n * 72 + seg * 16) * 2, o);
        }
        { const int v = tid & 255, s2 = tid >> 8, hh = v >> 6;
#pragma unroll
          for (int r = 0; r < 2; ++r) { const int seg = s2 * 2 + r; float o[16];
              conv16(p, lds, RX, 256, v, hu * 256 + v, seg, o);
              if constexpr (PASS == 1) { const float cl = SM[SM_CUM + hh * 64 + 63];
#pragma unroll
                  for (int i = 0; i < 16; ++i) { const int s = seg * 16 + i; o[i] *= __expf(cl - SM[SM_CUM + hh * 64 + s]) * SM[SM_DT + hh * 64 + s]; } }
              store16(lds, L_VT + (v * 72 + seg * 16) * 2, o); }
        }
    }
    if constexpr (BR == 3) {
        constexpr int RQ = L_BIG, RK = (PASS == 3) ? L_BIG + 8192 : L_QI, RV = (PASS == 3) ? L_BIG + 16384 : L_QI + 8192, RL = (PASS == 3) ? L_BIG + 32768 : L_QI + 24576;
        const int d = tid & 63, seg = tid >> 6, cc = hu * 64 + d;
        float w2r[16];
        {
            u32x4 rk[1], rv[2], rl[1], rq[1];
            stg_load<64, 64>(P + C_GK + hu * 64, tid, 0, rk); stg_load<128, 64>(P + C_GV + hu * 128, tid, 0, rv); stg_load<16, 64>(P + C_LR, tid, 0, rl);
            if constexpr (PASS == 3) stg_load<64, 64>(P + C_GQ + hu * 64, tid, 0, rq);
#pragma unroll
            for (int r = 0; r < 16; ++r) w2r[r] = p.w2[r * 256 + cc];
            __builtin_amdgcn_sched_barrier(0);
            stg_store<64, 64>(lds, RK, tid, rk); stg_store<128, 64>(lds, RV, tid, rv); stg_store<16, 64>(lds, RL, tid, rl);
            if constexpr (PASS == 3) stg_store<64, 64>(lds, RQ, tid, rq);
        }
        const float bb = p.b2[cc];
        __syncthreads();
        float cs[8]; float run = 0.f;
#pragma unroll
        for (int i = 0; i < 8; ++i) { const int t = seg * 8 + i; const LAS bf16x8* lp = (const LAS bf16x8*)(lds + RL + t * 32);
            const bf16x8 l0 = lp[0], l1 = lp[1]; float gk = bb;
#pragma unroll
            for (int r = 0; r < 8; ++r) { gk += w2r[r] * bf2f((bf16_t)l0[r]); gk += w2r[8 + r] * bf2f((bf16_t)l1[r]); }
            run += logsig_f(gk) * (1.f / 16.f); cs[i] = run; }
        SM[SM_SEG + seg * 64 + d] = run;
        __syncthreads();
        float off = 0.f, ref = 0.f, clast = 0.f;
#pragma unroll
        for (int s = 0; s < 8; ++s) { const float tv = SM[SM_SEG + s * 64 + d]; if (s < seg) off += tv; if (s < 4) ref += tv; clast += tv; }
        if (seg == 0) { SM[SM_REF + d] = ref; SM[SM_CLAST + d] = clast; }
        float kv[8];
#pragma unroll
        for (int i = 0; i < 8; ++i) { const int t = seg * 8 + i; const float c = off + cs[i];
            kv[i] = bf2f(((const LAS bf16_t*)(lds + RK))[t * 64 + d]) * __expf(ref - c);
            if constexpr (PASS == 3) { KI[t * LDK + d] = f2bf(kv[i]); QI[t * LDK + d] = f2bf(bf2f(((const LAS bf16_t*)(lds + RQ))[t * 64 + d]) * 0.125f * __expf(c - ref)); } }
        if constexpr (PASS == 1) store8(lds, L_BIG + (d * 72 + seg * 8) * 2, kv);
        const int v = tid & 127, s4 = tid >> 7; unsigned vv[16];
#pragma unroll
        for (int i = 0; i < 16; ++i) vv[i] = ((const LAS bf16_t*)(lds + RV))[(s4 * 16 + i) * 128 + v];
        u32x4 a, b; a.x = vv[0] | (vv[1] << 16); a.y = vv[2] | (vv[3] << 16); a.z = vv[4] | (vv[5] << 16); a.w = vv[6] | (vv[7] << 16);
        b.x = vv[8] | (vv[9] << 16); b.y = vv[10] | (vv[11] << 16); b.z = vv[12] | (vv[13] << 16); b.w = vv[14] | (vv[15] << 16);
        *(LAS u32x4*)(lds + L_VT + (v * 72 + s4 * 16) * 2) = a; *(LAS u32x4*)(lds + L_VT + (v * 72 + s4 * 16) * 2 + 16) = b;
    }
    __syncthreads();

    if constexpr (PASS == 1) {
        constexpr int NTN = DV / 32, NTILES = (DK / 32) * NTN;
#pragma unroll
        for (int i = 0; i < NTILES / 8; ++i) {
            const int ti = wid + 8 * i, tm = ti / NTN, tn = ti % NTN;
            f32x16 acc;
#pragma unroll
            for (int r = 0; r < 16; ++r) acc[r] = 0.f;
#pragma unroll
            for (int ks = 0; ks < 4; ++ks) acc = __builtin_amdgcn_mfma_f32_32x32x16_bf16(frag(lds, L_BIG, 72, tm * 32, ks, lane), frag(lds, L_VT, 72, tn * 32, ks, lane), acc, 0, 0, 0);
            const int v = tn * 32 + (lane & 31);
#pragma unroll
            for (int rg = 0; rg < 4; ++rg) { const int d0 = tm * 32 + 8 * rg + 4 * (lane >> 5);
                float o[4];
#pragma unroll
                for (int q = 0; q < 4; ++q) { o[q] = acc[rg * 4 + q]; if constexpr (VEC) o[q] *= __expf(SM[SM_CLAST + d0 + q] - SM[SM_REF + d0 + q]); }
                u32x2 w; w.x = pk2(o[0], o[1]); w.y = pk2(o[2], o[3]);
                *(u32x2*)(stg + (size_t)v * DK + d0) = w; }
        }
        float* dec = p.dec + (size_t)bc * 1024;
        if constexpr (BR == 0) { if (tid < 128) dec[hu * 128 + tid] = __expf(SM[SM_CLAST + tid]); }
        if constexpr (BR == 3) { if (tid < 64) dec[512 + hu * 64 + tid] = __expf(SM[SM_CLAST + tid]); }
        if constexpr (BR == 2) { if (tid < 4) dec[768 + hu * 4 + tid] = __expf(SM[SM_CUM + tid * 64 + 63]); }
        __syncthreads();
    } else {
        constexpr int NCT = DV / 32;
        const int gcol = (BR == 0) ? C_AG + hu * 128 : (BR == 1) ? C_RG + hu * 128 : (BR == 2) ? C_MZ + hu * 256 : C_GG + hu * 128;
        bf16_t gt[NT][16];
#pragma unroll
        for (int nt = 0; nt < NT; ++nt)
#pragma unroll
            for (int r = 0; r < 16; ++r) gt[nt][r] = P[(size_t)((wid >> 2) * 32 + rowmap(r, lane)) * LDP + gcol + ((wid & 3) + 4 * nt) * 32 + (lane & 31)];
        __builtin_amdgcn_sched_barrier(0);
        {
            constexpr int NVEC = DV * DK / 8, VPR = DK / 8;
            for (int vi = tid; vi < NVEC; vi += NTHR) { const int v = vi / VPR, d0 = (vi % VPR) * 8;
                u32x4 raw = *(const u32x4*)(stg + (size_t)vi * 8);
                if constexpr (VEC) { unsigned w[4] = {raw.x, raw.y, raw.z, raw.w};
#pragma unroll
                    for (int q = 0; q < 4; ++q) { const float lo = __uint_as_float(w[q] << 16) * __expf(SM[SM_REF + d0 + 2 * q]), hi = __uint_as_float(w[q] & 0xffff0000u) * __expf(SM[SM_REF + d0 + 2 * q + 1]);
                        w[q] = pk2(lo, hi); }
                    raw.x = w[0]; raw.y = w[1]; raw.z = w[2]; raw.w = w[3]; }
                *(LAS u32x4*)(lds + L_BIG + (v * LDK + d0) * 2) = raw; }
        }
        __syncthreads();
        const int tm = wid >> 2, tnb = wid & 3;
        f32x16 acc[NT];
#pragma unroll
        for (int nt = 0; nt < NT; ++nt)
#pragma unroll
            for (int r = 0; r < 16; ++r) acc[nt][r] = 0.f;
#pragma unroll
        for (int ks = 0; ks < DK / 16; ++ks) { const bf16x8 af = frag(lds, L_QI, LDK, tm * 32, ks, lane);
#pragma unroll
            for (int nt = 0; nt < NT; ++nt) acc[nt] = __builtin_amdgcn_mfma_f32_32x32x16_bf16(af, frag(lds, L_BIG, LDK, (tnb + 4 * nt) * 32, ks, lane), acc[nt], 0, 0, 0); }
        if constexpr (!VEC) {
#pragma unroll
            for (int nt = 0; nt < NT; ++nt) { const int hh = (NH == 1) ? 0 : ((tnb + 4 * nt) >> 1);
#pragma unroll
                for (int r = 0; r < 16; ++r) acc[nt][r] *= __expf(SM[SM_CUM + hh * 64 + tm * 32 + rowmap(r, lane)]); }
        }
        f32x16 sc;
#pragma unroll
        for (int r = 0; r < 16; ++r) sc[r] = 0.f;
        const int stm = wid >> 1, stn = wid & 1;
        if (wid < 4) {
#pragma unroll
            for (int ks = 0; ks < DK / 16; ++ks) sc = __builtin_amdgcn_mfma_f32_32x32x16_bf16(frag(lds, L_QI, LDK, stm * 32, ks, lane), frag(lds, L_KI, LDK, stn * 32, ks, lane), sc, 0, 0, 0);
        }
        __syncthreads();
        if (wid < 4) {
            const int s = stn * 32 + (lane & 31);
#pragma unroll
            for (int hh = 0; hh < NH; ++hh) {
                float cums = 0.f, dts = 1.f;
                if constexpr (!VEC) { cums = SM[SM_CUM + hh * 64 + s]; dts = SM[SM_DT + hh * 64 + s]; }
#pragma unroll
                for (int r = 0; r < 16; ++r) { const int t = stm * 32 + rowmap(r, lane);
                    float val = sc[r];
                    if constexpr (!VEC) { const float ex = (s <= t) ? SM[SM_CUM + hh * 64 + t] - cums : 0.f; val *= __expf(ex) * dts; }
                    val = (s <= t) ? val : 0.f;
                    *(LAS bf16_t*)(lds + L_BIG + ((hh * 64 + t) * 72 + s) * 2) = f2bf(val); }
            }
        }
        __syncthreads();
#pragma unroll
        for (int nt = 0; nt < NT; ++nt) { const int hh = (NH == 1) ? 0 : ((tnb + 4 * nt) >> 1);
#pragma unroll
            for (int ks = 0; ks < 4; ++ks) acc[nt] = __builtin_amdgcn_mfma_f32_32x32x16_bf16(frag(lds, L_BIG + hh * 9216, 72, tm * 32, ks, lane), frag(lds, L_VT, 72, (tnb + 4 * nt) * 32, ks, lane), acc[nt], 0, 0, 0); }
        const int ycol = (BR == 0) ? hu * 128 : (BR == 1) ? 512 + hu * 128 : (BR == 2) ? 1024 + hu * 256 : 1536 + hu * 128;
        const float* gain = (BR == 0) ? p.hgrn_g + hu * 128 : (BR == 1) ? p.ret_g + hu * 128 : (BR == 2) ? p.ssm_g + hu * 256 : p.gla_g + hu * 128;
#pragma unroll
        for (int nt = 0; nt < NT; ++nt) { const int ct = tnb + 4 * nt, v = ct * 32 + (lane & 31);
            float dsk = 0.f; if constexpr (BR == 2) dsk = p.dskip[hu * 4 + (ct >> 1)];
#pragma unroll
            for (int r = 0; r < 16; ++r) { const int t = tm * 32 + rowmap(r, lane);
                float val = acc[nt][r];
                if constexpr (BR == 2) { val = (val + dsk * bf2f(VT[v * 72 + t])) * silu_f(bf2f(gt[nt][r])); acc[nt][r] = val; }
                float sq = val * val;
#pragma unroll
                for (int o = 16; o > 0; o >>= 1) sq += __shfl_xor(sq, o);
                if ((lane & 31) == 0) SM[SM_RSS + ct * 64 + t] = sq; }
        }
        __syncthreads();
#pragma unroll
        for (int nt = 0; nt < NT; ++nt) { const int ct = tnb + 4 * nt, v = ct * 32 + (lane & 31);
            const float gn = gain[v];
#pragma unroll
            for (int r = 0; r < 16; ++r) { const int t = tm * 32 + rowmap(r, lane);
                float tot = 0.f;
#pragma unroll
                for (int q = 0; q < NCT; ++q) tot += SM[SM_RSS + q * 64 + t];
                float o = acc[nt][r] * rsqrtf(tot * (1.f / DV) + EPS) * gn;
                if constexpr (BR != 2) o *= silu_f(bf2f(gt[nt][r]));
                p.y[(size_t)(bc * 64 + t) * DI + ycol + v] = f2bf(o); }
        }
        __syncthreads();
    }
}

template <int PASS>
__device__ __forceinline__ void phase_mixer(const MixP& p, LAS unsigned char* lds) {
#pragma unroll 1
    for (int i = blockIdx.x; i < 128 * 14; i += gridDim.x) {
        const int bc = i / 14, u = i % 14;
        if (u < 4) mixer_unit<0, PASS>(p, lds, bc, u);
        else if (u < 8) mixer_unit<1, PASS>(p, lds, bc, u - 4);
        else if (u < 10) mixer_unit<2, PASS>(p, lds, bc, u - 8);
        else mixer_unit<3, PASS>(p, lds, bc, u - 10);
    }
}

__device__ __forceinline__ void phase_scan(bf16_t* st, const float* dec) {
    const int gt = blockIdx.x * NTHR + opaque_tid();
    constexpr int VPB = ST_PER_BC / 4;
    if (gt >= 2 * VPB) return;
    const int bl = gt / VPB, e0 = (gt % VPB) * 4;
    int mode, didx = 0; float cfac = 0.f;
    if (e0 < 65536) { mode = 0; didx = (e0 >> 14) * 128 + (e0 & 127); }
    else if (e0 < 131072) { mode = 1; const int h = (e0 - 65536) >> 14; cfac = __expf(64.f * log1pf(-exp2f(-(5.f + (float)h)))); }
    else if (e0 < 196608) { mode = 2; const int r = e0 - 131072; didx = 768 + (r >> 15) * 4 + (((r & 32767) >> 7) >> 6); }
    else { mode = 0; const int r = e0 - 196608; didx = 512 + (r >> 13) * 64 + (r & 63); }
    float s0 = 0.f, s1 = 0.f, s2 = 0.f, s3 = 0.f;
    bf16_t* ptr = st + (size_t)bl * 64 * ST_PER_BC + e0;
    const float* dp = dec + (size_t)bl * 64 * 1024 + didx;
#pragma unroll 1
    for (int c0 = 0; c0 < 64; c0 += 8) {
        u32x2 hv[8]; f32x4 dv[8];
#pragma unroll
        for (int j = 0; j < 8; ++j) {
            hv[j] = *(const u32x2*)(ptr + (size_t)(c0 + j) * ST_PER_BC);
            if (mode == 0) dv[j] = *(const f32x4*)(dp + (size_t)(c0 + j) * 1024);
            else if (mode == 1) dv[j] = (f32x4){cfac, cfac, cfac, cfac};
            else { const float d = dp[(size_t)(c0 + j) * 1024]; dv[j] = (f32x4){d, d, d, d}; }
        }
        __builtin_amdgcn_sched_barrier(0);
#pragma unroll
        for (int j = 0; j < 8; ++j) {
            u32x2 w; w.x = pk2(s0, s1); w.y = pk2(s2, s3);
            *(u32x2*)(ptr + (size_t)(c0 + j) * ST_PER_BC) = w;
            s0 = s0 * dv[j][0] + __uint_as_float(hv[j].x << 16); s1 = s1 * dv[j][1] + __uint_as_float(hv[j].x & 0xffff0000u);
            s2 = s2 * dv[j][2] + __uint_as_float(hv[j].y << 16); s3 = s3 * dv[j][3] + __uint_as_float(hv[j].y & 0xffff0000u);
        }
    }
}

__global__ void __launch_bounds__(NTHR, 2) fwd_megakernel(Args a) {
    extern __shared__ __attribute__((aligned(16))) unsigned char shm[];
    LAS unsigned char* lds = (LAS unsigned char*)shm;
    cg::grid_group grid = cg::this_grid();
    unsigned char* ws = a.ws;
    const int G = gridDim.x;

    for (int rep = 0; rep < REP_PREP; ++rep) { phase_prep(a, lds); grid.sync(); }

    bf16_t* hbuf = (bf16_t*)(ws + WS_HY); bf16_t* ybuf = (bf16_t*)(ws + WS_HY);
    bf16_t* proj = (bf16_t*)(ws + WS_PROJ); bf16_t* st = (bf16_t*)(ws + WS_ST); float* dec = (float*)(ws + WS_DEC);
    const float* mod = (const float*)(ws + WS_MOD);

#pragma unroll 1
    for (int half = 0; half < 2; ++half) {
        const size_t xoff = (size_t)half * HROWS * DM;
#pragma unroll 1
        for (int l = 0; l < DEPTH; ++l) {
            const float* xin = (l == 0) ? a.x + xoff : a.out + xoff;
            const float* modl = mod + (size_t)l * 4 * 3072;
            for (int rep = 0; rep < REP_NORM; ++rep) { phase_norm(xin, a.norm_g + l * DM, modl, half, hbuf); grid.sync(); }
            for (int rep = 0; rep < REP_G1; ++rep) {
                pg8::Gemm g{hbuf, (const bf16_t*)(ws + WS_WIN) + (size_t)l * LDP * DM, HROWS, LDP, DM};
                pg8::StaticOrder S; S.init(HROWS, LDP, G, (int)blockIdx.x);
                pg8::EpiProj E{proj, LDP};
                pg8::gemm_phase<pg8::EpiProj, pg8::StaticOrder>(lds, g, S, E);
                grid.sync();
            }
            MixP p;
            p.proj = proj; p.st = st; p.dec = dec; p.y = ybuf; p.rope = (const float2*)(ws + WS_ROPE);
            p.lbl = a.lb_logits; p.hgrn_g = a.hgrn_g + l * 512; p.ret_g = a.ret_g + l * 512; p.conv_w = a.conv_w + l * 4096; p.conv_b = a.conv_b + l * 1024;
            p.dt_bias = a.dt_bias + l * 8; p.a_log = a.a_log + l * 8; p.dskip = a.dskip + l * 8; p.ssm_g = a.ssm_g + l * 512;
            p.w2 = a.w_gk2 + l * 16 * 256; p.b2 = a.b_gk2 + l * 256; p.gla_g = a.gla_g + l * 512; p.layer = l;
            for (int rep = 0; rep < REP_M12; ++rep) { phase_mixer<1>(p, lds); grid.sync(); phase_scan(st, dec); grid.sync(); }
            for (int rep = 0; rep < REP_M3; ++rep) { phase_mixer<3>(p, lds); grid.sync(); }
            for (int rep = 0; rep < ((l == 0) ? REP_G2 : 1); ++rep) {
                pg8::Gemm g{ybuf, (const bf16_t*)(ws + WS_WOUT) + (size_t)l * DM * DI, HROWS, DM, DI};
                pg8::StaticOrder S; S.init(HROWS, DM, G, (int)blockIdx.x);
                pg8::EpiRes E{xin, a.out + xoff, modl + (size_t)(half * 2) * 3072 + 2048};
                pg8::gemm_phase<pg8::EpiRes, pg8::StaticOrder>(lds, g, S, E);
                grid.sync();
            }
        }
        phase_final(a.out + xoff, a.final_g);
    }
}

extern "C" void kernel_launch(void* const* d_in, const int* in_sizes, int n_in, void* d_out, int out_size, void* d_ws, size_t ws_size, hipStream_t stream) {
    static int grid = 0;
    if (grid == 0) {
        if (n_in != 20 || ws_size < WS_END) { fprintf(stderr, "kernel_launch: unexpected n_in %d / ws_size %zu (need %zu)\n", n_in, ws_size, (size_t)WS_END); grid = -1; return; }
        int dev = 0, cus = 0, per_cu = 0;
        hipGetDevice(&dev);
        hipDeviceGetAttribute(&cus, hipDeviceAttributeMultiprocessorCount, dev);
        if (hipFuncSetAttribute((const void*)fwd_megakernel, hipFuncAttributeMaxDynamicSharedMemorySize, LDS_BYTES) != hipSuccess) { fprintf(stderr, "kernel_launch: hipFuncSetAttribute failed\n"); grid = -1; return; }
        hipOccupancyMaxActiveBlocksPerMultiprocessor(&per_cu, (const void*)fwd_megakernel, NTHR, LDS_BYTES);
        if (per_cu < 1) { fprintf(stderr, "kernel_launch: occupancy query says %d blocks per CU\n", per_cu); per_cu = 1; }
        (void)hipGetLastError();
        grid = cus * per_cu;
    }
    if (grid < 0) return;
    Args a{};
    const float** f = (const float**)&a;
    for (int i = 0; i < 20; ++i) f[i] = (const float*)d_in[i];
    a.out = (float*)d_out; a.ws = (unsigned char*)d_ws;
    void* args[] = {&a};
    hipError_t e = hipLaunchCooperativeKernel((const void*)fwd_megakernel, dim3(grid), dim3(NTHR), args, LDS_BYTES, stream);
    if (e != hipSuccess) fprintf(stderr, "cooperative launch failed: %s (grid %d)\n", hipGetErrorString(e), grid);
}
```

```cpp
#include <hip/hip_runtime.h>
#include <hip/hip_cooperative_groups.h>
#include <cstdio>
namespace cg = cooperative_groups;

#define LAS __attribute__((address_space(3)))
typedef unsigned short bf16_t;
typedef short bf16x8 __attribute__((ext_vector_type(8)));
typedef float f32x4 __attribute__((ext_vector_type(4)));
typedef float f32x16 __attribute__((ext_vector_type(16)));
typedef unsigned u32x4 __attribute__((ext_vector_type(4)));
typedef unsigned u32x2 __attribute__((ext_vector_type(2)));

#ifndef REP_PREP
#define REP_PREP 1
#endif
#ifndef REP_NORM
#define REP_NORM 1
#endif
#ifndef REP_G1
#define REP_G1 1
#endif
#ifndef REP_M12
#define REP_M12 1
#endif
#ifndef REP_M3
#define REP_M3 1
#endif
#ifndef REP_G2
#define REP_G2 1
#endif
constexpr int NB = 4, SEQ = 4096, DM = 1024, DEPTH = 2, DI = 2048;
constexpr int NIN = 7192, LDP = 7424;
constexpr int HROWS = 8192;
constexpr int NTHR = 512;
constexpr float EPS = 1e-6f;
constexpr int C_AQ = 0, C_AF = 512, C_AI = 1024, C_AG = 1536, C_RQ = 2048, C_RK = 2560, C_RV = 3072, C_RG = 3584,
              C_MZ = 4096, C_XBC = 4608, C_DT = 5632, C_GQ = 5640, C_GK = 5896, C_GV = 6152, C_GG = 6664, C_LR = 7176;
constexpr int ST_PER_BC = 229376;
constexpr size_t WS_WIN = 0;
constexpr size_t WS_WOUT = WS_WIN + 2ull * LDP * DM * 2;
constexpr size_t WS_MOD = WS_WOUT + 2ull * DM * DI * 2;
constexpr size_t WS_ROPE = WS_MOD + 2ull * 4 * 3072 * 4;
constexpr size_t WS_DEC = WS_ROPE + 4096ull * 64 * 8;
constexpr size_t WS_HY = WS_DEC + 128ull * 1024 * 4;
constexpr size_t WS_PROJ = WS_HY + (size_t)HROWS * DI * 2;
constexpr size_t WS_ST = WS_PROJ + (size_t)HROWS * LDP * 2;
constexpr size_t WS_BAR = WS_ST + 128ull * ST_PER_BC * 2;
constexpr size_t WS_END = WS_BAR + 3456 * 4;
constexpr int L_QI = 0, L_KI = 17408, L_VT = 34816, L_BIG = 71680, L_SM = 141312;
constexpr int SM_CUM = 0, SM_DT = 256, SM_SEG = 512, SM_REF = 1536, SM_CLAST = 1664, SM_RSS = 1792;
constexpr int L_BARST = L_SM + (1792 + 512) * 4;
constexpr int LDS_BYTES = L_BARST + 16;

__device__ __forceinline__ float bf2f(bf16_t v) { return __uint_as_float(((unsigned)v) << 16); }
__device__ __forceinline__ bf16_t f2bf(float f) { unsigned u = __float_as_uint(f); u += 0x7FFFu + ((u >> 16) & 1u); return (bf16_t)(u >> 16); }
typedef float f32x2_t __attribute__((ext_vector_type(2)));
typedef __bf16 bf16x2_t __attribute__((ext_vector_type(2)));
__device__ __forceinline__ unsigned pk2(float lo, float hi) { f32x2_t v = {lo, hi}; bf16x2_t b = __builtin_convertvector(v, bf16x2_t); return __builtin_bit_cast(unsigned, b); }
__device__ __forceinline__ int opaque_tid() { int t = threadIdx.x; asm volatile("" : "+v"(t)); return t; }
__device__ __forceinline__ float silu_f(float x) { return x * __builtin_amdgcn_rcpf(1.f + __expf(-x)); }
__device__ __forceinline__ float softplus_f(float x) { return fmaxf(x, 0.f) + __logf(1.f + __expf(-fabsf(x))); }
__device__ __forceinline__ float logsig_f(float x) { return fminf(x, 0.f) - __logf(1.f + __expf(-fabsf(x))); }

namespace pg8 {
constexpr int BM = 256, BK = 64, HALF = 128, HTB = HALF * BK * 2, STAGE_BYTES = 8 * HTB, NXCD = 8, WGM = 8;
__device__ __forceinline__ int lds_byte(int r, int c) { const int st = (r >> 4) * 2 + (c >> 5), rr = r & 15, cc = c & 31, ob = rr * 64 + cc * 2; return st * 1024 + (ob ^ (((ob >> 9) & 1) << 5)); }
__device__ __forceinline__ void stage_rc(int b, int& R, int& C) { const int st = b / 1024, sb = b % 1024, swz = sb ^ (((sb >> 9) & 1) << 5); R = (st >> 1) * 16 + swz / 64; C = (st & 1) * 32 + (swz % 64) / 2; }
__device__ __forceinline__ int perm32(int rho) { const int n = rho >> 4, i = rho & 15; return 8 * (i >> 2) + 4 * n + (i & 3); }
struct Unit { int pm, pn; };
struct Gemm { const bf16_t* A; const bf16_t* Bt; int M, N, K; };
struct StaticOrder {
    int nM, nN, nwg, G, c;
    __device__ void init(int M, int N, int G_, int c_) { nM = M / BM; nN = N / BM; nwg = nM * nN; G = G_; c = c_; }
    __device__ bool next(int i, Unit& u) const {
        const long L = (long)i * G + c; if (L >= nwg) return false;
        int wgid = (int)L; { const int q = nwg / NXCD, r = nwg % NXCD, xcd = wgid % NXCD, off = wgid / NXCD; wgid = (xcd < r ? xcd * (q + 1) : r * (q + 1) + (xcd - r) * q) + off; }
        const int nig = WGM * nN, gid = wgid / nig, fm = gid * WGM, gsz = (nM - fm) < WGM ? (nM - fm) : WGM;
        u.pm = fm + ((wgid % nig) % gsz); u.pn = (wgid % nig) / gsz; return true;
    }
};
struct EpiProj {
    static constexpr bool PERM = true;
    bf16_t* O; int ldc;
    __device__ __forceinline__ void operator()(const f32x4 (&acc)[2][2][4][2], const Unit& u, int wr, int wc, int fr, int fq) const {
        const int row0 = u.pm * BM + wr * 64 + fr, col0 = u.pn * BM + wc * 32 + 8 * fq;
#pragma unroll
        for (int ai = 0; ai < 2; ++ai)
#pragma unroll
            for (int m = 0; m < 4; ++m) { bf16_t* rowp = O + (size_t)(row0 + ai * HALF + m * 16) * ldc + col0;
#pragma unroll
                for (int bj = 0; bj < 2; ++bj) { const f32x4 v0 = acc[ai][bj][m][0], v1 = acc[ai][bj][m][1];
                    u32x4 w; w.x = pk2(v0[0], v0[1]); w.y = pk2(v0[2], v0[3]); w.z = pk2(v1[0], v1[1]); w.w = pk2(v1[2], v1[3]);
                    *(u32x4*)(rowp + bj * HALF) = w; } }
    }
};
struct EpiRes {
    static constexpr bool PERM = false;
    const float* xin; float* xout; const float* gate;
    __device__ __forceinline__ void operator()(const f32x4 (&acc)[2][2][4][2], const Unit& u, int wr, int wc, int fr, int fq) const {
        const int row0 = u.pm * BM + wr * 64 + fr, col0 = u.pn * BM + wc * 32 + 4 * fq;
        const float* gp = gate + (size_t)(u.pm >> 4) * 3072 + col0;
        f32x4 gv[2][2];
#pragma unroll
        for (int bj = 0; bj < 2; ++bj)
#pragma unroll
            for (int n = 0; n < 2; ++n) gv[bj][n] = *(const f32x4*)(gp + bj * HALF + n * 16);
#pragma unroll
        for (int am = 0; am < 4; ++am) {
            const int ai = am >> 1, m0 = (am & 1) * 2;
            f32x4 xi[2][2][2];
#pragma unroll
            for (int m = 0; m < 2; ++m)
#pragma unroll
                for (int bj = 0; bj < 2; ++bj)
#pragma unroll
                    for (int n = 0; n < 2; ++n) xi[m][bj][n] = *(const f32x4*)(xin + (size_t)(row0 + ai * HALF + (m0 + m) * 16) * DM + col0 + bj * HALF + n * 16);
            __builtin_amdgcn_sched_barrier(0);
#pragma unroll
            for (int m = 0; m < 2; ++m)
#pragma unroll
                for (int bj = 0; bj < 2; ++bj)
#pragma unroll
                    for (int n = 0; n < 2; ++n) *(f32x4*)(xout + (size_t)(row0 + ai * HALF + (m0 + m) * 16) * DM + col0 + bj * HALF + n * 16) = xi[m][bj][n] + gv[bj][n] * acc[ai][bj][m0 + m][n];
        }
    }
};

template <class Epi, class Sched>
__device__ __forceinline__ void gemm_phase(LAS unsigned char* lds, const Gemm g, const Sched& S, const Epi& E) {
    const int tid = opaque_tid(), wid = __builtin_amdgcn_readfirstlane(tid >> 6), lane = tid & 63, wr = wid >> 2, wc = wid & 3, fr = lane & 15, fq = lane >> 4;
    const int K = g.K, nt = K / BK;
    unsigned voffA[2], voffB[2];
#pragma unroll
    for (int i = 0; i < 2; ++i) { int R, C; stage_rc(tid * 16 + i * 8192, R, C); const int Rb = Epi::PERM ? ((R & ~31) + perm32(R & 31)) : R;
        voffA[i] = (unsigned)(R * K + C) * 2u; voffB[i] = (unsigned)(Rb * K + C) * 2u; }
    const size_t kstep = (size_t)(BK * 2);
    const size_t hstep = (size_t)HALF * K * 2;
    const size_t tstep = 2 * hstep;
    const unsigned ldsw = (unsigned)wid * 1024u;
    const int aoff = lds_byte(wr * 64 + fr, fq * 8), boff = lds_byte(wc * 32 + fr, fq * 8);
#define PG8_SA(b, h) (((b) * 2 + (h)) * HTB)
#define PG8_SB(b, h) ((4 + (b) * 2 + (h)) * HTB)
#define PG8_STAGE(bufoff, gbase, voff) do { _Pragma("unroll") for (int _i = 0; _i < 2; ++_i) \
        __builtin_amdgcn_global_load_lds((const unsigned*)((const char*)(gbase) + (voff)[_i]), (LAS unsigned*)(lds + (bufoff) + ldsw + _i * 8192), 16, 0, 0); } while (0)
#define PG8_LDA(dst, b, h) do { _Pragma("unroll") for (int m = 0; m < 4; ++m) _Pragma("unroll") for (int k = 0; k < 2; ++k) dst[m][k] = *(const LAS bf16x8*)(lds + PG8_SA(b, h) + aoff + m * 2048 + k * 1024); } while (0)
#define PG8_LDB(dst, b, h) do { _Pragma("unroll") for (int n = 0; n < 2; ++n) _Pragma("unroll") for (int k = 0; k < 2; ++k) dst[n][k] = *(const LAS bf16x8*)(lds + PG8_SB(b, h) + boff + n * 2048 + k * 1024); } while (0)
#define PG8_MMA(ai, bj, At, Bt) do { __builtin_amdgcn_s_setprio(1); _Pragma("unroll") for (int m = 0; m < 4; ++m) _Pragma("unroll") for (int n = 0; n < 2; ++n) _Pragma("unroll") for (int k = 0; k < 2; ++k) \
        acc[ai][bj][m][n] = __builtin_amdgcn_mfma_f32_16x16x32_bf16(Bt[n][k], At[m][k], acc[ai][bj][m][n], 0, 0, 0); __builtin_amdgcn_s_setprio(0); } while (0)
#define PG8_WAIT_V(n) asm volatile("s_waitcnt vmcnt(" #n ")" ::: "memory")
#define PG8_WAIT_L(n) asm volatile("s_waitcnt lgkmcnt(" #n ")" ::: "memory")
#define PG8_BAR __builtin_amdgcn_s_barrier()
#define PG8_SCHED __builtin_amdgcn_sched_barrier(0)
    Unit cur, nxt; int ui = 0;
    if (!S.next(0, cur)) return;
    f32x4 acc[2][2][4][2];
#pragma unroll
    for (int a = 0; a < 2; ++a)
#pragma unroll
        for (int b = 0; b < 2; ++b)
#pragma unroll
            for (int m = 0; m < 4; ++m)
#pragma unroll
                for (int n = 0; n < 2; ++n) acc[a][b][m][n] = (f32x4){0.f, 0.f, 0.f, 0.f};
    bf16x8 At[4][2], B0[2][2], B1[2][2];
    const char* cA = (const char*)g.A + (size_t)cur.pm * tstep; const char* cB = (const char*)g.Bt + (size_t)cur.pn * tstep;
    PG8_STAGE(PG8_SB(0, 0), cB, voffB); PG8_STAGE(PG8_SA(0, 0), cA, voffA); PG8_STAGE(PG8_SB(0, 1), cB + hstep, voffB); PG8_STAGE(PG8_SA(0, 1), cA + hstep, voffA);
    if (wr == 1) PG8_BAR;
    PG8_WAIT_V(4); PG8_BAR;
    PG8_STAGE(PG8_SB(1, 0), cB + kstep, voffB); PG8_STAGE(PG8_SA(1, 0), cA + kstep, voffA); PG8_STAGE(PG8_SB(1, 1), cB + hstep + kstep, voffB);
    PG8_WAIT_V(6); PG8_BAR;
    for (;;) {
        const bool has_next = S.next(ui + 1, nxt);
        const char* nA = has_next ? (const char*)g.A + (size_t)nxt.pm * tstep : cA; const char* nB = has_next ? (const char*)g.Bt + (size_t)nxt.pn * tstep : cB;
        for (int t = 0; t < nt; t += 2) {
            const bool last = (t == nt - 2);
            const char* a1 = cA + (size_t)(t + 1) * kstep;
            const char* a2 = last ? nA : cA + (size_t)(t + 2) * kstep; const char* b2 = last ? nB : cB + (size_t)(t + 2) * kstep;
            const char* a3 = a2 + kstep; const char* b3 = b2 + kstep;
            PG8_LDB(B0, 0, 0); PG8_SCHED; PG8_LDA(At, 0, 0); PG8_STAGE(PG8_SA(1, 1), a1 + hstep, voffA);
            PG8_WAIT_L(8); PG8_BAR; PG8_WAIT_L(0); PG8_MMA(0, 0, At, B0); PG8_BAR; PG8_SCHED;
            PG8_LDB(B1, 0, 1); PG8_STAGE(PG8_SB(0, 0), b2, voffB);
            PG8_BAR; PG8_WAIT_L(0); PG8_MMA(0, 1, At, B1); PG8_BAR;
            PG8_LDA(At, 0, 1); PG8_STAGE(PG8_SA(0, 0), a2, voffA);
            PG8_BAR; PG8_WAIT_L(0); PG8_MMA(1, 0, At, B0); PG8_BAR; PG8_SCHED;
            PG8_STAGE(PG8_SB(0, 1), b2 + hstep, voffB);
            PG8_WAIT_V(6); PG8_BAR; PG8_MMA(1, 1, At, B1); PG8_BAR;
            PG8_LDB(B0, 1, 0); PG8_SCHED; PG8_LDA(At, 1, 0); PG8_STAGE(PG8_SA(0, 1), a2 + hstep, voffA);
            PG8_WAIT_L(8); PG8_BAR; PG8_WAIT_L(0); PG8_MMA(0, 0, At, B0); PG8_BAR; PG8_SCHED;
            PG8_LDB(B1, 1, 1); PG8_STAGE(PG8_SB(1, 0), b3, voffB);
            PG8_BAR; PG8_WAIT_L(0); PG8_MMA(0, 1, At, B1); PG8_BAR;
            PG8_LDA(At, 1, 1); PG8_STAGE(PG8_SA(1, 0), a3, voffA);
            PG8_BAR; PG8_WAIT_L(0); PG8_MMA(1, 0, At, B0); PG8_BAR; PG8_SCHED;
            PG8_STAGE(PG8_SB(1, 1), b3 + hstep, voffB);
            PG8_WAIT_V(6); PG8_BAR; PG8_MMA(1, 1, At, B1); PG8_BAR;
        }
        E(acc, cur, wr, wc, fr, fq);
        if (!has_next) break;
#pragma unroll
        for (int a = 0; a < 2; ++a)
#pragma unroll
            for (int b = 0; b < 2; ++b)
#pragma unroll
                for (int m = 0; m < 4; ++m)
#pragma unroll
                    for (int n = 0; n < 2; ++n) acc[a][b][m][n] = (f32x4){0.f, 0.f, 0.f, 0.f};
        cur = nxt; cA = nA; cB = nB; ++ui;
    }
    PG8_WAIT_V(0);
    if (wr == 0) PG8_BAR;
    PG8_BAR;
#undef PG8_SA
#undef PG8_SB
#undef PG8_STAGE
#undef PG8_LDA
#undef PG8_LDB
#undef PG8_MMA
#undef PG8_WAIT_V
#undef PG8_WAIT_L
#undef PG8_BAR
#undef PG8_SCHED
}
}

struct Args {
    const float* x; const float* c; const float* w_ada; const float* b_ada; const float* norm_g; const float* w_in;
    const float* lb_logits; const float* hgrn_g; const float* ret_g; const float* conv_w; const float* conv_b;
    const float* dt_bias; const float* a_log; const float* dskip; const float* ssm_g; const float* w_gk2; const float* b_gk2;
    const float* gla_g; const float* w_out; const float* final_g;
    float* out; unsigned char* ws;
};

__device__ __forceinline__ void transpose_cvt(const float* __restrict__ src, int K, int N, bf16_t* __restrict__ dst, int Npad, LAS unsigned char* lds, int gid, int gstride) {
    LAS float* T = (LAS float*)lds;
    const int tid = opaque_tid(), ntk = K / 64, ntn = Npad / 64;
    for (int tile = gid; tile < ntk * ntn; tile += gstride) {
        const int tk = tile % ntk, tn = tile / ntk;
#pragma unroll
        for (int i = 0; i < 8; ++i) { const int kk = (tid >> 6) + 8 * i, nn = tid & 63, n = tn * 64 + nn;
            T[kk * 65 + nn] = (n < N) ? src[(size_t)(tk * 64 + kk) * N + n] : 0.f; }
        __syncthreads();
#pragma unroll
        for (int i = 0; i < 4; ++i) { const int nn = (tid >> 5) + 16 * i, kk = (tid & 31) * 2;
            *(unsigned*)(dst + (size_t)(tn * 64 + nn) * K + tk * 64 + kk) = pk2(T[kk * 65 + nn], T[(kk + 1) * 65 + nn]); }
        __syncthreads();
    }
}

__device__ __forceinline__ void phase_prep(const Args& a, LAS unsigned char* lds) {
    const int tid = opaque_tid(), G = gridDim.x, bid = blockIdx.x;
    unsigned char* ws = a.ws;
    for (int l = 0; l < DEPTH; ++l) {
        transpose_cvt(a.w_in + (size_t)l * DM * NIN, DM, NIN, (bf16_t*)(ws + WS_WIN) + (size_t)l * LDP * DM, LDP, lds, bid, G);
        transpose_cvt(a.w_out + (size_t)l * DI * DM, DI, DM, (bf16_t*)(ws + WS_WOUT) + (size_t)l * DM * DI, DM, lds, (bid + 128) % G, G);
    }
    {
        LAS float* R = (LAS float*)lds;
        float* mod = (float*)(ws + WS_MOD);
        const int jj = tid & 63, ks = tid >> 6;
        for (int item = bid; item < DEPTH * 48; item += G) {
            const int l = item / 48, j = (item % 48) * 64 + jj;
            float s0 = 0.f, s1 = 0.f, s2 = 0.f, s3 = 0.f;
            const float* w = a.w_ada + (size_t)l * DM * 3072 + j;
            for (int k = ks * 128; k < ks * 128 + 128; ++k) { const float wv = w[(size_t)k * 3072];
                s0 += silu_f(a.c[k]) * wv; s1 += silu_f(a.c[DM + k]) * wv; s2 += silu_f(a.c[2 * DM + k]) * wv; s3 += silu_f(a.c[3 * DM + k]) * wv; }
            R[(ks * 4 + 0) * 64 + jj] = s0; R[(ks * 4 + 1) * 64 + jj] = s1; R[(ks * 4 + 2) * 64 + jj] = s2; R[(ks * 4 + 3) * 64 + jj] = s3;
            __syncthreads();
            if (tid < 256) { const int b = tid >> 6; float s = a.b_ada[l * 3072 + j];
#pragma unroll
                for (int q = 0; q < 8; ++q) s += R[(q * 4 + b) * 64 + jj];
                mod[(size_t)(l * 4 + b) * 3072 + j] = s; }
            __syncthreads();
        }
    }
    {
        float2* rope = (float2*)(ws + WS_ROPE);
        for (int i = bid * NTHR + tid; i < 4096 * 64; i += G * NTHR) {
            const int pos = i >> 6, j = i & 63;
            const float invf = powf(10000.f, -(float)(2 * j) / 128.f);
            const float ang = (float)pos * invf;
            const float k = rintf(ang * 0.15915494309189535f);
            float r = fmaf(-k, 6.2831854820251465f, ang); r = fmaf(-k, -1.7484555e-07f, r);
            rope[i] = make_float2(__cosf(r), __sinf(r));
        }
    }
}

__device__ __forceinline__ void phase_norm(const float* __restrict__ xin  , const float* __restrict__ g, const float* __restrict__ mod  ,
                                           int half, bf16_t* __restrict__ hout) {
    const int tid = opaque_tid(), lane = tid & 63, wid = tid >> 6;
    const int gw = blockIdx.x * 8 + wid, nw = gridDim.x * 8;
    for (int row = gw; row < HROWS; row += nw) {
        const float* xr = xin + (size_t)row * DM;
        f32x4 v[4]; float ss = 0.f;
#pragma unroll
        for (int i = 0; i < 4; ++i) { v[i] = *(const f32x4*)(xr + i * 256 + lane * 4); ss += v[i][0] * v[i][0] + v[i][1] * v[i][1] + v[i][2] * v[i][2] + v[i][3] * v[i][3]; }
#pragma unroll
        for (int o = 32; o > 0; o >>= 1) ss += __shfl_xor(ss, o);
        const float rinv = rsqrtf(ss * (1.f / DM) + EPS);
        const float* mb = mod + (size_t)(half * 2 + (row >> 12)) * 3072;
#pragma unroll
        for (int i = 0; i < 4; ++i) { const int col = i * 256 + lane * 4;
            const f32x4 gg = *(const f32x4*)(g + col), sh = *(const f32x4*)(mb + col), sc = *(const f32x4*)(mb + 1024 + col);
            float o0 = v[i][0] * rinv * gg[0] * (1.f + sc[0]) + sh[0], o1 = v[i][1] * rinv * gg[1] * (1.f + sc[1]) + sh[1];
            float o2 = v[i][2] * rinv * gg[2] * (1.f + sc[2]) + sh[2], o3 = v[i][3] * rinv * gg[3] * (1.f + sc[3]) + sh[3];
            u32x2 w; w.x = pk2(o0, o1); w.y = pk2(o2, o3);
            *(u32x2*)(hout + (size_t)row * DM + col) = w; }
    }
}
__device__ __forceinline__ void phase_final(float* __restrict__ xio  , const float* __restrict__ g) {
    const int tid = opaque_tid(), lane = tid & 63, wid = tid >> 6;
    const int gw = blockIdx.x * 8 + wid, nw = gridDim.x * 8;
    for (int row = gw; row < HROWS; row += nw) {
        float* xr = xio + (size_t)row * DM;
        f32x4 v[4]; float ss = 0.f;
#pragma unroll
        for (int i = 0; i < 4; ++i) { v[i] = *(const f32x4*)(xr + i * 256 + lane * 4); ss += v[i][0] * v[i][0] + v[i][1] * v[i][1] + v[i][2] * v[i][2] + v[i][3] * v[i][3]; }
#pragma unroll
        for (int o = 32; o > 0; o >>= 1) ss += __shfl_xor(ss, o);
        const float rinv = rsqrtf(ss * (1.f / DM) + EPS);
#pragma unroll
        for (int i = 0; i < 4; ++i) { const int col = i * 256 + lane * 4; const f32x4 gg = *(const f32x4*)(g + col);
            *(f32x4*)(xr + col) = v[i] * rinv * gg; }
    }
}

struct MixP {
    const bf16_t* proj; bf16_t* st; float* dec; bf16_t* y; const float2* rope;
    const float* lbl; const float* hgrn_g; const float* ret_g; const float* conv_w; const float* conv_b; const float* dt_bias; const float* a_log;
    const float* dskip; const float* ssm_g; const float* w2; const float* b2; const float* gla_g; int layer;
};

__device__ __forceinline__ bf16x8 frag(LAS unsigned char* lds, int off, int ld, int r0, int ks, int lane) {
    return *(const LAS bf16x8*)(lds + off + (((r0 + (lane & 31)) * ld + 16 * ks + 8 * (lane >> 5)) << 1));
}
__device__ __forceinline__ int rowmap(int r, int lane) { return (r & 3) + 8 * (r >> 2) + 4 * (lane >> 5); }

__device__ __forceinline__ void conv16(const MixP& p, LAS unsigned char* lds, int off, int ncols, int col, int chan, int seg, float (&out)[16]) {
    const float w0 = p.conv_w[chan], w1 = p.conv_w[1024 + chan], w2 = p.conv_w[2048 + chan], w3 = p.conv_w[3072 + chan], cb = p.conv_b[chan];
    const LAS bf16_t* rp = (const LAS bf16_t*)(lds + off) + seg * 16 * ncols + col;
    float u[19];
#pragma unroll
    for (int k = 0; k < 19; ++k) u[k] = bf2f(rp[k * ncols]);
#pragma unroll
    for (int i = 0; i < 16; ++i) out[i] = silu_f(cb + w0 * u[i] + w1 * u[i + 1] + w2 * u[i + 2] + w3 * u[i + 3]);
}
template <int NCOLS, int NROWS> struct Stg { static constexpr int VPR = NCOLS / 8, NV = NROWS * VPR, NIT = (NV + NTHR - 1) / NTHR; };
template <int NCOLS, int NROWS>
__device__ __forceinline__ void stg_load(const bf16_t* src, int tid, int zrows, u32x4 (&r)[Stg<NCOLS, NROWS>::NIT]) {
    using S = Stg<NCOLS, NROWS>;
#pragma unroll
    for (int j = 0; j < S::NIT; ++j) { const int vi = tid + NTHR * j, row = vi / S::VPR, cv = vi % S::VPR;
        const bool ok = (vi < S::NV) && (row >= zrows);
        r[j] = ok ? *(const u32x4*)(src + (ptrdiff_t)row * LDP + cv * 8) : (u32x4){0u, 0u, 0u, 0u}; }
}
template <int NCOLS, int NROWS>
__device__ __forceinline__ void stg_store(LAS unsigned char* lds, int off, int tid, const u32x4 (&r)[Stg<NCOLS, NROWS>::NIT]) {
    using S = Stg<NCOLS, NROWS>;
#pragma unroll
    for (int j = 0; j < S::NIT; ++j) { const int vi = tid + NTHR * j; if (vi < S::NV) *(LAS u32x4*)(lds + off + vi * 16) = r[j]; }
}
__device__ __forceinline__ void store16(LAS unsigned char* lds, int byteoff, const float (&v)[16]) {
    u32x4 a, b; a.x = pk2(v[0], v[1]); a.y = pk2(v[2], v[3]); a.z = pk2(v[4], v[5]); a.w = pk2(v[6], v[7]);
    b.x = pk2(v[8], v[9]); b.y = pk2(v[10], v[11]); b.z = pk2(v[12], v[13]); b.w = pk2(v[14], v[15]);
    *(LAS u32x4*)(lds + byteoff) = a; *(LAS u32x4*)(lds + byteoff + 16) = b;
}
__device__ __forceinline__ void store8(LAS unsigned char* lds, int byteoff, const float (&v)[8]) {
    u32x4 a; a.x = pk2(v[0], v[1]); a.y = pk2(v[2], v[3]); a.z = pk2(v[4], v[5]); a.w = pk2(v[6], v[7]);
    *(LAS u32x4*)(lds + byteoff) = a;
}

template <int BR, int PASS>
__device__ __forceinline__ void mixer_unit(const MixP& p, LAS unsigned char* lds, int bc, int hu  ) {
    constexpr int DK = (BR == 3) ? 64 : 128, LDK = DK + 8, NH = (BR == 2) ? 4 : 1, DV = (BR == 2) ? 256 : 128, NT = DV / 128;
    constexpr bool VEC = (BR == 0 || BR == 3);
    const int tid = opaque_tid(), lane = tid & 63, wid = __builtin_amdgcn_readfirstlane(tid >> 6);
    const int chunk = bc & 63;
    const bf16_t* P = p.proj + (size_t)bc * 64 * LDP;
    LAS float* SM = (LAS float*)(lds + L_SM);
    LAS bf16_t* QI = (LAS bf16_t*)(lds + L_QI); LAS bf16_t* KI = (LAS bf16_t*)(lds + L_KI); LAS bf16_t* VT = (LAS bf16_t*)(lds + L_VT);
    const int st_off = (BR == 0) ? hu * 16384 : (BR == 1) ? 65536 + hu * 16384 : (BR == 2) ? 131072 + hu * 32768 : 196608 + hu * 8192;
    bf16_t* stg = p.st + (size_t)bc * ST_PER_BC + st_off;

    if constexpr (BR == 0) {
        constexpr int RQ = L_BIG, RF = (PASS == 3) ? L_BIG + 16384 : L_QI, RV = (PASS == 3) ? L_BIG + 32768 : L_QI + 16384;
        {
            u32x4 rf[2], rv[2], rq[2];
            stg_load<128, 64>(P + C_AF + hu * 128, tid, 0, rf); stg_load<128, 64>(P + C_AI + hu * 128, tid, 0, rv);
            if constexpr (PASS == 3) stg_load<128, 64>(P + C_AQ + hu * 128, tid, 0, rq);
            __builtin_amdgcn_sched_barrier(0);
            stg_store<128, 64>(lds, RF, tid, rf); stg_store<128, 64>(lds, RV, tid, rv);
            if constexpr (PASS == 3) stg_store<128, 64>(lds, RQ, tid, rq);
        }
        const int d = tid & 127, seg = tid >> 7, cc = hu * 128 + d;
        float lb = 0.f;
        if (p.layer == 1) lb = 1.f / (1.f + __expf(p.lbl[cc] - p.lbl[512 + cc]));
        __syncthreads();
        const LAS bf16_t* rF = (const LAS bf16_t*)(lds + RF) + seg * 16 * 128 + d;
        const LAS bf16_t* rQ = (const LAS bf16_t*)(lds + RQ) + seg * 16 * 128 + d;
        const LAS bf16_t* rV = (const LAS bf16_t*)(lds + RV) + seg * 16 * 128 + d;
        float cs[16], kk[16]; float run = 0.f;
#pragma unroll
        for (int i = 0; i < 16; ++i) { const float av = fmaxf(bf2f(rF[i * 128]), -60.f); const float e = __expf(-av), sg = __builtin_amdgcn_rcpf(1.f + e);
            const float f = lb + (1.f - lb) * sg; run += __logf(f); cs[i] = run; kk[i] = (1.f - lb) * e * sg; }
        SM[SM_SEG + seg * 128 + d] = run;
        __syncthreads();
        const float t0 = SM[SM_SEG + d], t1 = SM[SM_SEG + 128 + d], t2 = SM[SM_SEG + 256 + d], t3 = SM[SM_SEG + 384 + d];
        const float off = (seg == 0) ? 0.f : (seg == 1) ? t0 : (seg == 2) ? t0 + t1 : t0 + t1 + t2;
        const float ref = t0 + t1, clast = ref + t2 + t3;
        if (seg == 0) { SM[SM_REF + d] = ref; SM[SM_CLAST + d] = clast; }
        float kv[16];
#pragma unroll
        for (int i = 0; i < 16; ++i) { const float c = off + cs[i]; kv[i] = kk[i] * __expf(ref - c);
            if constexpr (PASS == 3) { KI[(seg * 16 + i) * LDK + d] = f2bf(kv[i]);
                const float q = bf2f(rQ[i * 128]); QI[(seg * 16 + i) * LDK + d] = f2bf(silu_f(q) * __expf(c - ref)); } }
        if constexpr (PASS == 1) store16(lds, L_BIG + (d * 72 + seg * 16) * 2, kv);
        unsigned vv[16];
#pragma unroll
        for (int i = 0; i < 16; ++i) vv[i] = rV[i * 128];
        u32x4 a, b; a.x = vv[0] | (vv[1] << 16); a.y = vv[2] | (vv[3] << 16); a.z = vv[4] | (vv[5] << 16); a.w = vv[6] | (vv[7] << 16);
        b.x = vv[8] | (vv[9] << 16); b.y = vv[10] | (vv[11] << 16); b.z = vv[12] | (vv[13] << 16); b.w = vv[14] | (vv[15] << 16);
        *(LAS u32x4*)(lds + L_VT + (d * 72 + seg * 16) * 2) = a; *(LAS u32x4*)(lds + L_VT + (d * 72 + seg * 16) * 2 + 16) = b;
    }
    if constexpr (BR == 1) {
        constexpr int RQ = L_BIG, RK = (PASS == 3) ? L_BIG + 16384 : L_QI, RV = (PASS == 3) ? L_BIG + 32768 : L_QI + 16384;
        const int j = tid & 63, seg = tid >> 6;
        float2 cssn[8];
        {
            u32x4 rk[2], rv[2], rq[2];
            stg_load<128, 64>(P + C_RK + hu * 128, tid, 0, rk); stg_load<128, 64>(P + C_RV + hu * 128, tid, 0, rv);
            if constexpr (PASS == 3) stg_load<128, 64>(P + C_RQ + hu * 128, tid, 0, rq);
#pragma unroll
            for (int i = 0; i < 8; ++i) cssn[i] = p.rope[(chunk * 64 + seg * 8 + i) * 64 + j];
            __builtin_amdgcn_sched_barrier(0);
            stg_store<128, 64>(lds, RK, tid, rk); stg_store<128, 64>(lds, RV, tid, rv);
            if constexpr (PASS == 3) stg_store<128, 64>(lds, RQ, tid, rq);
        }
        const float lg = log1pf(-exp2f(-(5.f + (float)hu)));
        if (tid < 64) { SM[SM_CUM + tid] = (float)(tid + 1) * lg; SM[SM_DT + tid] = 1.f; }
        __syncthreads();
        float k1[8], k2[8];
#pragma unroll
        for (int i = 0; i < 8; ++i) { const int t = seg * 8 + i;
            const LAS bf16_t* rk = (const LAS bf16_t*)(lds + RK) + t * 128 + j;
            const float ka = bf2f(rk[0]) * 0.08838834764831845f, kb = bf2f(rk[64]) * 0.08838834764831845f;
            k1[i] = ka * cssn[i].x - kb * cssn[i].y; k2[i] = ka * cssn[i].y + kb * cssn[i].x;
            if constexpr (PASS == 3) { const LAS bf16_t* rq = (const LAS bf16_t*)(lds + RQ) + t * 128 + j;
                const float qa = bf2f(rq[0]), qb = bf2f(rq[64]);
                QI[t * LDK + j] = f2bf(qa * cssn[i].x - qb * cssn[i].y); QI[t * LDK + j + 64] = f2bf(qa * cssn[i].y + qb * cssn[i].x);
                KI[t * LDK + j] = f2bf(k1[i]); KI[t * LDK + j + 64] = f2bf(k2[i]); } }
        if constexpr (PASS == 1) { store8(lds, L_BIG + (j * 72 + seg * 8) * 2, k1); store8(lds, L_BIG + ((j + 64) * 72 + seg * 8) * 2, k2); }
        const int v = tid & 127, s4 = tid >> 7; float vv[16];
#pragma unroll
        for (int i = 0; i < 16; ++i) { const int s = s4 * 16 + i; float x = bf2f(((const LAS bf16_t*)(lds + RV))[s * 128 + v]);
            if constexpr (PASS == 1) x *= __expf((float)(63 - s) * lg);
            vv[i] = x; }
        store16(lds, L_VT + (v * 72 + s4 * 16) * 2, vv);
    }
    if constexpr (BR == 2) {
        constexpr int RB = (PASS == 3) ? L_BIG : L_QI, RC = L_BIG + 17152, RX = (PASS == 3) ? L_BIG + 34304 : L_BIG + 18432;
        const int zr = (chunk == 0) ? 3 : 0;
        const bf16_t* P3 = P - 3 * (ptrdiff_t)LDP + C_XBC;
        float dtr[4] = {0.f, 0.f, 0.f, 0.f};
        {
            u32x4 rb[3], rx[5], rc[3];
            stg_load<128, 67>(P3 + 512 + hu * 128, tid, zr, rb); stg_load<256, 67>(P3 + hu * 256, tid, zr, rx);
            if constexpr (PASS == 3) stg_load<128, 67>(P3 + 768 + hu * 128, tid, zr, rc);
            if (tid < 64) {
#pragma unroll
                for (int hh = 0; hh < 4; ++hh) dtr[hh] = bf2f(P[(size_t)tid * LDP + C_DT + hu * 4 + hh]);
            }
            __builtin_amdgcn_sched_barrier(0);
            stg_store<128, 67>(lds, RB, tid, rb); stg_store<256, 67>(lds, RX, tid, rx);
            if constexpr (PASS == 3) stg_store<128, 67>(lds, RC, tid, rc);
        }
        if (tid < 64) {
#pragma unroll
            for (int hh = 0; hh < 4; ++hh) { const int head = hu * 4 + hh;
                const float dt = softplus_f(dtr[hh] + p.dt_bias[head]);
                float la = -dt * __expf(p.a_log[head]);
#pragma unroll
                for (int o = 1; o < 64; o <<= 1) { const float yv = __shfl_up(la, o); if (tid >= o) la += yv; }
                SM[SM_CUM + hh * 64 + tid] = la; SM[SM_DT + hh * 64 + tid] = dt; }
        }
        __syncthreads();
        { const int n = tid & 127, seg = tid >> 7; float o[16];
          conv16(p, lds, RB, 128, n, 512 + hu * 128 + n, seg, o);
          if constexpr (PASS == 3) {
#pragma unroll
              for (int i = 0; i < 16; ++i) KI[(seg * 16 + i) * LDK + n] = f2bf(o[i]);
              conv16(p, lds, RC, 128, n, 768 + hu * 128 + n, seg, o);
#pragma unroll
              for (int i = 0; i < 16; ++i) QI[(seg * 16 + i) * LDK + n] = f2bf(o[i]);
          } else store16(lds, L_BIG + (n * 72 + seg * 16) * 2, o);
        }
        { const int v = tid & 255, s2 = tid >> 8, hh = v >> 6;
#pragma unroll
          for (int r = 0; r < 2; ++r) { const int seg = s2 * 2 + r; float o[16];
              conv16(p, lds, RX, 256, v, hu * 256 + v, seg, o);
              if constexpr (PASS == 1) { const float cl = SM[SM_CUM + hh * 64 + 63];
#pragma unroll
                  for (int i = 0; i < 16; ++i) { const int s = seg * 16 + i; o[i] *= __expf(cl - SM[SM_CUM + hh * 64 + s]) * SM[SM_DT + hh * 64 + s]; } }
              store16(lds, L_VT + (v * 72 + seg * 16) * 2, o); }
        }
    }
    if constexpr (BR == 3) {
        constexpr int RQ = L_BIG, RK = (PASS == 3) ? L_BIG + 8192 : L_QI, RV = (PASS == 3) ? L_BIG + 16384 : L_QI + 8192, RL = (PASS == 3) ? L_BIG + 32768 : L_QI + 24576;
        const int d = tid & 63, seg = tid >> 6, cc = hu * 64 + d;
        float w2r[16];
        {
            u32x4 rk[1], rv[2], rl[1], rq[1];
            stg_load<64, 64>(P + C_GK + hu * 64, tid, 0, rk); stg_load<128, 64>(P + C_GV + hu * 128, tid, 0, rv); stg_load<16, 64>(P + C_LR, tid, 0, rl);
            if constexpr (PASS == 3) stg_load<64, 64>(P + C_GQ + hu * 64, tid, 0, rq);
#pragma unroll
            for (int r = 0; r < 16; ++r) w2r[r] = p.w2[r * 256 + cc];
            __builtin_amdgcn_sched_barrier(0);
            stg_store<64, 64>(lds, RK, tid, rk); stg_store<128, 64>(lds, RV, tid, rv); stg_store<16, 64>(lds, RL, tid, rl);
            if constexpr (PASS == 3) stg_store<64, 64>(lds, RQ, tid, rq);
        }
        const float bb = p.b2[cc];
        __syncthreads();
        float cs[8]; float run = 0.f;
#pragma unroll
        for (int i = 0; i < 8; ++i) { const int t = seg * 8 + i; const LAS bf16x8* lp = (const LAS bf16x8*)(lds + RL + t * 32);
            const bf16x8 l0 = lp[0], l1 = lp[1]; float gk = bb;
#pragma unroll
            for (int r = 0; r < 8; ++r) { gk += w2r[r] * bf2f((bf16_t)l0[r]); gk += w2r[8 + r] * bf2f((bf16_t)l1[r]); }
            run += logsig_f(gk) * (1.f / 16.f); cs[i] = run; }
        SM[SM_SEG + seg * 64 + d] = run;
        __syncthreads();
        float off = 0.f, ref = 0.f, clast = 0.f;
#pragma unroll
        for (int s = 0; s < 8; ++s) { const float tv = SM[SM_SEG + s * 64 + d]; if (s < seg) off += tv; if (s < 4) ref += tv; clast += tv; }
        if (seg == 0) { SM[SM_REF + d] = ref; SM[SM_CLAST + d] = clast; }
        float kv[8];
#pragma unroll
        for (int i = 0; i < 8; ++i) { const int t = seg * 8 + i; const float c = off + cs[i];
            kv[i] = bf2f(((const LAS bf16_t*)(lds + RK))[t * 64 + d]) * __expf(ref - c);
            if constexpr (PASS == 3) { KI[t * LDK + d] = f2bf(kv[i]); QI[t * LDK + d] = f2bf(bf2f(((const LAS bf16_t*)(lds + RQ))[t * 64 + d]) * 0.125f * __expf(c - ref)); } }
        if constexpr (PASS == 1) store8(lds, L_BIG + (d * 72 + seg * 8) * 2, kv);
        const int v = tid & 127, s4 = tid >> 7; unsigned vv[16];
#pragma unroll
        for (int i = 0; i < 16; ++i) vv[i] = ((const LAS bf16_t*)(lds + RV))[(s4 * 16 + i) * 128 + v];
        u32x4 a, b; a.x = vv[0] | (vv[1] << 16); a.y = vv[2] | (vv[3] << 16); a.z = vv[4] | (vv[5] << 16); a.w = vv[6] | (vv[7] << 16);
        b.x = vv[8] | (vv[9] << 16); b.y = vv[10] | (vv[11] << 16); b.z = vv[12] | (vv[13] << 16); b.w = vv[14] | (vv[15] << 16);
        *(LAS u32x4*)(lds + L_VT + (v * 72 + s4 * 16) * 2) = a; *(LAS u32x4*)(lds + L_VT + (v * 72 + s4 * 16) * 2 + 16) = b;
    }
    __syncthreads();

    if constexpr (PASS == 1) {
        constexpr int NTN = DV / 32, NTILES = (DK / 32) * NTN;
#pragma unroll
        for (int i = 0; i < NTILES / 8; ++i) {
            const int ti = wid + 8 * i, tm = ti / NTN, tn = ti % NTN;
            f32x16 acc;
#pragma unroll
            for (int r = 0; r < 16; ++r) acc[r] = 0.f;
#pragma unroll
            for (int ks = 0; ks < 4; ++ks) acc = __builtin_amdgcn_mfma_f32_32x32x16_bf16(frag(lds, L_BIG, 72, tm * 32, ks, lane), frag(lds, L_VT, 72, tn * 32, ks, lane), acc, 0, 0, 0);
            const int v = tn * 32 + (lane & 31);
#pragma unroll
            for (int rg = 0; rg < 4; ++rg) { const int d0 = tm * 32 + 8 * rg + 4 * (lane >> 5);
                float o[4];
#pragma unroll
                for (int q = 0; q < 4; ++q) { o[q] = acc[rg * 4 + q]; if constexpr (VEC) o[q] *= __expf(SM[SM_CLAST + d0 + q] - SM[SM_REF + d0 + q]); }
                u32x2 w; w.x = pk2(o[0], o[1]); w.y = pk2(o[2], o[3]);
                *(u32x2*)(stg + (size_t)v * DK + d0) = w; }
        }
        float* dec = p.dec + (size_t)bc * 1024;
        if constexpr (BR == 0) { if (tid < 128) dec[hu * 128 + tid] = __expf(SM[SM_CLAST + tid]); }
        if constexpr (BR == 3) { if (tid < 64) dec[512 + hu * 64 + tid] = __expf(SM[SM_CLAST + tid]); }
        if constexpr (BR == 2) { if (tid < 4) dec[768 + hu * 4 + tid] = __expf(SM[SM_CUM + tid * 64 + 63]); }
        __syncthreads();
    } else {
        constexpr int NCT = DV / 32;
        const int gcol = (BR == 0) ? C_AG + hu * 128 : (BR == 1) ? C_RG + hu * 128 : (BR == 2) ? C_MZ + hu * 256 : C_GG + hu * 128;
        bf16_t gt[NT][16];
#pragma unroll
        for (int nt = 0; nt < NT; ++nt)
#pragma unroll
            for (int r = 0; r < 16; ++r) gt[nt][r] = P[(size_t)((wid >> 2) * 32 + rowmap(r, lane)) * LDP + gcol + ((wid & 3) + 4 * nt) * 32 + (lane & 31)];
        __builtin_amdgcn_sched_barrier(0);
        {
            constexpr int NVEC = DV * DK / 8, VPR = DK / 8;
            for (int vi = tid; vi < NVEC; vi += NTHR) { const int v = vi / VPR, d0 = (vi % VPR) * 8;
                u32x4 raw = *(const u32x4*)(stg + (size_t)vi * 8);
                if constexpr (VEC) { unsigned w[4] = {raw.x, raw.y, raw.z, raw.w};
#pragma unroll
                    for (int q = 0; q < 4; ++q) { const float lo = __uint_as_float(w[q] << 16) * __expf(SM[SM_REF + d0 + 2 * q]), hi = __uint_as_float(w[q] & 0xffff0000u) * __expf(SM[SM_REF + d0 + 2 * q + 1]);
                        w[q] = pk2(lo, hi); }
                    raw.x = w[0]; raw.y = w[1]; raw.z = w[2]; raw.w = w[3]; }
                *(LAS u32x4*)(lds + L_BIG + (v * LDK + d0) * 2) = raw; }
        }
        __syncthreads();
        const int tm = wid >> 2, tnb = wid & 3;
        f32x16 acc[NT];
#pragma unroll
        for (int nt = 0; nt < NT; ++nt)
#pragma unroll
            for (int r = 0; r < 16; ++r) acc[nt][r] = 0.f;
#pragma unroll
        for (int ks = 0; ks < DK / 16; ++ks) { const bf16x8 af = frag(lds, L_QI, LDK, tm * 32, ks, lane);
#pragma unroll
            for (int nt = 0; nt < NT; ++nt) acc[nt] = __builtin_amdgcn_mfma_f32_32x32x16_bf16(af, frag(lds, L_BIG, LDK, (tnb + 4 * nt) * 32, ks, lane), acc[nt], 0, 0, 0); }
        if constexpr (!VEC) {
#pragma unroll
            for (int nt = 0; nt < NT; ++nt) { const int hh = (NH == 1) ? 0 : ((tnb + 4 * nt) >> 1);
#pragma unroll
                for (int r = 0; r < 16; ++r) acc[nt][r] *= __expf(SM[SM_CUM + hh * 64 + tm * 32 + rowmap(r, lane)]); }
        }
        f32x16 sc;
#pragma unroll
        for (int r = 0; r < 16; ++r) sc[r] = 0.f;
        const int stm = wid >> 1, stn = wid & 1;
        if (wid < 4) {
#pragma unroll
            for (int ks = 0; ks < DK / 16; ++ks) sc = __builtin_amdgcn_mfma_f32_32x32x16_bf16(frag(lds, L_QI, LDK, stm * 32, ks, lane), frag(lds, L_KI, LDK, stn * 32, ks, lane), sc, 0, 0, 0);
        }
        __syncthreads();
        if (wid < 4) {
            const int s = stn * 32 + (lane & 31);
#pragma unroll
            for (int hh = 0; hh < NH; ++hh) {
                float cums = 0.f, dts = 1.f;
                if constexpr (!VEC) { cums = SM[SM_CUM + hh * 64 + s]; dts = SM[SM_DT + hh * 64 + s]; }
#pragma unroll
                for (int r = 0; r < 16; ++r) { const int t = stm * 32 + rowmap(r, lane);
                    float val = sc[r];
                    if constexpr (!VEC) { const float ex = (s <= t) ? SM[SM_CUM + hh * 64 + t] - cums : 0.f; val *= __expf(ex) * dts; }
                    val = (s <= t) ? val : 0.f;
                    *(LAS bf16_t*)(lds + L_BIG + ((hh * 64 + t) * 72 + s) * 2) = f2bf(val); }
            }
        }
        __syncthreads();
#pragma unroll
        for (int nt = 0; nt < NT; ++nt) { const int hh = (NH == 1) ? 0 : ((tnb + 4 * nt) >> 1);
#pragma unroll
            for (int ks = 0; ks < 4; ++ks) acc[nt] = __builtin_amdgcn_mfma_f32_32x32x16_bf16(frag(lds, L_BIG + hh * 9216, 72, tm * 32, ks, lane), frag(lds, L_VT, 72, (tnb + 4 * nt) * 32, ks, lane), acc[nt], 0, 0, 0); }
        const int ycol = (BR == 0) ? hu * 128 : (BR == 1) ? 512 + hu * 128 : (BR == 2) ? 1024 + hu * 256 : 1536 + hu * 128;
        const float* gain = (BR == 0) ? p.hgrn_g + hu * 128 : (BR == 1) ? p.ret_g + hu * 128 : (BR == 2) ? p.ssm_g + hu * 256 : p.gla_g + hu * 128;
#pragma unroll
        for (int nt = 0; nt < NT; ++nt) { const int ct = tnb + 4 * nt, v = ct * 32 + (lane & 31);
            float dsk = 0.f; if constexpr (BR == 2) dsk = p.dskip[hu * 4 + (ct >> 1)];
#pragma unroll
            for (int r = 0; r < 16; ++r) { const int t = tm * 32 + rowmap(r, lane);
                float val = acc[nt][r];
                if constexpr (BR == 2) { val = (val + dsk * bf2f(VT[v * 72 + t])) * silu_f(bf2f(gt[nt][r])); acc[nt][r] = val; }
                float sq = val * val;
#pragma unroll
                for (int o = 16; o > 0; o >>= 1) sq += __shfl_xor(sq, o);
                if ((lane & 31) == 0) SM[SM_RSS + ct * 64 + t] = sq; }
        }
        __syncthreads();
#pragma unroll
        for (int nt = 0; nt < NT; ++nt) { const int ct = tnb + 4 * nt, v = ct * 32 + (lane & 31);
            const float gn = gain[v];
#pragma unroll
            for (int r = 0; r < 16; ++r) { const int t = tm * 32 + rowmap(r, lane);
                float tot = 0.f;
#pragma unroll
                for (int q = 0; q < NCT; ++q) tot += SM[SM_RSS + q * 64 + t];
                float o = acc[nt][r] * rsqrtf(tot * (1.f / DV) + EPS) * gn;
                if constexpr (BR != 2) o *= silu_f(bf2f(gt[nt][r]));
                p.y[(size_t)(bc * 64 + t) * DI + ycol + v] = f2bf(o); }
        }
        __syncthreads();
    }
}

template <int PASS>
__device__ __forceinline__ void phase_mixer(const MixP& p, LAS unsigned char* lds) {
#pragma unroll 1
    for (int i = blockIdx.x; i < 128 * 14; i += gridDim.x) {
        const int bc = i / 14, u = i % 14;
        if (u < 4) mixer_unit<0, PASS>(p, lds, bc, u);
        else if (u < 8) mixer_unit<1, PASS>(p, lds, bc, u - 4);
        else if (u < 10) mixer_unit<2, PASS>(p, lds, bc, u - 8);
        else mixer_unit<3, PASS>(p, lds, bc, u - 10);
    }
}

__device__ __forceinline__ void phase_scan(bf16_t* st, const float* dec) {
    const int gt = blockIdx.x * NTHR + opaque_tid();
    constexpr int VPB = ST_PER_BC / 4;
    if (gt >= 2 * VPB) return;
    const int bl = gt / VPB, e0 = (gt % VPB) * 4;
    int mode, didx = 0; float cfac = 0.f;
    if (e0 < 65536) { mode = 0; didx = (e0 >> 14) * 128 + (e0 & 127); }
    else if (e0 < 131072) { mode = 1; const int h = (e0 - 65536) >> 14; cfac = __expf(64.f * log1pf(-exp2f(-(5.f + (float)h)))); }
    else if (e0 < 196608) { mode = 2; const int r = e0 - 131072; didx = 768 + (r >> 15) * 4 + (((r & 32767) >> 7) >> 6); }
    else { mode = 0; const int r = e0 - 196608; didx = 512 + (r >> 13) * 64 + (r & 63); }
    float s0 = 0.f, s1 = 0.f, s2 = 0.f, s3 = 0.f;
    bf16_t* ptr = st + (size_t)bl * 64 * ST_PER_BC + e0;
    const float* dp = dec + (size_t)bl * 64 * 1024 + didx;
#pragma unroll 1
    for (int c0 = 0; c0 < 64; c0 += 8) {
        u32x2 hv[8]; f32x4 dv[8];
#pragma unroll
        for (int j = 0; j < 8; ++j) {
            hv[j] = *(const u32x2*)(ptr + (size_t)(c0 + j) * ST_PER_BC);
            if (mode == 0) dv[j] = *(const f32x4*)(dp + (size_t)(c0 + j) * 1024);
            else if (mode == 1) dv[j] = (f32x4){cfac, cfac, cfac, cfac};
            else { const float d = dp[(size_t)(c0 + j) * 1024]; dv[j] = (f32x4){d, d, d, d}; }
        }
        __builtin_amdgcn_sched_barrier(0);
#pragma unroll
        for (int j = 0; j < 8; ++j) {
            u32x2 w; w.x = pk2(s0, s1); w.y = pk2(s2, s3);
            *(u32x2*)(ptr + (size_t)(c0 + j) * ST_PER_BC) = w;
            s0 = s0 * dv[j][0] + __uint_as_float(hv[j].x << 16); s1 = s1 * dv[j][1] + __uint_as_float(hv[j].x & 0xffff0000u);
            s2 = s2 * dv[j][2] + __uint_as_float(hv[j].y << 16); s3 = s3 * dv[j][3] + __uint_as_float(hv[j].y & 0xffff0000u);
        }
    }
}


#define XB_TMO      128
#define XB_XCNT(j)  (256  + 64 * (j))
#define XB_XSUB(j)  (1280 + 64 * (j))
#define XB_XGEN(j)  (2304 + 64 * (j))
#define XB_TOP      3328
#define XB_TOPGEN   3392
#define XCD_BAR_WORDS 3456
#define XB_SPIN_CAP (1u << 18)
__device__ __forceinline__ unsigned xb_ld(unsigned* p)              { return __hip_atomic_load(p, __ATOMIC_RELAXED, __HIP_MEMORY_SCOPE_AGENT); }
__device__ __forceinline__ unsigned xb_add(unsigned* p, unsigned v) { return __hip_atomic_fetch_add(p, v, __ATOMIC_RELAXED, __HIP_MEMORY_SCOPE_AGENT); }
__device__ __forceinline__ unsigned xb_xcc_id() { return (unsigned)__builtin_amdgcn_s_getreg((3 << 11) | 20) & 0xFu; }
#define XB_SPIN(cond, bar) do { unsigned _sp = 0; while (cond) { __builtin_amdgcn_s_sleep(1); \
    if ((++_sp & 255u) == 0u) { if (xb_ld(&(bar)[XB_TMO])) break; if (_sp > XB_SPIN_CAP) { atomicAdd(&(bar)[XB_TMO], 1u); break; } } } } while (0)
struct XcdBarrier { unsigned* bar; unsigned x; volatile LAS unsigned* st; };
__device__ __forceinline__ XcdBarrier xcd_barrier_post(unsigned* bar, volatile LAS unsigned* st) {
    XcdBarrier b; b.bar = bar; b.x = xb_xcc_id(); b.st = st;
    if (threadIdx.x == 0) (void)xb_add(&bar[XB_XCNT(b.x)], 1u);
    return b;
}
__device__ __forceinline__ void xcd_barrier_complete(unsigned* bar, unsigned x, unsigned& nloc, unsigned& nx) {
    const unsigned G = gridDim.x * gridDim.y * gridDim.z;
    unsigned sum, cnt, mine, sp = 0u;
    for (;;) {
        sum = 0u; cnt = 0u; mine = 0u;
#pragma unroll
        for (unsigned j = 0; j < 16; ++j) { const unsigned c = xb_ld(&bar[XB_XCNT(j)]); sum += c; cnt += (c > 0u) ? 1u : 0u; mine = (j == x) ? c : mine; }
        if (sum == G) break;
        __builtin_amdgcn_s_sleep(1);
        if ((++sp & 255u) == 0u) { if (xb_ld(&bar[XB_TMO])) break; if (sp > XB_SPIN_CAP) { atomicAdd(&bar[XB_TMO], 1u); break; } }
    }
    nloc = mine > 0u ? mine : 1u; nx = cnt > 0u ? cnt : 1u;
}
__device__ __forceinline__ void xcd_barrier(const XcdBarrier& b) {
    asm volatile("s_waitcnt vmcnt(0)" ::: "memory");
    __syncthreads();
    if (threadIdx.x == 0) {
        unsigned* bar = b.bar;
        __builtin_amdgcn_s_waitcnt(0);
        unsigned nloc = b.st[0], nx = b.st[1];
        if (nloc == 0u) { xcd_barrier_complete(bar, b.x, nloc, nx); b.st[0] = nloc; b.st[1] = nx; }
        const unsigned old = xb_add(&bar[XB_XSUB(b.x)], 1u);
        const unsigned gen = old / nloc;
        if (old + 1u == (gen + 1u) * nloc) {
            __builtin_amdgcn_fence(__ATOMIC_RELEASE, "agent");
            asm volatile("s_waitcnt vmcnt(0)" ::: "memory");
            const unsigned og = xb_add(&bar[XB_TOP], 1u);
            const unsigned tg = og / nx;
            if (og + 1u == (tg + 1u) * nx) xb_add(&bar[XB_TOPGEN], 1u);
            else XB_SPIN(xb_ld(&bar[XB_TOPGEN]) == tg, bar);
            __builtin_amdgcn_fence(__ATOMIC_ACQUIRE, "agent");
            xb_add(&bar[XB_XGEN(b.x)], 1u);
            asm volatile("s_waitcnt vmcnt(0)" ::: "memory");
        } else {
            XB_SPIN(xb_ld(&bar[XB_XGEN(b.x)]) == gen, bar);
            __builtin_amdgcn_fence(__ATOMIC_ACQUIRE, "agent");
            asm volatile("s_waitcnt vmcnt(0)" ::: "memory");
        }
    }
    __syncthreads();
}

__global__ void __launch_bounds__(NTHR, 2) fwd_megakernel(Args a) {
    extern __shared__ __attribute__((aligned(16))) unsigned char shm[];
    LAS unsigned char* lds = (LAS unsigned char*)shm;
    cg::grid_group grid = cg::this_grid();
    unsigned char* ws = a.ws;
    const int G = gridDim.x;

    {
        volatile LAS unsigned* stw = (volatile LAS unsigned*)(lds + L_BARST);
        if (threadIdx.x < 2) stw[threadIdx.x] = 0u;
        __syncthreads();
    }
    const XcdBarrier gbar = xcd_barrier_post((unsigned*)(ws + WS_BAR), (volatile LAS unsigned*)(lds + L_BARST));
    for (int rep = 0; rep < REP_PREP; ++rep) { phase_prep(a, lds); if (rep == 0) grid.sync(); else xcd_barrier(gbar); }

    bf16_t* hbuf = (bf16_t*)(ws + WS_HY); bf16_t* ybuf = (bf16_t*)(ws + WS_HY);
    bf16_t* proj = (bf16_t*)(ws + WS_PROJ); bf16_t* st = (bf16_t*)(ws + WS_ST); float* dec = (float*)(ws + WS_DEC);
    const float* mod = (const float*)(ws + WS_MOD);

#pragma unroll 1
    for (int half = 0; half < 2; ++half) {
        const size_t xoff = (size_t)half * HROWS * DM;
#pragma unroll 1
        for (int l = 0; l < DEPTH; ++l) {
            const float* xin = (l == 0) ? a.x + xoff : a.out + xoff;
            const float* modl = mod + (size_t)l * 4 * 3072;
            for (int rep = 0; rep < REP_NORM; ++rep) { phase_norm(xin, a.norm_g + l * DM, modl, half, hbuf); xcd_barrier(gbar); }
            for (int rep = 0; rep < REP_G1; ++rep) {
                pg8::Gemm g{hbuf, (const bf16_t*)(ws + WS_WIN) + (size_t)l * LDP * DM, HROWS, LDP, DM};
                pg8::StaticOrder S; S.init(HROWS, LDP, G, (int)blockIdx.x);
                pg8::EpiProj E{proj, LDP};
                pg8::gemm_phase<pg8::EpiProj, pg8::StaticOrder>(lds, g, S, E);
                xcd_barrier(gbar);
            }
            MixP p;
            p.proj = proj; p.st = st; p.dec = dec; p.y = ybuf; p.rope = (const float2*)(ws + WS_ROPE);
            p.lbl = a.lb_logits; p.hgrn_g = a.hgrn_g + l * 512; p.ret_g = a.ret_g + l * 512; p.conv_w = a.conv_w + l * 4096; p.conv_b = a.conv_b + l * 1024;
            p.dt_bias = a.dt_bias + l * 8; p.a_log = a.a_log + l * 8; p.dskip = a.dskip + l * 8; p.ssm_g = a.ssm_g + l * 512;
            p.w2 = a.w_gk2 + l * 16 * 256; p.b2 = a.b_gk2 + l * 256; p.gla_g = a.gla_g + l * 512; p.layer = l;
            for (int rep = 0; rep < REP_M12; ++rep) { phase_mixer<1>(p, lds); xcd_barrier(gbar); phase_scan(st, dec); xcd_barrier(gbar); }
            for (int rep = 0; rep < REP_M3; ++rep) { phase_mixer<3>(p, lds); xcd_barrier(gbar); }
            for (int rep = 0; rep < ((l == 0) ? REP_G2 : 1); ++rep) {
                pg8::Gemm g{ybuf, (const bf16_t*)(ws + WS_WOUT) + (size_t)l * DM * DI, HROWS, DM, DI};
                pg8::StaticOrder S; S.init(HROWS, DM, G, (int)blockIdx.x);
                pg8::EpiRes E{xin, a.out + xoff, modl + (size_t)(half * 2) * 3072 + 2048};
                pg8::gemm_phase<pg8::EpiRes, pg8::StaticOrder>(lds, g, S, E);
                xcd_barrier(gbar);
            }
        }
        phase_final(a.out + xoff, a.final_g);
    }
}

extern "C" void kernel_launch(void* const* d_in, const int* in_sizes, int n_in, void* d_out, int out_size, void* d_ws, size_t ws_size, hipStream_t stream) {
    static int grid = 0;
    if (grid == 0) {
        if (n_in != 20 || ws_size < WS_END) { fprintf(stderr, "kernel_launch: unexpected n_in %d / ws_size %zu (need %zu)\n", n_in, ws_size, (size_t)WS_END); grid = -1; return; }
        int dev = 0, cus = 0, per_cu = 0;
        hipGetDevice(&dev);
        hipDeviceGetAttribute(&cus, hipDeviceAttributeMultiprocessorCount, dev);
        if (hipFuncSetAttribute((const void*)fwd_megakernel, hipFuncAttributeMaxDynamicSharedMemorySize, LDS_BYTES) != hipSuccess) { fprintf(stderr, "kernel_launch: hipFuncSetAttribute failed\n"); grid = -1; return; }
        hipOccupancyMaxActiveBlocksPerMultiprocessor(&per_cu, (const void*)fwd_megakernel, NTHR, LDS_BYTES);
        if (per_cu < 1) { fprintf(stderr, "kernel_launch: occupancy query says %d blocks per CU\n", per_cu); per_cu = 1; }
        (void)hipGetLastError();
        grid = cus * per_cu;
    }
    if (grid < 0) return;
    Args a{};
    const float** f = (const float**)&a;
    for (int i = 0; i < 20; ++i) f[i] = (const float*)d_in[i];
    a.out = (float*)d_out; a.ws = (unsigned char*)d_ws;
    void* args[] = {&a};
    if (hipMemsetAsync((char*)d_ws + WS_BAR, 0, XCD_BAR_WORDS * 4, stream) != hipSuccess) { fprintf(stderr, "kernel_launch: memset of barrier words failed\n"); return; }
    hipError_t e = hipLaunchCooperativeKernel((const void*)fwd_megakernel, dim3(grid), dim3(NTHR), args, LDS_BYTES, stream);
    if (e != hipSuccess) fprintf(stderr, "cooperative launch failed: %s (grid %d)\n", hipGetErrorString(e), grid);
}
```

```cpp
#include <hip/hip_runtime.h>
#include <hip/hip_cooperative_groups.h>
#include <cstdio>
namespace cg = cooperative_groups;

#define LAS __attribute__((address_space(3)))
typedef unsigned short bf16_t;
typedef short bf16x8 __attribute__((ext_vector_type(8)));
typedef float f32x4 __attribute__((ext_vector_type(4)));
typedef float f32x16 __attribute__((ext_vector_type(16)));
typedef unsigned u32x4 __attribute__((ext_vector_type(4)));
typedef unsigned u32x2 __attribute__((ext_vector_type(2)));

#ifndef REP_PREP
#define REP_PREP 1
#endif
#ifndef REP_NORM
#define REP_NORM 1
#endif
#ifndef REP_G1
#define REP_G1 1
#endif
#ifndef REP_M12
#define REP_M12 1
#endif
#ifndef REP_M3
#define REP_M3 1
#endif
#ifndef REP_G2
#define REP_G2 1
#endif
#ifndef REP_UPREP
#define REP_UPREP 1
#endif
#ifndef REP_UCORE
#define REP_UCORE 1
#endif
constexpr int NB = 4, SEQ = 4096, DM = 1024, DEPTH = 2, DI = 2048;
constexpr int NIN = 7192, LDP = 7424;
constexpr int HROWS = 8192;
constexpr int NTHR = 512;
constexpr float EPS = 1e-6f;
constexpr int C_AQ = 0, C_AF = 512, C_AI = 1024, C_AG = 1536, C_RQ = 2048, C_RK = 2560, C_RV = 3072, C_RG = 3584,
              C_MZ = 4096, C_XBC = 4608, C_DT = 5632, C_GQ = 5640, C_GK = 5896, C_GV = 6152, C_GG = 6664, C_LR = 7176;
constexpr int ST_PER_BC = 229376;
constexpr size_t WS_WIN = 0;
constexpr size_t WS_WOUT = WS_WIN + 2ull * LDP * DM * 2;
constexpr size_t WS_MOD = WS_WOUT + 2ull * DM * DI * 2;
constexpr size_t WS_ROPE = WS_MOD + 2ull * 4 * 3072 * 4;
constexpr size_t WS_DEC = WS_ROPE + 4096ull * 64 * 8;
constexpr size_t WS_HY = WS_DEC + 128ull * 1024 * 4;
constexpr size_t WS_PROJ = WS_HY + (size_t)HROWS * DI * 2;
constexpr size_t WS_ST = WS_PROJ + (size_t)HROWS * LDP * 2;
constexpr size_t WS_BAR = WS_ST + 128ull * ST_PER_BC * 2;
constexpr size_t WS_END = WS_BAR + 3456 * 4;
constexpr int L_QI = 0, L_KI = 17408, L_VT = 34816, L_BIG = 71680, L_SM = 141312;
constexpr int SM_CUM = 0, SM_DT = 256, SM_SEG = 512, SM_REF = 1536, SM_CLAST = 1664, SM_RSS = 1792;
constexpr int L_BARST = L_SM + (1792 + 512) * 4;
constexpr int LDS_BYTES = L_BARST + 16;

__device__ __forceinline__ float bf2f(bf16_t v) { return __uint_as_float(((unsigned)v) << 16); }
__device__ __forceinline__ bf16_t f2bf(float f) { unsigned u = __float_as_uint(f); u += 0x7FFFu + ((u >> 16) & 1u); return (bf16_t)(u >> 16); }
typedef float f32x2_t __attribute__((ext_vector_type(2)));
typedef __bf16 bf16x2_t __attribute__((ext_vector_type(2)));
__device__ __forceinline__ unsigned pk2(float lo, float hi) { f32x2_t v = {lo, hi}; bf16x2_t b = __builtin_convertvector(v, bf16x2_t); return __builtin_bit_cast(unsigned, b); }
__device__ __forceinline__ int opaque_tid() { int t = threadIdx.x; asm volatile("" : "+v"(t)); return t; }
__device__ __forceinline__ float silu_f(float x) { return x * __builtin_amdgcn_rcpf(1.f + __expf(-x)); }
__device__ __forceinline__ float softplus_f(float x) { return fmaxf(x, 0.f) + __logf(1.f + __expf(-fabsf(x))); }
__device__ __forceinline__ float logsig_f(float x) { return fminf(x, 0.f) - __logf(1.f + __expf(-fabsf(x))); }

namespace pg8 {
constexpr int BM = 256, BK = 64, HALF = 128, HTB = HALF * BK * 2, STAGE_BYTES = 8 * HTB, NXCD = 8, WGM = 8;
__device__ __forceinline__ int lds_byte(int r, int c) { const int st = (r >> 4) * 2 + (c >> 5), rr = r & 15, cc = c & 31, ob = rr * 64 + cc * 2; return st * 1024 + (ob ^ (((ob >> 9) & 1) << 5)); }
__device__ __forceinline__ void stage_rc(int b, int& R, int& C) { const int st = b / 1024, sb = b % 1024, swz = sb ^ (((sb >> 9) & 1) << 5); R = (st >> 1) * 16 + swz / 64; C = (st & 1) * 32 + (swz % 64) / 2; }
__device__ __forceinline__ int perm32(int rho) { const int n = rho >> 4, i = rho & 15; return 8 * (i >> 2) + 4 * n + (i & 3); }
struct Unit { int pm, pn, kh; };
struct Gemm { const bf16_t* A; const bf16_t* Bt; int M, N, K, ld; };
struct StaticOrder {
    int nM, nN, nwg, G, c;
    __device__ void init(int M, int N, int G_, int c_) { nM = M / BM; nN = N / BM; nwg = nM * nN; G = G_; c = c_; }
    __device__ bool next(int i, Unit& u) const {
        const long L = (long)i * G + c; if (L >= nwg) return false;
        int wgid = (int)L; { const int q = nwg / NXCD, r = nwg % NXCD, xcd = wgid % NXCD, off = wgid / NXCD; wgid = (xcd < r ? xcd * (q + 1) : r * (q + 1) + (xcd - r) * q) + off; }
        const int nig = WGM * nN, gid = wgid / nig, fm = gid * WGM, gsz = (nM - fm) < WGM ? (nM - fm) : WGM;
        u.pm = fm + ((wgid % nig) % gsz); u.pn = (wgid % nig) / gsz; u.kh = 0; return true;
    }
};
struct SplitOrder {
    StaticOrder so;
    __device__ void init(int M, int N, int G_, int c_) { so.init(M, 2 * N, G_, c_); }
    __device__ bool next(int i, Unit& u) const { if (!so.next(i, u)) return false; u.kh = u.pn & 1; u.pn >>= 1; return true; }
};
struct EpiProj {
    static constexpr bool PERM = true;
    bf16_t* O; int ldc;
    __device__ __forceinline__ void operator()(const f32x4 (&acc)[2][2][4][2], const Unit& u, int wr, int wc, int fr, int fq) const {
        const int row0 = u.pm * BM + wr * 64 + fr, col0 = u.pn * BM + wc * 32 + 8 * fq;
#pragma unroll
        for (int ai = 0; ai < 2; ++ai)
#pragma unroll
            for (int m = 0; m < 4; ++m) { bf16_t* rowp = O + (size_t)(row0 + ai * HALF + m * 16) * ldc + col0;
#pragma unroll
                for (int bj = 0; bj < 2; ++bj) { const f32x4 v0 = acc[ai][bj][m][0], v1 = acc[ai][bj][m][1];
                    u32x4 w; w.x = pk2(v0[0], v0[1]); w.y = pk2(v0[2], v0[3]); w.z = pk2(v1[0], v1[1]); w.w = pk2(v1[2], v1[3]);
                    *(u32x4*)(rowp + bj * HALF) = w; } }
    }
};
struct EpiRes {
    static constexpr bool PERM = false;
    const float* xin; float* xout; const float* gate;
    __device__ __forceinline__ void operator()(const f32x4 (&acc)[2][2][4][2], const Unit& u, int wr, int wc, int fr, int fq) const {
        const int row0 = u.pm * BM + wr * 64 + fr, col0 = u.pn * BM + wc * 32 + 4 * fq;
        const float* gp = gate + (size_t)(u.pm >> 4) * 3072 + col0;
        f32x4 gv[2][2];
#pragma unroll
        for (int bj = 0; bj < 2; ++bj)
#pragma unroll
            for (int n = 0; n < 2; ++n) gv[bj][n] = *(const f32x4*)(gp + bj * HALF + n * 16);
#pragma unroll
        for (int am = 0; am < 4; ++am) {
            const int ai = am >> 1, m0 = (am & 1) * 2;
            f32x4 xi[2][2][2];
#pragma unroll
            for (int m = 0; m < 2; ++m)
#pragma unroll
                for (int bj = 0; bj < 2; ++bj)
#pragma unroll
                    for (int n = 0; n < 2; ++n) xi[m][bj][n] = *(const f32x4*)(xin + (size_t)(row0 + ai * HALF + (m0 + m) * 16) * DM + col0 + bj * HALF + n * 16);
            __builtin_amdgcn_sched_barrier(0);
#pragma unroll
            for (int m = 0; m < 2; ++m)
#pragma unroll
                for (int bj = 0; bj < 2; ++bj)
#pragma unroll
                    for (int n = 0; n < 2; ++n) *(f32x4*)(xout + (size_t)(row0 + ai * HALF + (m0 + m) * 16) * DM + col0 + bj * HALF + n * 16) = xi[m][bj][n] + gv[bj][n] * acc[ai][bj][m0 + m][n];
        }
    }
};

struct EpiSlab {
    static constexpr bool PERM = false;
    float* slab;
    __device__ __forceinline__ void operator()(const f32x4 (&acc)[2][2][4][2], const Unit& u, int wr, int wc, int fr, int fq) const {
        const int row0 = u.pm * BM + wr * 64 + fr, col0 = u.pn * BM + wc * 32 + 4 * fq;
        float* base = slab + (size_t)u.kh * HROWS * DM;
#pragma unroll
        for (int ai = 0; ai < 2; ++ai)
#pragma unroll
            for (int m = 0; m < 4; ++m) { float* rowp = base + (size_t)(row0 + ai * HALF + m * 16) * DM + col0;
#pragma unroll
                for (int bj = 0; bj < 2; ++bj)
#pragma unroll
                    for (int n = 0; n < 2; ++n) *(f32x4*)(rowp + bj * HALF + n * 16) = acc[ai][bj][m][n]; }
    }
};

template <class Epi, class Sched>
__device__ __forceinline__ void gemm_phase(LAS unsigned char* lds, const Gemm g, const Sched& S, const Epi& E) {
    const int tid = opaque_tid(), wid = __builtin_amdgcn_readfirstlane(tid >> 6), lane = tid & 63, wr = wid >> 2, wc = wid & 3, fr = lane & 15, fq = lane >> 4;
    const int K = g.K, nt = K / BK, ld = g.ld;
    unsigned voffA[2], voffB[2];
#pragma unroll
    for (int i = 0; i < 2; ++i) { int R, C; stage_rc(tid * 16 + i * 8192, R, C); const int Rb = Epi::PERM ? ((R & ~31) + perm32(R & 31)) : R;
        voffA[i] = (unsigned)(R * ld + C) * 2u; voffB[i] = (unsigned)(Rb * ld + C) * 2u; }
    const size_t kstep = (size_t)(BK * 2);
    const size_t hstep = (size_t)HALF * ld * 2;
    const size_t tstep = 2 * hstep;
    const unsigned ldsw = (unsigned)wid * 1024u;
    const int aoff = lds_byte(wr * 64 + fr, fq * 8), boff = lds_byte(wc * 32 + fr, fq * 8);
#define PG8_SA(b, h) (((b) * 2 + (h)) * HTB)
#define PG8_SB(b, h) ((4 + (b) * 2 + (h)) * HTB)
#define PG8_STAGE(bufoff, gbase, voff) do { _Pragma("unroll") for (int _i = 0; _i < 2; ++_i) \
        __builtin_amdgcn_global_load_lds((const unsigned*)((const char*)(gbase) + (voff)[_i]), (LAS unsigned*)(lds + (bufoff) + ldsw + _i * 8192), 16, 0, 0); } while (0)
#define PG8_LDA(dst, b, h) do { _Pragma("unroll") for (int m = 0; m < 4; ++m) _Pragma("unroll") for (int k = 0; k < 2; ++k) dst[m][k] = *(const LAS bf16x8*)(lds + PG8_SA(b, h) + aoff + m * 2048 + k * 1024); } while (0)
#define PG8_LDB(dst, b, h) do { _Pragma("unroll") for (int n = 0; n < 2; ++n) _Pragma("unroll") for (int k = 0; k < 2; ++k) dst[n][k] = *(const LAS bf16x8*)(lds + PG8_SB(b, h) + boff + n * 2048 + k * 1024); } while (0)
#define PG8_MMA(ai, bj, At, Bt) do { __builtin_amdgcn_s_setprio(1); _Pragma("unroll") for (int m = 0; m < 4; ++m) _Pragma("unroll") for (int n = 0; n < 2; ++n) _Pragma("unroll") for (int k = 0; k < 2; ++k) \
        acc[ai][bj][m][n] = __builtin_amdgcn_mfma_f32_16x16x32_bf16(Bt[n][k], At[m][k], acc[ai][bj][m][n], 0, 0, 0); __builtin_amdgcn_s_setprio(0); } while (0)
#define PG8_WAIT_V(n) asm volatile("s_waitcnt vmcnt(" #n ")" ::: "memory")
#define PG8_WAIT_L(n) asm volatile("s_waitcnt lgkmcnt(" #n ")" ::: "memory")
#define PG8_BAR __builtin_amdgcn_s_barrier()
#define PG8_SCHED __builtin_amdgcn_sched_barrier(0)
    Unit cur, nxt; int ui = 0;
    if (!S.next(0, cur)) return;
    f32x4 acc[2][2][4][2];
#pragma unroll
    for (int a = 0; a < 2; ++a)
#pragma unroll
        for (int b = 0; b < 2; ++b)
#pragma unroll
            for (int m = 0; m < 4; ++m)
#pragma unroll
                for (int n = 0; n < 2; ++n) acc[a][b][m][n] = (f32x4){0.f, 0.f, 0.f, 0.f};
    bf16x8 At[4][2], B0[2][2], B1[2][2];
    const char* cA = (const char*)g.A + (size_t)cur.pm * tstep + (size_t)cur.kh * K * 2; const char* cB = (const char*)g.Bt + (size_t)cur.pn * tstep + (size_t)cur.kh * K * 2;
    PG8_STAGE(PG8_SB(0, 0), cB, voffB); PG8_STAGE(PG8_SA(0, 0), cA, voffA); PG8_STAGE(PG8_SB(0, 1), cB + hstep, voffB); PG8_STAGE(PG8_SA(0, 1), cA + hstep, voffA);
    if (wr == 1) PG8_BAR;
    PG8_WAIT_V(4); PG8_BAR;
    PG8_STAGE(PG8_SB(1, 0), cB + kstep, voffB); PG8_STAGE(PG8_SA(1, 0), cA + kstep, voffA); PG8_STAGE(PG8_SB(1, 1), cB + hstep + kstep, voffB);
    PG8_WAIT_V(6); PG8_BAR;
    for (;;) {
        const bool has_next = S.next(ui + 1, nxt);
        const char* nA = has_next ? (const char*)g.A + (size_t)nxt.pm * tstep + (size_t)nxt.kh * K * 2 : cA; const char* nB = has_next ? (const char*)g.Bt + (size_t)nxt.pn * tstep + (size_t)nxt.kh * K * 2 : cB;
        for (int t = 0; t < nt; t += 2) {
            const bool last = (t == nt - 2);
            const char* a1 = cA + (size_t)(t + 1) * kstep;
            const char* a2 = last ? nA : cA + (size_t)(t + 2) * kstep; const char* b2 = last ? nB : cB + (size_t)(t + 2) * kstep;
            const char* a3 = a2 + kstep; const char* b3 = b2 + kstep;
            PG8_LDB(B0, 0, 0); PG8_SCHED; PG8_LDA(At, 0, 0); PG8_STAGE(PG8_SA(1, 1), a1 + hstep, voffA);
            PG8_WAIT_L(8); PG8_BAR; PG8_WAIT_L(0); PG8_MMA(0, 0, At, B0); PG8_BAR; PG8_SCHED;
            PG8_LDB(B1, 0, 1); PG8_STAGE(PG8_SB(0, 0), b2, voffB);
            PG8_BAR; PG8_WAIT_L(0); PG8_MMA(0, 1, At, B1); PG8_BAR;
            PG8_LDA(At, 0, 1); PG8_STAGE(PG8_SA(0, 0), a2, voffA);
            PG8_BAR; PG8_WAIT_L(0); PG8_MMA(1, 0, At, B0); PG8_BAR; PG8_SCHED;
            PG8_STAGE(PG8_SB(0, 1), b2 + hstep, voffB);
            PG8_WAIT_V(6); PG8_BAR; PG8_MMA(1, 1, At, B1); PG8_BAR;
            PG8_LDB(B0, 1, 0); PG8_SCHED; PG8_LDA(At, 1, 0); PG8_STAGE(PG8_SA(0, 1), a2 + hstep, voffA);
            PG8_WAIT_L(8); PG8_BAR; PG8_WAIT_L(0); PG8_MMA(0, 0, At, B0); PG8_BAR; PG8_SCHED;
            PG8_LDB(B1, 1, 1); PG8_STAGE(PG8_SB(1, 0), b3, voffB);
            PG8_BAR; PG8_WAIT_L(0); PG8_MMA(0, 1, At, B1); PG8_BAR;
            PG8_LDA(At, 1, 1); PG8_STAGE(PG8_SA(1, 0), a3, voffA);
            PG8_BAR; PG8_WAIT_L(0); PG8_MMA(1, 0, At, B0); PG8_BAR; PG8_SCHED;
            PG8_STAGE(PG8_SB(1, 1), b3 + hstep, voffB);
            PG8_WAIT_V(6); PG8_BAR; PG8_MMA(1, 1, At, B1); PG8_BAR;
        }
        E(acc, cur, wr, wc, fr, fq);
        if (!has_next) break;
#pragma unroll
        for (int a = 0; a < 2; ++a)
#pragma unroll
            for (int b = 0; b < 2; ++b)
#pragma unroll
                for (int m = 0; m < 4; ++m)
#pragma unroll
                    for (int n = 0; n < 2; ++n) acc[a][b][m][n] = (f32x4){0.f, 0.f, 0.f, 0.f};
        cur = nxt; cA = nA; cB = nB; ++ui;
    }
    PG8_WAIT_V(0);
    if (wr == 0) PG8_BAR;
    PG8_BAR;
#undef PG8_SA
#undef PG8_SB
#undef PG8_STAGE
#undef PG8_LDA
#undef PG8_LDB
#undef PG8_MMA
#undef PG8_WAIT_V
#undef PG8_WAIT_L
#undef PG8_BAR
#undef PG8_SCHED
}
}

struct Args {
    const float* x; const float* c; const float* w_ada; const float* b_ada; const float* norm_g; const float* w_in;
    const float* lb_logits; const float* hgrn_g; const float* ret_g; const float* conv_w; const float* conv_b;
    const float* dt_bias; const float* a_log; const float* dskip; const float* ssm_g; const float* w_gk2; const float* b_gk2;
    const float* gla_g; const float* w_out; const float* final_g;
    float* out; unsigned char* ws;
};

__device__ __forceinline__ void transpose_cvt(const float* __restrict__ src, int K, int N, bf16_t* __restrict__ dst, int Npad, LAS unsigned char* lds, int gid, int gstride) {
    LAS float* T = (LAS float*)lds;
    const int tid = opaque_tid(), ntk = K / 64, ntn = Npad / 64;
    for (int tile = gid; tile < ntk * ntn; tile += gstride) {
        const int tk = tile % ntk, tn = tile / ntk;
#pragma unroll
        for (int i = 0; i < 8; ++i) { const int kk = (tid >> 6) + 8 * i, nn = tid & 63, n = tn * 64 + nn;
            T[kk * 65 + nn] = (n < N) ? src[(size_t)(tk * 64 + kk) * N + n] : 0.f; }
        __syncthreads();
#pragma unroll
        for (int i = 0; i < 4; ++i) { const int nn = (tid >> 5) + 16 * i, kk = (tid & 31) * 2;
            *(unsigned*)(dst + (size_t)(tn * 64 + nn) * K + tk * 64 + kk) = pk2(T[kk * 65 + nn], T[(kk + 1) * 65 + nn]); }
        __syncthreads();
    }
}

__device__ __forceinline__ void phase_prep(const Args& a, LAS unsigned char* lds) {
    const int tid = opaque_tid(), G = gridDim.x, bid = blockIdx.x;
    unsigned char* ws = a.ws;
    for (int l = 0; l < DEPTH; ++l) {
        transpose_cvt(a.w_in + (size_t)l * DM * NIN, DM, NIN, (bf16_t*)(ws + WS_WIN) + (size_t)l * LDP * DM, LDP, lds, bid, G);
        transpose_cvt(a.w_out + (size_t)l * DI * DM, DI, DM, (bf16_t*)(ws + WS_WOUT) + (size_t)l * DM * DI, DM, lds, (bid + 128) % G, G);
    }
    {
        LAS float* R = (LAS float*)lds;
        float* mod = (float*)(ws + WS_MOD);
        const int jj = tid & 63, ks = tid >> 6;
        for (int item = bid; item < DEPTH * 48; item += G) {
            const int l = item / 48, j = (item % 48) * 64 + jj;
            float s0 = 0.f, s1 = 0.f, s2 = 0.f, s3 = 0.f;
            const float* w = a.w_ada + (size_t)l * DM * 3072 + j;
            for (int k = ks * 128; k < ks * 128 + 128; ++k) { const float wv = w[(size_t)k * 3072];
                s0 += silu_f(a.c[k]) * wv; s1 += silu_f(a.c[DM + k]) * wv; s2 += silu_f(a.c[2 * DM + k]) * wv; s3 += silu_f(a.c[3 * DM + k]) * wv; }
            R[(ks * 4 + 0) * 64 + jj] = s0; R[(ks * 4 + 1) * 64 + jj] = s1; R[(ks * 4 + 2) * 64 + jj] = s2; R[(ks * 4 + 3) * 64 + jj] = s3;
            __syncthreads();
            if (tid < 256) { const int b = tid >> 6; float s = a.b_ada[l * 3072 + j];
#pragma unroll
                for (int q = 0; q < 8; ++q) s += R[(q * 4 + b) * 64 + jj];
                mod[(size_t)(l * 4 + b) * 3072 + j] = s; }
            __syncthreads();
        }
    }
    {
        float2* rope = (float2*)(ws + WS_ROPE);
        for (int i = bid * NTHR + tid; i < 4096 * 64; i += G * NTHR) {
            const int pos = i >> 6, j = i & 63;
            const float invf = powf(10000.f, -(float)(2 * j) / 128.f);
            const float ang = (float)pos * invf;
            const float k = rintf(ang * 0.15915494309189535f);
            float r = fmaf(-k, 6.2831854820251465f, ang); r = fmaf(-k, -1.7484555e-07f, r);
            rope[i] = make_float2(__cosf(r), __sinf(r));
        }
    }
}

template <bool FINAL>
__device__ __forceinline__ void phase_norm(const float* __restrict__ xin  , const float* __restrict__ slab  ,
                                           const float* __restrict__ gate_prev  , float* xout  ,
                                           const float* __restrict__ g, const float* __restrict__ mod  , int half, bf16_t* __restrict__ hout) {
    const int tid = opaque_tid(), lane = tid & 63, wid = tid >> 6;
    const int gw = blockIdx.x * 8 + wid, nw = gridDim.x * 8;
    for (int row = gw; row < HROWS; row += nw) {
        const float* xr = xin + (size_t)row * DM;
        f32x4 v[4]; float ss = 0.f;
#pragma unroll
        for (int i = 0; i < 4; ++i) v[i] = *(const f32x4*)(xr + i * 256 + lane * 4);
        if (slab) {
            f32x4 a0[4], a1[4], gp[4];
#pragma unroll
            for (int i = 0; i < 4; ++i) { const int col = i * 256 + lane * 4;
                a0[i] = *(const f32x4*)(slab + (size_t)row * DM + col); a1[i] = *(const f32x4*)(slab + (size_t)(HROWS + row) * DM + col);
                gp[i] = *(const f32x4*)(gate_prev + (size_t)(row >> 12) * 3072 + col); }
#pragma unroll
            for (int i = 0; i < 4; ++i) v[i] = v[i] + gp[i] * (a0[i] + a1[i]);
        }
        if (!FINAL && xout) {
#pragma unroll
            for (int i = 0; i < 4; ++i) *(f32x4*)(xout + (size_t)row * DM + i * 256 + lane * 4) = v[i];
        }
#pragma unroll
        for (int i = 0; i < 4; ++i) ss += v[i][0] * v[i][0] + v[i][1] * v[i][1] + v[i][2] * v[i][2] + v[i][3] * v[i][3];
#pragma unroll
        for (int o = 32; o > 0; o >>= 1) ss += __shfl_xor(ss, o);
        const float rinv = rsqrtf(ss * (1.f / DM) + EPS);
        if constexpr (FINAL) {
#pragma unroll
            for (int i = 0; i < 4; ++i) { const int col = i * 256 + lane * 4; const f32x4 gg = *(const f32x4*)(g + col);
                *(f32x4*)(xout + (size_t)row * DM + col) = v[i] * rinv * gg; }
        } else {
            const float* mb = mod + (size_t)(half * 2 + (row >> 12)) * 3072;
#pragma unroll
            for (int i = 0; i < 4; ++i) { const int col = i * 256 + lane * 4;
                const f32x4 gg = *(const f32x4*)(g + col), sh = *(const f32x4*)(mb + col), sc = *(const f32x4*)(mb + 1024 + col);
                float o0 = v[i][0] * rinv * gg[0] * (1.f + sc[0]) + sh[0], o1 = v[i][1] * rinv * gg[1] * (1.f + sc[1]) + sh[1];
                float o2 = v[i][2] * rinv * gg[2] * (1.f + sc[2]) + sh[2], o3 = v[i][3] * rinv * gg[3] * (1.f + sc[3]) + sh[3];
                u32x2 w; w.x = pk2(o0, o1); w.y = pk2(o2, o3);
                *(u32x2*)(hout + (size_t)row * DM + col) = w; }
        }
    }
}

struct MixP {
    const bf16_t* proj; bf16_t* st; float* dec; bf16_t* y; const float2* rope;
    const float* lbl; const float* hgrn_g; const float* ret_g; const float* conv_w; const float* conv_b; const float* dt_bias; const float* a_log;
    const float* dskip; const float* ssm_g; const float* w2; const float* b2; const float* gla_g; int layer;
};

__device__ __forceinline__ bf16x8 frag(LAS unsigned char* lds, int off, int ld, int r0, int ks, int lane) {
    return *(const LAS bf16x8*)(lds + off + (((r0 + (lane & 31)) * ld + 16 * ks + 8 * (lane >> 5)) << 1));
}
__device__ __forceinline__ int rowmap(int r, int lane) { return (r & 3) + 8 * (r >> 2) + 4 * (lane >> 5); }

__device__ __forceinline__ void conv16(LAS unsigned char* lds, int off, int ncols, int col, const float* cw, int seg, float (&out)[16]) {
    const LAS bf16_t* rp = (const LAS bf16_t*)(lds + off) + seg * 16 * ncols + col;
    float u[19];
#pragma unroll
    for (int k = 0; k < 19; ++k) u[k] = bf2f(rp[k * ncols]);
#pragma unroll
    for (int i = 0; i < 16; ++i) out[i] = silu_f(cw[4] + cw[0] * u[i] + cw[1] * u[i + 1] + cw[2] * u[i + 2] + cw[3] * u[i + 3]);
}
__device__ __forceinline__ void conv_w_load(const MixP& p, int chan, float* cw) {
    cw[0] = p.conv_w[chan]; cw[1] = p.conv_w[1024 + chan]; cw[2] = p.conv_w[2048 + chan]; cw[3] = p.conv_w[3072 + chan]; cw[4] = p.conv_b[chan];
}
template <int NCOLS, int NROWS> struct Stg { static constexpr int VPR = NCOLS / 8, NV = NROWS * VPR, NIT = (NV + NTHR - 1) / NTHR; };
template <int NCOLS, int NROWS>
__device__ __forceinline__ void stg_load(const bf16_t* src, int tid, int zrows, u32x4* r) {
    using S = Stg<NCOLS, NROWS>;
#pragma unroll
    for (int j = 0; j < S::NIT; ++j) { const int vi = tid + NTHR * j, row = vi / S::VPR, cv = vi % S::VPR;
        const bool ok = (vi < S::NV) && (row >= zrows);
        r[j] = ok ? *(const u32x4*)(src + (ptrdiff_t)row * LDP + cv * 8) : (u32x4){0u, 0u, 0u, 0u}; }
}
template <int NCOLS, int NROWS>
__device__ __forceinline__ void stg_store(LAS unsigned char* lds, int off, int tid, const u32x4* r) {
    using S = Stg<NCOLS, NROWS>;
#pragma unroll
    for (int j = 0; j < S::NIT; ++j) { const int vi = tid + NTHR * j; if (vi < S::NV) *(LAS u32x4*)(lds + off + vi * 16) = r[j]; }
}
__device__ __forceinline__ void store16(LAS unsigned char* lds, int byteoff, const float (&v)[16]) {
    u32x4 a, b; a.x = pk2(v[0], v[1]); a.y = pk2(v[2], v[3]); a.z = pk2(v[4], v[5]); a.w = pk2(v[6], v[7]);
    b.x = pk2(v[8], v[9]); b.y = pk2(v[10], v[11]); b.z = pk2(v[12], v[13]); b.w = pk2(v[14], v[15]);
    *(LAS u32x4*)(lds + byteoff) = a; *(LAS u32x4*)(lds + byteoff + 16) = b;
}
__device__ __forceinline__ void store8(LAS unsigned char* lds, int byteoff, const float (&v)[8]) {
    u32x4 a; a.x = pk2(v[0], v[1]); a.y = pk2(v[2], v[3]); a.z = pk2(v[4], v[5]); a.w = pk2(v[6], v[7]);
    *(LAS u32x4*)(lds + byteoff) = a;
}

constexpr int NUNITS = 128 * 14;
struct Pref { u32x4 raw[11]; u32x4 st[8]; float aux[16]; };
template <int BR, int PASS>
__device__ __forceinline__ void load_A(const MixP& p, int bc, int hu, int tid, Pref& pf) {
    const bf16_t* P = p.proj + (size_t)bc * 64 * LDP;
    if constexpr (BR == 0) { stg_load<128, 64>(P + C_AF + hu * 128, tid, 0, pf.raw + 0); stg_load<128, 64>(P + C_AI + hu * 128, tid, 0, pf.raw + 2);
        if constexpr (PASS == 3) stg_load<128, 64>(P + C_AQ + hu * 128, tid, 0, pf.raw + 4); }
    if constexpr (BR == 1) { stg_load<128, 64>(P + C_RK + hu * 128, tid, 0, pf.raw + 0); stg_load<128, 64>(P + C_RV + hu * 128, tid, 0, pf.raw + 2);
        if constexpr (PASS == 3) stg_load<128, 64>(P + C_RQ + hu * 128, tid, 0, pf.raw + 4); }
    if constexpr (BR == 2) { const int zr = ((bc & 63) == 0) ? 3 : 0; const bf16_t* P3 = P - 3 * (ptrdiff_t)LDP + C_XBC;
        stg_load<128, 67>(P3 + 512 + hu * 128, tid, zr, pf.raw + 0); stg_load<256, 67>(P3 + hu * 256, tid, zr, pf.raw + 3);
        if constexpr (PASS == 3) stg_load<128, 67>(P3 + 768 + hu * 128, tid, zr, pf.raw + 8); }
    if constexpr (BR == 3) { stg_load<64, 64>(P + C_GK + hu * 64, tid, 0, pf.raw + 0); stg_load<128, 64>(P + C_GV + hu * 128, tid, 0, pf.raw + 1); stg_load<16, 64>(P + C_LR, tid, 0, pf.raw + 3);
        if constexpr (PASS == 3) stg_load<64, 64>(P + C_GQ + hu * 64, tid, 0, pf.raw + 4); }
}
template <int BR, int PASS>
__device__ __forceinline__ void load_B(const MixP& p, int bc, int hu, int tid, Pref& pf) {
    if constexpr (PASS == 3) {
        constexpr int DK = (BR == 3) ? 64 : 128, DV = (BR == 2) ? 256 : 128, NV = DV * DK / 8 / NTHR;
        const int st_off = (BR == 0) ? hu * 16384 : (BR == 1) ? 65536 + hu * 16384 : (BR == 2) ? 131072 + hu * 32768 : 196608 + hu * 8192;
        const bf16_t* stg = p.st + (size_t)bc * ST_PER_BC + st_off;
#pragma unroll
        for (int k = 0; k < NV; ++k) pf.st[k] = *(const u32x4*)(stg + (size_t)(tid + NTHR * k) * 8);
    }
    if constexpr (BR == 1) { const int j = tid & 63, seg = tid >> 6, chunk = bc & 63;
#pragma unroll
        for (int i = 0; i < 8; ++i) { const float2 c = p.rope[(chunk * 64 + seg * 8 + i) * 64 + j]; pf.aux[2 * i] = c.x; pf.aux[2 * i + 1] = c.y; } }
    if constexpr (BR == 2) { if (tid < 64) { const bf16_t* P = p.proj + (size_t)bc * 64 * LDP;
#pragma unroll
            for (int hh = 0; hh < 4; ++hh) pf.aux[hh] = bf2f(P[(size_t)tid * LDP + C_DT + hu * 4 + hh]); } }
    if constexpr (BR == 3) { const int cc = hu * 64 + (tid & 63);
#pragma unroll
        for (int r = 0; r < 16; ++r) pf.aux[r] = p.w2[r * 256 + cc]; }
}
template <int PASS>
__device__ __forceinline__ void load_A_any(const MixP& p, int i, int tid, Pref& pf) {
    const int bc = i / 14, u = i % 14;
    if (u < 4) load_A<0, PASS>(p, bc, u, tid, pf); else if (u < 8) load_A<1, PASS>(p, bc, u - 4, tid, pf);
    else if (u < 10) load_A<2, PASS>(p, bc, u - 8, tid, pf); else load_A<3, PASS>(p, bc, u - 10, tid, pf);
}
template <int PASS>
__device__ __forceinline__ void load_B_any(const MixP& p, int i, int tid, Pref& pf) {
    const int bc = i / 14, u = i % 14;
    if (u < 4) load_B<0, PASS>(p, bc, u, tid, pf); else if (u < 8) load_B<1, PASS>(p, bc, u - 4, tid, pf);
    else if (u < 10) load_B<2, PASS>(p, bc, u - 8, tid, pf); else load_B<3, PASS>(p, bc, u - 10, tid, pf);
}

template <int BR, int PASS>
__device__ __forceinline__ void mixer_unit(const MixP& p, LAS unsigned char* lds, int bc, int hu  ) {
    constexpr int DK = (BR == 3) ? 64 : 128, LDK = DK + 8, NH = (BR == 2) ? 4 : 1, DV = (BR == 2) ? 256 : 128, NT = DV / 128;
    constexpr bool VEC = (BR == 0 || BR == 3);
    const int tid = opaque_tid(), lane = tid & 63, wid = __builtin_amdgcn_readfirstlane(tid >> 6);
    const int chunk = bc & 63;
    const bf16_t* P = p.proj + (size_t)bc * 64 * LDP;
    LAS float* SM = (LAS float*)(lds + L_SM);
    LAS bf16_t* QI = (LAS bf16_t*)(lds + L_QI); LAS bf16_t* KI = (LAS bf16_t*)(lds + L_KI); LAS bf16_t* VT = (LAS bf16_t*)(lds + L_VT);
    const int st_off = (BR == 0) ? hu * 16384 : (BR == 1) ? 65536 + hu * 16384 : (BR == 2) ? 131072 + hu * 32768 : 196608 + hu * 8192;
    bf16_t* stg = p.st + (size_t)bc * ST_PER_BC + st_off;
    Pref pf;
    load_A<BR, PASS>(p, bc, hu, tid, pf);
    load_B<BR, PASS>(p, bc, hu, tid, pf);
    constexpr int NTG = (PASS == 3) ? NT : 1;
    const int gcol = (BR == 0) ? C_AG + hu * 128 : (BR == 1) ? C_RG + hu * 128 : (BR == 2) ? C_MZ + hu * 256 : C_GG + hu * 128;
    const float* gain = (BR == 0) ? p.hgrn_g + hu * 128 : (BR == 1) ? p.ret_g + hu * 128 : (BR == 2) ? p.ssm_g + hu * 256 : p.gla_g + hu * 128;
    bf16_t gt[NTG][16]; float gnv[NTG], dskv[NTG];
    if constexpr (PASS == 3) {
#pragma unroll
        for (int nt = 0; nt < NT; ++nt) { const int ct = (wid & 3) + 4 * nt;
            gnv[nt] = gain[ct * 32 + (lane & 31)]; dskv[nt] = (BR == 2) ? p.dskip[hu * 4 + (ct >> 1)] : 0.f;
#pragma unroll
            for (int r = 0; r < 16; ++r) gt[nt][r] = P[(size_t)((wid >> 2) * 32 + rowmap(r, lane)) * LDP + gcol + ct * 32 + (lane & 31)]; }
    }
    float lb = 0.f, bb = 0.f, cwb[5], cwc[5], cwx[5], dtb[4], alg[4];
    if constexpr (BR == 0) { if (p.layer == 1) { const int cc = hu * 128 + (tid & 127); lb = 1.f / (1.f + __expf(p.lbl[cc] - p.lbl[512 + cc])); } }
    if constexpr (BR == 3) bb = p.b2[hu * 64 + (tid & 63)];
    if constexpr (BR == 2) { conv_w_load(p, 512 + hu * 128 + (tid & 127), cwb); if constexpr (PASS == 3) conv_w_load(p, 768 + hu * 128 + (tid & 127), cwc); conv_w_load(p, hu * 256 + (tid & 255), cwx);
#pragma unroll
        for (int hh = 0; hh < 4; ++hh) { dtb[hh] = p.dt_bias[hu * 4 + hh]; alg[hh] = p.a_log[hu * 4 + hh]; } }
    __builtin_amdgcn_sched_barrier(0);

    for (int urep = 0; urep < REP_UPREP; ++urep) {
    if constexpr (BR == 0) {
        constexpr int RQ = L_BIG, RF = (PASS == 3) ? L_BIG + 16384 : L_QI, RV = (PASS == 3) ? L_BIG + 32768 : L_QI + 16384;
        stg_store<128, 64>(lds, RF, tid, pf.raw + 0); stg_store<128, 64>(lds, RV, tid, pf.raw + 2);
        if constexpr (PASS == 3) stg_store<128, 64>(lds, RQ, tid, pf.raw + 4);
        __builtin_amdgcn_sched_barrier(0);
        const int d = tid & 127, seg = tid >> 7;
        __syncthreads();
        const LAS bf16_t* rF = (const LAS bf16_t*)(lds + RF) + seg * 16 * 128 + d;
        const LAS bf16_t* rQ = (const LAS bf16_t*)(lds + RQ) + seg * 16 * 128 + d;
        const LAS bf16_t* rV = (const LAS bf16_t*)(lds + RV) + seg * 16 * 128 + d;
        float cs[16], kk[16]; float run = 0.f;
#pragma unroll
        for (int i = 0; i < 16; ++i) { const float av = fmaxf(bf2f(rF[i * 128]), -60.f); const float e = __expf(-av), sg = __builtin_amdgcn_rcpf(1.f + e);
            const float f = lb + (1.f - lb) * sg; run += __logf(f); cs[i] = run; kk[i] = (1.f - lb) * e * sg; }
        SM[SM_SEG + seg * 128 + d] = run;
        __syncthreads();
        const float t0 = SM[SM_SEG + d], t1 = SM[SM_SEG + 128 + d], t2 = SM[SM_SEG + 256 + d], t3 = SM[SM_SEG + 384 + d];
        const float off = (seg == 0) ? 0.f : (seg == 1) ? t0 : (seg == 2) ? t0 + t1 : t0 + t1 + t2;
        const float ref = t0 + t1, clast = ref + t2 + t3;
        if (seg == 0) { SM[SM_REF + d] = ref; SM[SM_CLAST + d] = clast; }
        float kv[16];
#pragma unroll
        for (int i = 0; i < 16; ++i) { const float c = off + cs[i]; kv[i] = kk[i] * __expf(ref - c);
            if constexpr (PASS == 3) { KI[(seg * 16 + i) * LDK + d] = f2bf(kv[i]);
                const float q = bf2f(rQ[i * 128]); QI[(seg * 16 + i) * LDK + d] = f2bf(silu_f(q) * __expf(c - ref)); } }
        if constexpr (PASS == 1) store16(lds, L_BIG + (d * 72 + seg * 16) * 2, kv);
        unsigned vv[16];
#pragma unroll
        for (int i = 0; i < 16; ++i) vv[i] = rV[i * 128];
        u32x4 a, b; a.x = vv[0] | (vv[1] << 16); a.y = vv[2] | (vv[3] << 16); a.z = vv[4] | (vv[5] << 16); a.w = vv[6] | (vv[7] << 16);
        b.x = vv[8] | (vv[9] << 16); b.y = vv[10] | (vv[11] << 16); b.z = vv[12] | (vv[13] << 16); b.w = vv[14] | (vv[15] << 16);
        *(LAS u32x4*)(lds + L_VT + (d * 72 + seg * 16) * 2) = a; *(LAS u32x4*)(lds + L_VT + (d * 72 + seg * 16) * 2 + 16) = b;
    }
    if constexpr (BR == 1) {
        constexpr int RQ = L_BIG, RK = (PASS == 3) ? L_BIG + 16384 : L_QI, RV = (PASS == 3) ? L_BIG + 32768 : L_QI + 16384;
        const int j = tid & 63, seg = tid >> 6;
        float2 cssn[8];
#pragma unroll
        for (int i = 0; i < 8; ++i) cssn[i] = make_float2(pf.aux[2 * i], pf.aux[2 * i + 1]);
        stg_store<128, 64>(lds, RK, tid, pf.raw + 0); stg_store<128, 64>(lds, RV, tid, pf.raw + 2);
        if constexpr (PASS == 3) stg_store<128, 64>(lds, RQ, tid, pf.raw + 4);
        __builtin_amdgcn_sched_barrier(0);
        const float lg = log1pf(-exp2f(-(5.f + (float)hu)));
        if (tid < 64) { SM[SM_CUM + tid] = (float)(tid + 1) * lg; SM[SM_DT + tid] = 1.f; }
        __syncthreads();
        float k1[8], k2[8];
#pragma unroll
        for (int i = 0; i < 8; ++i) { const int t = seg * 8 + i;
            const LAS bf16_t* rk = (const LAS bf16_t*)(lds + RK) + t * 128 + j;
            const float ka = bf2f(rk[0]) * 0.08838834764831845f, kb = bf2f(rk[64]) * 0.08838834764831845f;
            k1[i] = ka * cssn[i].x - kb * cssn[i].y; k2[i] = ka * cssn[i].y + kb * cssn[i].x;
            if constexpr (PASS == 3) { const LAS bf16_t* rq = (const LAS bf16_t*)(lds + RQ) + t * 128 + j;
                const float qa = bf2f(rq[0]), qb = bf2f(rq[64]);
                QI[t * LDK + j] = f2bf(qa * cssn[i].x - qb * cssn[i].y); QI[t * LDK + j + 64] = f2bf(qa * cssn[i].y + qb * cssn[i].x);
                KI[t * LDK + j] = f2bf(k1[i]); KI[t * LDK + j + 64] = f2bf(k2[i]); } }
        if constexpr (PASS == 1) { store8(lds, L_BIG + (j * 72 + seg * 8) * 2, k1); store8(lds, L_BIG + ((j + 64) * 72 + seg * 8) * 2, k2); }
        const int v = tid & 127, s4 = tid >> 7; float vv[16];
#pragma unroll
        for (int i = 0; i < 16; ++i) { const int s = s4 * 16 + i; float x = bf2f(((const LAS bf16_t*)(lds + RV))[s * 128 + v]);
            if constexpr (PASS == 1) x *= __expf((float)(63 - s) * lg);
            vv[i] = x; }
        store16(lds, L_VT + (v * 72 + s4 * 16) * 2, vv);
    }
    if constexpr (BR == 2) {
        constexpr int RB = (PASS == 3) ? L_BIG : L_QI, RC = L_BIG + 17152, RX = (PASS == 3) ? L_BIG + 34304 : L_BIG + 18432;
        float dtr[4];
#pragma unroll
        for (int hh = 0; hh < 4; ++hh) dtr[hh] = pf.aux[hh];
        stg_store<128, 67>(lds, RB, tid, pf.raw + 0); stg_store<256, 67>(lds, RX, tid, pf.raw + 3);
        if constexpr (PASS == 3) stg_store<128, 67>(lds, RC, tid, pf.raw + 8);
        __builtin_amdgcn_sched_barrier(0);
        if (tid < 64) {
#pragma unroll
            for (int hh = 0; hh < 4; ++hh) {
                const float dt = softplus_f(dtr[hh] + dtb[hh]);
                float la = -dt * __expf(alg[hh]);
#pragma unroll
                for (int o = 1; o < 64; o <<= 1) { const float yv = __shfl_up(la, o); if (tid >= o) la += yv; }
                SM[SM_CUM + hh * 64 + tid] = la; SM[SM_DT + hh * 64 + tid] = dt; }
        }
        __syncthreads();
        { const int n = tid & 127, seg = tid >> 7; float o[16];
          conv16(lds, RB, 128, n, cwb, seg, o);
          if constexpr (PASS == 3) {
#pragma unroll
              for (int i = 0; i < 16; ++i) KI[(seg * 16 + i) * LDK + n] = f2bf(o[i]);
              conv16(lds, RC, 128, n, cwc, seg, o);
#pragma unroll
              for (int i = 0; i < 16; ++i) QI[(seg * 16 + i) * LDK + n] = f2bf(o[i]);
          } else store16(lds, L_BIG + (n * 72 + seg * 16) * 2, o);
        }
        { const int v = tid & 255, s2 = tid >> 8, hh = v >> 6;
#pragma unroll
          for (int r = 0; r < 2; ++r) { const int seg = s2 * 2 + r; float o[16];
              conv16(lds, RX, 256, v, cwx, seg, o);
              if constexpr (PASS == 1) { const float cl = SM[SM_CUM + hh * 64 + 63];
#pragma unroll
                  for (int i = 0; i < 16; ++i) { const int s = seg * 16 + i; o[i] *= __expf(cl - SM[SM_CUM + hh * 64 + s]) * SM[SM_DT + hh * 64 + s]; } }
              store16(lds, L_VT + (v * 72 + seg * 16) * 2, o); }
        }
    }
    if constexpr (BR == 3) {
        constexpr int RQ = L_BIG, RK = (PASS == 3) ? L_BIG + 8192 : L_QI, RV = (PASS == 3) ? L_BIG + 16384 : L_QI + 8192, RL = (PASS == 3) ? L_BIG + 32768 : L_QI + 24576;
        const int d = tid & 63, seg = tid >> 6, cc = hu * 64 + d;
        float w2r[16];
#pragma unroll
        for (int r = 0; r < 16; ++r) w2r[r] = pf.aux[r];
        stg_store<64, 64>(lds, RK, tid, pf.raw + 0); stg_store<128, 64>(lds, RV, tid, pf.raw + 1); stg_store<16, 64>(lds, RL, tid, pf.raw + 3);
        if constexpr (PASS == 3) stg_store<64, 64>(lds, RQ, tid, pf.raw + 4);
        __builtin_amdgcn_sched_barrier(0);
        __syncthreads();
        float cs[8]; float run = 0.f;
#pragma unroll
        for (int i = 0; i < 8; ++i) { const int t = seg * 8 + i; const LAS bf16x8* lp = (const LAS bf16x8*)(lds + RL + t * 32);
            const bf16x8 l0 = lp[0], l1 = lp[1]; float gk = bb;
#pragma unroll
            for (int r = 0; r < 8; ++r) { gk += w2r[r] * bf2f((bf16_t)l0[r]); gk += w2r[8 + r] * bf2f((bf16_t)l1[r]); }
            run += logsig_f(gk) * (1.f / 16.f); cs[i] = run; }
        SM[SM_SEG + seg * 64 + d] = run;
        __syncthreads();
        float off = 0.f, ref = 0.f, clast = 0.f;
#pragma unroll
        for (int s = 0; s < 8; ++s) { const float tv = SM[SM_SEG + s * 64 + d]; if (s < seg) off += tv; if (s < 4) ref += tv; clast += tv; }
        if (seg == 0) { SM[SM_REF + d] = ref; SM[SM_CLAST + d] = clast; }
        float kv[8];
#pragma unroll
        for (int i = 0; i < 8; ++i) { const int t = seg * 8 + i; const float c = off + cs[i];
            kv[i] = bf2f(((const LAS bf16_t*)(lds + RK))[t * 64 + d]) * __expf(ref - c);
            if constexpr (PASS == 3) { KI[t * LDK + d] = f2bf(kv[i]); QI[t * LDK + d] = f2bf(bf2f(((const LAS bf16_t*)(lds + RQ))[t * 64 + d]) * 0.125f * __expf(c - ref)); } }
        if constexpr (PASS == 1) store8(lds, L_BIG + (d * 72 + seg * 8) * 2, kv);
        const int v = tid & 127, s4 = tid >> 7; unsigned vv[16];
#pragma unroll
        for (int i = 0; i < 16; ++i) vv[i] = ((const LAS bf16_t*)(lds + RV))[(s4 * 16 + i) * 128 + v];
        u32x4 a, b; a.x = vv[0] | (vv[1] << 16); a.y = vv[2] | (vv[3] << 16); a.z = vv[4] | (vv[5] << 16); a.w = vv[6] | (vv[7] << 16);
        b.x = vv[8] | (vv[9] << 16); b.y = vv[10] | (vv[11] << 16); b.z = vv[12] | (vv[13] << 16); b.w = vv[14] | (vv[15] << 16);
        *(LAS u32x4*)(lds + L_VT + (v * 72 + s4 * 16) * 2) = a; *(LAS u32x4*)(lds + L_VT + (v * 72 + s4 * 16) * 2 + 16) = b;
    }
    __syncthreads();
    }
    for (int urep = 0; urep < REP_UCORE; ++urep) {
    if constexpr (PASS == 1) {
        constexpr int NTN = DV / 32, NTILES = (DK / 32) * NTN;
#pragma unroll
        for (int i = 0; i < NTILES / 8; ++i) {
            const int ti = wid + 8 * i, tm = ti / NTN, tn = ti % NTN;
            f32x16 acc;
#pragma unroll
            for (int r = 0; r < 16; ++r) acc[r] = 0.f;
#pragma unroll
            for (int ks = 0; ks < 4; ++ks) acc = __builtin_amdgcn_mfma_f32_32x32x16_bf16(frag(lds, L_BIG, 72, tm * 32, ks, lane), frag(lds, L_VT, 72, tn * 32, ks, lane), acc, 0, 0, 0);
            const int v = tn * 32 + (lane & 31);
#pragma unroll
            for (int rg = 0; rg < 4; ++rg) { const int d0 = tm * 32 + 8 * rg + 4 * (lane >> 5);
                float o[4];
#pragma unroll
                for (int q = 0; q < 4; ++q) { o[q] = acc[rg * 4 + q]; if constexpr (VEC) o[q] *= __expf(SM[SM_CLAST + d0 + q] - SM[SM_REF + d0 + q]); }
                u32x2 w; w.x = pk2(o[0], o[1]); w.y = pk2(o[2], o[3]);
                *(u32x2*)(stg + (size_t)v * DK + d0) = w; }
        }
        float* dec = p.dec + (size_t)bc * 1024;
        if constexpr (BR == 0) { if (tid < 128) dec[hu * 128 + tid] = __expf(SM[SM_CLAST + tid]); }
        if constexpr (BR == 3) { if (tid < 64) dec[512 + hu * 64 + tid] = __expf(SM[SM_CLAST + tid]); }
        if constexpr (BR == 2) { if (tid < 4) dec[768 + hu * 4 + tid] = __expf(SM[SM_CUM + tid * 64 + 63]); }
        __syncthreads();
    } else {
        constexpr int NCT = DV / 32;
        {
            constexpr int NVEC = DV * DK / 8, VPR = DK / 8;
#pragma unroll
            for (int k = 0; k < NVEC / NTHR; ++k) { const int vi = tid + NTHR * k; const int v = vi / VPR, d0 = (vi % VPR) * 8;
                u32x4 raw = pf.st[k];
                if constexpr (VEC) { unsigned w[4] = {raw.x, raw.y, raw.z, raw.w};
#pragma unroll
                    for (int q = 0; q < 4; ++q) { const float lo = __uint_as_float(w[q] << 16) * __expf(SM[SM_REF + d0 + 2 * q]), hi = __uint_as_float(w[q] & 0xffff0000u) * __expf(SM[SM_REF + d0 + 2 * q + 1]);
                        w[q] = pk2(lo, hi); }
                    raw.x = w[0]; raw.y = w[1]; raw.z = w[2]; raw.w = w[3]; }
                *(LAS u32x4*)(lds + L_BIG + (v * LDK + d0) * 2) = raw; }
        }
        __builtin_amdgcn_sched_barrier(0);
        __syncthreads();
        const int tm = wid >> 2, tnb = wid & 3;
        f32x16 acc[NT];
#pragma unroll
        for (int nt = 0; nt < NT; ++nt)
#pragma unroll
            for (int r = 0; r < 16; ++r) acc[nt][r] = 0.f;
#pragma unroll
        for (int ks = 0; ks < DK / 16; ++ks) { const bf16x8 af = frag(lds, L_QI, LDK, tm * 32, ks, lane);
#pragma unroll
            for (int nt = 0; nt < NT; ++nt) acc[nt] = __builtin_amdgcn_mfma_f32_32x32x16_bf16(af, frag(lds, L_BIG, LDK, (tnb + 4 * nt) * 32, ks, lane), acc[nt], 0, 0, 0); }
        if constexpr (!VEC) {
#pragma unroll
            for (int nt = 0; nt < NT; ++nt) { const int hh = (NH == 1) ? 0 : ((tnb + 4 * nt) >> 1);
#pragma unroll
                for (int r = 0; r < 16; ++r) acc[nt][r] *= __expf(SM[SM_CUM + hh * 64 + tm * 32 + rowmap(r, lane)]); }
        }
        f32x16 sc;
#pragma unroll
        for (int r = 0; r < 16; ++r) sc[r] = 0.f;
        const int stm = wid >> 1, stn = wid & 1;
        if (wid < 4) {
#pragma unroll
            for (int ks = 0; ks < DK / 16; ++ks) sc = __builtin_amdgcn_mfma_f32_32x32x16_bf16(frag(lds, L_QI, LDK, stm * 32, ks, lane), frag(lds, L_KI, LDK, stn * 32, ks, lane), sc, 0, 0, 0);
        }
        __syncthreads();
        if (wid < 4) {
            const int s = stn * 32 + (lane & 31);
#pragma unroll
            for (int hh = 0; hh < NH; ++hh) {
                float cums = 0.f, dts = 1.f;
                if constexpr (!VEC) { cums = SM[SM_CUM + hh * 64 + s]; dts = SM[SM_DT + hh * 64 + s]; }
#pragma unroll
                for (int r = 0; r < 16; ++r) { const int t = stm * 32 + rowmap(r, lane);
                    float val = sc[r];
                    if constexpr (!VEC) { const float ex = (s <= t) ? SM[SM_CUM + hh * 64 + t] - cums : 0.f; val *= __expf(ex) * dts; }
                    val = (s <= t) ? val : 0.f;
                    *(LAS bf16_t*)(lds + L_BIG + ((hh * 64 + t) * 72 + s) * 2) = f2bf(val); }
            }
        }
        __syncthreads();
#pragma unroll
        for (int nt = 0; nt < NT; ++nt) { const int hh = (NH == 1) ? 0 : ((tnb + 4 * nt) >> 1);
#pragma unroll
            for (int ks = 0; ks < 4; ++ks) acc[nt] = __builtin_amdgcn_mfma_f32_32x32x16_bf16(frag(lds, L_BIG + hh * 9216, 72, tm * 32, ks, lane), frag(lds, L_VT, 72, (tnb + 4 * nt) * 32, ks, lane), acc[nt], 0, 0, 0); }
        const int ycol = (BR == 0) ? hu * 128 : (BR == 1) ? 512 + hu * 128 : (BR == 2) ? 1024 + hu * 256 : 1536 + hu * 128;
#pragma unroll
        for (int nt = 0; nt < NT; ++nt) { const int ct = tnb + 4 * nt, v = ct * 32 + (lane & 31);
            const float dsk = dskv[nt];
#pragma unroll
            for (int r = 0; r < 16; ++r) { const int t = tm * 32 + rowmap(r, lane);
                float val = acc[nt][r];
                if constexpr (BR == 2) { val = (val + dsk * bf2f(VT[v * 72 + t])) * silu_f(bf2f(gt[nt][r])); acc[nt][r] = val; }
                float sq = val * val;
#pragma unroll
                for (int o = 16; o > 0; o >>= 1) sq += __shfl_xor(sq, o);
                if ((lane & 31) == 0) SM[SM_RSS + ct * 64 + t] = sq; }
        }
        __syncthreads();
        if (tid < 64) { float tot = 0.f;
#pragma unroll
            for (int q = 0; q < NCT; ++q) tot += SM[SM_RSS + q * 64 + tid];
            SM[SM_SEG + tid] = rsqrtf(tot * (1.f / DV) + EPS); }
        __syncthreads();
        float rinv[16];
#pragma unroll
        for (int r = 0; r < 16; ++r) rinv[r] = SM[SM_SEG + tm * 32 + rowmap(r, lane)];
#pragma unroll
        for (int nt = 0; nt < NT; ++nt) { const int ct = tnb + 4 * nt, v = ct * 32 + (lane & 31);
            const float gn = gnv[nt];
#pragma unroll
            for (int r = 0; r < 16; ++r) { const int t = tm * 32 + rowmap(r, lane);
                float o = acc[nt][r] * rinv[r] * gn;
                if constexpr (BR != 2) o *= silu_f(bf2f(gt[nt][r]));
                p.y[(size_t)(bc * 64 + t) * DI + ycol + v] = f2bf(o); }
        }
        __syncthreads();
    }
    }
}

template <int PASS>
__device__ __forceinline__ void phase_mixer(const MixP& p, LAS unsigned char* lds) {
#pragma unroll 1
    for (int i = blockIdx.x; i < NUNITS; i += gridDim.x) {
        const int bc = i / 14, u = i % 14;
        if (u < 4) mixer_unit<0, PASS>(p, lds, bc, u);
        else if (u < 8) mixer_unit<1, PASS>(p, lds, bc, u - 4);
        else if (u < 10) mixer_unit<2, PASS>(p, lds, bc, u - 8);
        else mixer_unit<3, PASS>(p, lds, bc, u - 10);
    }
}

__device__ __forceinline__ void phase_scan(bf16_t* st, const float* dec) {
    const int gt = blockIdx.x * NTHR + opaque_tid();
    constexpr int VPB = ST_PER_BC / 4;
    if (gt >= 2 * VPB) return;
    const int bl = gt / VPB, e0 = (gt % VPB) * 4;
    int mode, didx = 0; float cfac = 0.f;
    if (e0 < 65536) { mode = 0; didx = (e0 >> 14) * 128 + (e0 & 127); }
    else if (e0 < 131072) { mode = 1; const int h = (e0 - 65536) >> 14; cfac = __expf(64.f * log1pf(-exp2f(-(5.f + (float)h)))); }
    else if (e0 < 196608) { mode = 2; const int r = e0 - 131072; didx = 768 + (r >> 15) * 4 + (((r & 32767) >> 7) >> 6); }
    else { mode = 0; const int r = e0 - 196608; didx = 512 + (r >> 13) * 64 + (r & 63); }
    float s0 = 0.f, s1 = 0.f, s2 = 0.f, s3 = 0.f;
    bf16_t* ptr = st + (size_t)bl * 64 * ST_PER_BC + e0;
    const float* dp = dec + (size_t)bl * 64 * 1024 + didx;
#pragma unroll 1
    for (int c0 = 0; c0 < 64; c0 += 8) {
        u32x2 hv[8]; f32x4 dv[8];
#pragma unroll
        for (int j = 0; j < 8; ++j) {
            hv[j] = *(const u32x2*)(ptr + (size_t)(c0 + j) * ST_PER_BC);
            if (mode == 0) dv[j] = *(const f32x4*)(dp + (size_t)(c0 + j) * 1024);
            else if (mode == 1) dv[j] = (f32x4){cfac, cfac, cfac, cfac};
            else { const float d = dp[(size_t)(c0 + j) * 1024]; dv[j] = (f32x4){d, d, d, d}; }
        }
        __builtin_amdgcn_sched_barrier(0);
#pragma unroll
        for (int j = 0; j < 8; ++j) {
            u32x2 w; w.x = pk2(s0, s1); w.y = pk2(s2, s3);
            *(u32x2*)(ptr + (size_t)(c0 + j) * ST_PER_BC) = w;
            s0 = s0 * dv[j][0] + __uint_as_float(hv[j].x << 16); s1 = s1 * dv[j][1] + __uint_as_float(hv[j].x & 0xffff0000u);
            s2 = s2 * dv[j][2] + __uint_as_float(hv[j].y << 16); s3 = s3 * dv[j][3] + __uint_as_float(hv[j].y & 0xffff0000u);
        }
    }
}


#define XB_TMO      128
#define XB_XCNT(j)  (256  + 64 * (j))
#define XB_XSUB(j)  (1280 + 64 * (j))
#define XB_XGEN(j)  (2304 + 64 * (j))
#define XB_TOP      3328
#define XB_TOPGEN   3392
#define XCD_BAR_WORDS 3456
#define XB_SPIN_CAP (1u << 18)
__device__ __forceinline__ unsigned xb_ld(unsigned* p)              { return __hip_atomic_load(p, __ATOMIC_RELAXED, __HIP_MEMORY_SCOPE_AGENT); }
__device__ __forceinline__ unsigned xb_add(unsigned* p, unsigned v) { return __hip_atomic_fetch_add(p, v, __ATOMIC_RELAXED, __HIP_MEMORY_SCOPE_AGENT); }
__device__ __forceinline__ unsigned xb_xcc_id() { return (unsigned)__builtin_amdgcn_s_getreg((3 << 11) | 20) & 0xFu; }
#define XB_SPIN(cond, bar) do { unsigned _sp = 0; while (cond) { __builtin_amdgcn_s_sleep(1); \
    if ((++_sp & 255u) == 0u) { if (xb_ld(&(bar)[XB_TMO])) break; if (_sp > XB_SPIN_CAP) { atomicAdd(&(bar)[XB_TMO], 1u); break; } } } } while (0)
struct XcdBarrier { unsigned* bar; unsigned x; volatile LAS unsigned* st; };
__device__ __forceinline__ XcdBarrier xcd_barrier_post(unsigned* bar, volatile LAS unsigned* st) {
    XcdBarrier b; b.bar = bar; b.x = xb_xcc_id(); b.st = st;
    if (threadIdx.x == 0) (void)xb_add(&bar[XB_XCNT(b.x)], 1u);
    return b;
}
__device__ __forceinline__ void xcd_barrier_complete(unsigned* bar, unsigned x, unsigned& nloc, unsigned& nx) {
    const unsigned G = gridDim.x * gridDim.y * gridDim.z;
    unsigned sum, cnt, mine, sp = 0u;
    for (;;) {
        sum = 0u; cnt = 0u; mine = 0u;
#pragma unroll
        for (unsigned j = 0; j < 16; ++j) { const unsigned c = xb_ld(&bar[XB_XCNT(j)]); sum += c; cnt += (c > 0u) ? 1u : 0u; mine = (j == x) ? c : mine; }
        if (sum == G) break;
        __builtin_amdgcn_s_sleep(1);
        if ((++sp & 255u) == 0u) { if (xb_ld(&bar[XB_TMO])) break; if (sp > XB_SPIN_CAP) { atomicAdd(&bar[XB_TMO], 1u); break; } }
    }
    nloc = mine > 0u ? mine : 1u; nx = cnt > 0u ? cnt : 1u;
}
__device__ __forceinline__ void xcd_barrier(const XcdBarrier& b) {
    asm volatile("s_waitcnt vmcnt(0)" ::: "memory");
    __syncthreads();
    if (threadIdx.x == 0) {
        unsigned* bar = b.bar;
        __builtin_amdgcn_s_waitcnt(0);
        unsigned nloc = b.st[0], nx = b.st[1];
        if (nloc == 0u) { xcd_barrier_complete(bar, b.x, nloc, nx); b.st[0] = nloc; b.st[1] = nx; }
        const unsigned old = xb_add(&bar[XB_XSUB(b.x)], 1u);
        const unsigned gen = old / nloc;
        if (old + 1u == (gen + 1u) * nloc) {
            __builtin_amdgcn_fence(__ATOMIC_RELEASE, "agent");
            asm volatile("s_waitcnt vmcnt(0)" ::: "memory");
            const unsigned og = xb_add(&bar[XB_TOP], 1u);
            const unsigned tg = og / nx;
            if (og + 1u == (tg + 1u) * nx) xb_add(&bar[XB_TOPGEN], 1u);
            else XB_SPIN(xb_ld(&bar[XB_TOPGEN]) == tg, bar);
            __builtin_amdgcn_fence(__ATOMIC_ACQUIRE, "agent");
            xb_add(&bar[XB_XGEN(b.x)], 1u);
            asm volatile("s_waitcnt vmcnt(0)" ::: "memory");
        } else {
            XB_SPIN(xb_ld(&bar[XB_XGEN(b.x)]) == gen, bar);
            __builtin_amdgcn_fence(__ATOMIC_ACQUIRE, "agent");
            asm volatile("s_waitcnt vmcnt(0)" ::: "memory");
        }
    }
    __syncthreads();
}

__global__ void __launch_bounds__(NTHR, 2) fwd_megakernel(Args a) {
    extern __shared__ __attribute__((aligned(16))) unsigned char shm[];
    LAS unsigned char* lds = (LAS unsigned char*)shm;
    cg::grid_group grid = cg::this_grid();
    unsigned char* ws = a.ws;
    const int G = gridDim.x;

    {
        volatile LAS unsigned* stw = (volatile LAS unsigned*)(lds + L_BARST);
        if (threadIdx.x < 2) stw[threadIdx.x] = 0u;
        __syncthreads();
    }
    const XcdBarrier gbar = xcd_barrier_post((unsigned*)(ws + WS_BAR), (volatile LAS unsigned*)(lds + L_BARST));
    for (int rep = 0; rep < REP_PREP; ++rep) { phase_prep(a, lds); if (rep == 0) grid.sync(); else xcd_barrier(gbar); }

    bf16_t* hbuf = (bf16_t*)(ws + WS_HY); bf16_t* ybuf = (bf16_t*)(ws + WS_HY);
    bf16_t* proj = (bf16_t*)(ws + WS_PROJ); bf16_t* st = (bf16_t*)(ws + WS_ST); float* dec = (float*)(ws + WS_DEC);
    const float* mod = (const float*)(ws + WS_MOD);

#pragma unroll 1
    for (int half = 0; half < 2; ++half) {
        const size_t xoff = (size_t)half * HROWS * DM;
#pragma unroll 1
        for (int l = 0; l < DEPTH; ++l) {
            const float* modl = mod + (size_t)l * 4 * 3072;
            float* slab = (float*)(ws + WS_PROJ);
            if (l == 0) phase_norm<false>(a.x + xoff, nullptr, nullptr, nullptr, a.norm_g, modl, half, hbuf);
            else phase_norm<false>(a.x + xoff, slab, mod + (size_t)(half * 2) * 3072 + 2048, a.out + xoff, a.norm_g + l * DM, modl, half, hbuf);
            xcd_barrier(gbar);
            for (int rep = 0; rep < REP_G1; ++rep) {
                pg8::Gemm g{hbuf, (const bf16_t*)(ws + WS_WIN) + (size_t)l * LDP * DM, HROWS, LDP, DM, DM};
                pg8::StaticOrder S; S.init(HROWS, LDP, G, (int)blockIdx.x);
                pg8::EpiProj E{proj, LDP};
                pg8::gemm_phase<pg8::EpiProj, pg8::StaticOrder>(lds, g, S, E);
                xcd_barrier(gbar);
            }
            MixP p;
            p.proj = proj; p.st = st; p.dec = dec; p.y = ybuf; p.rope = (const float2*)(ws + WS_ROPE);
            p.lbl = a.lb_logits; p.hgrn_g = a.hgrn_g + l * 512; p.ret_g = a.ret_g + l * 512; p.conv_w = a.conv_w + l * 4096; p.conv_b = a.conv_b + l * 1024;
            p.dt_bias = a.dt_bias + l * 8; p.a_log = a.a_log + l * 8; p.dskip = a.dskip + l * 8; p.ssm_g = a.ssm_g + l * 512;
            p.w2 = a.w_gk2 + l * 16 * 256; p.b2 = a.b_gk2 + l * 256; p.gla_g = a.gla_g + l * 512; p.layer = l;
            for (int rep = 0; rep < REP_M12; ++rep) { phase_mixer<1>(p, lds); xcd_barrier(gbar); phase_scan(st, dec); xcd_barrier(gbar); }
            for (int rep = 0; rep < REP_M3; ++rep) { phase_mixer<3>(p, lds); xcd_barrier(gbar); }
            for (int rep = 0; rep < REP_G2; ++rep) {
                pg8::Gemm g{ybuf, (const bf16_t*)(ws + WS_WOUT) + (size_t)l * DM * DI, HROWS, DM, DI / 2, DI};
                pg8::SplitOrder S; S.init(HROWS, DM, G, (int)blockIdx.x);
                pg8::EpiSlab E{slab};
                pg8::gemm_phase<pg8::EpiSlab, pg8::SplitOrder>(lds, g, S, E);
                xcd_barrier(gbar);
            }
        }
        phase_norm<true>(a.out + xoff, (const float*)(ws + WS_PROJ), mod + (size_t)(4 + half * 2) * 3072 + 2048, a.out + xoff, a.final_g, nullptr, half, nullptr);
    }
}

extern "C" void kernel_launch(void* const* d_in, const int* in_sizes, int n_in, void* d_out, int out_size, void* d_ws, size_t ws_size, hipStream_t stream) {
    static int grid = 0;
    if (grid == 0) {
        if (n_in != 20 || ws_size < WS_END) { fprintf(stderr, "kernel_launch: unexpected n_in %d / ws_size %zu (need %zu)\n", n_in, ws_size, (size_t)WS_END); grid = -1; return; }
        int dev = 0, cus = 0, per_cu = 0;
        hipGetDevice(&dev);
        hipDeviceGetAttribute(&cus, hipDeviceAttributeMultiprocessorCount, dev);
        if (hipFuncSetAttribute((const void*)fwd_megakernel, hipFuncAttributeMaxDynamicSharedMemorySize, LDS_BYTES) != hipSuccess) { fprintf(stderr, "kernel_launch: hipFuncSetAttribute failed\n"); grid = -1; return; }
        hipOccupancyMaxActiveBlocksPerMultiprocessor(&per_cu, (const void*)fwd_megakernel, NTHR, LDS_BYTES);
        if (per_cu < 1) { fprintf(stderr, "kernel_launch: occupancy query says %d blocks per CU\n", per_cu); per_cu = 1; }
        (void)hipGetLastError();
        grid = cus * per_cu;
    }
    if (grid < 0) return;
    Args a{};
    const float** f = (const float**)&a;
    for (int i = 0; i < 20; ++i) f[i] = (const float*)d_in[i];
    a.out = (float*)d_out; a.ws = (unsigned char*)d_ws;
    void* args[] = {&a};
    if (hipMemsetAsync((char*)d_ws + WS_BAR, 0, XCD_BAR_WORDS * 4, stream) != hipSuccess) { fprintf(stderr, "kernel_launch: memset of barrier words failed\n"); return; }
    hipError_t e = hipLaunchCooperativeKernel((const void*)fwd_megakernel, dim3(grid), dim3(NTHR), args, LDS_BYTES, stream);
    if (e != hipSuccess) fprintf(stderr, "cooperative launch failed: %s (grid %d)\n", hipGetErrorString(e), grid);
}
```

```cpp
#include <hip/hip_runtime.h>
#include <hip/hip_cooperative_groups.h>
#include <cstdio>
namespace cg = cooperative_groups;

#define LAS __attribute__((address_space(3)))
typedef unsigned short bf16_t;
typedef short bf16x8 __attribute__((ext_vector_type(8)));
typedef float f32x4 __attribute__((ext_vector_type(4)));
typedef float f32x16 __attribute__((ext_vector_type(16)));
typedef unsigned u32x4 __attribute__((ext_vector_type(4)));
typedef unsigned u32x2 __attribute__((ext_vector_type(2)));

#ifndef REP_PREP
#define REP_PREP 1
#endif
#ifndef REP_NORM
#define REP_NORM 1
#endif
#ifndef REP_G1
#define REP_G1 1
#endif
#ifndef REP_M12
#define REP_M12 1
#endif
#ifndef REP_M3
#define REP_M3 1
#endif
#ifndef REP_G2
#define REP_G2 1
#endif
#ifndef REP_UPREP
#define REP_UPREP 1
#endif
#ifndef REP_UCORE
#define REP_UCORE 1
#endif
constexpr int NB = 4, SEQ = 4096, DM = 1024, DEPTH = 2, DI = 2048;
constexpr int NIN = 7192, LDP = 7424;
constexpr int HROWS = 8192;
constexpr int NTHR = 512;
constexpr float EPS = 1e-6f;
constexpr int C_AQ = 0, C_AF = 512, C_AI = 1024, C_AG = 1536, C_RQ = 2048, C_RK = 2560, C_RV = 3072, C_RG = 3584,
              C_MZ = 4096, C_XBC = 4608, C_DT = 5632, C_GQ = 5640, C_GK = 5896, C_GV = 6152, C_GG = 6664, C_LR = 7176;
constexpr int ST_PER_BC = 229376;
constexpr size_t WS_WIN = 0;
constexpr size_t WS_WOUT = WS_WIN + 2ull * LDP * DM * 2;
constexpr size_t WS_MOD = WS_WOUT + 2ull * DM * DI * 2;
constexpr size_t WS_ROPE = WS_MOD + 2ull * 4 * 3072 * 4;
constexpr size_t WS_DEC = WS_ROPE + 4096ull * 64 * 8;
constexpr size_t WS_HY = WS_DEC + 128ull * 1024 * 4;
constexpr size_t WS_PROJ = WS_HY + (size_t)HROWS * DI * 2;
constexpr size_t WS_ST = WS_PROJ + (size_t)HROWS * LDP * 2;
constexpr size_t WS_BAR = WS_ST + 128ull * ST_PER_BC * 2;
constexpr size_t WS_END = WS_BAR + 3456 * 4;
constexpr int L_QI = 0, L_KI = 17408, L_VT = 34816, L_BIG = 71680, L_SM = 141312;
constexpr int SM_CUM = 0, SM_DT = 256, SM_SEG = 512, SM_REF = 1536, SM_CLAST = 1664, SM_RSS = 1792;
constexpr int L_BARST = L_SM + (1792 + 512) * 4;
constexpr int LDS_BYTES = L_BARST + 16;

__device__ __forceinline__ float bf2f(bf16_t v) { return __uint_as_float(((unsigned)v) << 16); }
__device__ __forceinline__ bf16_t f2bf(float f) { unsigned u = __float_as_uint(f); u += 0x7FFFu + ((u >> 16) & 1u); return (bf16_t)(u >> 16); }
typedef float f32x2_t __attribute__((ext_vector_type(2)));
typedef __bf16 bf16x2_t __attribute__((ext_vector_type(2)));
__device__ __forceinline__ unsigned pk2(float lo, float hi) { f32x2_t v = {lo, hi}; bf16x2_t b = __builtin_convertvector(v, bf16x2_t); return __builtin_bit_cast(unsigned, b); }
__device__ __forceinline__ int opaque_tid() { int t = threadIdx.x; asm volatile("" : "+v"(t)); return t; }
__device__ __forceinline__ float silu_f(float x) { return x * __builtin_amdgcn_rcpf(1.f + __expf(-x)); }
__device__ __forceinline__ float softplus_f(float x) { return fmaxf(x, 0.f) + __logf(1.f + __expf(-fabsf(x))); }
__device__ __forceinline__ float logsig_f(float x) { return fminf(x, 0.f) - __logf(1.f + __expf(-fabsf(x))); }

namespace pg8 {
constexpr int BM = 256, BK = 64, HALF = 128, HTB = HALF * BK * 2, STAGE_BYTES = 8 * HTB, NXCD = 8, WGM = 8;
__device__ __forceinline__ int lds_byte(int r, int c) { const int st = (r >> 4) * 2 + (c >> 5), rr = r & 15, cc = c & 31, ob = rr * 64 + cc * 2; return st * 1024 + (ob ^ (((ob >> 9) & 1) << 5)); }
__device__ __forceinline__ void stage_rc(int b, int& R, int& C) { const int st = b / 1024, sb = b % 1024, swz = sb ^ (((sb >> 9) & 1) << 5); R = (st >> 1) * 16 + swz / 64; C = (st & 1) * 32 + (swz % 64) / 2; }
__device__ __forceinline__ int perm32(int rho) { const int n = rho >> 4, i = rho & 15; return 8 * (i >> 2) + 4 * n + (i & 3); }
struct Unit { int pm, pn, kh; };
struct Gemm { const bf16_t* A; const bf16_t* Bt; int M, N, K, ld; };
struct StaticOrder {
    int nM, nN, nwg, G, c;
    __device__ void init(int M, int N, int G_, int c_) { nM = M / BM; nN = N / BM; nwg = nM * nN; G = G_; c = c_; }
    __device__ bool next(int i, Unit& u) const {
        const long L = (long)i * G + c; if (L >= nwg) return false;
        int wgid = (int)L; { const int q = nwg / NXCD, r = nwg % NXCD, xcd = wgid % NXCD, off = wgid / NXCD; wgid = (xcd < r ? xcd * (q + 1) : r * (q + 1) + (xcd - r) * q) + off; }
        const int nig = WGM * nN, gid = wgid / nig, fm = gid * WGM, gsz = (nM - fm) < WGM ? (nM - fm) : WGM;
        u.pm = fm + ((wgid % nig) % gsz); u.pn = (wgid % nig) / gsz; u.kh = 0; return true;
    }
};
struct SplitOrder {
    StaticOrder so;
    __device__ void init(int M, int N, int G_, int c_) { so.init(M, 2 * N, G_, c_); }
    __device__ bool next(int i, Unit& u) const { if (!so.next(i, u)) return false; u.kh = u.pn & 1; u.pn >>= 1; return true; }
};
struct EpiProj {
    static constexpr bool PERM = true;
    bf16_t* O; int ldc;
    __device__ __forceinline__ void operator()(const f32x4 (&acc)[2][2][4][2], const Unit& u, int wr, int wc, int fr, int fq) const {
        const int row0 = u.pm * BM + wr * 64 + fr, col0 = u.pn * BM + wc * 32 + 8 * fq;
#pragma unroll
        for (int ai = 0; ai < 2; ++ai)
#pragma unroll
            for (int m = 0; m < 4; ++m) { bf16_t* rowp = O + (size_t)(row0 + ai * HALF + m * 16) * ldc + col0;
#pragma unroll
                for (int bj = 0; bj < 2; ++bj) { const f32x4 v0 = acc[ai][bj][m][0], v1 = acc[ai][bj][m][1];
                    u32x4 w; w.x = pk2(v0[0], v0[1]); w.y = pk2(v0[2], v0[3]); w.z = pk2(v1[0], v1[1]); w.w = pk2(v1[2], v1[3]);
                    *(u32x4*)(rowp + bj * HALF) = w; } }
    }
};
struct EpiRes {
    static constexpr bool PERM = false;
    const float* xin; float* xout; const float* gate;
    __device__ __forceinline__ void operator()(const f32x4 (&acc)[2][2][4][2], const Unit& u, int wr, int wc, int fr, int fq) const {
        const int row0 = u.pm * BM + wr * 64 + fr, col0 = u.pn * BM + wc * 32 + 4 * fq;
        const float* gp = gate + (size_t)(u.pm >> 4) * 3072 + col0;
        f32x4 gv[2][2];
#pragma unroll
        for (int bj = 0; bj < 2; ++bj)
#pragma unroll
            for (int n = 0; n < 2; ++n) gv[bj][n] = *(const f32x4*)(gp + bj * HALF + n * 16);
#pragma unroll
        for (int am = 0; am < 4; ++am) {
            const int ai = am >> 1, m0 = (am & 1) * 2;
            f32x4 xi[2][2][2];
#pragma unroll
            for (int m = 0; m < 2; ++m)
#pragma unroll
                for (int bj = 0; bj < 2; ++bj)
#pragma unroll
                    for (int n = 0; n < 2; ++n) xi[m][bj][n] = *(const f32x4*)(xin + (size_t)(row0 + ai * HALF + (m0 + m) * 16) * DM + col0 + bj * HALF + n * 16);
            __builtin_amdgcn_sched_barrier(0);
#pragma unroll
            for (int m = 0; m < 2; ++m)
#pragma unroll
                for (int bj = 0; bj < 2; ++bj)
#pragma unroll
                    for (int n = 0; n < 2; ++n) *(f32x4*)(xout + (size_t)(row0 + ai * HALF + (m0 + m) * 16) * DM + col0 + bj * HALF + n * 16) = xi[m][bj][n] + gv[bj][n] * acc[ai][bj][m0 + m][n];
        }
    }
};

struct EpiSlab {
    static constexpr bool PERM = true;
    bf16_t* slab;
    __device__ __forceinline__ void operator()(const f32x4 (&acc)[2][2][4][2], const Unit& u, int wr, int wc, int fr, int fq) const {
        const int row0 = u.pm * BM + wr * 64 + fr, col0 = u.pn * BM + wc * 32 + 8 * fq;
        bf16_t* base = slab + (size_t)u.kh * HROWS * DM;
#pragma unroll
        for (int ai = 0; ai < 2; ++ai)
#pragma unroll
            for (int m = 0; m < 4; ++m) { bf16_t* rowp = base + (size_t)(row0 + ai * HALF + m * 16) * DM + col0;
#pragma unroll
                for (int bj = 0; bj < 2; ++bj) { const f32x4 v0 = acc[ai][bj][m][0], v1 = acc[ai][bj][m][1];
                    u32x4 w; w.x = pk2(v0[0], v0[1]); w.y = pk2(v0[2], v0[3]); w.z = pk2(v1[0], v1[1]); w.w = pk2(v1[2], v1[3]);
                    *(u32x4*)(rowp + bj * HALF) = w; } }
    }
};

template <class Epi, class Sched>
__device__ __forceinline__ void gemm_phase(LAS unsigned char* lds, const Gemm g, const Sched& S, const Epi& E) {
    const int tid = opaque_tid(), wid = __builtin_amdgcn_readfirstlane(tid >> 6), lane = tid & 63, wr = wid >> 2, wc = wid & 3, fr = lane & 15, fq = lane >> 4;
    const int K = g.K, nt = K / BK, ld = g.ld;
    unsigned voffA[2], voffB[2];
#pragma unroll
    for (int i = 0; i < 2; ++i) { int R, C; stage_rc(tid * 16 + i * 8192, R, C); const int Rb = Epi::PERM ? ((R & ~31) + perm32(R & 31)) : R;
        voffA[i] = (unsigned)(R * ld + C) * 2u; voffB[i] = (unsigned)(Rb * ld + C) * 2u; }
    const size_t kstep = (size_t)(BK * 2);
    const size_t hstep = (size_t)HALF * ld * 2;
    const size_t tstep = 2 * hstep;
    const unsigned ldsw = (unsigned)wid * 1024u;
    const int aoff = lds_byte(wr * 64 + fr, fq * 8), boff = lds_byte(wc * 32 + fr, fq * 8);
#define PG8_SA(b, h) (((b) * 2 + (h)) * HTB)
#define PG8_SB(b, h) ((4 + (b) * 2 + (h)) * HTB)
#define PG8_STAGE(bufoff, gbase, voff) do { _Pragma("unroll") for (int _i = 0; _i < 2; ++_i) \
        __builtin_amdgcn_global_load_lds((const unsigned*)((const char*)(gbase) + (voff)[_i]), (LAS unsigned*)(lds + (bufoff) + ldsw + _i * 8192), 16, 0, 0); } while (0)
#define PG8_LDA(dst, b, h) do { _Pragma("unroll") for (int m = 0; m < 4; ++m) _Pragma("unroll") for (int k = 0; k < 2; ++k) dst[m][k] = *(const LAS bf16x8*)(lds + PG8_SA(b, h) + aoff + m * 2048 + k * 1024); } while (0)
#define PG8_LDB(dst, b, h) do { _Pragma("unroll") for (int n = 0; n < 2; ++n) _Pragma("unroll") for (int k = 0; k < 2; ++k) dst[n][k] = *(const LAS bf16x8*)(lds + PG8_SB(b, h) + boff + n * 2048 + k * 1024); } while (0)
#define PG8_MMA(ai, bj, At, Bt) do { __builtin_amdgcn_s_setprio(1); _Pragma("unroll") for (int m = 0; m < 4; ++m) _Pragma("unroll") for (int n = 0; n < 2; ++n) _Pragma("unroll") for (int k = 0; k < 2; ++k) \
        acc[ai][bj][m][n] = __builtin_amdgcn_mfma_f32_16x16x32_bf16(Bt[n][k], At[m][k], acc[ai][bj][m][n], 0, 0, 0); __builtin_amdgcn_s_setprio(0); } while (0)
#define PG8_WAIT_V(n) asm volatile("s_waitcnt vmcnt(" #n ")" ::: "memory")
#define PG8_WAIT_L(n) asm volatile("s_waitcnt lgkmcnt(" #n ")" ::: "memory")
#define PG8_BAR __builtin_amdgcn_s_barrier()
#define PG8_SCHED __builtin_amdgcn_sched_barrier(0)
    Unit cur, nxt; int ui = 0;
    if (!S.next(0, cur)) return;
    f32x4 acc[2][2][4][2];
#pragma unroll
    for (int a = 0; a < 2; ++a)
#pragma unroll
        for (int b = 0; b < 2; ++b)
#pragma unroll
            for (int m = 0; m < 4; ++m)
#pragma unroll
                for (int n = 0; n < 2; ++n) acc[a][b][m][n] = (f32x4){0.f, 0.f, 0.f, 0.f};
    bf16x8 At[4][2], B0[2][2], B1[2][2];
    const char* cA = (const char*)g.A + (size_t)cur.pm * tstep + (size_t)cur.kh * K * 2; const char* cB = (const char*)g.Bt + (size_t)cur.pn * tstep + (size_t)cur.kh * K * 2;
    PG8_STAGE(PG8_SB(0, 0), cB, voffB); PG8_STAGE(PG8_SA(0, 0), cA, voffA); PG8_STAGE(PG8_SB(0, 1), cB + hstep, voffB); PG8_STAGE(PG8_SA(0, 1), cA + hstep, voffA);
    if (wr == 1) PG8_BAR;
    PG8_WAIT_V(4); PG8_BAR;
    PG8_STAGE(PG8_SB(1, 0), cB + kstep, voffB); PG8_STAGE(PG8_SA(1, 0), cA + kstep, voffA); PG8_STAGE(PG8_SB(1, 1), cB + hstep + kstep, voffB);
    PG8_WAIT_V(6); PG8_BAR;
    for (;;) {
        const bool has_next = S.next(ui + 1, nxt);
        const char* nA = has_next ? (const char*)g.A + (size_t)nxt.pm * tstep + (size_t)nxt.kh * K * 2 : cA; const char* nB = has_next ? (const char*)g.Bt + (size_t)nxt.pn * tstep + (size_t)nxt.kh * K * 2 : cB;
        for (int t = 0; t < nt; t += 2) {
            const bool last = (t == nt - 2);
            const char* a1 = cA + (size_t)(t + 1) * kstep;
            const char* a2 = last ? nA : cA + (size_t)(t + 2) * kstep; const char* b2 = last ? nB : cB + (size_t)(t + 2) * kstep;
            const char* a3 = a2 + kstep; const char* b3 = b2 + kstep;
            PG8_LDB(B0, 0, 0); PG8_SCHED; PG8_LDA(At, 0, 0); PG8_STAGE(PG8_SA(1, 1), a1 + hstep, voffA);
            PG8_WAIT_L(8); PG8_BAR; PG8_WAIT_L(0); PG8_MMA(0, 0, At, B0); PG8_BAR; PG8_SCHED;
            PG8_LDB(B1, 0, 1); PG8_STAGE(PG8_SB(0, 0), b2, voffB);
            PG8_BAR; PG8_WAIT_L(0); PG8_MMA(0, 1, At, B1); PG8_BAR;
            PG8_LDA(At, 0, 1); PG8_STAGE(PG8_SA(0, 0), a2, voffA);
            PG8_BAR; PG8_WAIT_L(0); PG8_MMA(1, 0, At, B0); PG8_BAR; PG8_SCHED;
            PG8_STAGE(PG8_SB(0, 1), b2 + hstep, voffB);
            PG8_WAIT_V(6); PG8_BAR; PG8_MMA(1, 1, At, B1); PG8_BAR;
            PG8_LDB(B0, 1, 0); PG8_SCHED; PG8_LDA(At, 1, 0); PG8_STAGE(PG8_SA(0, 1), a2 + hstep, voffA);
            PG8_WAIT_L(8); PG8_BAR; PG8_WAIT_L(0); PG8_MMA(0, 0, At, B0); PG8_BAR; PG8_SCHED;
            PG8_LDB(B1, 1, 1); PG8_STAGE(PG8_SB(1, 0), b3, voffB);
            PG8_BAR; PG8_WAIT_L(0); PG8_MMA(0, 1, At, B1); PG8_BAR;
            PG8_LDA(At, 1, 1); PG8_STAGE(PG8_SA(1, 0), a3, voffA);
            PG8_BAR; PG8_WAIT_L(0); PG8_MMA(1, 0, At, B0); PG8_BAR; PG8_SCHED;
            PG8_STAGE(PG8_SB(1, 1), b3 + hstep, voffB);
            PG8_WAIT_V(6); PG8_BAR; PG8_MMA(1, 1, At, B1); PG8_BAR;
        }
        E(acc, cur, wr, wc, fr, fq);
        if (!has_next) break;
#pragma unroll
        for (int a = 0; a < 2; ++a)
#pragma unroll
            for (int b = 0; b < 2; ++b)
#pragma unroll
                for (int m = 0; m < 4; ++m)
#pragma unroll
                    for (int n = 0; n < 2; ++n) acc[a][b][m][n] = (f32x4){0.f, 0.f, 0.f, 0.f};
        cur = nxt; cA = nA; cB = nB; ++ui;
    }
    PG8_WAIT_V(0);
    if (wr == 0) PG8_BAR;
    PG8_BAR;
#undef PG8_SA
#undef PG8_SB
#undef PG8_STAGE
#undef PG8_LDA
#undef PG8_LDB
#undef PG8_MMA
#undef PG8_WAIT_V
#undef PG8_WAIT_L
#undef PG8_BAR
#undef PG8_SCHED
}
}

struct Args {
    const float* x; const float* c; const float* w_ada; const float* b_ada; const float* norm_g; const float* w_in;
    const float* lb_logits; const float* hgrn_g; const float* ret_g; const float* conv_w; const float* conv_b;
    const float* dt_bias; const float* a_log; const float* dskip; const float* ssm_g; const float* w_gk2; const float* b_gk2;
    const float* gla_g; const float* w_out; const float* final_g;
    float* out; unsigned char* ws;
};

__device__ __forceinline__ void transpose_cvt(const float* __restrict__ src, int K, int N, bf16_t* __restrict__ dst, int Npad, LAS unsigned char* lds, int gid, int gstride) {
    LAS float* T = (LAS float*)lds;
    const int tid = opaque_tid(), ntk = K / 64, ntn = Npad / 256;
    for (int tile = gid; tile < ntk * ntn; tile += gstride) {
        const int tk = tile % ntk, tn = tile / ntk;
        float v[32];
#pragma unroll
        for (int i = 0; i < 32; ++i) { const int kk = (tid >> 8) + 2 * i, nn = tid & 255, n = tn * 256 + nn;
            v[i] = (n < N) ? src[(size_t)(tk * 64 + kk) * N + n] : 0.f; }
#pragma unroll
        for (int i = 0; i < 32; ++i) { const int kk = (tid >> 8) + 2 * i, nn = tid & 255; T[kk * 257 + nn] = v[i]; }
        __syncthreads();
#pragma unroll
        for (int i = 0; i < 16; ++i) { const int nn = (tid >> 5) + 16 * i, kk = (tid & 31) * 2;
            *(unsigned*)(dst + (size_t)(tn * 256 + nn) * K + tk * 64 + kk) = pk2(T[kk * 257 + nn], T[(kk + 1) * 257 + nn]); }
        __syncthreads();
    }
}

__device__ __forceinline__ void phase_prep(const Args& a, LAS unsigned char* lds) {
    const int tid = opaque_tid(), G = gridDim.x, bid = blockIdx.x;
    unsigned char* ws = a.ws;
    for (int l = 0; l < DEPTH; ++l) {
        transpose_cvt(a.w_in + (size_t)l * DM * NIN, DM, NIN, (bf16_t*)(ws + WS_WIN) + (size_t)l * LDP * DM, LDP, lds, bid, G);
        transpose_cvt(a.w_out + (size_t)l * DI * DM, DI, DM, (bf16_t*)(ws + WS_WOUT) + (size_t)l * DM * DI, DM, lds, (bid + 128) % G, G);
    }
    {
        LAS float* R = (LAS float*)lds;
        float* mod = (float*)(ws + WS_MOD);
        const int jj = tid & 63, ks = tid >> 6;
        for (int item = bid; item < DEPTH * 48; item += G) {
            const int l = item / 48, j = (item % 48) * 64 + jj;
            float s0 = 0.f, s1 = 0.f, s2 = 0.f, s3 = 0.f;
            const float* w = a.w_ada + (size_t)l * DM * 3072 + j;
#pragma unroll 16
            for (int k = ks * 128; k < ks * 128 + 128; ++k) { const float wv = w[(size_t)k * 3072];
                s0 += silu_f(a.c[k]) * wv; s1 += silu_f(a.c[DM + k]) * wv; s2 += silu_f(a.c[2 * DM + k]) * wv; s3 += silu_f(a.c[3 * DM + k]) * wv; }
            R[(ks * 4 + 0) * 64 + jj] = s0; R[(ks * 4 + 1) * 64 + jj] = s1; R[(ks * 4 + 2) * 64 + jj] = s2; R[(ks * 4 + 3) * 64 + jj] = s3;
            __syncthreads();
            if (tid < 256) { const int b = tid >> 6; float s = a.b_ada[l * 3072 + j];
#pragma unroll
                for (int q = 0; q < 8; ++q) s += R[(q * 4 + b) * 64 + jj];
                mod[(size_t)(l * 4 + b) * 3072 + j] = s; }
            __syncthreads();
        }
    }
    {
        float2* rope = (float2*)(ws + WS_ROPE);
        for (int i = bid * NTHR + tid; i < 4096 * 64; i += G * NTHR) {
            const int pos = i >> 6, j = i & 63;
            const float invf = powf(10000.f, -(float)(2 * j) / 128.f);
            const float ang = (float)pos * invf;
            const float k = rintf(ang * 0.15915494309189535f);
            float r = fmaf(-k, 6.2831854820251465f, ang); r = fmaf(-k, -1.7484555e-07f, r);
            rope[i] = make_float2(__cosf(r), __sinf(r));
        }
    }
}

template <bool FINAL>
__device__ __forceinline__ void phase_norm(const float* __restrict__ xin  , const bf16_t* __restrict__ slab  ,
                                           const float* __restrict__ gate_prev  , float* xout  ,
                                           const float* __restrict__ g, const float* __restrict__ mod  , int half, bf16_t* __restrict__ hout) {
    const int tid = opaque_tid(), lane = tid & 63, wid = tid >> 6;
    const int gw = blockIdx.x * 8 + wid, nw = gridDim.x * 8;
    for (int row = gw; row < HROWS; row += nw) {
        const float* xr = xin + (size_t)row * DM;
        f32x4 v[4]; float ss = 0.f;
#pragma unroll
        for (int i = 0; i < 4; ++i) v[i] = *(const f32x4*)(xr + i * 256 + lane * 4);
        if (slab) {
            u32x2 a0[4], a1[4]; f32x4 gp[4];
#pragma unroll
            for (int i = 0; i < 4; ++i) { const int col = i * 256 + lane * 4;
                a0[i] = *(const u32x2*)(slab + (size_t)row * DM + col); a1[i] = *(const u32x2*)(slab + (size_t)(HROWS + row) * DM + col);
                gp[i] = *(const f32x4*)(gate_prev + (size_t)(row >> 12) * 3072 + col); }
#pragma unroll
            for (int i = 0; i < 4; ++i) {
                const f32x4 sa = {__uint_as_float(a0[i].x << 16) + __uint_as_float(a1[i].x << 16), __uint_as_float(a0[i].x & 0xffff0000u) + __uint_as_float(a1[i].x & 0xffff0000u),
                                  __uint_as_float(a0[i].y << 16) + __uint_as_float(a1[i].y << 16), __uint_as_float(a0[i].y & 0xffff0000u) + __uint_as_float(a1[i].y & 0xffff0000u)};
                v[i] = v[i] + gp[i] * sa; }
        }
        if (!FINAL && xout) {
#pragma unroll
            for (int i = 0; i < 4; ++i) *(f32x4*)(xout + (size_t)row * DM + i * 256 + lane * 4) = v[i];
        }
#pragma unroll
        for (int i = 0; i < 4; ++i) ss += v[i][0] * v[i][0] + v[i][1] * v[i][1] + v[i][2] * v[i][2] + v[i][3] * v[i][3];
#pragma unroll
        for (int o = 32; o > 0; o >>= 1) ss += __shfl_xor(ss, o);
        const float rinv = rsqrtf(ss * (1.f / DM) + EPS);
        if constexpr (FINAL) {
#pragma unroll
            for (int i = 0; i < 4; ++i) { const int col = i * 256 + lane * 4; const f32x4 gg = *(const f32x4*)(g + col);
                *(f32x4*)(xout + (size_t)row * DM + col) = v[i] * rinv * gg; }
        } else {
            const float* mb = mod + (size_t)(half * 2 + (row >> 12)) * 3072;
#pragma unroll
            for (int i = 0; i < 4; ++i) { const int col = i * 256 + lane * 4;
                const f32x4 gg = *(const f32x4*)(g + col), sh = *(const f32x4*)(mb + col), sc = *(const f32x4*)(mb + 1024 + col);
                float o0 = v[i][0] * rinv * gg[0] * (1.f + sc[0]) + sh[0], o1 = v[i][1] * rinv * gg[1] * (1.f + sc[1]) + sh[1];
                float o2 = v[i][2] * rinv * gg[2] * (1.f + sc[2]) + sh[2], o3 = v[i][3] * rinv * gg[3] * (1.f + sc[3]) + sh[3];
                u32x2 w; w.x = pk2(o0, o1); w.y = pk2(o2, o3);
                *(u32x2*)(hout + (size_t)row * DM + col) = w; }
        }
    }
}

struct MixP {
    const bf16_t* proj; bf16_t* st; float* dec; bf16_t* y; const float2* rope;
    const float* lbl; const float* hgrn_g; const float* ret_g; const float* conv_w; const float* conv_b; const float* dt_bias; const float* a_log;
    const float* dskip; const float* ssm_g; const float* w2; const float* b2; const float* gla_g; int layer;
};

__device__ __forceinline__ bf16x8 frag(LAS unsigned char* lds, int off, int ld, int r0, int ks, int lane) {
    return *(const LAS bf16x8*)(lds + off + (((r0 + (lane & 31)) * ld + 16 * ks + 8 * (lane >> 5)) << 1));
}
__device__ __forceinline__ int rowmap(int r, int lane) { return (r & 3) + 8 * (r >> 2) + 4 * (lane >> 5); }

__device__ __forceinline__ void conv16(LAS unsigned char* lds, int off, int ncols, int col, const float* cw, int seg, float (&out)[16]) {
    const LAS bf16_t* rp = (const LAS bf16_t*)(lds + off) + seg * 16 * ncols + col;
    float u[19];
#pragma unroll
    for (int k = 0; k < 19; ++k) u[k] = bf2f(rp[k * ncols]);
#pragma unroll
    for (int i = 0; i < 16; ++i) out[i] = silu_f(cw[4] + cw[0] * u[i] + cw[1] * u[i + 1] + cw[2] * u[i + 2] + cw[3] * u[i + 3]);
}
__device__ __forceinline__ void conv_w_load(const MixP& p, int chan, float* cw) {
    cw[0] = p.conv_w[chan]; cw[1] = p.conv_w[1024 + chan]; cw[2] = p.conv_w[2048 + chan]; cw[3] = p.conv_w[3072 + chan]; cw[4] = p.conv_b[chan];
}
template <int NCOLS, int NROWS> struct Stg { static constexpr int VPR = NCOLS / 8, NV = NROWS * VPR, NIT = (NV + NTHR - 1) / NTHR; };
template <int NCOLS, int NROWS>
__device__ __forceinline__ void stg_load(const bf16_t* src, int tid, int zrows, u32x4* r) {
    using S = Stg<NCOLS, NROWS>;
#pragma unroll
    for (int j = 0; j < S::NIT; ++j) { const int vi = tid + NTHR * j, row = vi / S::VPR, cv = vi % S::VPR;
        const bool ok = (vi < S::NV) && (row >= zrows);
        r[j] = ok ? *(const u32x4*)(src + (ptrdiff_t)row * LDP + cv * 8) : (u32x4){0u, 0u, 0u, 0u}; }
}
template <int NCOLS, int NROWS>
__device__ __forceinline__ void stg_store(LAS unsigned char* lds, int off, int tid, const u32x4* r) {
    using S = Stg<NCOLS, NROWS>;
#pragma unroll
    for (int j = 0; j < S::NIT; ++j) { const int vi = tid + NTHR * j; if (vi < S::NV) *(LAS u32x4*)(lds + off + vi * 16) = r[j]; }
}
__device__ __forceinline__ void store16(LAS unsigned char* lds, int byteoff, const float (&v)[16]) {
    u32x4 a, b; a.x = pk2(v[0], v[1]); a.y = pk2(v[2], v[3]); a.z = pk2(v[4], v[5]); a.w = pk2(v[6], v[7]);
    b.x = pk2(v[8], v[9]); b.y = pk2(v[10], v[11]); b.z = pk2(v[12], v[13]); b.w = pk2(v[14], v[15]);
    *(LAS u32x4*)(lds + byteoff) = a; *(LAS u32x4*)(lds + byteoff + 16) = b;
}
__device__ __forceinline__ void store8(LAS unsigned char* lds, int byteoff, const float (&v)[8]) {
    u32x4 a; a.x = pk2(v[0], v[1]); a.y = pk2(v[2], v[3]); a.z = pk2(v[4], v[5]); a.w = pk2(v[6], v[7]);
    *(LAS u32x4*)(lds + byteoff) = a;
}

constexpr int NUNITS = 128 * 14;
struct Pref { u32x4 raw[11]; u32x4 st[8]; float aux[16]; };
template <int BR, int PASS>
__device__ __forceinline__ void load_A(const MixP& p, int bc, int hu, int tid, Pref& pf) {
    const bf16_t* P = p.proj + (size_t)bc * 64 * LDP;
    if constexpr (BR == 0) { stg_load<128, 64>(P + C_AF + hu * 128, tid, 0, pf.raw + 0); stg_load<128, 64>(P + C_AI + hu * 128, tid, 0, pf.raw + 2);
        if constexpr (PASS == 3) stg_load<128, 64>(P + C_AQ + hu * 128, tid, 0, pf.raw + 4); }
    if constexpr (BR == 1) { stg_load<128, 64>(P + C_RK + hu * 128, tid, 0, pf.raw + 0); stg_load<128, 64>(P + C_RV + hu * 128, tid, 0, pf.raw + 2);
        if constexpr (PASS == 3) stg_load<128, 64>(P + C_RQ + hu * 128, tid, 0, pf.raw + 4); }
    if constexpr (BR == 2) { const int zr = ((bc & 63) == 0) ? 3 : 0; const bf16_t* P3 = P - 3 * (ptrdiff_t)LDP + C_XBC;
        stg_load<128, 67>(P3 + 512 + hu * 128, tid, zr, pf.raw + 0); stg_load<256, 67>(P3 + hu * 256, tid, zr, pf.raw + 3);
        if constexpr (PASS == 3) stg_load<128, 67>(P3 + 768 + hu * 128, tid, zr, pf.raw + 8); }
    if constexpr (BR == 3) { stg_load<64, 64>(P + C_GK + hu * 64, tid, 0, pf.raw + 0); stg_load<128, 64>(P + C_GV + hu * 128, tid, 0, pf.raw + 1); stg_load<16, 64>(P + C_LR, tid, 0, pf.raw + 3);
        if constexpr (PASS == 3) stg_load<64, 64>(P + C_GQ + hu * 64, tid, 0, pf.raw + 4); }
}
template <int BR, int PASS>
__device__ __forceinline__ void load_B(const MixP& p, int bc, int hu, int tid, Pref& pf) {
    if constexpr (PASS == 3) {
        constexpr int DK = (BR == 3) ? 64 : 128, DV = (BR == 2) ? 256 : 128, NV = DV * DK / 8 / NTHR;
        const int st_off = (BR == 0) ? hu * 16384 : (BR == 1) ? 65536 + hu * 16384 : (BR == 2) ? 131072 + hu * 32768 : 196608 + hu * 8192;
        const bf16_t* stg = p.st + (size_t)bc * ST_PER_BC + st_off;
#pragma unroll
        for (int k = 0; k < NV; ++k) pf.st[k] = *(const u32x4*)(stg + (size_t)(tid + NTHR * k) * 8);
    }
    if constexpr (BR == 1) { const int j = tid & 63, seg = tid >> 6, chunk = bc & 63;
#pragma unroll
        for (int i = 0; i < 8; ++i) { const float2 c = p.rope[(chunk * 64 + seg * 8 + i) * 64 + j]; pf.aux[2 * i] = c.x; pf.aux[2 * i + 1] = c.y; } }
    if constexpr (BR == 2) { if (tid < 64) { const bf16_t* P = p.proj + (size_t)bc * 64 * LDP;
#pragma unroll
            for (int hh = 0; hh < 4; ++hh) pf.aux[hh] = bf2f(P[(size_t)tid * LDP + C_DT + hu * 4 + hh]); } }
    if constexpr (BR == 3) { const int cc = hu * 64 + (tid & 63);
#pragma unroll
        for (int r = 0; r < 16; ++r) pf.aux[r] = p.w2[r * 256 + cc]; }
}
template <int PASS>
__device__ __forceinline__ void load_A_any(const MixP& p, int i, int tid, Pref& pf) {
    const int bc = i / 14, u = i % 14;
    if (u < 4) load_A<0, PASS>(p, bc, u, tid, pf); else if (u < 8) load_A<1, PASS>(p, bc, u - 4, tid, pf);
    else if (u < 10) load_A<2, PASS>(p, bc, u - 8, tid, pf); else load_A<3, PASS>(p, bc, u - 10, tid, pf);
}
template <int PASS>
__device__ __forceinline__ void load_B_any(const MixP& p, int i, int tid, Pref& pf) {
    const int bc = i / 14, u = i % 14;
    if (u < 4) load_B<0, PASS>(p, bc, u, tid, pf); else if (u < 8) load_B<1, PASS>(p, bc, u - 4, tid, pf);
    else if (u < 10) load_B<2, PASS>(p, bc, u - 8, tid, pf); else load_B<3, PASS>(p, bc, u - 10, tid, pf);
}

template <int BR, int PASS>
__device__ __forceinline__ void mixer_unit(const MixP& p, LAS unsigned char* lds, int bc, int hu  ) {
    constexpr int DK = (BR == 3) ? 64 : 128, LDK = DK + 8, NH = (BR == 2) ? 4 : 1, DV = (BR == 2) ? 256 : 128, NT = DV / 128;
    constexpr bool VEC = (BR == 0 || BR == 3);
    const int tid = opaque_tid(), lane = tid & 63, wid = __builtin_amdgcn_readfirstlane(tid >> 6);
    const int chunk = bc & 63;
    const bf16_t* P = p.proj + (size_t)bc * 64 * LDP;
    LAS float* SM = (LAS float*)(lds + L_SM);
    LAS bf16_t* QI = (LAS bf16_t*)(lds + L_QI); LAS bf16_t* KI = (LAS bf16_t*)(lds + L_KI); LAS bf16_t* VT = (LAS bf16_t*)(lds + L_VT);
    const int st_off = (BR == 0) ? hu * 16384 : (BR == 1) ? 65536 + hu * 16384 : (BR == 2) ? 131072 + hu * 32768 : 196608 + hu * 8192;
    bf16_t* stg = p.st + (size_t)bc * ST_PER_BC + st_off;
    Pref pf;
    load_A<BR, PASS>(p, bc, hu, tid, pf);
    load_B<BR, PASS>(p, bc, hu, tid, pf);
    constexpr int NTG = (PASS == 3) ? NT : 1;
    const int gcol = (BR == 0) ? C_AG + hu * 128 : (BR == 1) ? C_RG + hu * 128 : (BR == 2) ? C_MZ + hu * 256 : C_GG + hu * 128;
    const float* gain = (BR == 0) ? p.hgrn_g + hu * 128 : (BR == 1) ? p.ret_g + hu * 128 : (BR == 2) ? p.ssm_g + hu * 256 : p.gla_g + hu * 128;
    bf16_t gt[NTG][16]; float gnv[NTG], dskv[NTG];
    if constexpr (PASS == 3) {
#pragma unroll
        for (int nt = 0; nt < NT; ++nt) { const int ct = (wid & 3) + 4 * nt;
            gnv[nt] = gain[ct * 32 + (lane & 31)]; dskv[nt] = (BR == 2) ? p.dskip[hu * 4 + (ct >> 1)] : 0.f;
#pragma unroll
            for (int r = 0; r < 16; ++r) gt[nt][r] = P[(size_t)((wid >> 2) * 32 + rowmap(r, lane)) * LDP + gcol + ct * 32 + (lane & 31)]; }
    }
    float lb = 0.f, bb = 0.f, cwb[5], cwc[5], cwx[5], dtb[4], alg[4];
    if constexpr (BR == 0) { if (p.layer == 1) { const int cc = hu * 128 + (tid & 127); lb = 1.f / (1.f + __expf(p.lbl[cc] - p.lbl[512 + cc])); } }
    if constexpr (BR == 3) bb = p.b2[hu * 64 + (tid & 63)];
    if constexpr (BR == 2) { conv_w_load(p, 512 + hu * 128 + (tid & 127), cwb); if constexpr (PASS == 3) conv_w_load(p, 768 + hu * 128 + (tid & 127), cwc); conv_w_load(p, hu * 256 + (tid & 255), cwx);
#pragma unroll
        for (int hh = 0; hh < 4; ++hh) { dtb[hh] = p.dt_bias[hu * 4 + hh]; alg[hh] = p.a_log[hu * 4 + hh]; } }
    __builtin_amdgcn_sched_barrier(0);

    for (int urep = 0; urep < REP_UPREP; ++urep) {
    if constexpr (BR == 0) {
        constexpr int RQ = L_BIG, RF = (PASS == 3) ? L_BIG + 16384 : L_QI, RV = (PASS == 3) ? L_BIG + 32768 : L_QI + 16384;
        stg_store<128, 64>(lds, RF, tid, pf.raw + 0); stg_store<128, 64>(lds, RV, tid, pf.raw + 2);
        if constexpr (PASS == 3) stg_store<128, 64>(lds, RQ, tid, pf.raw + 4);
        __builtin_amdgcn_sched_barrier(0);
        const int d = tid & 127, seg = tid >> 7;
        __syncthreads();
        const LAS bf16_t* rF = (const LAS bf16_t*)(lds + RF) + seg * 16 * 128 + d;
        const LAS bf16_t* rQ = (const LAS bf16_t*)(lds + RQ) + seg * 16 * 128 + d;
        const LAS bf16_t* rV = (const LAS bf16_t*)(lds + RV) + seg * 16 * 128 + d;
        float cs[16], kk[16]; float run = 0.f;
#pragma unroll
        for (int i = 0; i < 16; ++i) { const float av = fmaxf(bf2f(rF[i * 128]), -60.f); const float e = __expf(-av), sg = __builtin_amdgcn_rcpf(1.f + e);
            const float f = lb + (1.f - lb) * sg; run += __logf(f); cs[i] = run; kk[i] = (1.f - lb) * e * sg; }
        SM[SM_SEG + seg * 128 + d] = run;
        __syncthreads();
        const float t0 = SM[SM_SEG + d], t1 = SM[SM_SEG + 128 + d], t2 = SM[SM_SEG + 256 + d], t3 = SM[SM_SEG + 384 + d];
        const float off = (seg == 0) ? 0.f : (seg == 1) ? t0 : (seg == 2) ? t0 + t1 : t0 + t1 + t2;
        const float ref = t0 + t1, clast = ref + t2 + t3;
        if (seg == 0) { SM[SM_REF + d] = ref; SM[SM_CLAST + d] = clast; }
        float kv[16];
#pragma unroll
        for (int i = 0; i < 16; ++i) { const float c = off + cs[i]; kv[i] = kk[i] * __expf(ref - c);
            if constexpr (PASS == 3) { KI[(seg * 16 + i) * LDK + d] = f2bf(kv[i]);
                const float q = bf2f(rQ[i * 128]); QI[(seg * 16 + i) * LDK + d] = f2bf(silu_f(q) * __expf(c - ref)); } }
        if constexpr (PASS == 1) store16(lds, L_BIG + (d * 72 + seg * 16) * 2, kv);
        unsigned vv[16];
#pragma unroll
        for (int i = 0; i < 16; ++i) vv[i] = rV[i * 128];
        u32x4 a, b; a.x = vv[0] | (vv[1] << 16); a.y = vv[2] | (vv[3] << 16); a.z = vv[4] | (vv[5] << 16); a.w = vv[6] | (vv[7] << 16);
        b.x = vv[8] | (vv[9] << 16); b.y = vv[10] | (vv[11] << 16); b.z = vv[12] | (vv[13] << 16); b.w = vv[14] | (vv[15] << 16);
        *(LAS u32x4*)(lds + L_VT + (d * 72 + seg * 16) * 2) = a; *(LAS u32x4*)(lds + L_VT + (d * 72 + seg * 16) * 2 + 16) = b;
    }
    if constexpr (BR == 1) {
        constexpr int RQ = L_BIG, RK = (PASS == 3) ? L_BIG + 16384 : L_QI, RV = (PASS == 3) ? L_BIG + 32768 : L_QI + 16384;
        const int j = tid & 63, seg = tid >> 6;
        float2 cssn[8];
#pragma unroll
        for (int i = 0; i < 8; ++i) cssn[i] = make_float2(pf.aux[2 * i], pf.aux[2 * i + 1]);
        stg_store<128, 64>(lds, RK, tid, pf.raw + 0); stg_store<128, 64>(lds, RV, tid, pf.raw + 2);
        if constexpr (PASS == 3) stg_store<128, 64>(lds, RQ, tid, pf.raw + 4);
        __builtin_amdgcn_sched_barrier(0);
        const float lg = log1pf(-exp2f(-(5.f + (float)hu)));
        if (tid < 64) { SM[SM_CUM + tid] = (float)(tid + 1) * lg; SM[SM_DT + tid] = 1.f; }
        __syncthreads();
        float k1[8], k2[8];
#pragma unroll
        for (int i = 0; i < 8; ++i) { const int t = seg * 8 + i;
            const LAS bf16_t* rk = (const LAS bf16_t*)(lds + RK) + t * 128 + j;
            const float ka = bf2f(rk[0]) * 0.08838834764831845f, kb = bf2f(rk[64]) * 0.08838834764831845f;
            k1[i] = ka * cssn[i].x - kb * cssn[i].y; k2[i] = ka * cssn[i].y + kb * cssn[i].x;
            if constexpr (PASS == 3) { const LAS bf16_t* rq = (const LAS bf16_t*)(lds + RQ) + t * 128 + j;
                const float qa = bf2f(rq[0]), qb = bf2f(rq[64]);
                QI[t * LDK + j] = f2bf(qa * cssn[i].x - qb * cssn[i].y); QI[t * LDK + j + 64] = f2bf(qa * cssn[i].y + qb * cssn[i].x);
                KI[t * LDK + j] = f2bf(k1[i]); KI[t * LDK + j + 64] = f2bf(k2[i]); } }
        if constexpr (PASS == 1) { store8(lds, L_BIG + (j * 72 + seg * 8) * 2, k1); store8(lds, L_BIG + ((j + 64) * 72 + seg * 8) * 2, k2); }
        const int v = tid & 127, s4 = tid >> 7; float vv[16];
#pragma unroll
        for (int i = 0; i < 16; ++i) { const int s = s4 * 16 + i; float x = bf2f(((const LAS bf16_t*)(lds + RV))[s * 128 + v]);
            if constexpr (PASS == 1) x *= __expf((float)(63 - s) * lg);
            vv[i] = x; }
        store16(lds, L_VT + (v * 72 + s4 * 16) * 2, vv);
    }
    if constexpr (BR == 2) {
        constexpr int RB = (PASS == 3) ? L_BIG : L_QI, RC = L_BIG + 17152, RX = (PASS == 3) ? L_BIG + 34304 : L_BIG + 18432;
        float dtr[4];
#pragma unroll
        for (int hh = 0; hh < 4; ++hh) dtr[hh] = pf.aux[hh];
        stg_store<128, 67>(lds, RB, tid, pf.raw + 0); stg_store<256, 67>(lds, RX, tid, pf.raw + 3);
        if constexpr (PASS == 3) stg_store<128, 67>(lds, RC, tid, pf.raw + 8);
        __builtin_amdgcn_sched_barrier(0);
        if (tid < 64) {
#pragma unroll
            for (int hh = 0; hh < 4; ++hh) {
                const float dt = softplus_f(dtr[hh] + dtb[hh]);
                float la = -dt * __expf(alg[hh]);
#pragma unroll
                for (int o = 1; o < 64; o <<= 1) { const float yv = __shfl_up(la, o); if (tid >= o) la += yv; }
                SM[SM_CUM + hh * 64 + tid] = la; SM[SM_DT + hh * 64 + tid] = dt; }
        }
        __syncthreads();
        { const int n = tid & 127, seg = tid >> 7; float o[16];
          conv16(lds, RB, 128, n, cwb, seg, o);
          if constexpr (PASS == 3) {
#pragma unroll
              for (int i = 0; i < 16; ++i) KI[(seg * 16 + i) * LDK + n] = f2bf(o[i]);
              conv16(lds, RC, 128, n, cwc, seg, o);
#pragma unroll
              for (int i = 0; i < 16; ++i) QI[(seg * 16 + i) * LDK + n] = f2bf(o[i]);
          } else store16(lds, L_BIG + (n * 72 + seg * 16) * 2, o);
        }
        { const int v = tid & 255, s2 = tid >> 8, hh = v >> 6;
#pragma unroll
          for (int r = 0; r < 2; ++r) { const int seg = s2 * 2 + r; float o[16];
              conv16(lds, RX, 256, v, cwx, seg, o);
              if constexpr (PASS == 1) { const float cl = SM[SM_CUM + hh * 64 + 63];
#pragma unroll
                  for (int i = 0; i < 16; ++i) { const int s = seg * 16 + i; o[i] *= __expf(cl - SM[SM_CUM + hh * 64 + s]) * SM[SM_DT + hh * 64 + s]; } }
              store16(lds, L_VT + (v * 72 + seg * 16) * 2, o); }
        }
    }
    if constexpr (BR == 3) {
        constexpr int RQ = L_BIG, RK = (PASS == 3) ? L_BIG + 8192 : L_QI, RV = (PASS == 3) ? L_BIG + 16384 : L_QI + 8192, RL = (PASS == 3) ? L_BIG + 32768 : L_QI + 24576;
        const int d = tid & 63, seg = tid >> 6, cc = hu * 64 + d;
        float w2r[16];
#pragma unroll
        for (int r = 0; r < 16; ++r) w2r[r] = pf.aux[r];
        stg_store<64, 64>(lds, RK, tid, pf.raw + 0); stg_store<128, 64>(lds, RV, tid, pf.raw + 1); stg_store<16, 64>(lds, RL, tid, pf.raw + 3);
        if constexpr (PASS == 3) stg_store<64, 64>(lds, RQ, tid, pf.raw + 4);
        __builtin_amdgcn_sched_barrier(0);
        __syncthreads();
        float cs[8]; float run = 0.f;
#pragma unroll
        for (int i = 0; i < 8; ++i) { const int t = seg * 8 + i; const LAS bf16x8* lp = (const LAS bf16x8*)(lds + RL + t * 32);
            const bf16x8 l0 = lp[0], l1 = lp[1]; float gk = bb;
#pragma unroll
            for (int r = 0; r < 8; ++r) { gk += w2r[r] * bf2f((bf16_t)l0[r]); gk += w2r[8 + r] * bf2f((bf16_t)l1[r]); }
            run += logsig_f(gk) * (1.f / 16.f); cs[i] = run; }
        SM[SM_SEG + seg * 64 + d] = run;
        __syncthreads();
        float off = 0.f, ref = 0.f, clast = 0.f;
#pragma unroll
        for (int s = 0; s < 8; ++s) { const float tv = SM[SM_SEG + s * 64 + d]; if (s < seg) off += tv; if (s < 4) ref += tv; clast += tv; }
        if (seg == 0) { SM[SM_REF + d] = ref; SM[SM_CLAST + d] = clast; }
        float kv[8];
#pragma unroll
        for (int i = 0; i < 8; ++i) { const int t = seg * 8 + i; const float c = off + cs[i];
            kv[i] = bf2f(((const LAS bf16_t*)(lds + RK))[t * 64 + d]) * __expf(ref - c);
            if constexpr (PASS == 3) { KI[t * LDK + d] = f2bf(kv[i]); QI[t * LDK + d] = f2bf(bf2f(((const LAS bf16_t*)(lds + RQ))[t * 64 + d]) * 0.125f * __expf(c - ref)); } }
        if constexpr (PASS == 1) store8(lds, L_BIG + (d * 72 + seg * 8) * 2, kv);
        const int v = tid & 127, s4 = tid >> 7; unsigned vv[16];
#pragma unroll
        for (int i = 0; i < 16; ++i) vv[i] = ((const LAS bf16_t*)(lds + RV))[(s4 * 16 + i) * 128 + v];
        u32x4 a, b; a.x = vv[0] | (vv[1] << 16); a.y = vv[2] | (vv[3] << 16); a.z = vv[4] | (vv[5] << 16); a.w = vv[6] | (vv[7] << 16);
        b.x = vv[8] | (vv[9] << 16); b.y = vv[10] | (vv[11] << 16); b.z = vv[12] | (vv[13] << 16); b.w = vv[14] | (vv[15] << 16);
        *(LAS u32x4*)(lds + L_VT + (v * 72 + s4 * 16) * 2) = a; *(LAS u32x4*)(lds + L_VT + (v * 72 + s4 * 16) * 2 + 16) = b;
    }
    __syncthreads();
    }
    for (int urep = 0; urep < REP_UCORE; ++urep) {
    if constexpr (PASS == 1) {
        constexpr int NTN = DV / 32, NTILES = (DK / 32) * NTN;
#pragma unroll
        for (int i = 0; i < NTILES / 8; ++i) {
            const int ti = wid + 8 * i, tm = ti / NTN, tn = ti % NTN;
            f32x16 acc;
#pragma unroll
            for (int r = 0; r < 16; ++r) acc[r] = 0.f;
#pragma unroll
            for (int ks = 0; ks < 4; ++ks) acc = __builtin_amdgcn_mfma_f32_32x32x16_bf16(frag(lds, L_BIG, 72, tm * 32, ks, lane), frag(lds, L_VT, 72, tn * 32, ks, lane), acc, 0, 0, 0);
            const int v = tn * 32 + (lane & 31);
#pragma unroll
            for (int rg = 0; rg < 4; ++rg) { const int d0 = tm * 32 + 8 * rg + 4 * (lane >> 5);
                float o[4];
#pragma unroll
                for (int q = 0; q < 4; ++q) { o[q] = acc[rg * 4 + q]; if constexpr (VEC) o[q] *= __expf(SM[SM_CLAST + d0 + q] - SM[SM_REF + d0 + q]); }
                u32x2 w; w.x = pk2(o[0], o[1]); w.y = pk2(o[2], o[3]);
                *(u32x2*)(stg + (size_t)v * DK + d0) = w; }
        }
        float* dec = p.dec + (size_t)bc * 1024;
        if constexpr (BR == 0) { if (tid < 128) dec[hu * 128 + tid] = __expf(SM[SM_CLAST + tid]); }
        if constexpr (BR == 3) { if (tid < 64) dec[512 + hu * 64 + tid] = __expf(SM[SM_CLAST + tid]); }
        if constexpr (BR == 2) { if (tid < 4) dec[768 + hu * 4 + tid] = __expf(SM[SM_CUM + tid * 64 + 63]); }
        __syncthreads();
    } else {
        constexpr int NCT = DV / 32;
        {
            constexpr int NVEC = DV * DK / 8, VPR = DK / 8;
#pragma unroll
            for (int k = 0; k < NVEC / NTHR; ++k) { const int vi = tid + NTHR * k; const int v = vi / VPR, d0 = (vi % VPR) * 8;
                u32x4 raw = pf.st[k];
                if constexpr (VEC) { unsigned w[4] = {raw.x, raw.y, raw.z, raw.w};
#pragma unroll
                    for (int q = 0; q < 4; ++q) { const float lo = __uint_as_float(w[q] << 16) * __expf(SM[SM_REF + d0 + 2 * q]), hi = __uint_as_float(w[q] & 0xffff0000u) * __expf(SM[SM_REF + d0 + 2 * q + 1]);
                        w[q] = pk2(lo, hi); }
                    raw.x = w[0]; raw.y = w[1]; raw.z = w[2]; raw.w = w[3]; }
                *(LAS u32x4*)(lds + L_BIG + (v * LDK + d0) * 2) = raw; }
        }
        __builtin_amdgcn_sched_barrier(0);
        __syncthreads();
        const int tm = wid >> 2, tnb = wid & 3;
        f32x16 acc[NT];
#pragma unroll
        for (int nt = 0; nt < NT; ++nt)
#pragma unroll
            for (int r = 0; r < 16; ++r) acc[nt][r] = 0.f;
#pragma unroll
        for (int ks = 0; ks < DK / 16; ++ks) { const bf16x8 af = frag(lds, L_QI, LDK, tm * 32, ks, lane);
#pragma unroll
            for (int nt = 0; nt < NT; ++nt) acc[nt] = __builtin_amdgcn_mfma_f32_32x32x16_bf16(af, frag(lds, L_BIG, LDK, (tnb + 4 * nt) * 32, ks, lane), acc[nt], 0, 0, 0); }
        if constexpr (!VEC) {
#pragma unroll
            for (int nt = 0; nt < NT; ++nt) { const int hh = (NH == 1) ? 0 : ((tnb + 4 * nt) >> 1);
#pragma unroll
                for (int r = 0; r < 16; ++r) acc[nt][r] *= __expf(SM[SM_CUM + hh * 64 + tm * 32 + rowmap(r, lane)]); }
        }
        f32x16 sc;
#pragma unroll
        for (int r = 0; r < 16; ++r) sc[r] = 0.f;
        const int stm = wid >> 1, stn = wid & 1;
        if (wid < 4) {
#pragma unroll
            for (int ks = 0; ks < DK / 16; ++ks) sc = __builtin_amdgcn_mfma_f32_32x32x16_bf16(frag(lds, L_QI, LDK, stm * 32, ks, lane), frag(lds, L_KI, LDK, stn * 32, ks, lane), sc, 0, 0, 0);
        }
        __syncthreads();
        if (wid < 4) {
            const int s = stn * 32 + (lane & 31);
#pragma unroll
            for (int hh = 0; hh < NH; ++hh) {
                float cums = 0.f, dts = 1.f;
                if constexpr (!VEC) { cums = SM[SM_CUM + hh * 64 + s]; dts = SM[SM_DT + hh * 64 + s]; }
#pragma unroll
                for (int r = 0; r < 16; ++r) { const int t = stm * 32 + rowmap(r, lane);
                    float val = sc[r];
                    if constexpr (!VEC) { const float ex = (s <= t) ? SM[SM_CUM + hh * 64 + t] - cums : 0.f; val *= __expf(ex) * dts; }
                    val = (s <= t) ? val : 0.f;
                    *(LAS bf16_t*)(lds + L_BIG + ((hh * 64 + t) * 72 + s) * 2) = f2bf(val); }
            }
        }
        __syncthreads();
#pragma unroll
        for (int nt = 0; nt < NT; ++nt) { const int hh = (NH == 1) ? 0 : ((tnb + 4 * nt) >> 1);
#pragma unroll
            for (int ks = 0; ks < 4; ++ks) acc[nt] = __builtin_amdgcn_mfma_f32_32x32x16_bf16(frag(lds, L_BIG + hh * 9216, 72, tm * 32, ks, lane), frag(lds, L_VT, 72, (tnb + 4 * nt) * 32, ks, lane), acc[nt], 0, 0, 0); }
        const int ycol = (BR == 0) ? hu * 128 : (BR == 1) ? 512 + hu * 128 : (BR == 2) ? 1024 + hu * 256 : 1536 + hu * 128;
#pragma unroll
        for (int nt = 0; nt < NT; ++nt) { const int ct = tnb + 4 * nt, v = ct * 32 + (lane & 31);
            const float dsk = dskv[nt];
            float sq[16];
#pragma unroll
            for (int r = 0; r < 16; ++r) { const int t = tm * 32 + rowmap(r, lane);
                float val = acc[nt][r];
                if constexpr (BR == 2) { val = (val + dsk * bf2f(VT[v * 72 + t])) * silu_f(bf2f(gt[nt][r])); acc[nt][r] = val; }
                sq[r] = val * val; }
            const bool b4 = lane & 16, b3 = lane & 8, b2 = lane & 4, b1 = lane & 2;
#pragma unroll
            for (int i = 0; i < 8; ++i) { const float lo = sq[i], hi = sq[i + 8]; sq[i] = (b4 ? hi : lo) + __shfl_xor(b4 ? lo : hi, 16); }
#pragma unroll
            for (int i = 0; i < 4; ++i) { const float lo = sq[i], hi = sq[i + 4]; sq[i] = (b3 ? hi : lo) + __shfl_xor(b3 ? lo : hi, 8); }
#pragma unroll
            for (int i = 0; i < 2; ++i) { const float lo = sq[i], hi = sq[i + 2]; sq[i] = (b2 ? hi : lo) + __shfl_xor(b2 ? lo : hi, 4); }
            { const float lo = sq[0], hi = sq[1]; sq[0] = (b1 ? hi : lo) + __shfl_xor(b1 ? lo : hi, 2); }
            sq[0] += __shfl_xor(sq[0], 1);
            const int rr = (b4 ? 8 : 0) + (b3 ? 4 : 0) + (b2 ? 2 : 0) + (b1 ? 1 : 0);
            if ((lane & 1) == 0) SM[SM_RSS + ct * 64 + tm * 32 + rowmap(rr, lane)] = sq[0];
        }
        __syncthreads();
        if (tid < 64) { float tot = 0.f;
#pragma unroll
            for (int q = 0; q < NCT; ++q) tot += SM[SM_RSS + q * 64 + tid];
            SM[SM_SEG + tid] = rsqrtf(tot * (1.f / DV) + EPS); }
        __syncthreads();
        float rinv[16];
#pragma unroll
        for (int r = 0; r < 16; ++r) rinv[r] = SM[SM_SEG + tm * 32 + rowmap(r, lane)];
#pragma unroll
        for (int nt = 0; nt < NT; ++nt) { const int ct = tnb + 4 * nt, v = ct * 32 + (lane & 31);
            const float gn = gnv[nt];
#pragma unroll
            for (int r = 0; r < 16; ++r) { const int t = tm * 32 + rowmap(r, lane);
                float o = acc[nt][r] * rinv[r] * gn;
                if constexpr (BR != 2) o *= silu_f(bf2f(gt[nt][r]));
                p.y[(size_t)(bc * 64 + t) * DI + ycol + v] = f2bf(o); }
        }
        __syncthreads();
    }
    }
}

template <int PASS>
__device__ __forceinline__ void phase_mixer(const MixP& p, LAS unsigned char* lds) {
#pragma unroll 1
    for (int i = blockIdx.x; i < NUNITS; i += gridDim.x) {
        const int bc = i / 14, u = i % 14;
        if (u < 4) mixer_unit<0, PASS>(p, lds, bc, u);
        else if (u < 8) mixer_unit<1, PASS>(p, lds, bc, u - 4);
        else if (u < 10) mixer_unit<2, PASS>(p, lds, bc, u - 8);
        else mixer_unit<3, PASS>(p, lds, bc, u - 10);
    }
}

__device__ __forceinline__ void phase_scan(bf16_t* st, const float* dec) {
    const int gt = blockIdx.x * NTHR + opaque_tid();
    constexpr int VPB = ST_PER_BC / 4;
    if (gt >= 2 * VPB) return;
    const int bl = gt / VPB, e0 = (gt % VPB) * 4;
    int mode, didx = 0; float cfac = 0.f;
    if (e0 < 65536) { mode = 0; didx = (e0 >> 14) * 128 + (e0 & 127); }
    else if (e0 < 131072) { mode = 1; const int h = (e0 - 65536) >> 14; cfac = __expf(64.f * log1pf(-exp2f(-(5.f + (float)h)))); }
    else if (e0 < 196608) { mode = 2; const int r = e0 - 131072; didx = 768 + (r >> 15) * 4 + (((r & 32767) >> 7) >> 6); }
    else { mode = 0; const int r = e0 - 196608; didx = 512 + (r >> 13) * 64 + (r & 63); }
    float s0 = 0.f, s1 = 0.f, s2 = 0.f, s3 = 0.f;
    bf16_t* ptr = st + (size_t)bl * 64 * ST_PER_BC + e0;
    const float* dp = dec + (size_t)bl * 64 * 1024 + didx;
#pragma unroll 1
    for (int c0 = 0; c0 < 64; c0 += 8) {
        u32x2 hv[8]; f32x4 dv[8];
#pragma unroll
        for (int j = 0; j < 8; ++j) {
            hv[j] = *(const u32x2*)(ptr + (size_t)(c0 + j) * ST_PER_BC);
            if (mode == 0) dv[j] = *(const f32x4*)(dp + (size_t)(c0 + j) * 1024);
            else if (mode == 1) dv[j] = (f32x4){cfac, cfac, cfac, cfac};
            else { const float d = dp[(size_t)(c0 + j) * 1024]; dv[j] = (f32x4){d, d, d, d}; }
        }
        __builtin_amdgcn_sched_barrier(0);
#pragma unroll
        for (int j = 0; j < 8; ++j) {
            u32x2 w; w.x = pk2(s0, s1); w.y = pk2(s2, s3);
            *(u32x2*)(ptr + (size_t)(c0 + j) * ST_PER_BC) = w;
            s0 = s0 * dv[j][0] + __uint_as_float(hv[j].x << 16); s1 = s1 * dv[j][1] + __uint_as_float(hv[j].x & 0xffff0000u);
            s2 = s2 * dv[j][2] + __uint_as_float(hv[j].y << 16); s3 = s3 * dv[j][3] + __uint_as_float(hv[j].y & 0xffff0000u);
        }
    }
}


#define XB_TMO      128
#define XB_XCNT(j)  (256  + 64 * (j))
#define XB_XSUB(j)  (1280 + 64 * (j))
#define XB_XGEN(j)  (2304 + 64 * (j))
#define XB_TOP      3328
#define XB_TOPGEN   3392
#define XCD_BAR_WORDS 3456
#define XB_SPIN_CAP (1u << 18)
__device__ __forceinline__ unsigned xb_ld(unsigned* p)              { return __hip_atomic_load(p, __ATOMIC_RELAXED, __HIP_MEMORY_SCOPE_AGENT); }
__device__ __forceinline__ unsigned xb_add(unsigned* p, unsigned v) { return __hip_atomic_fetch_add(p, v, __ATOMIC_RELAXED, __HIP_MEMORY_SCOPE_AGENT); }
__device__ __forceinline__ unsigned xb_xcc_id() { return (unsigned)__builtin_amdgcn_s_getreg((3 << 11) | 20) & 0xFu; }
#define XB_SPIN(cond, bar) do { unsigned _sp = 0; while (cond) { __builtin_amdgcn_s_sleep(1); \
    if ((++_sp & 255u) == 0u) { if (xb_ld(&(bar)[XB_TMO])) break; if (_sp > XB_SPIN_CAP) { atomicAdd(&(bar)[XB_TMO], 1u); break; } } } } while (0)
struct XcdBarrier { unsigned* bar; unsigned x; volatile LAS unsigned* st; };
__device__ __forceinline__ XcdBarrier xcd_barrier_post(unsigned* bar, volatile LAS unsigned* st) {
    XcdBarrier b; b.bar = bar; b.x = xb_xcc_id(); b.st = st;
    if (threadIdx.x == 0) (void)xb_add(&bar[XB_XCNT(b.x)], 1u);
    return b;
}
__device__ __forceinline__ void xcd_barrier_complete(unsigned* bar, unsigned x, unsigned& nloc, unsigned& nx) {
    const unsigned G = gridDim.x * gridDim.y * gridDim.z;
    unsigned sum, cnt, mine, sp = 0u;
    for (;;) {
        sum = 0u; cnt = 0u; mine = 0u;
#pragma unroll
        for (unsigned j = 0; j < 16; ++j) { const unsigned c = xb_ld(&bar[XB_XCNT(j)]); sum += c; cnt += (c > 0u) ? 1u : 0u; mine = (j == x) ? c : mine; }
        if (sum == G) break;
        __builtin_amdgcn_s_sleep(1);
        if ((++sp & 255u) == 0u) { if (xb_ld(&bar[XB_TMO])) break; if (sp > XB_SPIN_CAP) { atomicAdd(&bar[XB_TMO], 1u); break; } }
    }
    nloc = mine > 0u ? mine : 1u; nx = cnt > 0u ? cnt : 1u;
}
__device__ __forceinline__ void xcd_barrier(const XcdBarrier& b) {
    asm volatile("s_waitcnt vmcnt(0)" ::: "memory");
    __syncthreads();
    if (threadIdx.x == 0) {
        unsigned* bar = b.bar;
        __builtin_amdgcn_s_waitcnt(0);
        unsigned nloc = b.st[0], nx = b.st[1];
        if (nloc == 0u) { xcd_barrier_complete(bar, b.x, nloc, nx); b.st[0] = nloc; b.st[1] = nx; }
        const unsigned old = xb_add(&bar[XB_XSUB(b.x)], 1u);
        const unsigned gen = old / nloc;
        if (old + 1u == (gen + 1u) * nloc) {
            __builtin_amdgcn_fence(__ATOMIC_RELEASE, "agent");
            asm volatile("s_waitcnt vmcnt(0)" ::: "memory");
            const unsigned og = xb_add(&bar[XB_TOP], 1u);
            const unsigned tg = og / nx;
            if (og + 1u == (tg + 1u) * nx) xb_add(&bar[XB_TOPGEN], 1u);
            else XB_SPIN(xb_ld(&bar[XB_TOPGEN]) == tg, bar);
            __builtin_amdgcn_fence(__ATOMIC_ACQUIRE, "agent");
            xb_add(&bar[XB_XGEN(b.x)], 1u);
            asm volatile("s_waitcnt vmcnt(0)" ::: "memory");
        } else {
            XB_SPIN(xb_ld(&bar[XB_XGEN(b.x)]) == gen, bar);
            __builtin_amdgcn_fence(__ATOMIC_ACQUIRE, "agent");
            asm volatile("s_waitcnt vmcnt(0)" ::: "memory");
        }
    }
    __syncthreads();
}

__global__ void __launch_bounds__(NTHR, 2) fwd_megakernel(Args a) {
    extern __shared__ __attribute__((aligned(16))) unsigned char shm[];
    LAS unsigned char* lds = (LAS unsigned char*)shm;
    cg::grid_group grid = cg::this_grid();
    unsigned char* ws = a.ws;
    const int G = gridDim.x;

    {
        volatile LAS unsigned* stw = (volatile LAS unsigned*)(lds + L_BARST);
        if (threadIdx.x < 2) stw[threadIdx.x] = 0u;
        __syncthreads();
    }
    const XcdBarrier gbar = xcd_barrier_post((unsigned*)(ws + WS_BAR), (volatile LAS unsigned*)(lds + L_BARST));
    for (int rep = 0; rep < REP_PREP; ++rep) { phase_prep(a, lds); if (rep == 0) grid.sync(); else xcd_barrier(gbar); }

    bf16_t* hbuf = (bf16_t*)(ws + WS_HY); bf16_t* ybuf = (bf16_t*)(ws + WS_HY);
    bf16_t* proj = (bf16_t*)(ws + WS_PROJ); bf16_t* st = (bf16_t*)(ws + WS_ST); float* dec = (float*)(ws + WS_DEC);
    const float* mod = (const float*)(ws + WS_MOD);

#pragma unroll 1
    for (int half = 0; half < 2; ++half) {
        const size_t xoff = (size_t)half * HROWS * DM;
#pragma unroll 1
        for (int l = 0; l < DEPTH; ++l) {
            const float* modl = mod + (size_t)l * 4 * 3072;
            bf16_t* slab = (bf16_t*)(ws + WS_PROJ);
            if (l == 0) phase_norm<false>(a.x + xoff, nullptr, nullptr, nullptr, a.norm_g, modl, half, hbuf);
            else phase_norm<false>(a.x + xoff, slab, mod + (size_t)(half * 2) * 3072 + 2048, a.out + xoff, a.norm_g + l * DM, modl, half, hbuf);
            xcd_barrier(gbar);
            for (int rep = 0; rep < REP_G1; ++rep) {
                pg8::Gemm g{hbuf, (const bf16_t*)(ws + WS_WIN) + (size_t)l * LDP * DM, HROWS, LDP, DM, DM};
                pg8::StaticOrder S; S.init(HROWS, LDP, G, (int)blockIdx.x);
                pg8::EpiProj E{proj, LDP};
                pg8::gemm_phase<pg8::EpiProj, pg8::StaticOrder>(lds, g, S, E);
                xcd_barrier(gbar);
            }
            MixP p;
            p.proj = proj; p.st = st; p.dec = dec; p.y = ybuf; p.rope = (const float2*)(ws + WS_ROPE);
            p.lbl = a.lb_logits; p.hgrn_g = a.hgrn_g + l * 512; p.ret_g = a.ret_g + l * 512; p.conv_w = a.conv_w + l * 4096; p.conv_b = a.conv_b + l * 1024;
            p.dt_bias = a.dt_bias + l * 8; p.a_log = a.a_log + l * 8; p.dskip = a.dskip + l * 8; p.ssm_g = a.ssm_g + l * 512;
            p.w2 = a.w_gk2 + l * 16 * 256; p.b2 = a.b_gk2 + l * 256; p.gla_g = a.gla_g + l * 512; p.layer = l;
            for (int rep = 0; rep < REP_M12; ++rep) { phase_mixer<1>(p, lds); xcd_barrier(gbar); phase_scan(st, dec); xcd_barrier(gbar); }
            for (int rep = 0; rep < REP_M3; ++rep) { phase_mixer<3>(p, lds); xcd_barrier(gbar); }
            for (int rep = 0; rep < REP_G2; ++rep) {
                pg8::Gemm g{ybuf, (const bf16_t*)(ws + WS_WOUT) + (size_t)l * DM * DI, HROWS, DM, DI / 2, DI};
                pg8::SplitOrder S; S.init(HROWS, DM, G, (int)blockIdx.x);
                pg8::EpiSlab E{slab};
                pg8::gemm_phase<pg8::EpiSlab, pg8::SplitOrder>(lds, g, S, E);
                xcd_barrier(gbar);
            }
        }
        phase_norm<true>(a.out + xoff, (const bf16_t*)(ws + WS_PROJ), mod + (size_t)(4 + half * 2) * 3072 + 2048, a.out + xoff, a.final_g, nullptr, half, nullptr);
    }
}

extern "C" void kernel_launch(void* const* d_in, const int* in_sizes, int n_in, void* d_out, int out_size, void* d_ws, size_t ws_size, hipStream_t stream) {
    static int grid = 0;
    if (grid == 0) {
        if (n_in != 20 || ws_size < WS_END) { fprintf(stderr, "kernel_launch: unexpected n_in %d / ws_size %zu (need %zu)\n", n_in, ws_size, (size_t)WS_END); grid = -1; return; }
        int dev = 0, cus = 0, per_cu = 0;
        hipGetDevice(&dev);
        hipDeviceGetAttribute(&cus, hipDeviceAttributeMultiprocessorCount, dev);
        if (hipFuncSetAttribute((const void*)fwd_megakernel, hipFuncAttributeMaxDynamicSharedMemorySize, LDS_BYTES) != hipSuccess) { fprintf(stderr, "kernel_launch: hipFuncSetAttribute failed\n"); grid = -1; return; }
        hipOccupancyMaxActiveBlocksPerMultiprocessor(&per_cu, (const void*)fwd_megakernel, NTHR, LDS_BYTES);
        if (per_cu < 1) { fprintf(stderr, "kernel_launch: occupancy query says %d blocks per CU\n", per_cu); per_cu = 1; }
        (void)hipGetLastError();
        grid = cus * per_cu;
    }
    if (grid < 0) return;
    Args a{};
    const float** f = (const float**)&a;
    for (int i = 0; i < 20; ++i) f[i] = (const float*)d_in[i];
    a.out = (float*)d_out; a.ws = (unsigned char*)d_ws;
    void* args[] = {&a};
    if (hipMemsetAsync((char*)d_ws + WS_BAR, 0, XCD_BAR_WORDS * 4, stream) != hipSuccess) { fprintf(stderr, "kernel_launch: memset of barrier words failed\n"); return; }
    hipError_t e = hipLaunchCooperativeKernel((const void*)fwd_megakernel, dim3(grid), dim3(NTHR), args, LDS_BYTES, stream);
    if (e != hipSuccess) fprintf(stderr, "cooperative launch failed: %s (grid %d)\n", hipGetErrorString(e), grid);
}
```

```cpp
#include <hip/hip_runtime.h>
#include <hip/hip_cooperative_groups.h>
#include <cstdio>
namespace cg = cooperative_groups;

#define LAS __attribute__((address_space(3)))
typedef unsigned short bf16_t;
typedef short bf16x8 __attribute__((ext_vector_type(8)));
typedef float f32x4 __attribute__((ext_vector_type(4)));
typedef float f32x16 __attribute__((ext_vector_type(16)));
typedef unsigned u32x4 __attribute__((ext_vector_type(4)));
typedef unsigned u32x2 __attribute__((ext_vector_type(2)));

#ifndef REP_PREP
#define REP_PREP 1
#endif
#ifndef REP_NORM
#define REP_NORM 1
#endif
#ifndef REP_G1
#define REP_G1 1
#endif
#ifndef REP_M12
#define REP_M12 1
#endif
#ifndef REP_M3
#define REP_M3 1
#endif
#ifndef REP_G2
#define REP_G2 1
#endif
#ifndef REP_UPREP
#define REP_UPREP 1
#endif
#ifndef REP_UCORE
#define REP_UCORE 1
#endif
constexpr int NB = 4, SEQ = 4096, DM = 1024, DEPTH = 2, DI = 2048;
constexpr int NIN = 7192, LDP = 7424;
constexpr int HROWS = 8192;
constexpr int NTHR = 512;
constexpr float EPS = 1e-6f;
constexpr int C_AQ = 0, C_AF = 512, C_AI = 1024, C_AG = 1536, C_RQ = 2048, C_RK = 2560, C_RV = 3072, C_RG = 3584,
              C_MZ = 4096, C_XBC = 4608, C_DT = 5632, C_GQ = 5640, C_GK = 5896, C_GV = 6152, C_GG = 6664, C_LR = 7176;
constexpr int ST_PER_BC = 229376;
constexpr size_t WS_WIN = 0;
constexpr size_t WS_WOUT = WS_WIN + 2ull * LDP * DM * 2;
constexpr size_t WS_MOD = WS_WOUT + 2ull * DM * DI * 2;
constexpr size_t WS_ROPE = WS_MOD + 2ull * 4 * 3072 * 4;
constexpr size_t WS_DEC = WS_ROPE + 4096ull * 64 * 8;
constexpr size_t WS_HY = WS_DEC + 128ull * 1024 * 4;
constexpr size_t WS_PROJ = WS_HY + (size_t)HROWS * DI * 2;
constexpr size_t WS_ST = WS_PROJ + (size_t)HROWS * LDP * 2;
constexpr size_t WS_BAR = WS_ST + 128ull * ST_PER_BC * 2;
constexpr size_t WS_END = WS_BAR + 3456 * 4;
constexpr int L_QI = 0, L_KI = 17408, L_VT = 34816, L_BIG = 71680, L_SM = 141312;
constexpr int SM_CUM = 0, SM_DT = 256, SM_SEG = 512, SM_REF = 1536, SM_CLAST = 1664, SM_RSS = 1792;
constexpr int L_BARST = L_SM + (1792 + 512) * 4;
constexpr int LDS_BYTES = L_BARST + 16;

__device__ __forceinline__ float bf2f(bf16_t v) { return __uint_as_float(((unsigned)v) << 16); }
__device__ __forceinline__ bf16_t f2bf(float f) { unsigned u = __float_as_uint(f); u += 0x7FFFu + ((u >> 16) & 1u); return (bf16_t)(u >> 16); }
typedef float f32x2_t __attribute__((ext_vector_type(2)));
typedef __bf16 bf16x2_t __attribute__((ext_vector_type(2)));
__device__ __forceinline__ unsigned pk2(float lo, float hi) { f32x2_t v = {lo, hi}; bf16x2_t b = __builtin_convertvector(v, bf16x2_t); return __builtin_bit_cast(unsigned, b); }
__device__ __forceinline__ int opaque_tid() { int t = threadIdx.x; asm volatile("" : "+v"(t)); return t; }
__device__ __forceinline__ float silu_f(float x) { return x * __builtin_amdgcn_rcpf(1.f + __expf(-x)); }
__device__ __forceinline__ float softplus_f(float x) { return fmaxf(x, 0.f) + __logf(1.f + __expf(-fabsf(x))); }
__device__ __forceinline__ float logsig_f(float x) { return fminf(x, 0.f) - __logf(1.f + __expf(-fabsf(x))); }

namespace pg8 {
constexpr int BM = 256, BK = 64, HALF = 128, HTB = HALF * BK * 2, STAGE_BYTES = 8 * HTB, NXCD = 8, WGM = 8;
__device__ __forceinline__ int lds_byte(int r, int c) { const int st = (r >> 4) * 2 + (c >> 5), rr = r & 15, cc = c & 31, ob = rr * 64 + cc * 2; return st * 1024 + (ob ^ (((ob >> 9) & 1) << 5)); }
__device__ __forceinline__ void stage_rc(int b, int& R, int& C) { const int st = b / 1024, sb = b % 1024, swz = sb ^ (((sb >> 9) & 1) << 5); R = (st >> 1) * 16 + swz / 64; C = (st & 1) * 32 + (swz % 64) / 2; }
__device__ __forceinline__ int perm32(int rho) { const int n = rho >> 4, i = rho & 15; return 8 * (i >> 2) + 4 * n + (i & 3); }
struct Unit { int pm, pn, kh; };
struct Gemm { const bf16_t* A; const bf16_t* Bt; int M, N, K, ld; };
struct StaticOrder {
    int nM, nN, nwg, G, c;
    __device__ void init(int M, int N, int G_, int c_) { nM = M / BM; nN = N / BM; nwg = nM * nN; G = G_; c = c_; }
    __device__ bool next(int i, Unit& u) const {
        const long L = (long)i * G + c; if (L >= nwg) return false;
        int wgid = (int)L; { const int q = nwg / NXCD, r = nwg % NXCD, xcd = wgid % NXCD, off = wgid / NXCD; wgid = (xcd < r ? xcd * (q + 1) : r * (q + 1) + (xcd - r) * q) + off; }
        const int nig = WGM * nN, gid = wgid / nig, fm = gid * WGM, gsz = (nM - fm) < WGM ? (nM - fm) : WGM;
        u.pm = fm + ((wgid % nig) % gsz); u.pn = (wgid % nig) / gsz; u.kh = 0; return true;
    }
};
struct SplitOrder {
    StaticOrder so;
    __device__ void init(int M, int N, int G_, int c_) { so.init(M, 2 * N, G_, c_); }
    __device__ bool next(int i, Unit& u) const { if (!so.next(i, u)) return false; u.kh = u.pn & 1; u.pn >>= 1; return true; }
};
struct EpiProj {
    static constexpr bool PERM = true;
    bf16_t* O; int ldc;
    __device__ __forceinline__ void operator()(const f32x4 (&acc)[2][2][4][2], const Unit& u, int wr, int wc, int fr, int fq) const {
        const int row0 = u.pm * BM + wr * 64 + fr, col0 = u.pn * BM + wc * 32 + 8 * fq;
#pragma unroll
        for (int ai = 0; ai < 2; ++ai)
#pragma unroll
            for (int m = 0; m < 4; ++m) { bf16_t* rowp = O + (size_t)(row0 + ai * HALF + m * 16) * ldc + col0;
#pragma unroll
                for (int bj = 0; bj < 2; ++bj) { const f32x4 v0 = acc[ai][bj][m][0], v1 = acc[ai][bj][m][1];
                    u32x4 w; w.x = pk2(v0[0], v0[1]); w.y = pk2(v0[2], v0[3]); w.z = pk2(v1[0], v1[1]); w.w = pk2(v1[2], v1[3]);
                    *(u32x4*)(rowp + bj * HALF) = w; } }
    }
};
struct EpiRes {
    static constexpr bool PERM = false;
    const float* xin; float* xout; const float* gate;
    __device__ __forceinline__ void operator()(const f32x4 (&acc)[2][2][4][2], const Unit& u, int wr, int wc, int fr, int fq) const {
        const int row0 = u.pm * BM + wr * 64 + fr, col0 = u.pn * BM + wc * 32 + 4 * fq;
        const float* gp = gate + (size_t)(u.pm >> 4) * 3072 + col0;
        f32x4 gv[2][2];
#pragma unroll
        for (int bj = 0; bj < 2; ++bj)
#pragma unroll
            for (int n = 0; n < 2; ++n) gv[bj][n] = *(const f32x4*)(gp + bj * HALF + n * 16);
#pragma unroll
        for (int am = 0; am < 4; ++am) {
            const int ai = am >> 1, m0 = (am & 1) * 2;
            f32x4 xi[2][2][2];
#pragma unroll
            for (int m = 0; m < 2; ++m)
#pragma unroll
                for (int bj = 0; bj < 2; ++bj)
#pragma unroll
                    for (int n = 0; n < 2; ++n) xi[m][bj][n] = *(const f32x4*)(xin + (size_t)(row0 + ai * HALF + (m0 + m) * 16) * DM + col0 + bj * HALF + n * 16);
            __builtin_amdgcn_sched_barrier(0);
#pragma unroll
            for (int m = 0; m < 2; ++m)
#pragma unroll
                for (int bj = 0; bj < 2; ++bj)
#pragma unroll
                    for (int n = 0; n < 2; ++n) *(f32x4*)(xout + (size_t)(row0 + ai * HALF + (m0 + m) * 16) * DM + col0 + bj * HALF + n * 16) = xi[m][bj][n] + gv[bj][n] * acc[ai][bj][m0 + m][n];
        }
    }
};

struct EpiSlab {
    static constexpr bool PERM = true;
    bf16_t* slab;
    __device__ __forceinline__ void operator()(const f32x4 (&acc)[2][2][4][2], const Unit& u, int wr, int wc, int fr, int fq) const {
        const int row0 = u.pm * BM + wr * 64 + fr, col0 = u.pn * BM + wc * 32 + 8 * fq;
        bf16_t* base = slab + (size_t)u.kh * HROWS * DM;
#pragma unroll
        for (int ai = 0; ai < 2; ++ai)
#pragma unroll
            for (int m = 0; m < 4; ++m) { bf16_t* rowp = base + (size_t)(row0 + ai * HALF + m * 16) * DM + col0;
#pragma unroll
                for (int bj = 0; bj < 2; ++bj) { const f32x4 v0 = acc[ai][bj][m][0], v1 = acc[ai][bj][m][1];
                    u32x4 w; w.x = pk2(v0[0], v0[1]); w.y = pk2(v0[2], v0[3]); w.z = pk2(v1[0], v1[1]); w.w = pk2(v1[2], v1[3]);
                    *(u32x4*)(rowp + bj * HALF) = w; } }
    }
};

template <class Epi, class Sched>
__device__ __forceinline__ void gemm_phase(LAS unsigned char* lds, const Gemm g, const Sched& S, const Epi& E) {
    const int tid = opaque_tid(), wid = __builtin_amdgcn_readfirstlane(tid >> 6), lane = tid & 63, wr = wid >> 2, wc = wid & 3, fr = lane & 15, fq = lane >> 4;
    const int K = g.K, nt = K / BK, ld = g.ld;
    unsigned voffA[2], voffB[2];
#pragma unroll
    for (int i = 0; i < 2; ++i) { int R, C; stage_rc(tid * 16 + i * 8192, R, C); const int Rb = Epi::PERM ? ((R & ~31) + perm32(R & 31)) : R;
        voffA[i] = (unsigned)(R * ld + C) * 2u; voffB[i] = (unsigned)(Rb * ld + C) * 2u; }
    const size_t kstep = (size_t)(BK * 2);
    const size_t hstep = (size_t)HALF * ld * 2;
    const size_t tstep = 2 * hstep;
    const unsigned ldsw = (unsigned)wid * 1024u;
    const int aoff = lds_byte(wr * 64 + fr, fq * 8), boff = lds_byte(wc * 32 + fr, fq * 8);
#define PG8_SA(b, h) (((b) * 2 + (h)) * HTB)
#define PG8_SB(b, h) ((4 + (b) * 2 + (h)) * HTB)
#define PG8_STAGE(bufoff, gbase, voff) do { _Pragma("unroll") for (int _i = 0; _i < 2; ++_i) \
        __builtin_amdgcn_global_load_lds((const unsigned*)((const char*)(gbase) + (voff)[_i]), (LAS unsigned*)(lds + (bufoff) + ldsw + _i * 8192), 16, 0, 0); } while (0)
#define PG8_LDA(dst, b, h) do { _Pragma("unroll") for (int m = 0; m < 4; ++m) _Pragma("unroll") for (int k = 0; k < 2; ++k) dst[m][k] = *(const LAS bf16x8*)(lds + PG8_SA(b, h) + aoff + m * 2048 + k * 1024); } while (0)
#define PG8_LDB(dst, b, h) do { _Pragma("unroll") for (int n = 0; n < 2; ++n) _Pragma("unroll") for (int k = 0; k < 2; ++k) dst[n][k] = *(const LAS bf16x8*)(lds + PG8_SB(b, h) + boff + n * 2048 + k * 1024); } while (0)
#define PG8_MMA(ai, bj, At, Bt) do { __builtin_amdgcn_s_setprio(1); _Pragma("unroll") for (int m = 0; m < 4; ++m) _Pragma("unroll") for (int n = 0; n < 2; ++n) _Pragma("unroll") for (int k = 0; k < 2; ++k) \
        acc[ai][bj][m][n] = __builtin_amdgcn_mfma_f32_16x16x32_bf16(Bt[n][k], At[m][k], acc[ai][bj][m][n], 0, 0, 0); __builtin_amdgcn_s_setprio(0); } while (0)
#define PG8_WAIT_V(n) asm volatile("s_waitcnt vmcnt(" #n ")" ::: "memory")
#define PG8_WAIT_L(n) asm volatile("s_waitcnt lgkmcnt(" #n ")" ::: "memory")
#define PG8_BAR __builtin_amdgcn_s_barrier()
#define PG8_SCHED __builtin_amdgcn_sched_barrier(0)
    Unit cur, nxt; int ui = 0;
    if (!S.next(0, cur)) return;
    f32x4 acc[2][2][4][2];
#pragma unroll
    for (int a = 0; a < 2; ++a)
#pragma unroll
        for (int b = 0; b < 2; ++b)
#pragma unroll
            for (int m = 0; m < 4; ++m)
#pragma unroll
                for (int n = 0; n < 2; ++n) acc[a][b][m][n] = (f32x4){0.f, 0.f, 0.f, 0.f};
    bf16x8 At[4][2], B0[2][2], B1[2][2];
    const char* cA = (const char*)g.A + (size_t)cur.pm * tstep + (size_t)cur.kh * K * 2; const char* cB = (const char*)g.Bt + (size_t)cur.pn * tstep + (size_t)cur.kh * K * 2;
    PG8_STAGE(PG8_SB(0, 0), cB, voffB); PG8_STAGE(PG8_SA(0, 0), cA, voffA); PG8_STAGE(PG8_SB(0, 1), cB + hstep, voffB); PG8_STAGE(PG8_SA(0, 1), cA + hstep, voffA);
    if (wr == 1) PG8_BAR;
    PG8_WAIT_V(4); PG8_BAR;
    PG8_STAGE(PG8_SB(1, 0), cB + kstep, voffB); PG8_STAGE(PG8_SA(1, 0), cA + kstep, voffA); PG8_STAGE(PG8_SB(1, 1), cB + hstep + kstep, voffB);
    PG8_WAIT_V(6); PG8_BAR;
    for (;;) {
        const bool has_next = S.next(ui + 1, nxt);
        const char* nA = has_next ? (const char*)g.A + (size_t)nxt.pm * tstep + (size_t)nxt.kh * K * 2 : cA; const char* nB = has_next ? (const char*)g.Bt + (size_t)nxt.pn * tstep + (size_t)nxt.kh * K * 2 : cB;
        for (int t = 0; t < nt; t += 2) {
            const bool last = (t == nt - 2);
            const char* a1 = cA + (size_t)(t + 1) * kstep;
            const char* a2 = last ? nA : cA + (size_t)(t + 2) * kstep; const char* b2 = last ? nB : cB + (size_t)(t + 2) * kstep;
            const char* a3 = a2 + kstep; const char* b3 = b2 + kstep;
            PG8_LDB(B0, 0, 0); PG8_SCHED; PG8_LDA(At, 0, 0); PG8_STAGE(PG8_SA(1, 1), a1 + hstep, voffA);
            PG8_WAIT_L(8); PG8_BAR; PG8_WAIT_L(0); PG8_MMA(0, 0, At, B0); PG8_BAR; PG8_SCHED;
            PG8_LDB(B1, 0, 1); PG8_STAGE(PG8_SB(0, 0), b2, voffB);
            PG8_BAR; PG8_WAIT_L(0); PG8_MMA(0, 1, At, B1); PG8_BAR;
            PG8_LDA(At, 0, 1); PG8_STAGE(PG8_SA(0, 0), a2, voffA);
            PG8_BAR; PG8_WAIT_L(0); PG8_MMA(1, 0, At, B0); PG8_BAR; PG8_SCHED;
            PG8_STAGE(PG8_SB(0, 1), b2 + hstep, voffB);
            PG8_WAIT_V(6); PG8_BAR; PG8_MMA(1, 1, At, B1); PG8_BAR;
            PG8_LDB(B0, 1, 0); PG8_SCHED; PG8_LDA(At, 1, 0); PG8_STAGE(PG8_SA(0, 1), a2 + hstep, voffA);
            PG8_WAIT_L(8); PG8_BAR; PG8_WAIT_L(0); PG8_MMA(0, 0, At, B0); PG8_BAR; PG8_SCHED;
            PG8_LDB(B1, 1, 1); PG8_STAGE(PG8_SB(1, 0), b3, voffB);
            PG8_BAR; PG8_WAIT_L(0); PG8_MMA(0, 1, At, B1); PG8_BAR;
            PG8_LDA(At, 1, 1); PG8_STAGE(PG8_SA(1, 0), a3, voffA);
            PG8_BAR; PG8_WAIT_L(0); PG8_MMA(1, 0, At, B0); PG8_BAR; PG8_SCHED;
            PG8_STAGE(PG8_SB(1, 1), b3 + hstep, voffB);
            PG8_WAIT_V(6); PG8_BAR; PG8_MMA(1, 1, At, B1); PG8_BAR;
        }
        E(acc, cur, wr, wc, fr, fq);
        if (!has_next) break;
#pragma unroll
        for (int a = 0; a < 2; ++a)
#pragma unroll
            for (int b = 0; b < 2; ++b)
#pragma unroll
                for (int m = 0; m < 4; ++m)
#pragma unroll
                    for (int n = 0; n < 2; ++n) acc[a][b][m][n] = (f32x4){0.f, 0.f, 0.f, 0.f};
        cur = nxt; cA = nA; cB = nB; ++ui;
    }
    PG8_WAIT_V(0);
    if (wr == 0) PG8_BAR;
    PG8_BAR;
#undef PG8_SA
#undef PG8_SB
#undef PG8_STAGE
#undef PG8_LDA
#undef PG8_LDB
#undef PG8_MMA
#undef PG8_WAIT_V
#undef PG8_WAIT_L
#undef PG8_BAR
#undef PG8_SCHED
}
}

struct Args {
    const float* x; const float* c; const float* w_ada; const float* b_ada; const float* norm_g; const float* w_in;
    const float* lb_logits; const float* hgrn_g; const float* ret_g; const float* conv_w; const float* conv_b;
    const float* dt_bias; const float* a_log; const float* dskip; const float* ssm_g; const float* w_gk2; const float* b_gk2;
    const float* gla_g; const float* w_out; const float* final_g;
    float* out; unsigned char* ws;
};

__device__ __forceinline__ void transpose_cvt(const float* __restrict__ src, int K, int N, bf16_t* __restrict__ dst, int Npad, LAS unsigned char* lds, int gid, int gstride) {
    LAS float* T = (LAS float*)lds;
    const int tid = opaque_tid(), ntk = K / 64, ntn = Npad / 256;
    for (int tile = gid; tile < ntk * ntn; tile += gstride) {
        const int tk = tile % ntk, tn = tile / ntk;
        float v[32];
#pragma unroll
        for (int i = 0; i < 32; ++i) { const int kk = (tid >> 8) + 2 * i, nn = tid & 255, n = tn * 256 + nn;
            v[i] = (n < N) ? src[(size_t)(tk * 64 + kk) * N + n] : 0.f; }
#pragma unroll
        for (int i = 0; i < 32; ++i) { const int kk = (tid >> 8) + 2 * i, nn = tid & 255; T[kk * 257 + nn] = v[i]; }
        __syncthreads();
#pragma unroll
        for (int i = 0; i < 16; ++i) { const int nn = (tid >> 5) + 16 * i, kk = (tid & 31) * 2;
            *(unsigned*)(dst + (size_t)(tn * 256 + nn) * K + tk * 64 + kk) = pk2(T[kk * 257 + nn], T[(kk + 1) * 257 + nn]); }
        __syncthreads();
    }
}

__device__ __forceinline__ void phase_wcvt(const Args& a, LAS unsigned char* lds) {
    const int G = gridDim.x, bid = blockIdx.x;
    unsigned char* ws = a.ws;
    for (int l = 0; l < DEPTH; ++l) {
        transpose_cvt(a.w_in + (size_t)l * DM * NIN, DM, NIN, (bf16_t*)(ws + WS_WIN) + (size_t)l * LDP * DM, LDP, lds, bid, G);
        transpose_cvt(a.w_out + (size_t)l * DI * DM, DI, DM, (bf16_t*)(ws + WS_WOUT) + (size_t)l * DM * DI, DM, lds, (bid + 128) % G, G);
    }
}
__device__ __forceinline__ void phase_prep(const Args& a, LAS unsigned char* lds) {
    const int tid = opaque_tid(), G = gridDim.x, bid = blockIdx.x;
    unsigned char* ws = a.ws;
    {
        LAS float* R = (LAS float*)lds;
        LAS float* CA = (LAS float*)(lds + 8192);
        float* mod = (float*)(ws + WS_MOD);
        const int jj = tid & 63, ks = tid >> 6;
        if (bid < DEPTH * 48) {
#pragma unroll
            for (int q = 0; q < 8; ++q) CA[tid + NTHR * q] = silu_f(a.c[tid + NTHR * q]);
            __syncthreads();
        }
        for (int item = bid; item < DEPTH * 48; item += G) {
            const int l = item / 48, j = (item % 48) * 64 + jj;
            float s0 = 0.f, s1 = 0.f, s2 = 0.f, s3 = 0.f;
            const float* w = a.w_ada + (size_t)l * DM * 3072 + j;
#pragma unroll 16
            for (int k = ks * 128; k < ks * 128 + 128; ++k) { const float wv = w[(size_t)k * 3072];
                s0 += CA[k] * wv; s1 += CA[DM + k] * wv; s2 += CA[2 * DM + k] * wv; s3 += CA[3 * DM + k] * wv; }
            R[(ks * 4 + 0) * 64 + jj] = s0; R[(ks * 4 + 1) * 64 + jj] = s1; R[(ks * 4 + 2) * 64 + jj] = s2; R[(ks * 4 + 3) * 64 + jj] = s3;
            __syncthreads();
            if (tid < 256) { const int b = tid >> 6; float s = a.b_ada[l * 3072 + j];
#pragma unroll
                for (int q = 0; q < 8; ++q) s += R[(q * 4 + b) * 64 + jj];
                mod[(size_t)(l * 4 + b) * 3072 + j] = s; }
            __syncthreads();
        }
    }
    {
        float2* rope = (float2*)(ws + WS_ROPE);
        for (int i = bid * NTHR + tid; i < 4096 * 64; i += G * NTHR) {
            const int pos = i >> 6, j = i & 63;
            const float invf = powf(10000.f, -(float)(2 * j) / 128.f);
            const float ang = (float)pos * invf;
            const float k = rintf(ang * 0.15915494309189535f);
            float r = fmaf(-k, 6.2831854820251465f, ang); r = fmaf(-k, -1.7484555e-07f, r);
            rope[i] = make_float2(__cosf(r), __sinf(r));
        }
    }
}

template <bool FINAL>
__device__ __forceinline__ void phase_norm(const float* __restrict__ xin  , const bf16_t* __restrict__ slab  ,
                                           const float* __restrict__ gate_prev  , float* xout  ,
                                           const float* __restrict__ g, const float* __restrict__ mod  , int half, bf16_t* __restrict__ hout) {
    const int tid = opaque_tid(), lane = tid & 63, wid = tid >> 6;
    const int gw = blockIdx.x * 8 + wid, nw = gridDim.x * 8;
    for (int row = gw; row < HROWS; row += nw) {
        const float* xr = xin + (size_t)row * DM;
        f32x4 v[4]; float ss = 0.f;
#pragma unroll
        for (int i = 0; i < 4; ++i) v[i] = *(const f32x4*)(xr + i * 256 + lane * 4);
        if (slab) {
            u32x2 a0[4], a1[4]; f32x4 gp[4];
#pragma unroll
            for (int i = 0; i < 4; ++i) { const int col = i * 256 + lane * 4;
                a0[i] = *(const u32x2*)(slab + (size_t)row * DM + col); a1[i] = *(const u32x2*)(slab + (size_t)(HROWS + row) * DM + col);
                gp[i] = *(const f32x4*)(gate_prev + (size_t)(row >> 12) * 3072 + col); }
#pragma unroll
            for (int i = 0; i < 4; ++i) {
                const f32x4 sa = {__uint_as_float(a0[i].x << 16) + __uint_as_float(a1[i].x << 16), __uint_as_float(a0[i].x & 0xffff0000u) + __uint_as_float(a1[i].x & 0xffff0000u),
                                  __uint_as_float(a0[i].y << 16) + __uint_as_float(a1[i].y << 16), __uint_as_float(a0[i].y & 0xffff0000u) + __uint_as_float(a1[i].y & 0xffff0000u)};
                v[i] = v[i] + gp[i] * sa; }
        }
        if (!FINAL && xout) {
#pragma unroll
            for (int i = 0; i < 4; ++i) *(f32x4*)(xout + (size_t)row * DM + i * 256 + lane * 4) = v[i];
        }
#pragma unroll
        for (int i = 0; i < 4; ++i) ss += v[i][0] * v[i][0] + v[i][1] * v[i][1] + v[i][2] * v[i][2] + v[i][3] * v[i][3];
#pragma unroll
        for (int o = 32; o > 0; o >>= 1) ss += __shfl_xor(ss, o);
        const float rinv = rsqrtf(ss * (1.f / DM) + EPS);
        if constexpr (FINAL) {
#pragma unroll
            for (int i = 0; i < 4; ++i) { const int col = i * 256 + lane * 4; const f32x4 gg = *(const f32x4*)(g + col);
                *(f32x4*)(xout + (size_t)row * DM + col) = v[i] * rinv * gg; }
        } else {
            const float* mb = mod + (size_t)(half * 2 + (row >> 12)) * 3072;
#pragma unroll
            for (int i = 0; i < 4; ++i) { const int col = i * 256 + lane * 4;
                const f32x4 gg = *(const f32x4*)(g + col), sh = *(const f32x4*)(mb + col), sc = *(const f32x4*)(mb + 1024 + col);
                float o0 = v[i][0] * rinv * gg[0] * (1.f + sc[0]) + sh[0], o1 = v[i][1] * rinv * gg[1] * (1.f + sc[1]) + sh[1];
                float o2 = v[i][2] * rinv * gg[2] * (1.f + sc[2]) + sh[2], o3 = v[i][3] * rinv * gg[3] * (1.f + sc[3]) + sh[3];
                u32x2 w; w.x = pk2(o0, o1); w.y = pk2(o2, o3);
                *(u32x2*)(hout + (size_t)row * DM + col) = w; }
        }
    }
}

struct MixP {
    const bf16_t* proj; bf16_t* st; float* dec; bf16_t* y; const float2* rope;
    const float* lbl; const float* hgrn_g; const float* ret_g; const float* conv_w; const float* conv_b; const float* dt_bias; const float* a_log;
    const float* dskip; const float* ssm_g; const float* w2; const float* b2; const float* gla_g; int layer;
};

__device__ __forceinline__ bf16x8 frag(LAS unsigned char* lds, int off, int ld, int r0, int ks, int lane) {
    return *(const LAS bf16x8*)(lds + off + (((r0 + (lane & 31)) * ld + 16 * ks + 8 * (lane >> 5)) << 1));
}
__device__ __forceinline__ int rowmap(int r, int lane) { return (r & 3) + 8 * (r >> 2) + 4 * (lane >> 5); }

__device__ __forceinline__ void conv16(LAS unsigned char* lds, int off, int ncols, int col, const float* cw, int seg, float (&out)[16]) {
    const LAS bf16_t* rp = (const LAS bf16_t*)(lds + off) + seg * 16 * ncols + col;
    float u[19];
#pragma unroll
    for (int k = 0; k < 19; ++k) u[k] = bf2f(rp[k * ncols]);
#pragma unroll
    for (int i = 0; i < 16; ++i) out[i] = silu_f(cw[4] + cw[0] * u[i] + cw[1] * u[i + 1] + cw[2] * u[i + 2] + cw[3] * u[i + 3]);
}
__device__ __forceinline__ void conv_w_load(const MixP& p, int chan, float* cw) {
    cw[0] = p.conv_w[chan]; cw[1] = p.conv_w[1024 + chan]; cw[2] = p.conv_w[2048 + chan]; cw[3] = p.conv_w[3072 + chan]; cw[4] = p.conv_b[chan];
}
template <int NCOLS, int NROWS> struct Stg { static constexpr int VPR = NCOLS / 8, NV = NROWS * VPR, NIT = (NV + NTHR - 1) / NTHR; };
template <int NCOLS, int NROWS>
__device__ __forceinline__ void stg_load(const bf16_t* src, int tid, int zrows, u32x4* r) {
    using S = Stg<NCOLS, NROWS>;
#pragma unroll
    for (int j = 0; j < S::NIT; ++j) { const int vi = tid + NTHR * j, row = vi / S::VPR, cv = vi % S::VPR;
        const bool ok = (vi < S::NV) && (row >= zrows);
        r[j] = ok ? *(const u32x4*)(src + (ptrdiff_t)row * LDP + cv * 8) : (u32x4){0u, 0u, 0u, 0u}; }
}
template <int NCOLS, int NROWS>
__device__ __forceinline__ void stg_store(LAS unsigned char* lds, int off, int tid, const u32x4* r) {
    using S = Stg<NCOLS, NROWS>;
#pragma unroll
    for (int j = 0; j < S::NIT; ++j) { const int vi = tid + NTHR * j; if (vi < S::NV) *(LAS u32x4*)(lds + off + vi * 16) = r[j]; }
}
__device__ __forceinline__ void store16(LAS unsigned char* lds, int byteoff, const float (&v)[16]) {
    u32x4 a, b; a.x = pk2(v[0], v[1]); a.y = pk2(v[2], v[3]); a.z = pk2(v[4], v[5]); a.w = pk2(v[6], v[7]);
    b.x = pk2(v[8], v[9]); b.y = pk2(v[10], v[11]); b.z = pk2(v[12], v[13]); b.w = pk2(v[14], v[15]);
    *(LAS u32x4*)(lds + byteoff) = a; *(LAS u32x4*)(lds + byteoff + 16) = b;
}
__device__ __forceinline__ void store8(LAS unsigned char* lds, int byteoff, const float (&v)[8]) {
    u32x4 a; a.x = pk2(v[0], v[1]); a.y = pk2(v[2], v[3]); a.z = pk2(v[4], v[5]); a.w = pk2(v[6], v[7]);
    *(LAS u32x4*)(lds + byteoff) = a;
}

constexpr int NUNITS = 128 * 14;
struct Pref { u32x4 raw[11]; u32x4 st[8]; float aux[16]; };
template <int BR, int PASS>
__device__ __forceinline__ void load_A(const MixP& p, int bc, int hu, int tid, Pref& pf) {
    const bf16_t* P = p.proj + (size_t)bc * 64 * LDP;
    if constexpr (BR == 0) { stg_load<128, 64>(P + C_AF + hu * 128, tid, 0, pf.raw + 0); stg_load<128, 64>(P + C_AI + hu * 128, tid, 0, pf.raw + 2);
        if constexpr (PASS == 3) stg_load<128, 64>(P + C_AQ + hu * 128, tid, 0, pf.raw + 4); }
    if constexpr (BR == 1) { stg_load<128, 64>(P + C_RK + hu * 128, tid, 0, pf.raw + 0); stg_load<128, 64>(P + C_RV + hu * 128, tid, 0, pf.raw + 2);
        if constexpr (PASS == 3) stg_load<128, 64>(P + C_RQ + hu * 128, tid, 0, pf.raw + 4); }
    if constexpr (BR == 2) { const int zr = ((bc & 63) == 0) ? 3 : 0; const bf16_t* P3 = P - 3 * (ptrdiff_t)LDP + C_XBC;
        stg_load<128, 67>(P3 + 512 + hu * 128, tid, zr, pf.raw + 0); stg_load<256, 67>(P3 + hu * 256, tid, zr, pf.raw + 3);
        if constexpr (PASS == 3) stg_load<128, 67>(P3 + 768 + hu * 128, tid, zr, pf.raw + 8); }
    if constexpr (BR == 3) { stg_load<64, 64>(P + C_GK + hu * 64, tid, 0, pf.raw + 0); stg_load<128, 64>(P + C_GV + hu * 128, tid, 0, pf.raw + 1); stg_load<16, 64>(P + C_LR, tid, 0, pf.raw + 3);
        if constexpr (PASS == 3) stg_load<64, 64>(P + C_GQ + hu * 64, tid, 0, pf.raw + 4); }
}
template <int BR, int PASS>
__device__ __forceinline__ void load_B(const MixP& p, int bc, int hu, int tid, Pref& pf) {
    if constexpr (PASS == 3) {
        constexpr int DK = (BR == 3) ? 64 : 128, DV = (BR == 2) ? 256 : 128, NV = DV * DK / 8 / NTHR;
        const int st_off = (BR == 0) ? hu * 16384 : (BR == 1) ? 65536 + hu * 16384 : (BR == 2) ? 131072 + hu * 32768 : 196608 + hu * 8192;
        const bf16_t* stg = p.st + (size_t)bc * ST_PER_BC + st_off;
#pragma unroll
        for (int k = 0; k < NV; ++k) pf.st[k] = *(const u32x4*)(stg + (size_t)(tid + NTHR * k) * 8);
    }
    if constexpr (BR == 1) { const int j = tid & 63, seg = tid >> 6, chunk = bc & 63;
#pragma unroll
        for (int i = 0; i < 8; ++i) { const float2 c = p.rope[(chunk * 64 + seg * 8 + i) * 64 + j]; pf.aux[2 * i] = c.x; pf.aux[2 * i + 1] = c.y; } }
    if constexpr (BR == 2) { if (tid < 64) { const bf16_t* P = p.proj + (size_t)bc * 64 * LDP;
#pragma unroll
            for (int hh = 0; hh < 4; ++hh) pf.aux[hh] = bf2f(P[(size_t)tid * LDP + C_DT + hu * 4 + hh]); } }
    if constexpr (BR == 3) { const int cc = hu * 64 + (tid & 63);
#pragma unroll
        for (int r = 0; r < 16; ++r) pf.aux[r] = p.w2[r * 256 + cc]; }
}
template <int PASS>
__device__ __forceinline__ void load_A_any(const MixP& p, int i, int tid, Pref& pf) {
    const int bc = i / 14, u = i % 14;
    if (u < 4) load_A<0, PASS>(p, bc, u, tid, pf); else if (u < 8) load_A<1, PASS>(p, bc, u - 4, tid, pf);
    else if (u < 10) load_A<2, PASS>(p, bc, u - 8, tid, pf); else load_A<3, PASS>(p, bc, u - 10, tid, pf);
}
template <int PASS>
__device__ __forceinline__ void load_B_any(const MixP& p, int i, int tid, Pref& pf) {
    const int bc = i / 14, u = i % 14;
    if (u < 4) load_B<0, PASS>(p, bc, u, tid, pf); else if (u < 8) load_B<1, PASS>(p, bc, u - 4, tid, pf);
    else if (u < 10) load_B<2, PASS>(p, bc, u - 8, tid, pf); else load_B<3, PASS>(p, bc, u - 10, tid, pf);
}

template <int BR, int PASS>
__device__ __forceinline__ void mixer_unit(const MixP& p, LAS unsigned char* lds, int bc, int hu  ) {
    constexpr int DK = (BR == 3) ? 64 : 128, LDK = DK + 8, NH = (BR == 2) ? 4 : 1, DV = (BR == 2) ? 256 : 128, NT = DV / 128;
    constexpr bool VEC = (BR == 0 || BR == 3);
    const int tid = opaque_tid(), lane = tid & 63, wid = __builtin_amdgcn_readfirstlane(tid >> 6);
    const int chunk = bc & 63;
    const bf16_t* P = p.proj + (size_t)bc * 64 * LDP;
    LAS float* SM = (LAS float*)(lds + L_SM);
    LAS bf16_t* QI = (LAS bf16_t*)(lds + L_QI); LAS bf16_t* KI = (LAS bf16_t*)(lds + L_KI); LAS bf16_t* VT = (LAS bf16_t*)(lds + L_VT);
    const int st_off = (BR == 0) ? hu * 16384 : (BR == 1) ? 65536 + hu * 16384 : (BR == 2) ? 131072 + hu * 32768 : 196608 + hu * 8192;
    bf16_t* stg = p.st + (size_t)bc * ST_PER_BC + st_off;
    Pref pf;
    load_A<BR, PASS>(p, bc, hu, tid, pf);
    load_B<BR, PASS>(p, bc, hu, tid, pf);
    constexpr int NTG = (PASS == 3) ? NT : 1;
    const int gcol = (BR == 0) ? C_AG + hu * 128 : (BR == 1) ? C_RG + hu * 128 : (BR == 2) ? C_MZ + hu * 256 : C_GG + hu * 128;
    const float* gain = (BR == 0) ? p.hgrn_g + hu * 128 : (BR == 1) ? p.ret_g + hu * 128 : (BR == 2) ? p.ssm_g + hu * 256 : p.gla_g + hu * 128;
    bf16_t gt[NTG][16]; float gnv[NTG], dskv[NTG];
    if constexpr (PASS == 3) {
#pragma unroll
        for (int nt = 0; nt < NT; ++nt) { const int ct = (wid & 3) + 4 * nt;
            gnv[nt] = gain[ct * 32 + (lane & 31)]; dskv[nt] = (BR == 2) ? p.dskip[hu * 4 + (ct >> 1)] : 0.f;
#pragma unroll
            for (int r = 0; r < 16; ++r) gt[nt][r] = P[(size_t)((wid >> 2) * 32 + rowmap(r, lane)) * LDP + gcol + ct * 32 + (lane & 31)]; }
    }
    float lb = 0.f, bb = 0.f, cwb[5], cwc[5], cwx[5], dtb[4], alg[4];
    if constexpr (BR == 0) { if (p.layer == 1) { const int cc = hu * 128 + (tid & 127); lb = 1.f / (1.f + __expf(p.lbl[cc] - p.lbl[512 + cc])); } }
    if constexpr (BR == 3) bb = p.b2[hu * 64 + (tid & 63)];
    if constexpr (BR == 2) { conv_w_load(p, 512 + hu * 128 + (tid & 127), cwb); if constexpr (PASS == 3) conv_w_load(p, 768 + hu * 128 + (tid & 127), cwc); conv_w_load(p, hu * 256 + (tid & 255), cwx);
#pragma unroll
        for (int hh = 0; hh < 4; ++hh) { dtb[hh] = p.dt_bias[hu * 4 + hh]; alg[hh] = p.a_log[hu * 4 + hh]; } }
    __builtin_amdgcn_sched_barrier(0);

    for (int urep = 0; urep < REP_UPREP; ++urep) {
    if constexpr (BR == 0) {
        constexpr int RQ = L_BIG, RF = (PASS == 3) ? L_BIG + 16384 : L_QI, RV = (PASS == 3) ? L_BIG + 32768 : L_QI + 16384;
        stg_store<128, 64>(lds, RF, tid, pf.raw + 0); stg_store<128, 64>(lds, RV, tid, pf.raw + 2);
        if constexpr (PASS == 3) stg_store<128, 64>(lds, RQ, tid, pf.raw + 4);
        __builtin_amdgcn_sched_barrier(0);
        const int d = tid & 127, seg = tid >> 7;
        __syncthreads();
        const LAS bf16_t* rF = (const LAS bf16_t*)(lds + RF) + seg * 16 * 128 + d;
        const LAS bf16_t* rQ = (const LAS bf16_t*)(lds + RQ) + seg * 16 * 128 + d;
        const LAS bf16_t* rV = (const LAS bf16_t*)(lds + RV) + seg * 16 * 128 + d;
        float cs[16], kk[16]; float run = 0.f;
#pragma unroll
        for (int i = 0; i < 16; ++i) { const float av = fmaxf(bf2f(rF[i * 128]), -60.f); const float e = __expf(-av), sg = __builtin_amdgcn_rcpf(1.f + e);
            const float f = lb + (1.f - lb) * sg; run += __logf(f); cs[i] = run; kk[i] = (1.f - lb) * e * sg; }
        SM[SM_SEG + seg * 128 + d] = run;
        __syncthreads();
        const float t0 = SM[SM_SEG + d], t1 = SM[SM_SEG + 128 + d], t2 = SM[SM_SEG + 256 + d], t3 = SM[SM_SEG + 384 + d];
        const float off = (seg == 0) ? 0.f : (seg == 1) ? t0 : (seg == 2) ? t0 + t1 : t0 + t1 + t2;
        const float ref = t0 + t1, clast = ref + t2 + t3;
        if (seg == 0) { SM[SM_REF + d] = ref; SM[SM_CLAST + d] = clast; }
        float kv[16];
#pragma unroll
        for (int i = 0; i < 16; ++i) { const float c = off + cs[i]; kv[i] = kk[i] * __expf(ref - c);
            if constexpr (PASS == 3) { KI[(seg * 16 + i) * LDK + d] = f2bf(kv[i]);
                const float q = bf2f(rQ[i * 128]); QI[(seg * 16 + i) * LDK + d] = f2bf(silu_f(q) * __expf(c - ref)); } }
        if constexpr (PASS == 1) store16(lds, L_BIG + (d * 72 + seg * 16) * 2, kv);
        unsigned vv[16];
#pragma unroll
        for (int i = 0; i < 16; ++i) vv[i] = rV[i * 128];
        u32x4 a, b; a.x = vv[0] | (vv[1] << 16); a.y = vv[2] | (vv[3] << 16); a.z = vv[4] | (vv[5] << 16); a.w = vv[6] | (vv[7] << 16);
        b.x = vv[8] | (vv[9] << 16); b.y = vv[10] | (vv[11] << 16); b.z = vv[12] | (vv[13] << 16); b.w = vv[14] | (vv[15] << 16);
        *(LAS u32x4*)(lds + L_VT + (d * 72 + seg * 16) * 2) = a; *(LAS u32x4*)(lds + L_VT + (d * 72 + seg * 16) * 2 + 16) = b;
    }
    if constexpr (BR == 1) {
        constexpr int RQ = L_BIG, RK = (PASS == 3) ? L_BIG + 16384 : L_QI, RV = (PASS == 3) ? L_BIG + 32768 : L_QI + 16384;
        const int j = tid & 63, seg = tid >> 6;
        float2 cssn[8];
#pragma unroll
        for (int i = 0; i < 8; ++i) cssn[i] = make_float2(pf.aux[2 * i], pf.aux[2 * i + 1]);
        stg_store<128, 64>(lds, RK, tid, pf.raw + 0); stg_store<128, 64>(lds, RV, tid, pf.raw + 2);
        if constexpr (PASS == 3) stg_store<128, 64>(lds, RQ, tid, pf.raw + 4);
        __builtin_amdgcn_sched_barrier(0);
        const float lg = log1pf(-exp2f(-(5.f + (float)hu)));
        if (tid < 64) { SM[SM_CUM + tid] = (float)(tid + 1) * lg; SM[SM_DT + tid] = 1.f; }
        __syncthreads();
        float k1[8], k2[8];
#pragma unroll
        for (int i = 0; i < 8; ++i) { const int t = seg * 8 + i;
            const LAS bf16_t* rk = (const LAS bf16_t*)(lds + RK) + t * 128 + j;
            const float ka = bf2f(rk[0]) * 0.08838834764831845f, kb = bf2f(rk[64]) * 0.08838834764831845f;
            k1[i] = ka * cssn[i].x - kb * cssn[i].y; k2[i] = ka * cssn[i].y + kb * cssn[i].x;
            if constexpr (PASS == 3) { const LAS bf16_t* rq = (const LAS bf16_t*)(lds + RQ) + t * 128 + j;
                const float qa = bf2f(rq[0]), qb = bf2f(rq[64]);
                QI[t * LDK + j] = f2bf(qa * cssn[i].x - qb * cssn[i].y); QI[t * LDK + j + 64] = f2bf(qa * cssn[i].y + qb * cssn[i].x);
                KI[t * LDK + j] = f2bf(k1[i]); KI[t * LDK + j + 64] = f2bf(k2[i]); } }
        if constexpr (PASS == 1) { store8(lds, L_BIG + (j * 72 + seg * 8) * 2, k1); store8(lds, L_BIG + ((j + 64) * 72 + seg * 8) * 2, k2); }
        const int v = tid & 127, s4 = tid >> 7; float vv[16];
#pragma unroll
        for (int i = 0; i < 16; ++i) { const int s = s4 * 16 + i; float x = bf2f(((const LAS bf16_t*)(lds + RV))[s * 128 + v]);
            if constexpr (PASS == 1) x *= __expf((float)(63 - s) * lg);
            vv[i] = x; }
        store16(lds, L_VT + (v * 72 + s4 * 16) * 2, vv);
    }
    if constexpr (BR == 2) {
        constexpr int RB = (PASS == 3) ? L_BIG : L_QI, RC = L_BIG + 17152, RX = (PASS == 3) ? L_BIG + 34304 : L_BIG + 18432;
        float dtr[4];
#pragma unroll
        for (int hh = 0; hh < 4; ++hh) dtr[hh] = pf.aux[hh];
        stg_store<128, 67>(lds, RB, tid, pf.raw + 0); stg_store<256, 67>(lds, RX, tid, pf.raw + 3);
        if constexpr (PASS == 3) stg_store<128, 67>(lds, RC, tid, pf.raw + 8);
        __builtin_amdgcn_sched_barrier(0);
        if (tid < 64) {
#pragma unroll
            for (int hh = 0; hh < 4; ++hh) {
                const float dt = softplus_f(dtr[hh] + dtb[hh]);
                float la = -dt * __expf(alg[hh]);
#pragma unroll
                for (int o = 1; o < 64; o <<= 1) { const float yv = __shfl_up(la, o); if (tid >= o) la += yv; }
                SM[SM_CUM + hh * 64 + tid] = la; SM[SM_DT + hh * 64 + tid] = dt; }
        }
        __syncthreads();
        { const int n = tid & 127, seg = tid >> 7; float o[16];
          conv16(lds, RB, 128, n, cwb, seg, o);
          if constexpr (PASS == 3) {
#pragma unroll
              for (int i = 0; i < 16; ++i) KI[(seg * 16 + i) * LDK + n] = f2bf(o[i]);
              conv16(lds, RC, 128, n, cwc, seg, o);
#pragma unroll
              for (int i = 0; i < 16; ++i) QI[(seg * 16 + i) * LDK + n] = f2bf(o[i]);
          } else store16(lds, L_BIG + (n * 72 + seg * 16) * 2, o);
        }
        { const int v = tid & 255, s2 = tid >> 8, hh = v >> 6;
#pragma unroll
          for (int r = 0; r < 2; ++r) { const int seg = s2 * 2 + r; float o[16];
              conv16(lds, RX, 256, v, cwx, seg, o);
              if constexpr (PASS == 1) { const float cl = SM[SM_CUM + hh * 64 + 63];
#pragma unroll
                  for (int i = 0; i < 16; ++i) { const int s = seg * 16 + i; o[i] *= __expf(cl - SM[SM_CUM + hh * 64 + s]) * SM[SM_DT + hh * 64 + s]; } }
              store16(lds, L_VT + (v * 72 + seg * 16) * 2, o); }
        }
    }
    if constexpr (BR == 3) {
        constexpr int RQ = L_BIG, RK = (PASS == 3) ? L_BIG + 8192 : L_QI, RV = (PASS == 3) ? L_BIG + 16384 : L_QI + 8192, RL = (PASS == 3) ? L_BIG + 32768 : L_QI + 24576;
        const int d = tid & 63, seg = tid >> 6, cc = hu * 64 + d;
        float w2r[16];
#pragma unroll
        for (int r = 0; r < 16; ++r) w2r[r] = pf.aux[r];
        stg_store<64, 64>(lds, RK, tid, pf.raw + 0); stg_store<128, 64>(lds, RV, tid, pf.raw + 1); stg_store<16, 64>(lds, RL, tid, pf.raw + 3);
        if constexpr (PASS == 3) stg_store<64, 64>(lds, RQ, tid, pf.raw + 4);
        __builtin_amdgcn_sched_barrier(0);
        __syncthreads();
        float cs[8]; float run = 0.f;
#pragma unroll
        for (int i = 0; i < 8; ++i) { const int t = seg * 8 + i; const LAS bf16x8* lp = (const LAS bf16x8*)(lds + RL + t * 32);
            const bf16x8 l0 = lp[0], l1 = lp[1]; float gk = bb;
#pragma unroll
            for (int r = 0; r < 8; ++r) { gk += w2r[r] * bf2f((bf16_t)l0[r]); gk += w2r[8 + r] * bf2f((bf16_t)l1[r]); }
            run += logsig_f(gk) * (1.f / 16.f); cs[i] = run; }
        SM[SM_SEG + seg * 64 + d] = run;
        __syncthreads();
        float off = 0.f, ref = 0.f, clast = 0.f;
#pragma unroll
        for (int s = 0; s < 8; ++s) { const float tv = SM[SM_SEG + s * 64 + d]; if (s < seg) off += tv; if (s < 4) ref += tv; clast += tv; }
        if (seg == 0) { SM[SM_REF + d] = ref; SM[SM_CLAST + d] = clast; }
        float kv[8];
#pragma unroll
        for (int i = 0; i < 8; ++i) { const int t = seg * 8 + i; const float c = off + cs[i];
            kv[i] = bf2f(((const LAS bf16_t*)(lds + RK))[t * 64 + d]) * __expf(ref - c);
            if constexpr (PASS == 3) { KI[t * LDK + d] = f2bf(kv[i]); QI[t * LDK + d] = f2bf(bf2f(((const LAS bf16_t*)(lds + RQ))[t * 64 + d]) * 0.125f * __expf(c - ref)); } }
        if constexpr (PASS == 1) store8(lds, L_BIG + (d * 72 + seg * 8) * 2, kv);
        const int v = tid & 127, s4 = tid >> 7; unsigned vv[16];
#pragma unroll
        for (int i = 0; i < 16; ++i) vv[i] = ((const LAS bf16_t*)(lds + RV))[(s4 * 16 + i) * 128 + v];
        u32x4 a, b; a.x = vv[0] | (vv[1] << 16); a.y = vv[2] | (vv[3] << 16); a.z = vv[4] | (vv[5] << 16); a.w = vv[6] | (vv[7] << 16);
        b.x = vv[8] | (vv[9] << 16); b.y = vv[10] | (vv[11] << 16); b.z = vv[12] | (vv[13] << 16); b.w = vv[14] | (vv[15] << 16);
        *(LAS u32x4*)(lds + L_VT + (v * 72 + s4 * 16) * 2) = a; *(LAS u32x4*)(lds + L_VT + (v * 72 + s4 * 16) * 2 + 16) = b;
    }
    __syncthreads();
    }
    for (int urep = 0; urep < REP_UCORE; ++urep) {
    if constexpr (PASS == 1) {
        constexpr int NTN = DV / 32, NTILES = (DK / 32) * NTN, NTL = NTILES / 8;
        f32x16 hacc[NTL];
#pragma unroll
        for (int i = 0; i < NTL; ++i) {
            const int ti = wid + 8 * i, tm = ti / NTN, tn = ti % NTN;
#pragma unroll
            for (int r = 0; r < 16; ++r) hacc[i][r] = 0.f;
#pragma unroll
            for (int ks = 0; ks < 4; ++ks) hacc[i] = __builtin_amdgcn_mfma_f32_32x32x16_bf16(frag(lds, L_BIG, 72, tm * 32, ks, lane), frag(lds, L_VT, 72, tn * 32, ks, lane), hacc[i], 0, 0, 0);
            if constexpr (VEC) {
#pragma unroll
                for (int r = 0; r < 16; ++r) { const int d = tm * 32 + rowmap(r, lane); hacc[i][r] *= __expf(SM[SM_CLAST + d] - SM[SM_REF + d]); }
            }
        }
        float decv = 0.f;
        if constexpr (BR == 0) { if (tid < 128) decv = __expf(SM[SM_CLAST + tid]); }
        if constexpr (BR == 3) { if (tid < 64) decv = __expf(SM[SM_CLAST + tid]); }
        if constexpr (BR == 2) { if (tid < 4) decv = __expf(SM[SM_CUM + tid * 64 + 63]); }
        __syncthreads();
#pragma unroll
        for (int i = 0; i < NTL; ++i) {
            const int ti = wid + 8 * i, tm = ti / NTN, tn = ti % NTN;
            const int v = tn * 32 + (lane & 31);
#pragma unroll
            for (int rg = 0; rg < 4; ++rg) { const int d0 = tm * 32 + 8 * rg + 4 * (lane >> 5);
                u32x2 w; w.x = pk2(hacc[i][rg * 4 + 0], hacc[i][rg * 4 + 1]); w.y = pk2(hacc[i][rg * 4 + 2], hacc[i][rg * 4 + 3]);
                *(u32x2*)(stg + (size_t)v * DK + d0) = w; }
        }
        float* dec = p.dec + (size_t)bc * 1024;
        if constexpr (BR == 0) { if (tid < 128) dec[hu * 128 + tid] = decv; }
        if constexpr (BR == 3) { if (tid < 64) dec[512 + hu * 64 + tid] = decv; }
        if constexpr (BR == 2) { if (tid < 4) dec[768 + hu * 4 + tid] = decv; }
    } else {
        constexpr int NCT = DV / 32;
        {
            constexpr int NVEC = DV * DK / 8, VPR = DK / 8;
#pragma unroll
            for (int k = 0; k < NVEC / NTHR; ++k) { const int vi = tid + NTHR * k; const int v = vi / VPR, d0 = (vi % VPR) * 8;
                u32x4 raw = pf.st[k];
                if constexpr (VEC) { unsigned w[4] = {raw.x, raw.y, raw.z, raw.w};
#pragma unroll
                    for (int q = 0; q < 4; ++q) { const float lo = __uint_as_float(w[q] << 16) * __expf(SM[SM_REF + d0 + 2 * q]), hi = __uint_as_float(w[q] & 0xffff0000u) * __expf(SM[SM_REF + d0 + 2 * q + 1]);
                        w[q] = pk2(lo, hi); }
                    raw.x = w[0]; raw.y = w[1]; raw.z = w[2]; raw.w = w[3]; }
                *(LAS u32x4*)(lds + L_BIG + (v * LDK + d0) * 2) = raw; }
        }
        __builtin_amdgcn_sched_barrier(0);
        __syncthreads();
        const int tm = wid >> 2, tnb = wid & 3;
        f32x16 acc[NT];
#pragma unroll
        for (int nt = 0; nt < NT; ++nt)
#pragma unroll
            for (int r = 0; r < 16; ++r) acc[nt][r] = 0.f;
#pragma unroll
        for (int ks = 0; ks < DK / 16; ++ks) { const bf16x8 af = frag(lds, L_QI, LDK, tm * 32, ks, lane);
#pragma unroll
            for (int nt = 0; nt < NT; ++nt) acc[nt] = __builtin_amdgcn_mfma_f32_32x32x16_bf16(af, frag(lds, L_BIG, LDK, (tnb + 4 * nt) * 32, ks, lane), acc[nt], 0, 0, 0); }
        if constexpr (!VEC) {
#pragma unroll
            for (int nt = 0; nt < NT; ++nt) { const int hh = (NH == 1) ? 0 : ((tnb + 4 * nt) >> 1);
#pragma unroll
                for (int r = 0; r < 16; ++r) acc[nt][r] *= __expf(SM[SM_CUM + hh * 64 + tm * 32 + rowmap(r, lane)]); }
        }
        constexpr int P_OFF = (NH == 1) ? L_BIG + 34816 : L_BIG;
        f32x16 sc;
#pragma unroll
        for (int r = 0; r < 16; ++r) sc[r] = 0.f;
        const int stm = wid >> 1, stn = wid & 1;
        if (wid < 4) {
#pragma unroll
            for (int ks = 0; ks < DK / 16; ++ks) sc = __builtin_amdgcn_mfma_f32_32x32x16_bf16(frag(lds, L_QI, LDK, stm * 32, ks, lane), frag(lds, L_KI, LDK, stn * 32, ks, lane), sc, 0, 0, 0);
        }
        if constexpr (NH != 1) __syncthreads();
        if (wid < 4) {
            const int s = stn * 32 + (lane & 31);
#pragma unroll
            for (int hh = 0; hh < NH; ++hh) {
                float cums = 0.f, dts = 1.f;
                if constexpr (!VEC) { cums = SM[SM_CUM + hh * 64 + s]; dts = SM[SM_DT + hh * 64 + s]; }
#pragma unroll
                for (int r = 0; r < 16; ++r) { const int t = stm * 32 + rowmap(r, lane);
                    float val = sc[r];
                    if constexpr (!VEC) { const float ex = (s <= t) ? SM[SM_CUM + hh * 64 + t] - cums : 0.f; val *= __expf(ex) * dts; }
                    val = (s <= t) ? val : 0.f;
                    *(LAS bf16_t*)(lds + P_OFF + ((hh * 64 + t) * 72 + s) * 2) = f2bf(val); }
            }
        }
        __syncthreads();
#pragma unroll
        for (int nt = 0; nt < NT; ++nt) { const int hh = (NH == 1) ? 0 : ((tnb + 4 * nt) >> 1);
#pragma unroll
            for (int ks = 0; ks < 4; ++ks) acc[nt] = __builtin_amdgcn_mfma_f32_32x32x16_bf16(frag(lds, P_OFF + hh * 9216, 72, tm * 32, ks, lane), frag(lds, L_VT, 72, (tnb + 4 * nt) * 32, ks, lane), acc[nt], 0, 0, 0); }
        const int ycol = (BR == 0) ? hu * 128 : (BR == 1) ? 512 + hu * 128 : (BR == 2) ? 1024 + hu * 256 : 1536 + hu * 128;
#pragma unroll
        for (int nt = 0; nt < NT; ++nt) { const int ct = tnb + 4 * nt, v = ct * 32 + (lane & 31);
            const float dsk = dskv[nt];
            float sq[16];
#pragma unroll
            for (int r = 0; r < 16; ++r) { const int t = tm * 32 + rowmap(r, lane);
                float val = acc[nt][r];
                if constexpr (BR == 2) { val = (val + dsk * bf2f(VT[v * 72 + t])) * silu_f(bf2f(gt[nt][r])); acc[nt][r] = val; }
                sq[r] = val * val; }
            const bool b4 = lane & 16, b3 = lane & 8, b2 = lane & 4, b1 = lane & 2;
#pragma unroll
            for (int i = 0; i < 8; ++i) { const float lo = sq[i], hi = sq[i + 8]; sq[i] = (b4 ? hi : lo) + __shfl_xor(b4 ? lo : hi, 16); }
#pragma unroll
            for (int i = 0; i < 4; ++i) { const float lo = sq[i], hi = sq[i + 4]; sq[i] = (b3 ? hi : lo) + __shfl_xor(b3 ? lo : hi, 8); }
#pragma unroll
            for (int i = 0; i < 2; ++i) { const float lo = sq[i], hi = sq[i + 2]; sq[i] = (b2 ? hi : lo) + __shfl_xor(b2 ? lo : hi, 4); }
            { const float lo = sq[0], hi = sq[1]; sq[0] = (b1 ? hi : lo) + __shfl_xor(b1 ? lo : hi, 2); }
            sq[0] += __shfl_xor(sq[0], 1);
            const int rr = (b4 ? 8 : 0) + (b3 ? 4 : 0) + (b2 ? 2 : 0) + (b1 ? 1 : 0);
            if ((lane & 1) == 0) SM[SM_RSS + ct * 64 + tm * 32 + rowmap(rr, lane)] = sq[0];
        }
        __syncthreads();
        if (tid < 64) { float tot = 0.f;
#pragma unroll
            for (int q = 0; q < NCT; ++q) tot += SM[SM_RSS + q * 64 + tid];
            SM[SM_SEG + tid] = rsqrtf(tot * (1.f / DV) + EPS); }
        __syncthreads();
        float rinv[16];
#pragma unroll
        for (int r = 0; r < 16; ++r) rinv[r] = SM[SM_SEG + tm * 32 + rowmap(r, lane)];
        __syncthreads();
#pragma unroll
        for (int nt = 0; nt < NT; ++nt) { const int ct = tnb + 4 * nt, v = ct * 32 + (lane & 31);
            const float gn = gnv[nt];
#pragma unroll
            for (int r = 0; r < 16; ++r) { const int t = tm * 32 + rowmap(r, lane);
                float o = acc[nt][r] * rinv[r] * gn;
                if constexpr (BR != 2) o *= silu_f(bf2f(gt[nt][r]));
                p.y[(size_t)(bc * 64 + t) * DI + ycol + v] = f2bf(o); }
        }
    }
    }
}

template <int PASS>
__device__ __forceinline__ void phase_mixer(const MixP& p, LAS unsigned char* lds) {
#pragma unroll 1
    for (int i = blockIdx.x; i < NUNITS; i += gridDim.x) {
        const int bc = i / 14, u = i % 14;
        if (u < 4) mixer_unit<0, PASS>(p, lds, bc, u);
        else if (u < 8) mixer_unit<1, PASS>(p, lds, bc, u - 4);
        else if (u < 10) mixer_unit<2, PASS>(p, lds, bc, u - 8);
        else mixer_unit<3, PASS>(p, lds, bc, u - 10);
    }
}

__device__ __forceinline__ void phase_scan(bf16_t* st, const float* dec) {
    const int gt = blockIdx.x * NTHR + opaque_tid();
    constexpr int VPB = ST_PER_BC / 4;
    if (gt >= 2 * VPB) return;
    const int bl = gt / VPB, e0 = (gt % VPB) * 4;
    int mode, didx = 0; float cfac = 0.f;
    if (e0 < 65536) { mode = 0; didx = (e0 >> 14) * 128 + (e0 & 127); }
    else if (e0 < 131072) { mode = 1; const int h = (e0 - 65536) >> 14; cfac = __expf(64.f * log1pf(-exp2f(-(5.f + (float)h)))); }
    else if (e0 < 196608) { mode = 2; const int r = e0 - 131072; didx = 768 + (r >> 15) * 4 + (((r & 32767) >> 7) >> 6); }
    else { mode = 0; const int r = e0 - 196608; didx = 512 + (r >> 13) * 64 + (r & 63); }
    float s0 = 0.f, s1 = 0.f, s2 = 0.f, s3 = 0.f;
    bf16_t* ptr = st + (size_t)bl * 64 * ST_PER_BC + e0;
    const float* dp = dec + (size_t)bl * 64 * 1024 + didx;
#pragma unroll 1
    for (int c0 = 0; c0 < 64; c0 += 8) {
        u32x2 hv[8]; f32x4 dv[8];
#pragma unroll
        for (int j = 0; j < 8; ++j) {
            hv[j] = *(const u32x2*)(ptr + (size_t)(c0 + j) * ST_PER_BC);
            if (mode == 0) dv[j] = *(const f32x4*)(dp + (size_t)(c0 + j) * 1024);
            else if (mode == 1) dv[j] = (f32x4){cfac, cfac, cfac, cfac};
            else { const float d = dp[(size_t)(c0 + j) * 1024]; dv[j] = (f32x4){d, d, d, d}; }
        }
        __builtin_amdgcn_sched_barrier(0);
#pragma unroll
        for (int j = 0; j < 8; ++j) {
            u32x2 w; w.x = pk2(s0, s1); w.y = pk2(s2, s3);
            *(u32x2*)(ptr + (size_t)(c0 + j) * ST_PER_BC) = w;
            s0 = s0 * dv[j][0] + __uint_as_float(hv[j].x << 16); s1 = s1 * dv[j][1] + __uint_as_float(hv[j].x & 0xffff0000u);
            s2 = s2 * dv[j][2] + __uint_as_float(hv[j].y << 16); s3 = s3 * dv[j][3] + __uint_as_float(hv[j].y & 0xffff0000u);
        }
    }
}


#define XB_TMO      128
#define XB_XCNT(j)  (256  + 64 * (j))
#define XB_XSUB(j)  (1280 + 64 * (j))
#define XB_XGEN(j)  (2304 + 64 * (j))
#define XB_TOP      3328
#define XB_TOPGEN   3392
#define XCD_BAR_WORDS 3456
#define XB_SPIN_CAP (1u << 18)
__device__ __forceinline__ unsigned xb_ld(unsigned* p)              { return __hip_atomic_load(p, __ATOMIC_RELAXED, __HIP_MEMORY_SCOPE_AGENT); }
__device__ __forceinline__ unsigned xb_add(unsigned* p, unsigned v) { return __hip_atomic_fetch_add(p, v, __ATOMIC_RELAXED, __HIP_MEMORY_SCOPE_AGENT); }
__device__ __forceinline__ unsigned xb_xcc_id() { return (unsigned)__builtin_amdgcn_s_getreg((3 << 11) | 20) & 0xFu; }
#define XB_SPIN(cond, bar) do { unsigned _sp = 0; while (cond) { __builtin_amdgcn_s_sleep(1); \
    if ((++_sp & 255u) == 0u) { if (xb_ld(&(bar)[XB_TMO])) break; if (_sp > XB_SPIN_CAP) { atomicAdd(&(bar)[XB_TMO], 1u); break; } } } } while (0)
struct XcdBarrier { unsigned* bar; unsigned x; volatile LAS unsigned* st; };
__device__ __forceinline__ XcdBarrier xcd_barrier_post(unsigned* bar, volatile LAS unsigned* st) {
    XcdBarrier b; b.bar = bar; b.x = xb_xcc_id(); b.st = st;
    if (threadIdx.x == 0) (void)xb_add(&bar[XB_XCNT(b.x)], 1u);
    return b;
}
__device__ __forceinline__ void xcd_barrier_complete(unsigned* bar, unsigned x, unsigned& nloc, unsigned& nx) {
    const unsigned G = gridDim.x * gridDim.y * gridDim.z;
    unsigned sum, cnt, mine, sp = 0u;
    for (;;) {
        sum = 0u; cnt = 0u; mine = 0u;
#pragma unroll
        for (unsigned j = 0; j < 16; ++j) { const unsigned c = xb_ld(&bar[XB_XCNT(j)]); sum += c; cnt += (c > 0u) ? 1u : 0u; mine = (j == x) ? c : mine; }
        if (sum == G) break;
        __builtin_amdgcn_s_sleep(1);
        if ((++sp & 255u) == 0u) { if (xb_ld(&bar[XB_TMO])) break; if (sp > XB_SPIN_CAP) { atomicAdd(&bar[XB_TMO], 1u); break; } }
    }
    nloc = mine > 0u ? mine : 1u; nx = cnt > 0u ? cnt : 1u;
}
__device__ __forceinline__ void xcd_barrier(const XcdBarrier& b) {
    asm volatile("s_waitcnt vmcnt(0)" ::: "memory");
    __syncthreads();
    if (threadIdx.x == 0) {
        unsigned* bar = b.bar;
        __builtin_amdgcn_s_waitcnt(0);
        unsigned nloc = b.st[0], nx = b.st[1];
        if (nloc == 0u) { xcd_barrier_complete(bar, b.x, nloc, nx); b.st[0] = nloc; b.st[1] = nx; }
        const unsigned old = xb_add(&bar[XB_XSUB(b.x)], 1u);
        const unsigned gen = old / nloc;
        if (old + 1u == (gen + 1u) * nloc) {
            __builtin_amdgcn_fence(__ATOMIC_RELEASE, "agent");
            asm volatile("s_waitcnt vmcnt(0)" ::: "memory");
            const unsigned og = xb_add(&bar[XB_TOP], 1u);
            const unsigned tg = og / nx;
            if (og + 1u == (tg + 1u) * nx) xb_add(&bar[XB_TOPGEN], 1u);
            else XB_SPIN(xb_ld(&bar[XB_TOPGEN]) == tg, bar);
            __builtin_amdgcn_fence(__ATOMIC_ACQUIRE, "agent");
            xb_add(&bar[XB_XGEN(b.x)], 1u);
            asm volatile("s_waitcnt vmcnt(0)" ::: "memory");
        } else {
            XB_SPIN(xb_ld(&bar[XB_XGEN(b.x)]) == gen, bar);
            __builtin_amdgcn_fence(__ATOMIC_ACQUIRE, "agent");
            asm volatile("s_waitcnt vmcnt(0)" ::: "memory");
        }
    }
    __syncthreads();
}

__global__ void __launch_bounds__(NTHR, 2) fwd_megakernel(Args a) {
    extern __shared__ __attribute__((aligned(16))) unsigned char shm[];
    LAS unsigned char* lds = (LAS unsigned char*)shm;
    cg::grid_group grid = cg::this_grid();
    unsigned char* ws = a.ws;
    const int G = gridDim.x;

    {
        volatile LAS unsigned* stw = (volatile LAS unsigned*)(lds + L_BARST);
        if (threadIdx.x < 2) stw[threadIdx.x] = 0u;
        __syncthreads();
    }
    const XcdBarrier gbar = xcd_barrier_post((unsigned*)(ws + WS_BAR), (volatile LAS unsigned*)(lds + L_BARST));
    for (int rep = 0; rep < REP_PREP; ++rep) { phase_prep(a, lds); if (rep == 0) grid.sync(); else xcd_barrier(gbar); }

    bf16_t* hbuf = (bf16_t*)(ws + WS_HY); bf16_t* ybuf = (bf16_t*)(ws + WS_HY);
    bf16_t* proj = (bf16_t*)(ws + WS_PROJ); bf16_t* st = (bf16_t*)(ws + WS_ST); float* dec = (float*)(ws + WS_DEC);
    const float* mod = (const float*)(ws + WS_MOD);

#pragma unroll 1
    for (int half = 0; half < 2; ++half) {
        const size_t xoff = (size_t)half * HROWS * DM;
#pragma unroll 1
        for (int l = 0; l < DEPTH; ++l) {
            const float* modl = mod + (size_t)l * 4 * 3072;
            bf16_t* slab = (bf16_t*)(ws + WS_PROJ);
            if (l == 0) { phase_norm<false>(a.x + xoff, nullptr, nullptr, nullptr, a.norm_g, modl, half, hbuf); if (half == 0) phase_wcvt(a, lds); }
            else phase_norm<false>(a.x + xoff, slab, mod + (size_t)(half * 2) * 3072 + 2048, a.out + xoff, a.norm_g + l * DM, modl, half, hbuf);
            xcd_barrier(gbar);
            for (int rep = 0; rep < REP_G1; ++rep) {
                pg8::Gemm g{hbuf, (const bf16_t*)(ws + WS_WIN) + (size_t)l * LDP * DM, HROWS, LDP, DM, DM};
                pg8::StaticOrder S; S.init(HROWS, LDP, G, (int)blockIdx.x);
                pg8::EpiProj E{proj, LDP};
                pg8::gemm_phase<pg8::EpiProj, pg8::StaticOrder>(lds, g, S, E);
                xcd_barrier(gbar);
            }
            MixP p;
            p.proj = proj; p.st = st; p.dec = dec; p.y = ybuf; p.rope = (const float2*)(ws + WS_ROPE);
            p.lbl = a.lb_logits; p.hgrn_g = a.hgrn_g + l * 512; p.ret_g = a.ret_g + l * 512; p.conv_w = a.conv_w + l * 4096; p.conv_b = a.conv_b + l * 1024;
            p.dt_bias = a.dt_bias + l * 8; p.a_log = a.a_log + l * 8; p.dskip = a.dskip + l * 8; p.ssm_g = a.ssm_g + l * 512;
            p.w2 = a.w_gk2 + l * 16 * 256; p.b2 = a.b_gk2 + l * 256; p.gla_g = a.gla_g + l * 512; p.layer = l;
            for (int rep = 0; rep < REP_M12; ++rep) { phase_mixer<1>(p, lds); xcd_barrier(gbar); phase_scan(st, dec); xcd_barrier(gbar); }
            for (int rep = 0; rep < REP_M3; ++rep) { phase_mixer<3>(p, lds); xcd_barrier(gbar); }
            for (int rep = 0; rep < REP_G2; ++rep) {
                pg8::Gemm g{ybuf, (const bf16_t*)(ws + WS_WOUT) + (size_t)l * DM * DI, HROWS, DM, DI / 2, DI};
                pg8::SplitOrder S; S.init(HROWS, DM, G, (int)blockIdx.x);
                pg8::EpiSlab E{slab};
                pg8::gemm_phase<pg8::EpiSlab, pg8::SplitOrder>(lds, g, S, E);
                xcd_barrier(gbar);
            }
        }
        phase_norm<true>(a.out + xoff, (const bf16_t*)(ws + WS_PROJ), mod + (size_t)(4 + half * 2) * 3072 + 2048, a.out + xoff, a.final_g, nullptr, half, nullptr);
    }
}

extern "C" void kernel_launch(void* const* d_in, const int* in_sizes, int n_in, void* d_out, int out_size, void* d_ws, size_t ws_size, hipStream_t stream) {
    static int grid = 0;
    if (grid == 0) {
        if (n_in != 20 || ws_size < WS_END) { fprintf(stderr, "kernel_launch: unexpected n_in %d / ws_size %zu (need %zu)\n", n_in, ws_size, (size_t)WS_END); grid = -1; return; }
        int dev = 0, cus = 0, per_cu = 0;
        hipGetDevice(&dev);
        hipDeviceGetAttribute(&cus, hipDeviceAttributeMultiprocessorCount, dev);
        if (hipFuncSetAttribute((const void*)fwd_megakernel, hipFuncAttributeMaxDynamicSharedMemorySize, LDS_BYTES) != hipSuccess) { fprintf(stderr, "kernel_launch: hipFuncSetAttribute failed\n"); grid = -1; return; }
        hipOccupancyMaxActiveBlocksPerMultiprocessor(&per_cu, (const void*)fwd_megakernel, NTHR, LDS_BYTES);
        if (per_cu < 1) { fprintf(stderr, "kernel_launch: occupancy query says %d blocks per CU\n", per_cu); per_cu = 1; }
        (void)hipGetLastError();
        grid = cus * per_cu;
    }
    if (grid < 0) return;
    Args a{};
    const float** f = (const float**)&a;
    for (int i = 0; i < 20; ++i) f[i] = (const float*)d_in[i];
    a.out = (float*)d_out; a.ws = (unsigned char*)d_ws;
    void* args[] = {&a};
    if (hipMemsetAsync((char*)d_ws + WS_BAR, 0, XCD_BAR_WORDS * 4, stream) != hipSuccess) { fprintf(stderr, "kernel_launch: memset of barrier words failed\n"); return; }
    hipError_t e = hipLaunchCooperativeKernel((const void*)fwd_megakernel, dim3(grid), dim3(NTHR), args, LDS_BYTES, stream);
    if (e != hipSuccess) fprintf(stderr, "cooperative launch failed: %s (grid %d)\n", hipGetErrorString(e), grid);
}
```

```cpp
#include <hip/hip_runtime.h>
#include <hip/hip_cooperative_groups.h>
#include <cstdio>
namespace cg = cooperative_groups;

#define LAS __attribute__((address_space(3)))
typedef unsigned short bf16_t;
typedef short bf16x8 __attribute__((ext_vector_type(8)));
typedef float f32x4 __attribute__((ext_vector_type(4)));
typedef float f32x16 __attribute__((ext_vector_type(16)));
typedef unsigned u32x4 __attribute__((ext_vector_type(4)));
typedef unsigned u32x2 __attribute__((ext_vector_type(2)));

#ifndef REP_PREP
#define REP_PREP 1
#endif
#ifndef REP_NORM
#define REP_NORM 1
#endif
#ifndef REP_G1
#define REP_G1 1
#endif
#ifndef REP_M12
#define REP_M12 1
#endif
#ifndef REP_M3
#define REP_M3 1
#endif
#ifndef REP_G2
#define REP_G2 1
#endif
#ifndef REP_UPREP
#define REP_UPREP 1
#endif
#ifndef REP_UCORE
#define REP_UCORE 1
#endif
constexpr int NB = 4, SEQ = 4096, DM = 1024, DEPTH = 2, DI = 2048;
constexpr int NIN = 7192, LDP = 7424;
constexpr int HROWS = 8192;
constexpr int NTHR = 512;
constexpr float EPS = 1e-6f;
constexpr int C_AQ = 0, C_AF = 512, C_AI = 1024, C_AG = 1536, C_RQ = 2048, C_RK = 2560, C_RV = 3072, C_RG = 3584,
              C_MZ = 4096, C_XBC = 4608, C_GQ = 5632, C_GK = 5888, C_GV = 6144, C_GG = 6656, C_DT = 7168, C_LR = 7176;
constexpr int ST_PER_BC = 229376;
constexpr size_t WS_WIN = 0;
constexpr size_t WS_WOUT = WS_WIN + 2ull * LDP * DM * 2;
constexpr size_t WS_MOD = WS_WOUT + 2ull * DM * DI * 2;
constexpr size_t WS_ROPE = WS_MOD + 2ull * 4 * 3072 * 4;
constexpr size_t WS_DEC = WS_ROPE + 4096ull * 64 * 8;
constexpr size_t WS_HY = WS_DEC + 128ull * 1024 * 4;
constexpr size_t WS_PROJ = WS_HY + (size_t)HROWS * DI * 2;
constexpr size_t WS_ST = WS_PROJ + (size_t)HROWS * LDP * 2;
constexpr size_t WS_BAR = WS_ST + 128ull * ST_PER_BC * 2;
constexpr size_t WS_END = WS_BAR + 3456 * 4;
constexpr int L_QI = 0, L_KI = 17408, L_VT = 34816, L_BIG = 71680, L_SM = 141312;
constexpr int SM_CUM = 0, SM_DT = 256, SM_SEG = 512, SM_REF = 1536, SM_CLAST = 1664, SM_RSS = 1792;
constexpr int L_BARST = L_SM + (1792 + 512) * 4;
constexpr int LDS_BYTES = L_BARST + 16;

constexpr int NCG = LDP / 128;
__device__ __forceinline__ size_t pidx(int row, int col) { return ((size_t)((row >> 6) * NCG + (col >> 7)) * 64 + (row & 63)) * 128 + (col & 127); }
__device__ __forceinline__ float bf2f(bf16_t v) { return __uint_as_float(((unsigned)v) << 16); }
__device__ __forceinline__ bf16_t f2bf(float f) { unsigned u = __float_as_uint(f); u += 0x7FFFu + ((u >> 16) & 1u); return (bf16_t)(u >> 16); }
typedef float f32x2_t __attribute__((ext_vector_type(2)));
typedef __bf16 bf16x2_t __attribute__((ext_vector_type(2)));
__device__ __forceinline__ unsigned pk2(float lo, float hi) { f32x2_t v = {lo, hi}; bf16x2_t b = __builtin_convertvector(v, bf16x2_t); return __builtin_bit_cast(unsigned, b); }
__device__ __forceinline__ int opaque_tid() { int t = threadIdx.x; asm volatile("" : "+v"(t)); return t; }
__device__ __forceinline__ float silu_f(float x) { return x * __builtin_amdgcn_rcpf(1.f + __expf(-x)); }
__device__ __forceinline__ float softplus_f(float x) { return fmaxf(x, 0.f) + __logf(1.f + __expf(-fabsf(x))); }
__device__ __forceinline__ float logsig_f(float x) { return fminf(x, 0.f) - __logf(1.f + __expf(-fabsf(x))); }

namespace pg8 {
constexpr int BM = 256, BK = 64, HALF = 128, HTB = HALF * BK * 2, STAGE_BYTES = 8 * HTB, NXCD = 8, WGM = 8;
__device__ __forceinline__ int lds_byte(int r, int c) { const int st = (r >> 4) * 2 + (c >> 5), rr = r & 15, cc = c & 31, ob = rr * 64 + cc * 2; return st * 1024 + (ob ^ (((ob >> 9) & 1) << 5)); }
__device__ __forceinline__ void stage_rc(int b, int& R, int& C) { const int st = b / 1024, sb = b % 1024, swz = sb ^ (((sb >> 9) & 1) << 5); R = (st >> 1) * 16 + swz / 64; C = (st & 1) * 32 + (swz % 64) / 2; }
__device__ __forceinline__ int perm32(int rho) { const int n = rho >> 4, i = rho & 15; return 8 * (i >> 2) + 4 * n + (i & 3); }
struct Unit { int pm, pn, kh; };
struct Gemm { const bf16_t* A; const bf16_t* Bt; int M, N, K, ld; };
struct StaticOrder {
    int nM, nN, nwg, G, c;
    __device__ void init(int M, int N, int G_, int c_) { nM = M / BM; nN = N / BM; nwg = nM * nN; G = G_; c = c_; }
    __device__ bool next(int i, Unit& u) const {
        const long L = (long)i * G + c; if (L >= nwg) return false;
        int wgid = (int)L; { const int q = nwg / NXCD, r = nwg % NXCD, xcd = wgid % NXCD, off = wgid / NXCD; wgid = (xcd < r ? xcd * (q + 1) : r * (q + 1) + (xcd - r) * q) + off; }
        const int nig = WGM * nN, gid = wgid / nig, fm = gid * WGM, gsz = (nM - fm) < WGM ? (nM - fm) : WGM;
        u.pm = fm + ((wgid % nig) % gsz); u.pn = (wgid % nig) / gsz; u.kh = 0; return true;
    }
};
struct SplitOrder {
    StaticOrder so;
    __device__ void init(int M, int N, int G_, int c_) { so.init(M, 2 * N, G_, c_); }
    __device__ bool next(int i, Unit& u) const { if (!so.next(i, u)) return false; u.kh = u.pn & 1; u.pn >>= 1; return true; }
};
struct EpiProj {
    static constexpr bool PERM = true;
    bf16_t* O; int ldc;
    __device__ __forceinline__ void operator()(const f32x4 (&acc)[2][2][4][2], const Unit& u, int wr, int wc, int fr, int fq) const {
        bf16_t* base = O + ((size_t)((u.pm * 4 + wr) * NCG + u.pn * 2) * 64 + fr) * 128 + wc * 32 + 8 * fq;
#pragma unroll
        for (int ai = 0; ai < 2; ++ai)
#pragma unroll
            for (int m = 0; m < 4; ++m)
#pragma unroll
                for (int bj = 0; bj < 2; ++bj) { const f32x4 v0 = acc[ai][bj][m][0], v1 = acc[ai][bj][m][1];
                    u32x4 w; w.x = pk2(v0[0], v0[1]); w.y = pk2(v0[2], v0[3]); w.z = pk2(v1[0], v1[1]); w.w = pk2(v1[2], v1[3]);
                    *(u32x4*)(base + (size_t)ai * (2 * NCG * 8192) + bj * 8192 + m * (16 * 128)) = w; }
    }
};
struct EpiRes {
    static constexpr bool PERM = false;
    const float* xin; float* xout; const float* gate;
    __device__ __forceinline__ void operator()(const f32x4 (&acc)[2][2][4][2], const Unit& u, int wr, int wc, int fr, int fq) const {
        const int row0 = u.pm * BM + wr * 64 + fr, col0 = u.pn * BM + wc * 32 + 4 * fq;
        const float* gp = gate + (size_t)(u.pm >> 4) * 3072 + col0;
        f32x4 gv[2][2];
#pragma unroll
        for (int bj = 0; bj < 2; ++bj)
#pragma unroll
            for (int n = 0; n < 2; ++n) gv[bj][n] = *(const f32x4*)(gp + bj * HALF + n * 16);
#pragma unroll
        for (int am = 0; am < 4; ++am) {
            const int ai = am >> 1, m0 = (am & 1) * 2;
            f32x4 xi[2][2][2];
#pragma unroll
            for (int m = 0; m < 2; ++m)
#pragma unroll
                for (int bj = 0; bj < 2; ++bj)
#pragma unroll
                    for (int n = 0; n < 2; ++n) xi[m][bj][n] = *(const f32x4*)(xin + (size_t)(row0 + ai * HALF + (m0 + m) * 16) * DM + col0 + bj * HALF + n * 16);
            __builtin_amdgcn_sched_barrier(0);
#pragma unroll
            for (int m = 0; m < 2; ++m)
#pragma unroll
                for (int bj = 0; bj < 2; ++bj)
#pragma unroll
                    for (int n = 0; n < 2; ++n) *(f32x4*)(xout + (size_t)(row0 + ai * HALF + (m0 + m) * 16) * DM + col0 + bj * HALF + n * 16) = xi[m][bj][n] + gv[bj][n] * acc[ai][bj][m0 + m][n];
        }
    }
};

struct EpiSlab {
    static constexpr bool PERM = true;
    bf16_t* slab;
    __device__ __forceinline__ void operator()(const f32x4 (&acc)[2][2][4][2], const Unit& u, int wr, int wc, int fr, int fq) const {
        const int row0 = u.pm * BM + wr * 64 + fr, col0 = u.pn * BM + wc * 32 + 8 * fq;
        bf16_t* base = slab + (size_t)u.kh * HROWS * DM;
#pragma unroll
        for (int ai = 0; ai < 2; ++ai)
#pragma unroll
            for (int m = 0; m < 4; ++m) { bf16_t* rowp = base + (size_t)(row0 + ai * HALF + m * 16) * DM + col0;
#pragma unroll
                for (int bj = 0; bj < 2; ++bj) { const f32x4 v0 = acc[ai][bj][m][0], v1 = acc[ai][bj][m][1];
                    u32x4 w; w.x = pk2(v0[0], v0[1]); w.y = pk2(v0[2], v0[3]); w.z = pk2(v1[0], v1[1]); w.w = pk2(v1[2], v1[3]);
                    *(u32x4*)(rowp + bj * HALF) = w; } }
    }
};

template <class Epi, class Sched>
__device__ __forceinline__ void gemm_phase(LAS unsigned char* lds, const Gemm g, const Sched& S, const Epi& E) {
    const int tid = opaque_tid(), wid = __builtin_amdgcn_readfirstlane(tid >> 6), lane = tid & 63, wr = wid >> 2, wc = wid & 3, fr = lane & 15, fq = lane >> 4;
    const int K = g.K, nt = K / BK, ld = g.ld;
    unsigned voffA[2], voffB[2];
#pragma unroll
    for (int i = 0; i < 2; ++i) { int R, C; stage_rc(tid * 16 + i * 8192, R, C); const int Rb = Epi::PERM ? ((R & ~31) + perm32(R & 31)) : R;
        voffA[i] = (unsigned)(R * ld + C) * 2u; voffB[i] = (unsigned)(Rb * ld + C) * 2u; }
    const size_t kstep = (size_t)(BK * 2);
    const size_t hstep = (size_t)HALF * ld * 2;
    const size_t tstep = 2 * hstep;
    const unsigned ldsw = (unsigned)wid * 1024u;
    const int aoff = lds_byte(wr * 64 + fr, fq * 8), boff = lds_byte(wc * 32 + fr, fq * 8);
#define PG8_SA(b, h) (((b) * 2 + (h)) * HTB)
#define PG8_SB(b, h) ((4 + (b) * 2 + (h)) * HTB)
#define PG8_STAGE(bufoff, gbase, voff) do { _Pragma("unroll") for (int _i = 0; _i < 2; ++_i) \
        __builtin_amdgcn_global_load_lds((const unsigned*)((const char*)(gbase) + (voff)[_i]), (LAS unsigned*)(lds + (bufoff) + ldsw + _i * 8192), 16, 0, 0); } while (0)
#define PG8_LDA(dst, b, h) do { _Pragma("unroll") for (int m = 0; m < 4; ++m) _Pragma("unroll") for (int k = 0; k < 2; ++k) dst[m][k] = *(const LAS bf16x8*)(lds + PG8_SA(b, h) + aoff + m * 2048 + k * 1024); } while (0)
#define PG8_LDB(dst, b, h) do { _Pragma("unroll") for (int n = 0; n < 2; ++n) _Pragma("unroll") for (int k = 0; k < 2; ++k) dst[n][k] = *(const LAS bf16x8*)(lds + PG8_SB(b, h) + boff + n * 2048 + k * 1024); } while (0)
#define PG8_MMA(ai, bj, At, Bt) do { __builtin_amdgcn_s_setprio(1); _Pragma("unroll") for (int m = 0; m < 4; ++m) _Pragma("unroll") for (int n = 0; n < 2; ++n) _Pragma("unroll") for (int k = 0; k < 2; ++k) \
        acc[ai][bj][m][n] = __builtin_amdgcn_mfma_f32_16x16x32_bf16(Bt[n][k], At[m][k], acc[ai][bj][m][n], 0, 0, 0); __builtin_amdgcn_s_setprio(0); } while (0)
#define PG8_WAIT_V(n) asm volatile("s_waitcnt vmcnt(" #n ")" ::: "memory")
#define PG8_WAIT_L(n) asm volatile("s_waitcnt lgkmcnt(" #n ")" ::: "memory")
#define PG8_BAR __builtin_amdgcn_s_barrier()
#define PG8_SCHED __builtin_amdgcn_sched_barrier(0)
    Unit cur, nxt; int ui = 0;
    if (!S.next(0, cur)) return;
    f32x4 acc[2][2][4][2];
#pragma unroll
    for (int a = 0; a < 2; ++a)
#pragma unroll
        for (int b = 0; b < 2; ++b)
#pragma unroll
            for (int m = 0; m < 4; ++m)
#pragma unroll
                for (int n = 0; n < 2; ++n) acc[a][b][m][n] = (f32x4){0.f, 0.f, 0.f, 0.f};
    bf16x8 At[4][2], B0[2][2], B1[2][2];
    const char* cA = (const char*)g.A + (size_t)cur.pm * tstep + (size_t)cur.kh * K * 2; const char* cB = (const char*)g.Bt + (size_t)cur.pn * tstep + (size_t)cur.kh * K * 2;
    PG8_STAGE(PG8_SB(0, 0), cB, voffB); PG8_STAGE(PG8_SA(0, 0), cA, voffA); PG8_STAGE(PG8_SB(0, 1), cB + hstep, voffB); PG8_STAGE(PG8_SA(0, 1), cA + hstep, voffA);
    if (wr == 1) PG8_BAR;
    PG8_WAIT_V(4); PG8_BAR;
    PG8_STAGE(PG8_SB(1, 0), cB + kstep, voffB); PG8_STAGE(PG8_SA(1, 0), cA + kstep, voffA); PG8_STAGE(PG8_SB(1, 1), cB + hstep + kstep, voffB);
    PG8_WAIT_V(6); PG8_BAR;
    for (;;) {
        const bool has_next = S.next(ui + 1, nxt);
        const char* nA = has_next ? (const char*)g.A + (size_t)nxt.pm * tstep + (size_t)nxt.kh * K * 2 : cA; const char* nB = has_next ? (const char*)g.Bt + (size_t)nxt.pn * tstep + (size_t)nxt.kh * K * 2 : cB;
        for (int t = 0; t < nt; t += 2) {
            const bool last = (t == nt - 2);
            const char* a1 = cA + (size_t)(t + 1) * kstep;
            const char* a2 = last ? nA : cA + (size_t)(t + 2) * kstep; const char* b2 = last ? nB : cB + (size_t)(t + 2) * kstep;
            const char* a3 = a2 + kstep; const char* b3 = b2 + kstep;
            PG8_LDB(B0, 0, 0); PG8_SCHED; PG8_LDA(At, 0, 0); PG8_STAGE(PG8_SA(1, 1), a1 + hstep, voffA);
            PG8_WAIT_L(8); PG8_BAR; PG8_WAIT_L(0); PG8_MMA(0, 0, At, B0); PG8_BAR; PG8_SCHED;
            PG8_LDB(B1, 0, 1); PG8_STAGE(PG8_SB(0, 0), b2, voffB);
            PG8_BAR; PG8_WAIT_L(0); PG8_MMA(0, 1, At, B1); PG8_BAR;
            PG8_LDA(At, 0, 1); PG8_STAGE(PG8_SA(0, 0), a2, voffA);
            PG8_BAR; PG8_WAIT_L(0); PG8_MMA(1, 0, At, B0); PG8_BAR; PG8_SCHED;
            PG8_STAGE(PG8_SB(0, 1), b2 + hstep, voffB);
            PG8_WAIT_V(6); PG8_BAR; PG8_MMA(1, 1, At, B1); PG8_BAR;
            PG8_LDB(B0, 1, 0); PG8_SCHED; PG8_LDA(At, 1, 0); PG8_STAGE(PG8_SA(0, 1), a2 + hstep, voffA);
            PG8_WAIT_L(8); PG8_BAR; PG8_WAIT_L(0); PG8_MMA(0, 0, At, B0); PG8_BAR; PG8_SCHED;
            PG8_LDB(B1, 1, 1); PG8_STAGE(PG8_SB(1, 0), b3, voffB);
            PG8_BAR; PG8_WAIT_L(0); PG8_MMA(0, 1, At, B1); PG8_BAR;
            PG8_LDA(At, 1, 1); PG8_STAGE(PG8_SA(1, 0), a3, voffA);
            PG8_BAR; PG8_WAIT_L(0); PG8_MMA(1, 0, At, B0); PG8_BAR; PG8_SCHED;
            PG8_STAGE(PG8_SB(1, 1), b3 + hstep, voffB);
            PG8_WAIT_V(6); PG8_BAR; PG8_MMA(1, 1, At, B1); PG8_BAR;
        }
        E(acc, cur, wr, wc, fr, fq);
        if (!has_next) break;
#pragma unroll
        for (int a = 0; a < 2; ++a)
#pragma unroll
            for (int b = 0; b < 2; ++b)
#pragma unroll
                for (int m = 0; m < 4; ++m)
#pragma unroll
                    for (int n = 0; n < 2; ++n) acc[a][b][m][n] = (f32x4){0.f, 0.f, 0.f, 0.f};
        cur = nxt; cA = nA; cB = nB; ++ui;
    }
    PG8_WAIT_V(0);
    if (wr == 0) PG8_BAR;
    PG8_BAR;
#undef PG8_SA
#undef PG8_SB
#undef PG8_STAGE
#undef PG8_LDA
#undef PG8_LDB
#undef PG8_MMA
#undef PG8_WAIT_V
#undef PG8_WAIT_L
#undef PG8_BAR
#undef PG8_SCHED
}
}

struct Args {
    const float* x; const float* c; const float* w_ada; const float* b_ada; const float* norm_g; const float* w_in;
    const float* lb_logits; const float* hgrn_g; const float* ret_g; const float* conv_w; const float* conv_b;
    const float* dt_bias; const float* a_log; const float* dskip; const float* ssm_g; const float* w_gk2; const float* b_gk2;
    const float* gla_g; const float* w_out; const float* final_g;
    float* out; unsigned char* ws;
};

__device__ __forceinline__ void transpose_cvt(const float* __restrict__ src, int K, int N, bf16_t* __restrict__ dst, int Npad, LAS unsigned char* lds, int gid, int gstride, bool perm) {
    LAS float* T = (LAS float*)lds;
    const int tid = opaque_tid(), ntk = K / 64, ntn = Npad / 256;
    for (int tile = gid; tile < ntk * ntn; tile += gstride) {
        const int tk = tile % ntk, tn = tile / ntk;
        float v[32];
#pragma unroll
        for (int i = 0; i < 32; ++i) { const int kk = (tid >> 8) + 2 * i, nn = tid & 255, n = tn * 256 + nn;
            const int ns = !perm ? n : (n < 5632) ? n : (n < 7168) ? n + 8 : (n < 7176) ? n - 7168 + 5632 : n;
            v[i] = (n < N) ? src[(size_t)(tk * 64 + kk) * N + ns] : 0.f; }
#pragma unroll
        for (int i = 0; i < 32; ++i) { const int kk = (tid >> 8) + 2 * i, nn = tid & 255; T[kk * 257 + nn] = v[i]; }
        __syncthreads();
#pragma unroll
        for (int i = 0; i < 16; ++i) { const int nn = (tid >> 5) + 16 * i, kk = (tid & 31) * 2;
            *(unsigned*)(dst + (size_t)(tn * 256 + nn) * K + tk * 64 + kk) = pk2(T[kk * 257 + nn], T[(kk + 1) * 257 + nn]); }
        __syncthreads();
    }
}

__device__ __forceinline__ void phase_wcvt(const Args& a, LAS unsigned char* lds) {
    const int G = gridDim.x, bid = blockIdx.x;
    unsigned char* ws = a.ws;
    for (int l = 0; l < DEPTH; ++l) {
        transpose_cvt(a.w_in + (size_t)l * DM * NIN, DM, NIN, (bf16_t*)(ws + WS_WIN) + (size_t)l * LDP * DM, LDP, lds, bid, G, true);
        transpose_cvt(a.w_out + (size_t)l * DI * DM, DI, DM, (bf16_t*)(ws + WS_WOUT) + (size_t)l * DM * DI, DM, lds, (bid + 128) % G, G, false);
    }
}
__device__ __forceinline__ void phase_prep(const Args& a, LAS unsigned char* lds) {
    const int tid = opaque_tid(), G = gridDim.x, bid = blockIdx.x;
    unsigned char* ws = a.ws;
    {
        LAS float* R = (LAS float*)lds;
        LAS float* CA = (LAS float*)(lds + 8192);
        float* mod = (float*)(ws + WS_MOD);
        const int jj = tid & 63, ks = tid >> 6;
        if (bid < DEPTH * 48) {
#pragma unroll
            for (int q = 0; q < 8; ++q) CA[tid + NTHR * q] = silu_f(a.c[tid + NTHR * q]);
            __syncthreads();
        }
        for (int item = bid; item < DEPTH * 48; item += G) {
            const int l = item / 48, j = (item % 48) * 64 + jj;
            float s0 = 0.f, s1 = 0.f, s2 = 0.f, s3 = 0.f;
            const float* w = a.w_ada + (size_t)l * DM * 3072 + j;
#pragma unroll 16
            for (int k = ks * 128; k < ks * 128 + 128; ++k) { const float wv = w[(size_t)k * 3072];
                s0 += CA[k] * wv; s1 += CA[DM + k] * wv; s2 += CA[2 * DM + k] * wv; s3 += CA[3 * DM + k] * wv; }
            R[(ks * 4 + 0) * 64 + jj] = s0; R[(ks * 4 + 1) * 64 + jj] = s1; R[(ks * 4 + 2) * 64 + jj] = s2; R[(ks * 4 + 3) * 64 + jj] = s3;
            __syncthreads();
            if (tid < 256) { const int b = tid >> 6; float s = a.b_ada[l * 3072 + j];
#pragma unroll
                for (int q = 0; q < 8; ++q) s += R[(q * 4 + b) * 64 + jj];
                mod[(size_t)(l * 4 + b) * 3072 + j] = s; }
            __syncthreads();
        }
    }
    {
        float2* rope = (float2*)(ws + WS_ROPE);
        for (int i = bid * NTHR + tid; i < 4096 * 64; i += G * NTHR) {
            const int pos = i >> 6, j = i & 63;
            const float invf = powf(10000.f, -(float)(2 * j) / 128.f);
            const float ang = (float)pos * invf;
            const float k = rintf(ang * 0.15915494309189535f);
            float r = fmaf(-k, 6.2831854820251465f, ang); r = fmaf(-k, -1.7484555e-07f, r);
            rope[i] = make_float2(__cosf(r), __sinf(r));
        }
    }
}

template <bool FINAL>
__device__ __forceinline__ void phase_norm(const float* __restrict__ xin  , const bf16_t* __restrict__ slab  ,
                                           const float* __restrict__ gate_prev  , float* xout  ,
                                           const float* __restrict__ g, const float* __restrict__ mod  , int half, bf16_t* __restrict__ hout) {
    const int tid = opaque_tid(), lane = tid & 63, wid = tid >> 6;
    const int gw = blockIdx.x * 8 + wid, nw = gridDim.x * 8;
    for (int row = gw; row < HROWS; row += nw) {
        const float* xr = xin + (size_t)row * DM;
        f32x4 v[4]; float ss = 0.f;
#pragma unroll
        for (int i = 0; i < 4; ++i) v[i] = *(const f32x4*)(xr + i * 256 + lane * 4);
        if (slab) {
            u32x2 a0[4], a1[4]; f32x4 gp[4];
#pragma unroll
            for (int i = 0; i < 4; ++i) { const int col = i * 256 + lane * 4;
                a0[i] = *(const u32x2*)(slab + (size_t)row * DM + col); a1[i] = *(const u32x2*)(slab + (size_t)(HROWS + row) * DM + col);
                gp[i] = *(const f32x4*)(gate_prev + (size_t)(row >> 12) * 3072 + col); }
#pragma unroll
            for (int i = 0; i < 4; ++i) {
                const f32x4 sa = {__uint_as_float(a0[i].x << 16) + __uint_as_float(a1[i].x << 16), __uint_as_float(a0[i].x & 0xffff0000u) + __uint_as_float(a1[i].x & 0xffff0000u),
                                  __uint_as_float(a0[i].y << 16) + __uint_as_float(a1[i].y << 16), __uint_as_float(a0[i].y & 0xffff0000u) + __uint_as_float(a1[i].y & 0xffff0000u)};
                v[i] = v[i] + gp[i] * sa; }
        }
        if (!FINAL && xout) {
#pragma unroll
            for (int i = 0; i < 4; ++i) *(f32x4*)(xout + (size_t)row * DM + i * 256 + lane * 4) = v[i];
        }
#pragma unroll
        for (int i = 0; i < 4; ++i) ss += v[i][0] * v[i][0] + v[i][1] * v[i][1] + v[i][2] * v[i][2] + v[i][3] * v[i][3];
#pragma unroll
        for (int o = 32; o > 0; o >>= 1) ss += __shfl_xor(ss, o);
        const float rinv = rsqrtf(ss * (1.f / DM) + EPS);
        if constexpr (FINAL) {
#pragma unroll
            for (int i = 0; i < 4; ++i) { const int col = i * 256 + lane * 4; const f32x4 gg = *(const f32x4*)(g + col);
                *(f32x4*)(xout + (size_t)row * DM + col) = v[i] * rinv * gg; }
        } else {
            const float* mb = mod + (size_t)(half * 2 + (row >> 12)) * 3072;
#pragma unroll
            for (int i = 0; i < 4; ++i) { const int col = i * 256 + lane * 4;
                const f32x4 gg = *(const f32x4*)(g + col), sh = *(const f32x4*)(mb + col), sc = *(const f32x4*)(mb + 1024 + col);
                float o0 = v[i][0] * rinv * gg[0] * (1.f + sc[0]) + sh[0], o1 = v[i][1] * rinv * gg[1] * (1.f + sc[1]) + sh[1];
                float o2 = v[i][2] * rinv * gg[2] * (1.f + sc[2]) + sh[2], o3 = v[i][3] * rinv * gg[3] * (1.f + sc[3]) + sh[3];
                u32x2 w; w.x = pk2(o0, o1); w.y = pk2(o2, o3);
                *(u32x2*)(hout + (size_t)row * DM + col) = w; }
        }
    }
}

struct MixP {
    const bf16_t* proj; bf16_t* st; float* dec; bf16_t* y; const float2* rope;
    const float* lbl; const float* hgrn_g; const float* ret_g; const float* conv_w; const float* conv_b; const float* dt_bias; const float* a_log;
    const float* dskip; const float* ssm_g; const float* w2; const float* b2; const float* gla_g; int layer;
};

__device__ __forceinline__ bf16x8 frag(LAS unsigned char* lds, int off, int ld, int r0, int ks, int lane) {
    return *(const LAS bf16x8*)(lds + off + (((r0 + (lane & 31)) * ld + 16 * ks + 8 * (lane >> 5)) << 1));
}
__device__ __forceinline__ int rowmap(int r, int lane) { return (r & 3) + 8 * (r >> 2) + 4 * (lane >> 5); }

__device__ __forceinline__ void conv16(LAS unsigned char* lds, int off, int ncols, int col, const float* cw, int seg, float (&out)[16]) {
    const LAS bf16_t* rp = (const LAS bf16_t*)(lds + off) + seg * 16 * ncols + col;
    float u[19];
#pragma unroll
    for (int k = 0; k < 19; ++k) u[k] = bf2f(rp[k * ncols]);
#pragma unroll
    for (int i = 0; i < 16; ++i) out[i] = silu_f(cw[4] + cw[0] * u[i] + cw[1] * u[i + 1] + cw[2] * u[i + 2] + cw[3] * u[i + 3]);
}
__device__ __forceinline__ void conv_w_load(const MixP& p, int chan, float* cw) {
    cw[0] = p.conv_w[chan]; cw[1] = p.conv_w[1024 + chan]; cw[2] = p.conv_w[2048 + chan]; cw[3] = p.conv_w[3072 + chan]; cw[4] = p.conv_b[chan];
}
template <int NCOLS, int NROWS> struct Stg { static constexpr int VPR = NCOLS / 8, NV = NROWS * VPR, NIT = (NV + NTHR - 1) / NTHR; };
template <int NCOLS, int NROWS>
__device__ __forceinline__ void stg_load(const bf16_t* proj, int grow0, int col0, int tid, int zrows, u32x4* r) {
    using S = Stg<NCOLS, NROWS>;
#pragma unroll
    for (int j = 0; j < S::NIT; ++j) { const int vi = tid + NTHR * j, row = vi / S::VPR, cv = vi % S::VPR;
        const bool ok = (vi < S::NV) && (row >= zrows);
        r[j] = ok ? *(const u32x4*)(proj + pidx(grow0 + row, col0 + cv * 8)) : (u32x4){0u, 0u, 0u, 0u}; }
}
template <int NCOLS, int NROWS>
__device__ __forceinline__ void stg_store(LAS unsigned char* lds, int off, int tid, const u32x4* r) {
    using S = Stg<NCOLS, NROWS>;
#pragma unroll
    for (int j = 0; j < S::NIT; ++j) { const int vi = tid + NTHR * j; if (vi < S::NV) *(LAS u32x4*)(lds + off + vi * 16) = r[j]; }
}
__device__ __forceinline__ void store16(LAS unsigned char* lds, int byteoff, const float (&v)[16]) {
    u32x4 a, b; a.x = pk2(v[0], v[1]); a.y = pk2(v[2], v[3]); a.z = pk2(v[4], v[5]); a.w = pk2(v[6], v[7]);
    b.x = pk2(v[8], v[9]); b.y = pk2(v[10], v[11]); b.z = pk2(v[12], v[13]); b.w = pk2(v[14], v[15]);
    *(LAS u32x4*)(lds + byteoff) = a; *(LAS u32x4*)(lds + byteoff + 16) = b;
}
__device__ __forceinline__ void store8(LAS unsigned char* lds, int byteoff, const float (&v)[8]) {
    u32x4 a; a.x = pk2(v[0], v[1]); a.y = pk2(v[2], v[3]); a.z = pk2(v[4], v[5]); a.w = pk2(v[6], v[7]);
    *(LAS u32x4*)(lds + byteoff) = a;
}

constexpr int NUNITS = 128 * 14;
struct Pref { u32x4 raw[11]; u32x4 st[8]; float aux[16]; };
template <int BR, int PASS>
__device__ __forceinline__ void load_A(const MixP& p, int bc, int hu, int tid, Pref& pf) {
    const bf16_t* P = p.proj; const int g0 = bc * 64;
    if constexpr (BR == 0) { stg_load<128, 64>(P, g0, C_AF + hu * 128, tid, 0, pf.raw + 0); stg_load<128, 64>(P, g0, C_AI + hu * 128, tid, 0, pf.raw + 2);
        if constexpr (PASS == 3) stg_load<128, 64>(P, g0, C_AQ + hu * 128, tid, 0, pf.raw + 4); }
    if constexpr (BR == 1) { stg_load<128, 64>(P, g0, C_RK + hu * 128, tid, 0, pf.raw + 0); stg_load<128, 64>(P, g0, C_RV + hu * 128, tid, 0, pf.raw + 2);
        if constexpr (PASS == 3) stg_load<128, 64>(P, g0, C_RQ + hu * 128, tid, 0, pf.raw + 4); }
    if constexpr (BR == 2) { const int zr = ((bc & 63) == 0) ? 3 : 0;
        stg_load<128, 67>(P, g0 - 3, C_XBC + 512 + hu * 128, tid, zr, pf.raw + 0); stg_load<256, 67>(P, g0 - 3, C_XBC + hu * 256, tid, zr, pf.raw + 3);
        if constexpr (PASS == 3) stg_load<128, 67>(P, g0 - 3, C_XBC + 768 + hu * 128, tid, zr, pf.raw + 8); }
    if constexpr (BR == 3) { stg_load<64, 64>(P, g0, C_GK + hu * 64, tid, 0, pf.raw + 0); stg_load<128, 64>(P, g0, C_GV + hu * 128, tid, 0, pf.raw + 1); stg_load<16, 64>(P, g0, C_LR, tid, 0, pf.raw + 3);
        if constexpr (PASS == 3) stg_load<64, 64>(P, g0, C_GQ + hu * 64, tid, 0, pf.raw + 4); }
}
template <int BR, int PASS>
__device__ __forceinline__ void load_B(const MixP& p, int bc, int hu, int tid, Pref& pf) {
    if constexpr (PASS == 3) {
        constexpr int DK = (BR == 3) ? 64 : 128, DV = (BR == 2) ? 256 : 128, NV = DV * DK / 8 / NTHR;
        const int st_off = (BR == 0) ? hu * 16384 : (BR == 1) ? 65536 + hu * 16384 : (BR == 2) ? 131072 + hu * 32768 : 196608 + hu * 8192;
        const bf16_t* stg = p.st + (size_t)bc * ST_PER_BC + st_off;
#pragma unroll
        for (int k = 0; k < NV; ++k) pf.st[k] = *(const u32x4*)(stg + (size_t)(tid + NTHR * k) * 8);
    }
    if constexpr (BR == 1) { const int j = tid & 63, seg = tid >> 6, chunk = bc & 63;
#pragma unroll
        for (int i = 0; i < 8; ++i) { const float2 c = p.rope[(chunk * 64 + seg * 8 + i) * 64 + j]; pf.aux[2 * i] = c.x; pf.aux[2 * i + 1] = c.y; } }
    if constexpr (BR == 2) { if (tid < 64) {
#pragma unroll
            for (int hh = 0; hh < 4; ++hh) pf.aux[hh] = bf2f(p.proj[pidx(bc * 64 + tid, C_DT + hu * 4 + hh)]); } }
    if constexpr (BR == 3) { const int cc = hu * 64 + (tid & 63);
#pragma unroll
        for (int r = 0; r < 16; ++r) pf.aux[r] = p.w2[r * 256 + cc]; }
}
template <int PASS>
__device__ __forceinline__ void load_A_any(const MixP& p, int i, int tid, Pref& pf) {
    const int bc = i / 14, u = i % 14;
    if (u < 4) load_A<0, PASS>(p, bc, u, tid, pf); else if (u < 8) load_A<1, PASS>(p, bc, u - 4, tid, pf);
    else if (u < 10) load_A<2, PASS>(p, bc, u - 8, tid, pf); else load_A<3, PASS>(p, bc, u - 10, tid, pf);
}
template <int PASS>
__device__ __forceinline__ void load_B_any(const MixP& p, int i, int tid, Pref& pf) {
    const int bc = i / 14, u = i % 14;
    if (u < 4) load_B<0, PASS>(p, bc, u, tid, pf); else if (u < 8) load_B<1, PASS>(p, bc, u - 4, tid, pf);
    else if (u < 10) load_B<2, PASS>(p, bc, u - 8, tid, pf); else load_B<3, PASS>(p, bc, u - 10, tid, pf);
}

template <int BR, int PASS>
__device__ __forceinline__ void mixer_unit(const MixP& p, LAS unsigned char* lds, int bc, int hu  ) {
    constexpr int DK = (BR == 3) ? 64 : 128, LDK = DK + 8, NH = (BR == 2) ? 4 : 1, DV = (BR == 2) ? 256 : 128, NT = DV / 128;
    constexpr bool VEC = (BR == 0 || BR == 3);
    const int tid = opaque_tid(), lane = tid & 63, wid = __builtin_amdgcn_readfirstlane(tid >> 6);
    const int chunk = bc & 63;
    const bf16_t* P = p.proj;
    LAS float* SM = (LAS float*)(lds + L_SM);
    LAS bf16_t* QI = (LAS bf16_t*)(lds + L_QI); LAS bf16_t* KI = (LAS bf16_t*)(lds + L_KI); LAS bf16_t* VT = (LAS bf16_t*)(lds + L_VT);
    const int st_off = (BR == 0) ? hu * 16384 : (BR == 1) ? 65536 + hu * 16384 : (BR == 2) ? 131072 + hu * 32768 : 196608 + hu * 8192;
    bf16_t* stg = p.st + (size_t)bc * ST_PER_BC + st_off;
    Pref pf;
    load_A<BR, PASS>(p, bc, hu, tid, pf);
    load_B<BR, PASS>(p, bc, hu, tid, pf);
    constexpr int NTG = (PASS == 3) ? NT : 1;
    const int gcol = (BR == 0) ? C_AG + hu * 128 : (BR == 1) ? C_RG + hu * 128 : (BR == 2) ? C_MZ + hu * 256 : C_GG + hu * 128;
    const float* gain = (BR == 0) ? p.hgrn_g + hu * 128 : (BR == 1) ? p.ret_g + hu * 128 : (BR == 2) ? p.ssm_g + hu * 256 : p.gla_g + hu * 128;
    bf16_t gt[NTG][16]; float gnv[NTG], dskv[NTG];
    if constexpr (PASS == 3) {
#pragma unroll
        for (int nt = 0; nt < NT; ++nt) { const int ct = (wid & 3) + 4 * nt;
            gnv[nt] = gain[ct * 32 + (lane & 31)]; dskv[nt] = (BR == 2) ? p.dskip[hu * 4 + (ct >> 1)] : 0.f;
#pragma unroll
            for (int r = 0; r < 16; ++r) gt[nt][r] = P[pidx(bc * 64 + (wid >> 2) * 32 + rowmap(r, lane), gcol + ct * 32 + (lane & 31))]; }
    }
    float lb = 0.f, bb = 0.f, cwb[5], cwc[5], cwx[5], dtb[4], alg[4];
    if constexpr (BR == 0) { if (p.layer == 1) { const int cc = hu * 128 + (tid & 127); lb = 1.f / (1.f + __expf(p.lbl[cc] - p.lbl[512 + cc])); } }
    if constexpr (BR == 3) bb = p.b2[hu * 64 + (tid & 63)];
    if constexpr (BR == 2) { conv_w_load(p, 512 + hu * 128 + (tid & 127), cwb); if constexpr (PASS == 3) conv_w_load(p, 768 + hu * 128 + (tid & 127), cwc); conv_w_load(p, hu * 256 + (tid & 255), cwx);
#pragma unroll
        for (int hh = 0; hh < 4; ++hh) { dtb[hh] = p.dt_bias[hu * 4 + hh]; alg[hh] = p.a_log[hu * 4 + hh]; } }
    __builtin_amdgcn_sched_barrier(0);

    for (int urep = 0; urep < REP_UPREP; ++urep) {
    if constexpr (BR == 0) {
        constexpr int RQ = L_BIG, RF = (PASS == 3) ? L_BIG + 16384 : L_QI, RV = (PASS == 3) ? L_BIG + 32768 : L_QI + 16384;
        stg_store<128, 64>(lds, RF, tid, pf.raw + 0); stg_store<128, 64>(lds, RV, tid, pf.raw + 2);
        if constexpr (PASS == 3) stg_store<128, 64>(lds, RQ, tid, pf.raw + 4);
        __builtin_amdgcn_sched_barrier(0);
        const int d = tid & 127, seg = tid >> 7;
        __syncthreads();
        const LAS bf16_t* rF = (const LAS bf16_t*)(lds + RF) + seg * 16 * 128 + d;
        const LAS bf16_t* rQ = (const LAS bf16_t*)(lds + RQ) + seg * 16 * 128 + d;
        const LAS bf16_t* rV = (const LAS bf16_t*)(lds + RV) + seg * 16 * 128 + d;
        float cs[16], kk[16]; float run = 0.f;
#pragma unroll
        for (int i = 0; i < 16; ++i) { const float av = fmaxf(bf2f(rF[i * 128]), -60.f); const float e = __expf(-av), sg = __builtin_amdgcn_rcpf(1.f + e);
            const float f = lb + (1.f - lb) * sg; run += __logf(f); cs[i] = run; kk[i] = (1.f - lb) * e * sg; }
        SM[SM_SEG + seg * 128 + d] = run;
        __syncthreads();
        const float t0 = SM[SM_SEG + d], t1 = SM[SM_SEG + 128 + d], t2 = SM[SM_SEG + 256 + d], t3 = SM[SM_SEG + 384 + d];
        const float off = (seg == 0) ? 0.f : (seg == 1) ? t0 : (seg == 2) ? t0 + t1 : t0 + t1 + t2;
        const float ref = t0 + t1, clast = ref + t2 + t3;
        if (seg == 0) { SM[SM_REF + d] = ref; SM[SM_CLAST + d] = clast; }
        float kv[16];
#pragma unroll
        for (int i = 0; i < 16; ++i) { const float c = off + cs[i]; kv[i] = kk[i] * __expf(ref - c);
            if constexpr (PASS == 3) { KI[(seg * 16 + i) * LDK + d] = f2bf(kv[i]);
                const float q = bf2f(rQ[i * 128]); QI[(seg * 16 + i) * LDK + d] = f2bf(silu_f(q) * __expf(c - ref)); } }
        if constexpr (PASS == 1) store16(lds, L_BIG + (d * 72 + seg * 16) * 2, kv);
        unsigned vv[16];
#pragma unroll
        for (int i = 0; i < 16; ++i) vv[i] = rV[i * 128];
        u32x4 a, b; a.x = vv[0] | (vv[1] << 16); a.y = vv[2] | (vv[3] << 16); a.z = vv[4] | (vv[5] << 16); a.w = vv[6] | (vv[7] << 16);
        b.x = vv[8] | (vv[9] << 16); b.y = vv[10] | (vv[11] << 16); b.z = vv[12] | (vv[13] << 16); b.w = vv[14] | (vv[15] << 16);
        *(LAS u32x4*)(lds + L_VT + (d * 72 + seg * 16) * 2) = a; *(LAS u32x4*)(lds + L_VT + (d * 72 + seg * 16) * 2 + 16) = b;
    }
    if constexpr (BR == 1) {
        constexpr int RQ = L_BIG, RK = (PASS == 3) ? L_BIG + 16384 : L_QI, RV = (PASS == 3) ? L_BIG + 32768 : L_QI + 16384;
        const int j = tid & 63, seg = tid >> 6;
        float2 cssn[8];
#pragma unroll
        for (int i = 0; i < 8; ++i) cssn[i] = make_float2(pf.aux[2 * i], pf.aux[2 * i + 1]);
        stg_store<128, 64>(lds, RK, tid, pf.raw + 0); stg_store<128, 64>(lds, RV, tid, pf.raw + 2);
        if constexpr (PASS == 3) stg_store<128, 64>(lds, RQ, tid, pf.raw + 4);
        __builtin_amdgcn_sched_barrier(0);
        const float lg = log1pf(-exp2f(-(5.f + (float)hu)));
        if (tid < 64) { SM[SM_CUM + tid] = (float)(tid + 1) * lg; SM[SM_DT + tid] = 1.f; }
        __syncthreads();
        float k1[8], k2[8];
#pragma unroll
        for (int i = 0; i < 8; ++i) { const int t = seg * 8 + i;
            const LAS bf16_t* rk = (const LAS bf16_t*)(lds + RK) + t * 128 + j;
            const float ka = bf2f(rk[0]) * 0.08838834764831845f, kb = bf2f(rk[64]) * 0.08838834764831845f;
            k1[i] = ka * cssn[i].x - kb * cssn[i].y; k2[i] = ka * cssn[i].y + kb * cssn[i].x;
            if constexpr (PASS == 3) { const LAS bf16_t* rq = (const LAS bf16_t*)(lds + RQ) + t * 128 + j;
                const float qa = bf2f(rq[0]), qb = bf2f(rq[64]);
                QI[t * LDK + j] = f2bf(qa * cssn[i].x - qb * cssn[i].y); QI[t * LDK + j + 64] = f2bf(qa * cssn[i].y + qb * cssn[i].x);
                KI[t * LDK + j] = f2bf(k1[i]); KI[t * LDK + j + 64] = f2bf(k2[i]); } }
        if constexpr (PASS == 1) { store8(lds, L_BIG + (j * 72 + seg * 8) * 2, k1); store8(lds, L_BIG + ((j + 64) * 72 + seg * 8) * 2, k2); }
        const int v = tid & 127, s4 = tid >> 7; float vv[16];
#pragma unroll
        for (int i = 0; i < 16; ++i) { const int s = s4 * 16 + i; float x = bf2f(((const LAS bf16_t*)(lds + RV))[s * 128 + v]);
            if constexpr (PASS == 1) x *= __expf((float)(63 - s) * lg);
            vv[i] = x; }
        store16(lds, L_VT + (v * 72 + s4 * 16) * 2, vv);
    }
    if constexpr (BR == 2) {
        constexpr int RB = (PASS == 3) ? L_BIG : L_QI, RC = L_BIG + 17152, RX = (PASS == 3) ? L_BIG + 34304 : L_BIG + 18432;
        float dtr[4];
#pragma unroll
        for (int hh = 0; hh < 4; ++hh) dtr[hh] = pf.aux[hh];
        stg_store<128, 67>(lds, RB, tid, pf.raw + 0); stg_store<256, 67>(lds, RX, tid, pf.raw + 3);
        if constexpr (PASS == 3) stg_store<128, 67>(lds, RC, tid, pf.raw + 8);
        __builtin_amdgcn_sched_barrier(0);
        if (tid < 64) {
#pragma unroll
            for (int hh = 0; hh < 4; ++hh) {
                const float dt = softplus_f(dtr[hh] + dtb[hh]);
                float la = -dt * __expf(alg[hh]);
#pragma unroll
                for (int o = 1; o < 64; o <<= 1) { const float yv = __shfl_up(la, o); if (tid >= o) la += yv; }
                SM[SM_CUM + hh * 64 + tid] = la; SM[SM_DT + hh * 64 + tid] = dt; }
        }
        __syncthreads();
        { const int n = tid & 127, seg = tid >> 7; float o[16];
          conv16(lds, RB, 128, n, cwb, seg, o);
          if constexpr (PASS == 3) {
#pragma unroll
              for (int i = 0; i < 16; ++i) KI[(seg * 16 + i) * LDK + n] = f2bf(o[i]);
              conv16(lds, RC, 128, n, cwc, seg, o);
#pragma unroll
              for (int i = 0; i < 16; ++i) QI[(seg * 16 + i) * LDK + n] = f2bf(o[i]);
          } else store16(lds, L_BIG + (n * 72 + seg * 16) * 2, o);
        }
        { const int v = tid & 255, s2 = tid >> 8, hh = v >> 6;
#pragma unroll
          for (int r = 0; r < 2; ++r) { const int seg = s2 * 2 + r; float o[16];
              conv16(lds, RX, 256, v, cwx, seg, o);
              if constexpr (PASS == 1) { const float cl = SM[SM_CUM + hh * 64 + 63];
#pragma unroll
                  for (int i = 0; i < 16; ++i) { const int s = seg * 16 + i; o[i] *= __expf(cl - SM[SM_CUM + hh * 64 + s]) * SM[SM_DT + hh * 64 + s]; } }
              store16(lds, L_VT + (v * 72 + seg * 16) * 2, o); }
        }
    }
    if constexpr (BR == 3) {
        constexpr int RQ = L_BIG, RK = (PASS == 3) ? L_BIG + 8192 : L_QI, RV = (PASS == 3) ? L_BIG + 16384 : L_QI + 8192, RL = (PASS == 3) ? L_BIG + 32768 : L_QI + 24576;
        const int d = tid & 63, seg = tid >> 6, cc = hu * 64 + d;
        float w2r[16];
#pragma unroll
        for (int r = 0; r < 16; ++r) w2r[r] = pf.aux[r];
        stg_store<64, 64>(lds, RK, tid, pf.raw + 0); stg_store<128, 64>(lds, RV, tid, pf.raw + 1); stg_store<16, 64>(lds, RL, tid, pf.raw + 3);
        if constexpr (PASS == 3) stg_store<64, 64>(lds, RQ, tid, pf.raw + 4);
        __builtin_amdgcn_sched_barrier(0);
        __syncthreads();
        float cs[8]; float run = 0.f;
#pragma unroll
        for (int i = 0; i < 8; ++i) { const int t = seg * 8 + i; const LAS bf16x8* lp = (const LAS bf16x8*)(lds + RL + t * 32);
            const bf16x8 l0 = lp[0], l1 = lp[1]; float gk = bb;
#pragma unroll
            for (int r = 0; r < 8; ++r) { gk += w2r[r] * bf2f((bf16_t)l0[r]); gk += w2r[8 + r] * bf2f((bf16_t)l1[r]); }
            run += logsig_f(gk) * (1.f / 16.f); cs[i] = run; }
        SM[SM_SEG + seg * 64 + d] = run;
        __syncthreads();
        float off = 0.f, ref = 0.f, clast = 0.f;
#pragma unroll
        for (int s = 0; s < 8; ++s) { const float tv = SM[SM_SEG + s * 64 + d]; if (s < seg) off += tv; if (s < 4) ref += tv; clast += tv; }
        if (seg == 0) { SM[SM_REF + d] = ref; SM[SM_CLAST + d] = clast; }
        float kv[8];
#pragma unroll
        for (int i = 0; i < 8; ++i) { const int t = seg * 8 + i; const float c = off + cs[i];
            kv[i] = bf2f(((const LAS bf16_t*)(lds + RK))[t * 64 + d]) * __expf(ref - c);
            if constexpr (PASS == 3) { KI[t * LDK + d] = f2bf(kv[i]); QI[t * LDK + d] = f2bf(bf2f(((const LAS bf16_t*)(lds + RQ))[t * 64 + d]) * 0.125f * __expf(c - ref)); } }
        if constexpr (PASS == 1) store8(lds, L_BIG + (d * 72 + seg * 8) * 2, kv);
        const int v = tid & 127, s4 = tid >> 7; unsigned vv[16];
#pragma unroll
        for (int i = 0; i < 16; ++i) vv[i] = ((const LAS bf16_t*)(lds + RV))[(s4 * 16 + i) * 128 + v];
        u32x4 a, b; a.x = vv[0] | (vv[1] << 16); a.y = vv[2] | (vv[3] << 16); a.z = vv[4] | (vv[5] << 16); a.w = vv[6] | (vv[7] << 16);
        b.x = vv[8] | (vv[9] << 16); b.y = vv[10] | (vv[11] << 16); b.z = vv[12] | (vv[13] << 16); b.w = vv[14] | (vv[15] << 16);
        *(LAS u32x4*)(lds + L_VT + (v * 72 + s4 * 16) * 2) = a; *(LAS u32x4*)(lds + L_VT + (v * 72 + s4 * 16) * 2 + 16) = b;
    }
    __syncthreads();
    }
    for (int urep = 0; urep < REP_UCORE; ++urep) {
    if constexpr (PASS == 1) {
        constexpr int NTN = DV / 32, NTILES = (DK / 32) * NTN, NTL = NTILES / 8;
        f32x16 hacc[NTL];
#pragma unroll
        for (int i = 0; i < NTL; ++i) {
            const int ti = wid + 8 * i, tm = ti / NTN, tn = ti % NTN;
#pragma unroll
            for (int r = 0; r < 16; ++r) hacc[i][r] = 0.f;
#pragma unroll
            for (int ks = 0; ks < 4; ++ks) hacc[i] = __builtin_amdgcn_mfma_f32_32x32x16_bf16(frag(lds, L_BIG, 72, tm * 32, ks, lane), frag(lds, L_VT, 72, tn * 32, ks, lane), hacc[i], 0, 0, 0);
            if constexpr (VEC) {
#pragma unroll
                for (int r = 0; r < 16; ++r) { const int d = tm * 32 + rowmap(r, lane); hacc[i][r] *= __expf(SM[SM_CLAST + d] - SM[SM_REF + d]); }
            }
        }
        float decv = 0.f;
        if constexpr (BR == 0) { if (tid < 128) decv = __expf(SM[SM_CLAST + tid]); }
        if constexpr (BR == 3) { if (tid < 64) decv = __expf(SM[SM_CLAST + tid]); }
        if constexpr (BR == 2) { if (tid < 4) decv = __expf(SM[SM_CUM + tid * 64 + 63]); }
        __syncthreads();
#pragma unroll
        for (int i = 0; i < NTL; ++i) {
            const int ti = wid + 8 * i, tm = ti / NTN, tn = ti % NTN;
            const int v = tn * 32 + (lane & 31);
#pragma unroll
            for (int rg = 0; rg < 4; ++rg) { const int d0 = tm * 32 + 8 * rg + 4 * (lane >> 5);
                u32x2 w; w.x = pk2(hacc[i][rg * 4 + 0], hacc[i][rg * 4 + 1]); w.y = pk2(hacc[i][rg * 4 + 2], hacc[i][rg * 4 + 3]);
                *(u32x2*)(stg + (size_t)v * DK + d0) = w; }
        }
        float* dec = p.dec + (size_t)bc * 1024;
        if constexpr (BR == 0) { if (tid < 128) dec[hu * 128 + tid] = decv; }
        if constexpr (BR == 3) { if (tid < 64) dec[512 + hu * 64 + tid] = decv; }
        if constexpr (BR == 2) { if (tid < 4) dec[768 + hu * 4 + tid] = decv; }
    } else {
        constexpr int NCT = DV / 32;
        {
            constexpr int NVEC = DV * DK / 8, VPR = DK / 8;
#pragma unroll
            for (int k = 0; k < NVEC / NTHR; ++k) { const int vi = tid + NTHR * k; const int v = vi / VPR, d0 = (vi % VPR) * 8;
                u32x4 raw = pf.st[k];
                if constexpr (VEC) { unsigned w[4] = {raw.x, raw.y, raw.z, raw.w};
#pragma unroll
                    for (int q = 0; q < 4; ++q) { const float lo = __uint_as_float(w[q] << 16) * __expf(SM[SM_REF + d0 + 2 * q]), hi = __uint_as_float(w[q] & 0xffff0000u) * __expf(SM[SM_REF + d0 + 2 * q + 1]);
                        w[q] = pk2(lo, hi); }
                    raw.x = w[0]; raw.y = w[1]; raw.z = w[2]; raw.w = w[3]; }
                *(LAS u32x4*)(lds + L_BIG + (v * LDK + d0) * 2) = raw; }
        }
        __builtin_amdgcn_sched_barrier(0);
        __syncthreads();
        const int tm = wid >> 2, tnb = wid & 3;
        f32x16 acc[NT];
#pragma unroll
        for (int nt = 0; nt < NT; ++nt)
#pragma unroll
            for (int r = 0; r < 16; ++r) acc[nt][r] = 0.f;
#pragma unroll
        for (int ks = 0; ks < DK / 16; ++ks) { const bf16x8 af = frag(lds, L_QI, LDK, tm * 32, ks, lane);
#pragma unroll
            for (int nt = 0; nt < NT; ++nt) acc[nt] = __builtin_amdgcn_mfma_f32_32x32x16_bf16(af, frag(lds, L_BIG, LDK, (tnb + 4 * nt) * 32, ks, lane), acc[nt], 0, 0, 0); }
        if constexpr (!VEC) {
#pragma unroll
            for (int nt = 0; nt < NT; ++nt) { const int hh = (NH == 1) ? 0 : ((tnb + 4 * nt) >> 1);
#pragma unroll
                for (int r = 0; r < 16; ++r) acc[nt][r] *= __expf(SM[SM_CUM + hh * 64 + tm * 32 + rowmap(r, lane)]); }
        }
        constexpr int P_OFF = (NH == 1) ? L_BIG + 34816 : L_BIG;
        f32x16 sc;
#pragma unroll
        for (int r = 0; r < 16; ++r) sc[r] = 0.f;
        const int stm = wid >> 1, stn = wid & 1;
        if (wid < 4) {
#pragma unroll
            for (int ks = 0; ks < DK / 16; ++ks) sc = __builtin_amdgcn_mfma_f32_32x32x16_bf16(frag(lds, L_QI, LDK, stm * 32, ks, lane), frag(lds, L_KI, LDK, stn * 32, ks, lane), sc, 0, 0, 0);
        }
        if constexpr (NH != 1) __syncthreads();
        if (wid < 4) {
            const int s = stn * 32 + (lane & 31);
#pragma unroll
            for (int hh = 0; hh < NH; ++hh) {
                float cums = 0.f, dts = 1.f;
                if constexpr (!VEC) { cums = SM[SM_CUM + hh * 64 + s]; dts = SM[SM_DT + hh * 64 + s]; }
#pragma unroll
                for (int r = 0; r < 16; ++r) { const int t = stm * 32 + rowmap(r, lane);
                    float val = sc[r];
                    if constexpr (!VEC) { const float ex = (s <= t) ? SM[SM_CUM + hh * 64 + t] - cums : 0.f; val *= __expf(ex) * dts; }
                    val = (s <= t) ? val : 0.f;
                    *(LAS bf16_t*)(lds + P_OFF + ((hh * 64 + t) * 72 + s) * 2) = f2bf(val); }
            }
        }
        __syncthreads();
#pragma unroll
        for (int nt = 0; nt < NT; ++nt) { const int hh = (NH == 1) ? 0 : ((tnb + 4 * nt) >> 1);
#pragma unroll
            for (int ks = 0; ks < 4; ++ks) acc[nt] = __builtin_amdgcn_mfma_f32_32x32x16_bf16(frag(lds, P_OFF + hh * 9216, 72, tm * 32, ks, lane), frag(lds, L_VT, 72, (tnb + 4 * nt) * 32, ks, lane), acc[nt], 0, 0, 0); }
        const int ycol = (BR == 0) ? hu * 128 : (BR == 1) ? 512 + hu * 128 : (BR == 2) ? 1024 + hu * 256 : 1536 + hu * 128;
#pragma unroll
        for (int nt = 0; nt < NT; ++nt) { const int ct = tnb + 4 * nt, v = ct * 32 + (lane & 31);
            const float dsk = dskv[nt];
            float sq[16];
#pragma unroll
            for (int r = 0; r < 16; ++r) { const int t = tm * 32 + rowmap(r, lane);
                float val = acc[nt][r];
                if constexpr (BR == 2) { val = (val + dsk * bf2f(VT[v * 72 + t])) * silu_f(bf2f(gt[nt][r])); acc[nt][r] = val; }
                sq[r] = val * val; }
            const bool b4 = lane & 16, b3 = lane & 8, b2 = lane & 4, b1 = lane & 2;
#pragma unroll
            for (int i = 0; i < 8; ++i) { const float lo = sq[i], hi = sq[i + 8]; sq[i] = (b4 ? hi : lo) + __shfl_xor(b4 ? lo : hi, 16); }
#pragma unroll
            for (int i = 0; i < 4; ++i) { const float lo = sq[i], hi = sq[i + 4]; sq[i] = (b3 ? hi : lo) + __shfl_xor(b3 ? lo : hi, 8); }
#pragma unroll
            for (int i = 0; i < 2; ++i) { const float lo = sq[i], hi = sq[i + 2]; sq[i] = (b2 ? hi : lo) + __shfl_xor(b2 ? lo : hi, 4); }
            { const float lo = sq[0], hi = sq[1]; sq[0] = (b1 ? hi : lo) + __shfl_xor(b1 ? lo : hi, 2); }
            sq[0] += __shfl_xor(sq[0], 1);
            const int rr = (b4 ? 8 : 0) + (b3 ? 4 : 0) + (b2 ? 2 : 0) + (b1 ? 1 : 0);
            if ((lane & 1) == 0) SM[SM_RSS + ct * 64 + tm * 32 + rowmap(rr, lane)] = sq[0];
        }
        __syncthreads();
        if (tid < 64) { float tot = 0.f;
#pragma unroll
            for (int q = 0; q < NCT; ++q) tot += SM[SM_RSS + q * 64 + tid];
            SM[SM_SEG + tid] = rsqrtf(tot * (1.f / DV) + EPS); }
        __syncthreads();
        float rinv[16];
#pragma unroll
        for (int r = 0; r < 16; ++r) rinv[r] = SM[SM_SEG + tm * 32 + rowmap(r, lane)];
        __syncthreads();
#pragma unroll
        for (int nt = 0; nt < NT; ++nt) { const int ct = tnb + 4 * nt, v = ct * 32 + (lane & 31);
            const float gn = gnv[nt];
#pragma unroll
            for (int r = 0; r < 16; ++r) { const int t = tm * 32 + rowmap(r, lane);
                float o = acc[nt][r] * rinv[r] * gn;
                if constexpr (BR != 2) o *= silu_f(bf2f(gt[nt][r]));
                p.y[(size_t)(bc * 64 + t) * DI + ycol + v] = f2bf(o); }
        }
    }
    }
}

template <int PASS>
__device__ __forceinline__ void phase_mixer(const MixP& p, LAS unsigned char* lds) {
#pragma unroll 1
    for (int i = blockIdx.x; i < NUNITS; i += gridDim.x) {
        const int bc = i / 14, u = i % 14;
        if (u < 4) mixer_unit<0, PASS>(p, lds, bc, u);
        else if (u < 8) mixer_unit<1, PASS>(p, lds, bc, u - 4);
        else if (u < 10) mixer_unit<2, PASS>(p, lds, bc, u - 8);
        else mixer_unit<3, PASS>(p, lds, bc, u - 10);
    }
}

__device__ __forceinline__ void phase_scan(bf16_t* st, const float* dec) {
    const int gt = blockIdx.x * NTHR + opaque_tid();
    constexpr int VPB = ST_PER_BC / 4;
    if (gt >= 2 * VPB) return;
    const int bl = gt / VPB, e0 = (gt % VPB) * 4;
    int mode, didx = 0; float cfac = 0.f;
    if (e0 < 65536) { mode = 0; didx = (e0 >> 14) * 128 + (e0 & 127); }
    else if (e0 < 131072) { mode = 1; const int h = (e0 - 65536) >> 14; cfac = __expf(64.f * log1pf(-exp2f(-(5.f + (float)h)))); }
    else if (e0 < 196608) { mode = 2; const int r = e0 - 131072; didx = 768 + (r >> 15) * 4 + (((r & 32767) >> 7) >> 6); }
    else { mode = 0; const int r = e0 - 196608; didx = 512 + (r >> 13) * 64 + (r & 63); }
    float s0 = 0.f, s1 = 0.f, s2 = 0.f, s3 = 0.f;
    bf16_t* ptr = st + (size_t)bl * 64 * ST_PER_BC + e0;
    const float* dp = dec + (size_t)bl * 64 * 1024 + didx;
#pragma unroll 1
    for (int c0 = 0; c0 < 64; c0 += 8) {
        u32x2 hv[8]; f32x4 dv[8];
#pragma unroll
        for (int j = 0; j < 8; ++j) {
            hv[j] = *(const u32x2*)(ptr + (size_t)(c0 + j) * ST_PER_BC);
            if (mode == 0) dv[j] = *(const f32x4*)(dp + (size_t)(c0 + j) * 1024);
            else if (mode == 1) dv[j] = (f32x4){cfac, cfac, cfac, cfac};
            else { const float d = dp[(size_t)(c0 + j) * 1024]; dv[j] = (f32x4){d, d, d, d}; }
        }
        __builtin_amdgcn_sched_barrier(0);
#pragma unroll
        for (int j = 0; j < 8; ++j) {
            u32x2 w; w.x = pk2(s0, s1); w.y = pk2(s2, s3);
            *(u32x2*)(ptr + (size_t)(c0 + j) * ST_PER_BC) = w;
            s0 = s0 * dv[j][0] + __uint_as_float(hv[j].x << 16); s1 = s1 * dv[j][1] + __uint_as_float(hv[j].x & 0xffff0000u);
            s2 = s2 * dv[j][2] + __uint_as_float(hv[j].y << 16); s3 = s3 * dv[j][3] + __uint_as_float(hv[j].y & 0xffff0000u);
        }
    }
}


#define XB_TMO      128
#define XB_XCNT(j)  (256  + 64 * (j))
#define XB_XSUB(j)  (1280 + 64 * (j))
#define XB_XGEN(j)  (2304 + 64 * (j))
#define XB_TOP      3328
#define XB_TOPGEN   3392
#define XCD_BAR_WORDS 3456
#define XB_SPIN_CAP (1u << 18)
__device__ __forceinline__ unsigned xb_ld(unsigned* p)              { return __hip_atomic_load(p, __ATOMIC_RELAXED, __HIP_MEMORY_SCOPE_AGENT); }
__device__ __forceinline__ unsigned xb_add(unsigned* p, unsigned v) { return __hip_atomic_fetch_add(p, v, __ATOMIC_RELAXED, __HIP_MEMORY_SCOPE_AGENT); }
__device__ __forceinline__ unsigned xb_xcc_id() { return (unsigned)__builtin_amdgcn_s_getreg((3 << 11) | 20) & 0xFu; }
#define XB_SPIN(cond, bar) do { unsigned _sp = 0; while (cond) { __builtin_amdgcn_s_sleep(1); \
    if ((++_sp & 255u) == 0u) { if (xb_ld(&(bar)[XB_TMO])) break; if (_sp > XB_SPIN_CAP) { atomicAdd(&(bar)[XB_TMO], 1u); break; } } } } while (0)
struct XcdBarrier { unsigned* bar; unsigned x; volatile LAS unsigned* st; };
__device__ __forceinline__ XcdBarrier xcd_barrier_post(unsigned* bar, volatile LAS unsigned* st) {
    XcdBarrier b; b.bar = bar; b.x = xb_xcc_id(); b.st = st;
    if (threadIdx.x == 0) (void)xb_add(&bar[XB_XCNT(b.x)], 1u);
    return b;
}
__device__ __forceinline__ void xcd_barrier_complete(unsigned* bar, unsigned x, unsigned& nloc, unsigned& nx) {
    const unsigned G = gridDim.x * gridDim.y * gridDim.z;
    unsigned sum, cnt, mine, sp = 0u;
    for (;;) {
        sum = 0u; cnt = 0u; mine = 0u;
#pragma unroll
        for (unsigned j = 0; j < 16; ++j) { const unsigned c = xb_ld(&bar[XB_XCNT(j)]); sum += c; cnt += (c > 0u) ? 1u : 0u; mine = (j == x) ? c : mine; }
        if (sum == G) break;
        __builtin_amdgcn_s_sleep(1);
        if ((++sp & 255u) == 0u) { if (xb_ld(&bar[XB_TMO])) break; if (sp > XB_SPIN_CAP) { atomicAdd(&bar[XB_TMO], 1u); break; } }
    }
    nloc = mine > 0u ? mine : 1u; nx = cnt > 0u ? cnt : 1u;
}
__device__ __forceinline__ void xcd_barrier(const XcdBarrier& b) {
    asm volatile("s_waitcnt vmcnt(0)" ::: "memory");
    __syncthreads();
    if (threadIdx.x == 0) {
        unsigned* bar = b.bar;
        __builtin_amdgcn_s_waitcnt(0);
        unsigned nloc = b.st[0], nx = b.st[1];
        if (nloc == 0u) { xcd_barrier_complete(bar, b.x, nloc, nx); b.st[0] = nloc; b.st[1] = nx; }
        const unsigned old = xb_add(&bar[XB_XSUB(b.x)], 1u);
        const unsigned gen = old / nloc;
        if (old + 1u == (gen + 1u) * nloc) {
            __builtin_amdgcn_fence(__ATOMIC_RELEASE, "agent");
            asm volatile("s_waitcnt vmcnt(0)" ::: "memory");
            const unsigned og = xb_add(&bar[XB_TOP], 1u);
            const unsigned tg = og / nx;
            if (og + 1u == (tg + 1u) * nx) xb_add(&bar[XB_TOPGEN], 1u);
            else XB_SPIN(xb_ld(&bar[XB_TOPGEN]) == tg, bar);
            __builtin_amdgcn_fence(__ATOMIC_ACQUIRE, "agent");
            xb_add(&bar[XB_XGEN(b.x)], 1u);
            asm volatile("s_waitcnt vmcnt(0)" ::: "memory");
        } else {
            XB_SPIN(xb_ld(&bar[XB_XGEN(b.x)]) == gen, bar);
            __builtin_amdgcn_fence(__ATOMIC_ACQUIRE, "agent");
            asm volatile("s_waitcnt vmcnt(0)" ::: "memory");
        }
    }
    __syncthreads();
}

__global__ void __launch_bounds__(NTHR, 2) fwd_megakernel(Args a) {
    extern __shared__ __attribute__((aligned(16))) unsigned char shm[];
    LAS unsigned char* lds = (LAS unsigned char*)shm;
    cg::grid_group grid = cg::this_grid();
    unsigned char* ws = a.ws;
    const int G = gridDim.x;

    {
        volatile LAS unsigned* stw = (volatile LAS unsigned*)(lds + L_BARST);
        if (threadIdx.x < 2) stw[threadIdx.x] = 0u;
        __syncthreads();
    }
    const XcdBarrier gbar = xcd_barrier_post((unsigned*)(ws + WS_BAR), (volatile LAS unsigned*)(lds + L_BARST));
    for (int rep = 0; rep < REP_PREP; ++rep) { phase_prep(a, lds); if (rep == 0) grid.sync(); else xcd_barrier(gbar); }

    bf16_t* hbuf = (bf16_t*)(ws + WS_HY); bf16_t* ybuf = (bf16_t*)(ws + WS_HY);
    bf16_t* proj = (bf16_t*)(ws + WS_PROJ); bf16_t* st = (bf16_t*)(ws + WS_ST); float* dec = (float*)(ws + WS_DEC);
    const float* mod = (const float*)(ws + WS_MOD);

#pragma unroll 1
    for (int half = 0; half < 2; ++half) {
        const size_t xoff = (size_t)half * HROWS * DM;
#pragma unroll 1
        for (int l = 0; l < DEPTH; ++l) {
            const float* modl = mod + (size_t)l * 4 * 3072;
            bf16_t* slab = (bf16_t*)(ws + WS_PROJ);
            if (l == 0) { phase_norm<false>(a.x + xoff, nullptr, nullptr, nullptr, a.norm_g, modl, half, hbuf); if (half == 0) phase_wcvt(a, lds); }
            else phase_norm<false>(a.x + xoff, slab, mod + (size_t)(half * 2) * 3072 + 2048, a.out + xoff, a.norm_g + l * DM, modl, half, hbuf);
            xcd_barrier(gbar);
            for (int rep = 0; rep < REP_G1; ++rep) {
                pg8::Gemm g{hbuf, (const bf16_t*)(ws + WS_WIN) + (size_t)l * LDP * DM, HROWS, LDP, DM, DM};
                pg8::StaticOrder S; S.init(HROWS, LDP, G, (int)blockIdx.x);
                pg8::EpiProj E{proj, LDP};
                pg8::gemm_phase<pg8::EpiProj, pg8::StaticOrder>(lds, g, S, E);
                xcd_barrier(gbar);
            }
            MixP p;
            p.proj = proj; p.st = st; p.dec = dec; p.y = ybuf; p.rope = (const float2*)(ws + WS_ROPE);
            p.lbl = a.lb_logits; p.hgrn_g = a.hgrn_g + l * 512; p.ret_g = a.ret_g + l * 512; p.conv_w = a.conv_w + l * 4096; p.conv_b = a.conv_b + l * 1024;
            p.dt_bias = a.dt_bias + l * 8; p.a_log = a.a_log + l * 8; p.dskip = a.dskip + l * 8; p.ssm_g = a.ssm_g + l * 512;
            p.w2 = a.w_gk2 + l * 16 * 256; p.b2 = a.b_gk2 + l * 256; p.gla_g = a.gla_g + l * 512; p.layer = l;
            for (int rep = 0; rep < REP_M12; ++rep) { phase_mixer<1>(p, lds); xcd_barrier(gbar); phase_scan(st, dec); xcd_barrier(gbar); }
            for (int rep = 0; rep < REP_M3; ++rep) { phase_mixer<3>(p, lds); xcd_barrier(gbar); }
            for (int rep = 0; rep < REP_G2; ++rep) {
                pg8::Gemm g{ybuf, (const bf16_t*)(ws + WS_WOUT) + (size_t)l * DM * DI, HROWS, DM, DI / 2, DI};
                pg8::SplitOrder S; S.init(HROWS, DM, G, (int)blockIdx.x);
                pg8::EpiSlab E{slab};
                pg8::gemm_phase<pg8::EpiSlab, pg8::SplitOrder>(lds, g, S, E);
                xcd_barrier(gbar);
            }
        }
        phase_norm<true>(a.out + xoff, (const bf16_t*)(ws + WS_PROJ), mod + (size_t)(4 + half * 2) * 3072 + 2048, a.out + xoff, a.final_g, nullptr, half, nullptr);
    }
}

extern "C" void kernel_launch(void* const* d_in, const int* in_sizes, int n_in, void* d_out, int out_size, void* d_ws, size_t ws_size, hipStream_t stream) {
    static int grid = 0;
    if (grid == 0) {
        if (n_in != 20 || ws_size < WS_END) { fprintf(stderr, "kernel_launch: unexpected n_in %d / ws_size %zu (need %zu)\n", n_in, ws_size, (size_t)WS_END); grid = -1; return; }
        int dev = 0, cus = 0, per_cu = 0;
        hipGetDevice(&dev);
        hipDeviceGetAttribute(&cus, hipDeviceAttributeMultiprocessorCount, dev);
        if (hipFuncSetAttribute((const void*)fwd_megakernel, hipFuncAttributeMaxDynamicSharedMemorySize, LDS_BYTES) != hipSuccess) { fprintf(stderr, "kernel_launch: hipFuncSetAttribute failed\n"); grid = -1; return; }
        hipOccupancyMaxActiveBlocksPerMultiprocessor(&per_cu, (const void*)fwd_megakernel, NTHR, LDS_BYTES);
        if (per_cu < 1) { fprintf(stderr, "kernel_launch: occupancy query says %d blocks per CU\n", per_cu); per_cu = 1; }
        (void)hipGetLastError();
        grid = cus * per_cu;
    }
    if (grid < 0) return;
    Args a{};
    const float** f = (const float**)&a;
    for (int i = 0; i < 20; ++i) f[i] = (const float*)d_in[i];
    a.out = (float*)d_out; a.ws = (unsigned char*)d_ws;
    void* args[] = {&a};
    if (hipMemsetAsync((char*)d_ws + WS_BAR, 0, XCD_BAR_WORDS * 4, stream) != hipSuccess) { fprintf(stderr, "kernel_launch: memset of barrier words failed\n"); return; }
    hipError_t e = hipLaunchCooperativeKernel((const void*)fwd_megakernel, dim3(grid), dim3(NTHR), args, LDS_BYTES, stream);
    if (e != hipSuccess) fprintf(stderr, "cooperative launch failed: %s (grid %d)\n", hipGetErrorString(e), grid);
}
```

```cpp
#include <hip/hip_runtime.h>
#include <hip/hip_cooperative_groups.h>
#include <cstdio>
namespace cg = cooperative_groups;

#define LAS __attribute__((address_space(3)))
typedef unsigned short bf16_t;
typedef short bf16x8 __attribute__((ext_vector_type(8)));
typedef float f32x4 __attribute__((ext_vector_type(4)));
typedef float f32x16 __attribute__((ext_vector_type(16)));
typedef unsigned u32x4 __attribute__((ext_vector_type(4)));
typedef unsigned u32x2 __attribute__((ext_vector_type(2)));

#ifndef REP_PREP
#define REP_PREP 1
#endif
#ifndef REP_NORM
#define REP_NORM 1
#endif
#ifndef REP_G1
#define REP_G1 1
#endif
#ifndef REP_M12
#define REP_M12 1
#endif
#ifndef REP_M3
#define REP_M3 1
#endif
#ifndef REP_G2
#define REP_G2 1
#endif
#ifndef REP_UPREP
#define REP_UPREP 1
#endif
#ifndef REP_UCORE
#define REP_UCORE 1
#endif
constexpr int NB = 4, SEQ = 4096, DM = 1024, DEPTH = 2, DI = 2048;
constexpr int NIN = 7192, LDP = 7424;
constexpr int HROWS = 8192;
constexpr int NTHR = 512;
constexpr float EPS = 1e-6f;
constexpr int C_AQ = 0, C_AF = 512, C_AI = 1024, C_AG = 1536, C_RQ = 2048, C_RK = 2560, C_RV = 3072, C_RG = 3584,
              C_MZ = 4096, C_XBC = 4608, C_GQ = 5632, C_GK = 5888, C_GV = 6144, C_GG = 6656, C_DT = 7168, C_LR = 7176;
constexpr int ST_PER_BC = 229376;
constexpr size_t WS_WIN = 0;
constexpr size_t WS_WOUT = WS_WIN + 2ull * LDP * DM * 2;
constexpr size_t WS_MOD = WS_WOUT + 2ull * DM * DI * 2;
constexpr size_t WS_ROPE = WS_MOD + 2ull * 4 * 3072 * 4;
constexpr size_t WS_DEC = WS_ROPE + 4096ull * 64 * 8;
constexpr size_t WS_HY = WS_DEC + 128ull * 1024 * 4;
constexpr size_t WS_PROJ = WS_HY + (size_t)HROWS * DI * 2;
constexpr size_t WS_ST = WS_PROJ + (size_t)HROWS * LDP * 2;
constexpr size_t WS_BAR = WS_ST + 128ull * ST_PER_BC * 2;
constexpr size_t WS_END = WS_BAR + 3456 * 4;
constexpr int L_QI = 0, L_KI = 17408, L_VT = 34816, L_BIG = 71680, L_SM = 141312;
constexpr int SM_CUM = 0, SM_DT = 256, SM_SEG = 512, SM_REF = 1536, SM_CLAST = 1664, SM_RSS = 1792;
constexpr int L_BARST = L_SM + (1792 + 512) * 4;
constexpr int LDS_BYTES = L_BARST + 16;

constexpr int NCG = LDP / 128;
__device__ __forceinline__ size_t pidx(int row, int col) { return ((size_t)((row >> 6) * NCG + (col >> 7)) * 64 + (row & 63)) * 128 + (col & 127); }
__device__ __forceinline__ float bf2f(bf16_t v) { return __uint_as_float(((unsigned)v) << 16); }
__device__ __forceinline__ bf16_t f2bf(float f) { unsigned u = __float_as_uint(f); u += 0x7FFFu + ((u >> 16) & 1u); return (bf16_t)(u >> 16); }
typedef float f32x2_t __attribute__((ext_vector_type(2)));
typedef __bf16 bf16x2_t __attribute__((ext_vector_type(2)));
__device__ __forceinline__ unsigned pk2(float lo, float hi) { f32x2_t v = {lo, hi}; bf16x2_t b = __builtin_convertvector(v, bf16x2_t); return __builtin_bit_cast(unsigned, b); }
__device__ __forceinline__ int opaque_tid() { int t = threadIdx.x; asm volatile("" : "+v"(t)); return t; }
__device__ __forceinline__ float silu_f(float x) { return x * __builtin_amdgcn_rcpf(1.f + __expf(-x)); }
__device__ __forceinline__ float softplus_f(float x) { return fmaxf(x, 0.f) + __logf(1.f + __expf(-fabsf(x))); }
__device__ __forceinline__ float logsig_f(float x) { return fminf(x, 0.f) - __logf(1.f + __expf(-fabsf(x))); }

namespace pg8 {
constexpr int BM = 256, BK = 64, HALF = 128, HTB = HALF * BK * 2, STAGE_BYTES = 8 * HTB, NXCD = 8, WGM = 8;
__device__ __forceinline__ int lds_byte(int r, int c) { const int st = (r >> 4) * 2 + (c >> 5), rr = r & 15, cc = c & 31, ob = rr * 64 + cc * 2; return st * 1024 + (ob ^ (((ob >> 9) & 1) << 5)); }
__device__ __forceinline__ void stage_rc(int b, int& R, int& C) { const int st = b / 1024, sb = b % 1024, swz = sb ^ (((sb >> 9) & 1) << 5); R = (st >> 1) * 16 + swz / 64; C = (st & 1) * 32 + (swz % 64) / 2; }
__device__ __forceinline__ int perm32(int rho) { const int n = rho >> 4, i = rho & 15; return 8 * (i >> 2) + 4 * n + (i & 3); }
struct Unit { int pm, pn, kh; };
struct Gemm { const bf16_t* A; const bf16_t* Bt; int M, N, K, ld; };
struct StaticOrder {
    int nM, nN, nwg, G, c;
    __device__ void init(int M, int N, int G_, int c_) { nM = M / BM; nN = N / BM; nwg = nM * nN; G = G_; c = c_; }
    __device__ bool next(int i, Unit& u) const {
        const long L = (long)i * G + c; if (L >= nwg) return false;
        int wgid = (int)L; { const int q = nwg / NXCD, r = nwg % NXCD, xcd = wgid % NXCD, off = wgid / NXCD; wgid = (xcd < r ? xcd * (q + 1) : r * (q + 1) + (xcd - r) * q) + off; }
        const int nig = WGM * nN, gid = wgid / nig, fm = gid * WGM, gsz = (nM - fm) < WGM ? (nM - fm) : WGM;
        u.pm = fm + ((wgid % nig) % gsz); u.pn = (wgid % nig) / gsz; u.kh = 0; return true;
    }
};
struct SplitOrder {
    StaticOrder so;
    __device__ void init(int M, int N, int G_, int c_) { so.init(M, 2 * N, G_, c_); }
    __device__ bool next(int i, Unit& u) const { if (!so.next(i, u)) return false; u.kh = u.pn & 1; u.pn >>= 1; return true; }
};
struct EpiProj {
    static constexpr bool PERM = true;
    bf16_t* O; int ldc;
    __device__ __forceinline__ void operator()(const f32x4 (&acc)[2][2][4][2], const Unit& u, int wr, int wc, int fr, int fq) const {
        bf16_t* base = O + ((size_t)((u.pm * 4 + wr) * NCG + u.pn * 2) * 64 + fr) * 128 + wc * 32 + 8 * fq;
#pragma unroll
        for (int ai = 0; ai < 2; ++ai)
#pragma unroll
            for (int m = 0; m < 4; ++m)
#pragma unroll
                for (int bj = 0; bj < 2; ++bj) { const f32x4 v0 = acc[ai][bj][m][0], v1 = acc[ai][bj][m][1];
                    u32x4 w; w.x = pk2(v0[0], v0[1]); w.y = pk2(v0[2], v0[3]); w.z = pk2(v1[0], v1[1]); w.w = pk2(v1[2], v1[3]);
                    *(u32x4*)(base + (size_t)ai * (2 * NCG * 8192) + bj * 8192 + m * (16 * 128)) = w; }
    }
};
struct EpiRes {
    static constexpr bool PERM = false;
    const float* xin; float* xout; const float* gate;
    __device__ __forceinline__ void operator()(const f32x4 (&acc)[2][2][4][2], const Unit& u, int wr, int wc, int fr, int fq) const {
        const int row0 = u.pm * BM + wr * 64 + fr, col0 = u.pn * BM + wc * 32 + 4 * fq;
        const float* gp = gate + (size_t)(u.pm >> 4) * 3072 + col0;
        f32x4 gv[2][2];
#pragma unroll
        for (int bj = 0; bj < 2; ++bj)
#pragma unroll
            for (int n = 0; n < 2; ++n) gv[bj][n] = *(const f32x4*)(gp + bj * HALF + n * 16);
#pragma unroll
        for (int am = 0; am < 4; ++am) {
            const int ai = am >> 1, m0 = (am & 1) * 2;
            f32x4 xi[2][2][2];
#pragma unroll
            for (int m = 0; m < 2; ++m)
#pragma unroll
                for (int bj = 0; bj < 2; ++bj)
#pragma unroll
                    for (int n = 0; n < 2; ++n) xi[m][bj][n] = *(const f32x4*)(xin + (size_t)(row0 + ai * HALF + (m0 + m) * 16) * DM + col0 + bj * HALF + n * 16);
            __builtin_amdgcn_sched_barrier(0);
#pragma unroll
            for (int m = 0; m < 2; ++m)
#pragma unroll
                for (int bj = 0; bj < 2; ++bj)
#pragma unroll
                    for (int n = 0; n < 2; ++n) *(f32x4*)(xout + (size_t)(row0 + ai * HALF + (m0 + m) * 16) * DM + col0 + bj * HALF + n * 16) = xi[m][bj][n] + gv[bj][n] * acc[ai][bj][m0 + m][n];
        }
    }
};

struct EpiSlab {
    static constexpr bool PERM = true;
    bf16_t* slab;
    __device__ __forceinline__ void operator()(const f32x4 (&acc)[2][2][4][2], const Unit& u, int wr, int wc, int fr, int fq) const {
        const int row0 = u.pm * BM + wr * 64 + fr, col0 = u.pn * BM + wc * 32 + 8 * fq;
        bf16_t* base = slab + (size_t)u.kh * HROWS * DM;
#pragma unroll
        for (int ai = 0; ai < 2; ++ai)
#pragma unroll
            for (int m = 0; m < 4; ++m) { bf16_t* rowp = base + (size_t)(row0 + ai * HALF + m * 16) * DM + col0;
#pragma unroll
                for (int bj = 0; bj < 2; ++bj) { const f32x4 v0 = acc[ai][bj][m][0], v1 = acc[ai][bj][m][1];
                    u32x4 w; w.x = pk2(v0[0], v0[1]); w.y = pk2(v0[2], v0[3]); w.z = pk2(v1[0], v1[1]); w.w = pk2(v1[2], v1[3]);
                    *(u32x4*)(rowp + bj * HALF) = w; } }
    }
};

template <class Epi, class Sched>
__device__ __forceinline__ void gemm_phase(LAS unsigned char* lds, const Gemm g, const Sched& S, const Epi& E) {
    const int tid = opaque_tid(), wid = __builtin_amdgcn_readfirstlane(tid >> 6), lane = tid & 63, wr = wid >> 2, wc = wid & 3, fr = lane & 15, fq = lane >> 4;
    const int K = g.K, nt = K / BK, ld = g.ld;
    unsigned voffA[2], voffB[2];
#pragma unroll
    for (int i = 0; i < 2; ++i) { int R, C; stage_rc(tid * 16 + i * 8192, R, C); const int Rb = Epi::PERM ? ((R & ~31) + perm32(R & 31)) : R;
        voffA[i] = (unsigned)(R * ld + C) * 2u; voffB[i] = (unsigned)(Rb * ld + C) * 2u; }
    const size_t kstep = (size_t)(BK * 2);
    const size_t hstep = (size_t)HALF * ld * 2;
    const size_t tstep = 2 * hstep;
    const unsigned ldsw = (unsigned)wid * 1024u;
    const int aoff = lds_byte(wr * 64 + fr, fq * 8), boff = lds_byte(wc * 32 + fr, fq * 8);
#define PG8_SA(b, h) (((b) * 2 + (h)) * HTB)
#define PG8_SB(b, h) ((4 + (b) * 2 + (h)) * HTB)
#define PG8_STAGE(bufoff, gbase, voff) do { _Pragma("unroll") for (int _i = 0; _i < 2; ++_i) \
        __builtin_amdgcn_global_load_lds((const unsigned*)((const char*)(gbase) + (voff)[_i]), (LAS unsigned*)(lds + (bufoff) + ldsw + _i * 8192), 16, 0, 0); } while (0)
#define PG8_LDA(dst, b, h) do { _Pragma("unroll") for (int m = 0; m < 4; ++m) _Pragma("unroll") for (int k = 0; k < 2; ++k) dst[m][k] = *(const LAS bf16x8*)(lds + PG8_SA(b, h) + aoff + m * 2048 + k * 1024); } while (0)
#define PG8_LDB(dst, b, h) do { _Pragma("unroll") for (int n = 0; n < 2; ++n) _Pragma("unroll") for (int k = 0; k < 2; ++k) dst[n][k] = *(const LAS bf16x8*)(lds + PG8_SB(b, h) + boff + n * 2048 + k * 1024); } while (0)
#define PG8_MMA(ai, bj, At, Bt) do { __builtin_amdgcn_s_setprio(1); _Pragma("unroll") for (int m = 0; m < 4; ++m) _Pragma("unroll") for (int n = 0; n < 2; ++n) _Pragma("unroll") for (int k = 0; k < 2; ++k) \
        acc[ai][bj][m][n] = __builtin_amdgcn_mfma_f32_16x16x32_bf16(Bt[n][k], At[m][k], acc[ai][bj][m][n], 0, 0, 0); __builtin_amdgcn_s_setprio(0); } while (0)
#define PG8_WAIT_V(n) asm volatile("s_waitcnt vmcnt(" #n ")" ::: "memory")
#define PG8_WAIT_L(n) asm volatile("s_waitcnt lgkmcnt(" #n ")" ::: "memory")
#define PG8_BAR __builtin_amdgcn_s_barrier()
#define PG8_SCHED __builtin_amdgcn_sched_barrier(0)
    Unit cur, nxt; int ui = 0;
    if (!S.next(0, cur)) return;
    f32x4 acc[2][2][4][2];
#pragma unroll
    for (int a = 0; a < 2; ++a)
#pragma unroll
        for (int b = 0; b < 2; ++b)
#pragma unroll
            for (int m = 0; m < 4; ++m)
#pragma unroll
                for (int n = 0; n < 2; ++n) acc[a][b][m][n] = (f32x4){0.f, 0.f, 0.f, 0.f};
    bf16x8 At[4][2], B0[2][2], B1[2][2];
    const char* cA = (const char*)g.A + (size_t)cur.pm * tstep + (size_t)cur.kh * K * 2; const char* cB = (const char*)g.Bt + (size_t)cur.pn * tstep + (size_t)cur.kh * K * 2;
    PG8_STAGE(PG8_SB(0, 0), cB, voffB); PG8_STAGE(PG8_SA(0, 0), cA, voffA); PG8_STAGE(PG8_SB(0, 1), cB + hstep, voffB); PG8_STAGE(PG8_SA(0, 1), cA + hstep, voffA);
    if (wr == 1) PG8_BAR;
    PG8_WAIT_V(4); PG8_BAR;
    PG8_STAGE(PG8_SB(1, 0), cB + kstep, voffB); PG8_STAGE(PG8_SA(1, 0), cA + kstep, voffA); PG8_STAGE(PG8_SB(1, 1), cB + hstep + kstep, voffB);
    PG8_WAIT_V(6); PG8_BAR;
    for (;;) {
        const bool has_next = S.next(ui + 1, nxt);
        const char* nA = has_next ? (const char*)g.A + (size_t)nxt.pm * tstep + (size_t)nxt.kh * K * 2 : cA; const char* nB = has_next ? (const char*)g.Bt + (size_t)nxt.pn * tstep + (size_t)nxt.kh * K * 2 : cB;
        for (int t = 0; t < nt; t += 2) {
            const bool last = (t == nt - 2);
            const char* a1 = cA + (size_t)(t + 1) * kstep;
            const char* a2 = last ? nA : cA + (size_t)(t + 2) * kstep; const char* b2 = last ? nB : cB + (size_t)(t + 2) * kstep;
            const char* a3 = a2 + kstep; const char* b3 = b2 + kstep;
            PG8_LDB(B0, 0, 0); PG8_SCHED; PG8_LDA(At, 0, 0); PG8_STAGE(PG8_SA(1, 1), a1 + hstep, voffA);
            PG8_WAIT_L(8); PG8_BAR; PG8_WAIT_L(0); PG8_MMA(0, 0, At, B0); PG8_BAR; PG8_SCHED;
            PG8_LDB(B1, 0, 1); PG8_STAGE(PG8_SB(0, 0), b2, voffB);
            PG8_BAR; PG8_WAIT_L(0); PG8_MMA(0, 1, At, B1); PG8_BAR;
            PG8_LDA(At, 0, 1); PG8_STAGE(PG8_SA(0, 0), a2, voffA);
            PG8_BAR; PG8_WAIT_L(0); PG8_MMA(1, 0, At, B0); PG8_BAR; PG8_SCHED;
            PG8_STAGE(PG8_SB(0, 1), b2 + hstep, voffB);
            PG8_WAIT_V(6); PG8_BAR; PG8_MMA(1, 1, At, B1); PG8_BAR;
            PG8_LDB(B0, 1, 0); PG8_SCHED; PG8_LDA(At, 1, 0); PG8_STAGE(PG8_SA(0, 1), a2 + hstep, voffA);
            PG8_WAIT_L(8); PG8_BAR; PG8_WAIT_L(0); PG8_MMA(0, 0, At, B0); PG8_BAR; PG8_SCHED;
            PG8_LDB(B1, 1, 1); PG8_STAGE(PG8_SB(1, 0), b3, voffB);
            PG8_BAR; PG8_WAIT_L(0); PG8_MMA(0, 1, At, B1); PG8_BAR;
            PG8_LDA(At, 1, 1); PG8_STAGE(PG8_SA(1, 0), a3, voffA);
            PG8_BAR; PG8_WAIT_L(0); PG8_MMA(1, 0, At, B0); PG8_BAR; PG8_SCHED;
            PG8_STAGE(PG8_SB(1, 1), b3 + hstep, voffB);
            PG8_WAIT_V(6); PG8_BAR; PG8_MMA(1, 1, At, B1); PG8_BAR;
        }
        E(acc, cur, wr, wc, fr, fq);
        if (!has_next) break;
#pragma unroll
        for (int a = 0; a < 2; ++a)
#pragma unroll
            for (int b = 0; b < 2; ++b)
#pragma unroll
                for (int m = 0; m < 4; ++m)
#pragma unroll
                    for (int n = 0; n < 2; ++n) acc[a][b][m][n] = (f32x4){0.f, 0.f, 0.f, 0.f};
        cur = nxt; cA = nA; cB = nB; ++ui;
    }
    PG8_WAIT_V(0);
    if (wr == 0) PG8_BAR;
    PG8_BAR;
#undef PG8_SA
#undef PG8_SB
#undef PG8_STAGE
#undef PG8_LDA
#undef PG8_LDB
#undef PG8_MMA
#undef PG8_WAIT_V
#undef PG8_WAIT_L
#undef PG8_BAR
#undef PG8_SCHED
}
}

struct Args {
    const float* x; const float* c; const float* w_ada; const float* b_ada; const float* norm_g; const float* w_in;
    const float* lb_logits; const float* hgrn_g; const float* ret_g; const float* conv_w; const float* conv_b;
    const float* dt_bias; const float* a_log; const float* dskip; const float* ssm_g; const float* w_gk2; const float* b_gk2;
    const float* gla_g; const float* w_out; const float* final_g;
    float* out; unsigned char* ws;
};

__device__ __forceinline__ void transpose_cvt(const float* __restrict__ src, int K, int N, bf16_t* __restrict__ dst, int Npad, LAS unsigned char* lds, int gid, int gstride, bool perm) {
    LAS float* T = (LAS float*)lds;
    const int tid = opaque_tid(), ntk = K / 64, ntn = Npad / 256;
    for (int tile = gid; tile < ntk * ntn; tile += gstride) {
        const int tk = tile % ntk, tn = tile / ntk;
        float v[32];
#pragma unroll
        for (int i = 0; i < 32; ++i) { const int kk = (tid >> 8) + 2 * i, nn = tid & 255, n = tn * 256 + nn;
            const int ns = !perm ? n : (n < 5632) ? n : (n < 7168) ? n + 8 : (n < 7176) ? n - 7168 + 5632 : n;
            v[i] = (n < N) ? src[(size_t)(tk * 64 + kk) * N + ns] : 0.f; }
#pragma unroll
        for (int i = 0; i < 32; ++i) { const int kk = (tid >> 8) + 2 * i, nn = tid & 255; T[kk * 257 + nn] = v[i]; }
        __syncthreads();
#pragma unroll
        for (int i = 0; i < 16; ++i) { const int nn = (tid >> 5) + 16 * i, kk = (tid & 31) * 2;
            *(unsigned*)(dst + (size_t)(tn * 256 + nn) * K + tk * 64 + kk) = pk2(T[kk * 257 + nn], T[(kk + 1) * 257 + nn]); }
        __syncthreads();
    }
}

__device__ __forceinline__ void phase_wcvt(const Args& a, LAS unsigned char* lds) {
    const int G = gridDim.x, bid = blockIdx.x;
    unsigned char* ws = a.ws;
    for (int l = 0; l < DEPTH; ++l) {
        transpose_cvt(a.w_in + (size_t)l * DM * NIN, DM, NIN, (bf16_t*)(ws + WS_WIN) + (size_t)l * LDP * DM, LDP, lds, bid, G, true);
        transpose_cvt(a.w_out + (size_t)l * DI * DM, DI, DM, (bf16_t*)(ws + WS_WOUT) + (size_t)l * DM * DI, DM, lds, (bid + 128) % G, G, false);
    }
}
__device__ __forceinline__ void phase_prep(const Args& a, LAS unsigned char* lds) {
    const int tid = opaque_tid(), G = gridDim.x, bid = blockIdx.x;
    unsigned char* ws = a.ws;
    {
        LAS float* R = (LAS float*)lds;
        LAS float* CA = (LAS float*)(lds + 8192);
        float* mod = (float*)(ws + WS_MOD);
        const int jj = tid & 63, ks = tid >> 6;
        if (bid < DEPTH * 48) {
#pragma unroll
            for (int q = 0; q < 8; ++q) CA[tid + NTHR * q] = silu_f(a.c[tid + NTHR * q]);
            __syncthreads();
        }
        for (int item = bid; item < DEPTH * 48; item += G) {
            const int l = item / 48, j = (item % 48) * 64 + jj;
            float s0 = 0.f, s1 = 0.f, s2 = 0.f, s3 = 0.f;
            const float* w = a.w_ada + (size_t)l * DM * 3072 + j;
#pragma unroll 16
            for (int k = ks * 128; k < ks * 128 + 128; ++k) { const float wv = w[(size_t)k * 3072];
                s0 += CA[k] * wv; s1 += CA[DM + k] * wv; s2 += CA[2 * DM + k] * wv; s3 += CA[3 * DM + k] * wv; }
            R[(ks * 4 + 0) * 64 + jj] = s0; R[(ks * 4 + 1) * 64 + jj] = s1; R[(ks * 4 + 2) * 64 + jj] = s2; R[(ks * 4 + 3) * 64 + jj] = s3;
            __syncthreads();
            if (tid < 256) { const int b = tid >> 6; float s = a.b_ada[l * 3072 + j];
#pragma unroll
                for (int q = 0; q < 8; ++q) s += R[(q * 4 + b) * 64 + jj];
                mod[(size_t)(l * 4 + b) * 3072 + j] = s; }
            __syncthreads();
        }
    }
    {
        float2* rope = (float2*)(ws + WS_ROPE);
        for (int i = bid * NTHR + tid; i < 4096 * 64; i += G * NTHR) {
            const int pos = i >> 6, j = i & 63;
            const float invf = powf(10000.f, -(float)(2 * j) / 128.f);
            const float ang = (float)pos * invf;
            const float k = rintf(ang * 0.15915494309189535f);
            float r = fmaf(-k, 6.2831854820251465f, ang); r = fmaf(-k, -1.7484555e-07f, r);
            rope[i] = make_float2(__cosf(r), __sinf(r));
        }
    }
}

template <bool FINAL>
__device__ __forceinline__ void phase_norm(const float* __restrict__ xin  , const bf16_t* __restrict__ slab  ,
                                           const float* __restrict__ gate_prev  , float* xout  ,
                                           const float* __restrict__ g, const float* __restrict__ mod  , int half, bf16_t* __restrict__ hout) {
    const int tid = opaque_tid(), lane = tid & 63, wid = tid >> 6;
    const int gw = blockIdx.x * 8 + wid, nw = gridDim.x * 8;
    for (int row = gw; row < HROWS; row += nw) {
        const float* xr = xin + (size_t)row * DM;
        f32x4 v[4]; float ss = 0.f;
#pragma unroll
        for (int i = 0; i < 4; ++i) v[i] = *(const f32x4*)(xr + i * 256 + lane * 4);
        if (slab) {
            u32x2 a0[4], a1[4]; f32x4 gp[4];
#pragma unroll
            for (int i = 0; i < 4; ++i) { const int col = i * 256 + lane * 4;
                a0[i] = *(const u32x2*)(slab + (size_t)row * DM + col); a1[i] = *(const u32x2*)(slab + (size_t)(HROWS + row) * DM + col);
                gp[i] = *(const f32x4*)(gate_prev + (size_t)(row >> 12) * 3072 + col); }
#pragma unroll
            for (int i = 0; i < 4; ++i) {
                const f32x4 sa = {__uint_as_float(a0[i].x << 16) + __uint_as_float(a1[i].x << 16), __uint_as_float(a0[i].x & 0xffff0000u) + __uint_as_float(a1[i].x & 0xffff0000u),
                                  __uint_as_float(a0[i].y << 16) + __uint_as_float(a1[i].y << 16), __uint_as_float(a0[i].y & 0xffff0000u) + __uint_as_float(a1[i].y & 0xffff0000u)};
                v[i] = v[i] + gp[i] * sa; }
        }
        if (!FINAL && xout) {
#pragma unroll
            for (int i = 0; i < 4; ++i) *(f32x4*)(xout + (size_t)row * DM + i * 256 + lane * 4) = v[i];
        }
#pragma unroll
        for (int i = 0; i < 4; ++i) ss += v[i][0] * v[i][0] + v[i][1] * v[i][1] + v[i][2] * v[i][2] + v[i][3] * v[i][3];
#pragma unroll
        for (int o = 32; o > 0; o >>= 1) ss += __shfl_xor(ss, o);
        const float rinv = rsqrtf(ss * (1.f / DM) + EPS);
        if constexpr (FINAL) {
#pragma unroll
            for (int i = 0; i < 4; ++i) { const int col = i * 256 + lane * 4; const f32x4 gg = *(const f32x4*)(g + col);
                *(f32x4*)(xout + (size_t)row * DM + col) = v[i] * rinv * gg; }
        } else {
            const float* mb = mod + (size_t)(half * 2 + (row >> 12)) * 3072;
#pragma unroll
            for (int i = 0; i < 4; ++i) { const int col = i * 256 + lane * 4;
                const f32x4 gg = *(const f32x4*)(g + col), sh = *(const f32x4*)(mb + col), sc = *(const f32x4*)(mb + 1024 + col);
                float o0 = v[i][0] * rinv * gg[0] * (1.f + sc[0]) + sh[0], o1 = v[i][1] * rinv * gg[1] * (1.f + sc[1]) + sh[1];
                float o2 = v[i][2] * rinv * gg[2] * (1.f + sc[2]) + sh[2], o3 = v[i][3] * rinv * gg[3] * (1.f + sc[3]) + sh[3];
                u32x2 w; w.x = pk2(o0, o1); w.y = pk2(o2, o3);
                *(u32x2*)(hout + (size_t)row * DM + col) = w; }
        }
    }
}

struct MixP {
    const bf16_t* proj; bf16_t* st; float* dec; bf16_t* y; const float2* rope;
    const float* lbl; const float* hgrn_g; const float* ret_g; const float* conv_w; const float* conv_b; const float* dt_bias; const float* a_log;
    const float* dskip; const float* ssm_g; const float* w2; const float* b2; const float* gla_g; int layer;
};

__device__ __forceinline__ bf16x8 frag(LAS unsigned char* lds, int off, int ld, int r0, int ks, int lane) {
    return *(const LAS bf16x8*)(lds + off + (((r0 + (lane & 31)) * ld + 16 * ks + 8 * (lane >> 5)) << 1));
}
__device__ __forceinline__ int rowmap(int r, int lane) { return (r & 3) + 8 * (r >> 2) + 4 * (lane >> 5); }

__device__ __forceinline__ void conv16(LAS unsigned char* lds, int off, int ncols, int col, const float* cw, int seg, float (&out)[16]) {
    const LAS bf16_t* rp = (const LAS bf16_t*)(lds + off) + seg * 16 * ncols + col;
    float u[19];
#pragma unroll
    for (int k = 0; k < 19; ++k) u[k] = bf2f(rp[k * ncols]);
#pragma unroll
    for (int i = 0; i < 16; ++i) out[i] = silu_f(cw[4] + cw[0] * u[i] + cw[1] * u[i + 1] + cw[2] * u[i + 2] + cw[3] * u[i + 3]);
}
__device__ __forceinline__ void conv_w_load(const MixP& p, int chan, float* cw) {
    cw[0] = p.conv_w[chan]; cw[1] = p.conv_w[1024 + chan]; cw[2] = p.conv_w[2048 + chan]; cw[3] = p.conv_w[3072 + chan]; cw[4] = p.conv_b[chan];
}
template <int NCOLS, int NROWS> struct Stg { static constexpr int VPR = NCOLS / 8, NV = NROWS * VPR, NIT = (NV + NTHR - 1) / NTHR; };
template <int NCOLS, int NROWS>
__device__ __forceinline__ void stg_load(const bf16_t* proj, int grow0, int col0, int tid, int zrows, u32x4* r) {
    using S = Stg<NCOLS, NROWS>;
#pragma unroll
    for (int j = 0; j < S::NIT; ++j) { const int vi = tid + NTHR * j, row = vi / S::VPR, cv = vi % S::VPR;
        const bool ok = (vi < S::NV) && (row >= zrows);
        r[j] = ok ? *(const u32x4*)(proj + pidx(grow0 + row, col0 + cv * 8)) : (u32x4){0u, 0u, 0u, 0u}; }
}
template <int NCOLS, int NROWS>
__device__ __forceinline__ void stg_store(LAS unsigned char* lds, int off, int tid, const u32x4* r) {
    using S = Stg<NCOLS, NROWS>;
#pragma unroll
    for (int j = 0; j < S::NIT; ++j) { const int vi = tid + NTHR * j; if (vi < S::NV) *(LAS u32x4*)(lds + off + vi * 16) = r[j]; }
}
__device__ __forceinline__ void store16(LAS unsigned char* lds, int byteoff, const float (&v)[16]) {
    u32x4 a, b; a.x = pk2(v[0], v[1]); a.y = pk2(v[2], v[3]); a.z = pk2(v[4], v[5]); a.w = pk2(v[6], v[7]);
    b.x = pk2(v[8], v[9]); b.y = pk2(v[10], v[11]); b.z = pk2(v[12], v[13]); b.w = pk2(v[14], v[15]);
    *(LAS u32x4*)(lds + byteoff) = a; *(LAS u32x4*)(lds + byteoff + 16) = b;
}
__device__ __forceinline__ void store8(LAS unsigned char* lds, int byteoff, const float (&v)[8]) {
    u32x4 a; a.x = pk2(v[0], v[1]); a.y = pk2(v[2], v[3]); a.z = pk2(v[4], v[5]); a.w = pk2(v[6], v[7]);
    *(LAS u32x4*)(lds + byteoff) = a;
}

constexpr int NUNITS = 128 * 14;
struct Pref { u32x4 raw[11]; u32x4 st[8]; float aux[16]; };
template <int BR, int PASS>
__device__ __forceinline__ void load_A(const MixP& p, int bc, int hu, int tid, Pref& pf) {
    const bf16_t* P = p.proj; const int g0 = bc * 64;
    if constexpr (BR == 0) { stg_load<128, 64>(P, g0, C_AF + hu * 128, tid, 0, pf.raw + 0); stg_load<128, 64>(P, g0, C_AI + hu * 128, tid, 0, pf.raw + 2);
        if constexpr (PASS == 3) stg_load<128, 64>(P, g0, C_AQ + hu * 128, tid, 0, pf.raw + 4); }
    if constexpr (BR == 1) { stg_load<128, 64>(P, g0, C_RK + hu * 128, tid, 0, pf.raw + 0); stg_load<128, 64>(P, g0, C_RV + hu * 128, tid, 0, pf.raw + 2);
        if constexpr (PASS == 3) stg_load<128, 64>(P, g0, C_RQ + hu * 128, tid, 0, pf.raw + 4); }
    if constexpr (BR == 2) { const int zr = ((bc & 63) == 0) ? 3 : 0;
        stg_load<128, 67>(P, g0 - 3, C_XBC + 512 + hu * 128, tid, zr, pf.raw + 0); stg_load<256, 67>(P, g0 - 3, C_XBC + hu * 256, tid, zr, pf.raw + 3);
        if constexpr (PASS == 3) stg_load<128, 67>(P, g0 - 3, C_XBC + 768 + hu * 128, tid, zr, pf.raw + 8); }
    if constexpr (BR == 3) { stg_load<64, 64>(P, g0, C_GK + hu * 64, tid, 0, pf.raw + 0); stg_load<128, 64>(P, g0, C_GV + hu * 128, tid, 0, pf.raw + 1); stg_load<16, 64>(P, g0, C_LR, tid, 0, pf.raw + 3);
        if constexpr (PASS == 3) stg_load<64, 64>(P, g0, C_GQ + hu * 64, tid, 0, pf.raw + 4); }
}
template <int BR, int PASS>
__device__ __forceinline__ void load_B(const MixP& p, int bc, int hu, int tid, Pref& pf) {
    if constexpr (PASS == 3) {
        constexpr int DK = (BR == 3) ? 64 : 128, DV = (BR == 2) ? 256 : 128, NV = DV * DK / 8 / NTHR;
        const int st_off = (BR == 0) ? hu * 16384 : (BR == 1) ? 65536 + hu * 16384 : (BR == 2) ? 131072 + hu * 32768 : 196608 + hu * 8192;
        const bf16_t* stg = p.st + (size_t)bc * ST_PER_BC + st_off;
#pragma unroll
        for (int k = 0; k < NV; ++k) pf.st[k] = *(const u32x4*)(stg + (size_t)(tid + NTHR * k) * 8);
    }
    if constexpr (BR == 1) { const int j = tid & 63, seg = tid >> 6, chunk = bc & 63;
#pragma unroll
        for (int i = 0; i < 8; ++i) { const float2 c = p.rope[(chunk * 64 + seg * 8 + i) * 64 + j]; pf.aux[2 * i] = c.x; pf.aux[2 * i + 1] = c.y; } }
    if constexpr (BR == 2) { if (tid < 64) {
#pragma unroll
            for (int hh = 0; hh < 4; ++hh) pf.aux[hh] = bf2f(p.proj[pidx(bc * 64 + tid, C_DT + hu * 4 + hh)]); } }
    if constexpr (BR == 3) { const int cc = hu * 64 + (tid & 63);
#pragma unroll
        for (int r = 0; r < 16; ++r) pf.aux[r] = p.w2[r * 256 + cc]; }
}
template <int PASS>
__device__ __forceinline__ void load_A_any(const MixP& p, int i, int tid, Pref& pf) {
    const int bc = i / 14, u = i % 14;
    if (u < 4) load_A<0, PASS>(p, bc, u, tid, pf); else if (u < 8) load_A<1, PASS>(p, bc, u - 4, tid, pf);
    else if (u < 10) load_A<2, PASS>(p, bc, u - 8, tid, pf); else load_A<3, PASS>(p, bc, u - 10, tid, pf);
}
template <int PASS>
__device__ __forceinline__ void load_B_any(const MixP& p, int i, int tid, Pref& pf) {
    const int bc = i / 14, u = i % 14;
    if (u < 4) load_B<0, PASS>(p, bc, u, tid, pf); else if (u < 8) load_B<1, PASS>(p, bc, u - 4, tid, pf);
    else if (u < 10) load_B<2, PASS>(p, bc, u - 8, tid, pf); else load_B<3, PASS>(p, bc, u - 10, tid, pf);
}

template <int BR, int PASS>
__device__ __forceinline__ void mixer_unit(const MixP& p, LAS unsigned char* lds, int bc, int hu  ) {
    constexpr int DK = (BR == 3) ? 64 : 128, LDK = DK + 8, NH = (BR == 2) ? 4 : 1, DV = (BR == 2) ? 256 : 128, NT = DV / 128;
    constexpr bool VEC = (BR == 0 || BR == 3);
    const int tid = opaque_tid(), lane = tid & 63, wid = __builtin_amdgcn_readfirstlane(tid >> 6);
    const int chunk = bc & 63;
    const bf16_t* P = p.proj;
    LAS float* SM = (LAS float*)(lds + L_SM);
    LAS bf16_t* QI = (LAS bf16_t*)(lds + L_QI); LAS bf16_t* KI = (LAS bf16_t*)(lds + L_KI); LAS bf16_t* VT = (LAS bf16_t*)(lds + L_VT);
    const int st_off = (BR == 0) ? hu * 16384 : (BR == 1) ? 65536 + hu * 16384 : (BR == 2) ? 131072 + hu * 32768 : 196608 + hu * 8192;
    bf16_t* stg = p.st + (size_t)bc * ST_PER_BC + st_off;
    Pref pf;
    load_A<BR, PASS>(p, bc, hu, tid, pf);
    load_B<BR, PASS>(p, bc, hu, tid, pf);
    constexpr int NTG = (PASS == 3) ? NT : 1;
    const int gcol = (BR == 0) ? C_AG + hu * 128 : (BR == 1) ? C_RG + hu * 128 : (BR == 2) ? C_MZ + hu * 256 : C_GG + hu * 128;
    const float* gain = (BR == 0) ? p.hgrn_g + hu * 128 : (BR == 1) ? p.ret_g + hu * 128 : (BR == 2) ? p.ssm_g + hu * 256 : p.gla_g + hu * 128;
    bf16_t gt[NTG][16]; float gnv[NTG], dskv[NTG];
    float lb = 0.f, bb = 0.f, cwb[5], cwc[5], cwx[5], dtb[4], alg[4];
    if constexpr (BR == 0) { if (p.layer == 1) { const int cc = hu * 128 + (tid & 127); lb = 1.f / (1.f + __expf(p.lbl[cc] - p.lbl[512 + cc])); } }
    if constexpr (BR == 3) bb = p.b2[hu * 64 + (tid & 63)];
    if constexpr (BR == 2) { conv_w_load(p, 512 + hu * 128 + (tid & 127), cwb); if constexpr (PASS == 3) conv_w_load(p, 768 + hu * 128 + (tid & 127), cwc); conv_w_load(p, hu * 256 + (tid & 255), cwx);
#pragma unroll
        for (int hh = 0; hh < 4; ++hh) { dtb[hh] = p.dt_bias[hu * 4 + hh]; alg[hh] = p.a_log[hu * 4 + hh]; } }
    __builtin_amdgcn_sched_barrier(0);

    for (int urep = 0; urep < REP_UPREP; ++urep) {
    if constexpr (BR == 0) {
        constexpr int RQ = L_BIG, RF = (PASS == 3) ? L_BIG + 16384 : L_QI, RV = (PASS == 3) ? L_BIG + 32768 : L_QI + 16384;
        stg_store<128, 64>(lds, RF, tid, pf.raw + 0); stg_store<128, 64>(lds, RV, tid, pf.raw + 2);
        if constexpr (PASS == 3) stg_store<128, 64>(lds, RQ, tid, pf.raw + 4);
        __builtin_amdgcn_sched_barrier(0);
        const int d = tid & 127, seg = tid >> 7;
        __syncthreads();
        const LAS bf16_t* rF = (const LAS bf16_t*)(lds + RF) + seg * 16 * 128 + d;
        const LAS bf16_t* rQ = (const LAS bf16_t*)(lds + RQ) + seg * 16 * 128 + d;
        const LAS bf16_t* rV = (const LAS bf16_t*)(lds + RV) + seg * 16 * 128 + d;
        float cs[16], kk[16]; float run = 0.f;
#pragma unroll
        for (int i = 0; i < 16; ++i) { const float av = fmaxf(bf2f(rF[i * 128]), -60.f); const float e = __expf(-av), sg = __builtin_amdgcn_rcpf(1.f + e);
            const float f = lb + (1.f - lb) * sg; run += __logf(f); cs[i] = run; kk[i] = (1.f - lb) * e * sg; }
        SM[SM_SEG + seg * 128 + d] = run;
        __syncthreads();
        const float t0 = SM[SM_SEG + d], t1 = SM[SM_SEG + 128 + d], t2 = SM[SM_SEG + 256 + d], t3 = SM[SM_SEG + 384 + d];
        const float off = (seg == 0) ? 0.f : (seg == 1) ? t0 : (seg == 2) ? t0 + t1 : t0 + t1 + t2;
        const float ref = t0 + t1, clast = ref + t2 + t3;
        if (seg == 0) { SM[SM_REF + d] = ref; SM[SM_CLAST + d] = clast; }
        float kv[16];
#pragma unroll
        for (int i = 0; i < 16; ++i) { const float c = off + cs[i]; kv[i] = kk[i] * __expf(ref - c);
            if constexpr (PASS == 3) { KI[(seg * 16 + i) * LDK + d] = f2bf(kv[i]);
                const float q = bf2f(rQ[i * 128]); QI[(seg * 16 + i) * LDK + d] = f2bf(silu_f(q) * __expf(c - ref)); } }
        if constexpr (PASS == 1) store16(lds, L_BIG + (d * 72 + seg * 16) * 2, kv);
        unsigned vv[16];
#pragma unroll
        for (int i = 0; i < 16; ++i) vv[i] = rV[i * 128];
        u32x4 a, b; a.x = vv[0] | (vv[1] << 16); a.y = vv[2] | (vv[3] << 16); a.z = vv[4] | (vv[5] << 16); a.w = vv[6] | (vv[7] << 16);
        b.x = vv[8] | (vv[9] << 16); b.y = vv[10] | (vv[11] << 16); b.z = vv[12] | (vv[13] << 16); b.w = vv[14] | (vv[15] << 16);
        *(LAS u32x4*)(lds + L_VT + (d * 72 + seg * 16) * 2) = a; *(LAS u32x4*)(lds + L_VT + (d * 72 + seg * 16) * 2 + 16) = b;
    }
    if constexpr (BR == 1) {
        constexpr int RQ = L_BIG, RK = (PASS == 3) ? L_BIG + 16384 : L_QI, RV = (PASS == 3) ? L_BIG + 32768 : L_QI + 16384;
        const int j = tid & 63, seg = tid >> 6;
        float2 cssn[8];
#pragma unroll
        for (int i = 0; i < 8; ++i) cssn[i] = make_float2(pf.aux[2 * i], pf.aux[2 * i + 1]);
        stg_store<128, 64>(lds, RK, tid, pf.raw + 0); stg_store<128, 64>(lds, RV, tid, pf.raw + 2);
        if constexpr (PASS == 3) stg_store<128, 64>(lds, RQ, tid, pf.raw + 4);
        __builtin_amdgcn_sched_barrier(0);
        const float lg = log1pf(-exp2f(-(5.f + (float)hu)));
        if (tid < 64) { SM[SM_CUM + tid] = (float)(tid + 1) * lg; SM[SM_DT + tid] = 1.f; }
        __syncthreads();
        float k1[8], k2[8];
#pragma unroll
        for (int i = 0; i < 8; ++i) { const int t = seg * 8 + i;
            const LAS bf16_t* rk = (const LAS bf16_t*)(lds + RK) + t * 128 + j;
            const float ka = bf2f(rk[0]) * 0.08838834764831845f, kb = bf2f(rk[64]) * 0.08838834764831845f;
            k1[i] = ka * cssn[i].x - kb * cssn[i].y; k2[i] = ka * cssn[i].y + kb * cssn[i].x;
            if constexpr (PASS == 3) { const LAS bf16_t* rq = (const LAS bf16_t*)(lds + RQ) + t * 128 + j;
                const float qa = bf2f(rq[0]), qb = bf2f(rq[64]);
                QI[t * LDK + j] = f2bf(qa * cssn[i].x - qb * cssn[i].y); QI[t * LDK + j + 64] = f2bf(qa * cssn[i].y + qb * cssn[i].x);
                KI[t * LDK + j] = f2bf(k1[i]); KI[t * LDK + j + 64] = f2bf(k2[i]); } }
        if constexpr (PASS == 1) { store8(lds, L_BIG + (j * 72 + seg * 8) * 2, k1); store8(lds, L_BIG + ((j + 64) * 72 + seg * 8) * 2, k2); }
        const int v = tid & 127, s4 = tid >> 7; float vv[16];
#pragma unroll
        for (int i = 0; i < 16; ++i) { const int s = s4 * 16 + i; float x = bf2f(((const LAS bf16_t*)(lds + RV))[s * 128 + v]);
            if constexpr (PASS == 1) x *= __expf((float)(63 - s) * lg);
            vv[i] = x; }
        store16(lds, L_VT + (v * 72 + s4 * 16) * 2, vv);
    }
    if constexpr (BR == 2) {
        constexpr int RB = (PASS == 3) ? L_BIG : L_QI, RC = L_BIG + 17152, RX = (PASS == 3) ? L_BIG + 34304 : L_BIG + 18432;
        float dtr[4];
#pragma unroll
        for (int hh = 0; hh < 4; ++hh) dtr[hh] = pf.aux[hh];
        stg_store<128, 67>(lds, RB, tid, pf.raw + 0); stg_store<256, 67>(lds, RX, tid, pf.raw + 3);
        if constexpr (PASS == 3) stg_store<128, 67>(lds, RC, tid, pf.raw + 8);
        __builtin_amdgcn_sched_barrier(0);
        if (tid < 64) {
#pragma unroll
            for (int hh = 0; hh < 4; ++hh) {
                const float dt = softplus_f(dtr[hh] + dtb[hh]);
                float la = -dt * __expf(alg[hh]);
#pragma unroll
                for (int o = 1; o < 64; o <<= 1) { const float yv = __shfl_up(la, o); if (tid >= o) la += yv; }
                SM[SM_CUM + hh * 64 + tid] = la; SM[SM_DT + hh * 64 + tid] = dt; }
        }
        __syncthreads();
        { const int n = tid & 127, seg = tid >> 7; float o[16];
          conv16(lds, RB, 128, n, cwb, seg, o);
          if constexpr (PASS == 3) {
#pragma unroll
              for (int i = 0; i < 16; ++i) KI[(seg * 16 + i) * LDK + n] = f2bf(o[i]);
              conv16(lds, RC, 128, n, cwc, seg, o);
#pragma unroll
              for (int i = 0; i < 16; ++i) QI[(seg * 16 + i) * LDK + n] = f2bf(o[i]);
          } else store16(lds, L_BIG + (n * 72 + seg * 16) * 2, o);
        }
        { const int v = tid & 255, s2 = tid >> 8, hh = v >> 6;
#pragma unroll
          for (int r = 0; r < 2; ++r) { const int seg = s2 * 2 + r; float o[16];
              conv16(lds, RX, 256, v, cwx, seg, o);
              if constexpr (PASS == 1) { const float cl = SM[SM_CUM + hh * 64 + 63];
#pragma unroll
                  for (int i = 0; i < 16; ++i) { const int s = seg * 16 + i; o[i] *= __expf(cl - SM[SM_CUM + hh * 64 + s]) * SM[SM_DT + hh * 64 + s]; } }
              store16(lds, L_VT + (v * 72 + seg * 16) * 2, o); }
        }
    }
    if constexpr (BR == 3) {
        constexpr int RQ = L_BIG, RK = (PASS == 3) ? L_BIG + 8192 : L_QI, RV = (PASS == 3) ? L_BIG + 16384 : L_QI + 8192, RL = (PASS == 3) ? L_BIG + 32768 : L_QI + 24576;
        const int d = tid & 63, seg = tid >> 6, cc = hu * 64 + d;
        float w2r[16];
#pragma unroll
        for (int r = 0; r < 16; ++r) w2r[r] = pf.aux[r];
        stg_store<64, 64>(lds, RK, tid, pf.raw + 0); stg_store<128, 64>(lds, RV, tid, pf.raw + 1); stg_store<16, 64>(lds, RL, tid, pf.raw + 3);
        if constexpr (PASS == 3) stg_store<64, 64>(lds, RQ, tid, pf.raw + 4);
        __builtin_amdgcn_sched_barrier(0);
        __syncthreads();
        float cs[8]; float run = 0.f;
#pragma unroll
        for (int i = 0; i < 8; ++i) { const int t = seg * 8 + i; const LAS bf16x8* lp = (const LAS bf16x8*)(lds + RL + t * 32);
            const bf16x8 l0 = lp[0], l1 = lp[1]; float gk = bb;
#pragma unroll
            for (int r = 0; r < 8; ++r) { gk += w2r[r] * bf2f((bf16_t)l0[r]); gk += w2r[8 + r] * bf2f((bf16_t)l1[r]); }
            run += logsig_f(gk) * (1.f / 16.f); cs[i] = run; }
        SM[SM_SEG + seg * 64 + d] = run;
        __syncthreads();
        float off = 0.f, ref = 0.f, clast = 0.f;
#pragma unroll
        for (int s = 0; s < 8; ++s) { const float tv = SM[SM_SEG + s * 64 + d]; if (s < seg) off += tv; if (s < 4) ref += tv; clast += tv; }
        if (seg == 0) { SM[SM_REF + d] = ref; SM[SM_CLAST + d] = clast; }
        float kv[8];
#pragma unroll
        for (int i = 0; i < 8; ++i) { const int t = seg * 8 + i; const float c = off + cs[i];
            kv[i] = bf2f(((const LAS bf16_t*)(lds + RK))[t * 64 + d]) * __expf(ref - c);
            if constexpr (PASS == 3) { KI[t * LDK + d] = f2bf(kv[i]); QI[t * LDK + d] = f2bf(bf2f(((const LAS bf16_t*)(lds + RQ))[t * 64 + d]) * 0.125f * __expf(c - ref)); } }
        if constexpr (PASS == 1) store8(lds, L_BIG + (d * 72 + seg * 8) * 2, kv);
        const int v = tid & 127, s4 = tid >> 7; unsigned vv[16];
#pragma unroll
        for (int i = 0; i < 16; ++i) vv[i] = ((const LAS bf16_t*)(lds + RV))[(s4 * 16 + i) * 128 + v];
        u32x4 a, b; a.x = vv[0] | (vv[1] << 16); a.y = vv[2] | (vv[3] << 16); a.z = vv[4] | (vv[5] << 16); a.w = vv[6] | (vv[7] << 16);
        b.x = vv[8] | (vv[9] << 16); b.y = vv[10] | (vv[11] << 16); b.z = vv[12] | (vv[13] << 16); b.w = vv[14] | (vv[15] << 16);
        *(LAS u32x4*)(lds + L_VT + (v * 72 + s4 * 16) * 2) = a; *(LAS u32x4*)(lds + L_VT + (v * 72 + s4 * 16) * 2 + 16) = b;
    }
    __syncthreads();
    }
    for (int urep = 0; urep < REP_UCORE; ++urep) {
    if constexpr (PASS == 1) {
        constexpr int NTN = DV / 32, NTILES = (DK / 32) * NTN, NTL = NTILES / 8;
        f32x16 hacc[NTL];
#pragma unroll
        for (int i = 0; i < NTL; ++i) {
            const int ti = wid + 8 * i, tm = ti / NTN, tn = ti % NTN;
#pragma unroll
            for (int r = 0; r < 16; ++r) hacc[i][r] = 0.f;
#pragma unroll
            for (int ks = 0; ks < 4; ++ks) hacc[i] = __builtin_amdgcn_mfma_f32_32x32x16_bf16(frag(lds, L_BIG, 72, tm * 32, ks, lane), frag(lds, L_VT, 72, tn * 32, ks, lane), hacc[i], 0, 0, 0);
            if constexpr (VEC) {
#pragma unroll
                for (int r = 0; r < 16; ++r) { const int d = tm * 32 + rowmap(r, lane); hacc[i][r] *= __expf(SM[SM_CLAST + d] - SM[SM_REF + d]); }
            }
        }
        float decv = 0.f;
        if constexpr (BR == 0) { if (tid < 128) decv = __expf(SM[SM_CLAST + tid]); }
        if constexpr (BR == 3) { if (tid < 64) decv = __expf(SM[SM_CLAST + tid]); }
        if constexpr (BR == 2) { if (tid < 4) decv = __expf(SM[SM_CUM + tid * 64 + 63]); }
        __syncthreads();
#pragma unroll
        for (int i = 0; i < NTL; ++i) {
            const int ti = wid + 8 * i, tm = ti / NTN, tn = ti % NTN;
            const int v = tn * 32 + (lane & 31);
#pragma unroll
            for (int rg = 0; rg < 4; ++rg) { const int d0 = tm * 32 + 8 * rg + 4 * (lane >> 5);
                u32x2 w; w.x = pk2(hacc[i][rg * 4 + 0], hacc[i][rg * 4 + 1]); w.y = pk2(hacc[i][rg * 4 + 2], hacc[i][rg * 4 + 3]);
                *(u32x2*)(stg + (size_t)v * DK + d0) = w; }
        }
        float* dec = p.dec + (size_t)bc * 1024;
        if constexpr (BR == 0) { if (tid < 128) dec[hu * 128 + tid] = decv; }
        if constexpr (BR == 3) { if (tid < 64) dec[512 + hu * 64 + tid] = decv; }
        if constexpr (BR == 2) { if (tid < 4) dec[768 + hu * 4 + tid] = decv; }
    } else {
        constexpr int NCT = DV / 32;
    if constexpr (PASS == 3) {
#pragma unroll
            for (int nt = 0; nt < NT; ++nt) { const int ct = (wid & 3) + 4 * nt;
                gnv[nt] = gain[ct * 32 + (lane & 31)]; dskv[nt] = (BR == 2) ? p.dskip[hu * 4 + (ct >> 1)] : 0.f;
#pragma unroll
                for (int r = 0; r < 16; ++r) gt[nt][r] = P[pidx(bc * 64 + (wid >> 2) * 32 + rowmap(r, lane), gcol + ct * 32 + (lane & 31))]; }
        }
        __builtin_amdgcn_sched_barrier(0);
        {
            constexpr int NVEC = DV * DK / 8, VPR = DK / 8;
#pragma unroll
            for (int k = 0; k < NVEC / NTHR; ++k) { const int vi = tid + NTHR * k; const int v = vi / VPR, d0 = (vi % VPR) * 8;
                u32x4 raw = pf.st[k];
                if constexpr (VEC) { unsigned w[4] = {raw.x, raw.y, raw.z, raw.w};
#pragma unroll
                    for (int q = 0; q < 4; ++q) { const float lo = __uint_as_float(w[q] << 16) * __expf(SM[SM_REF + d0 + 2 * q]), hi = __uint_as_float(w[q] & 0xffff0000u) * __expf(SM[SM_REF + d0 + 2 * q + 1]);
                        w[q] = pk2(lo, hi); }
                    raw.x = w[0]; raw.y = w[1]; raw.z = w[2]; raw.w = w[3]; }
                *(LAS u32x4*)(lds + L_BIG + (v * LDK + d0) * 2) = raw; }
        }
        __builtin_amdgcn_sched_barrier(0);
        __syncthreads();
        const int tm = wid >> 2, tnb = wid & 3;
        f32x16 acc[NT];
#pragma unroll
        for (int nt = 0; nt < NT; ++nt)
#pragma unroll
            for (int r = 0; r < 16; ++r) acc[nt][r] = 0.f;
#pragma unroll
        for (int ks = 0; ks < DK / 16; ++ks) { const bf16x8 af = frag(lds, L_QI, LDK, tm * 32, ks, lane);
#pragma unroll
            for (int nt = 0; nt < NT; ++nt) acc[nt] = __builtin_amdgcn_mfma_f32_32x32x16_bf16(af, frag(lds, L_BIG, LDK, (tnb + 4 * nt) * 32, ks, lane), acc[nt], 0, 0, 0); }
        if constexpr (!VEC) {
#pragma unroll
            for (int nt = 0; nt < NT; ++nt) { const int hh = (NH == 1) ? 0 : ((tnb + 4 * nt) >> 1);
#pragma unroll
                for (int r = 0; r < 16; ++r) acc[nt][r] *= __expf(SM[SM_CUM + hh * 64 + tm * 32 + rowmap(r, lane)]); }
        }
        constexpr int P_OFF = (NH == 1) ? L_BIG + 34816 : L_BIG;
        f32x16 sc;
#pragma unroll
        for (int r = 0; r < 16; ++r) sc[r] = 0.f;
        const int w4 = wid & 3, stm = w4 >> 1, stn = w4 & 1, whalf = wid >> 2;
#pragma unroll
        for (int ks = 0; ks < DK / 16; ++ks) sc = __builtin_amdgcn_mfma_f32_32x32x16_bf16(frag(lds, L_QI, LDK, stm * 32, ks, lane), frag(lds, L_KI, LDK, stn * 32, ks, lane), sc, 0, 0, 0);
        if constexpr (NH != 1) __syncthreads();
        {
            const int s = stn * 32 + (lane & 31);
            if constexpr (NH == 1) {
                float cums = 0.f, dts = 1.f;
                if constexpr (!VEC) { cums = SM[SM_CUM + s]; dts = SM[SM_DT + s]; }
#pragma unroll
                for (int r8 = 0; r8 < 8; ++r8) { const int rlo = r8, rhi = r8 + 8; const int r = whalf ? rhi : rlo; const int t = stm * 32 + (whalf ? rowmap(rhi, lane) : rowmap(rlo, lane));
                    float val = whalf ? sc[rhi] : sc[rlo]; (void)r;
                    if constexpr (!VEC) { const float ex = (s <= t) ? SM[SM_CUM + t] - cums : 0.f; val *= __expf(ex) * dts; }
                    val = (s <= t) ? val : 0.f;
                    *(LAS bf16_t*)(lds + P_OFF + (t * 72 + s) * 2) = f2bf(val); }
            } else {
#pragma unroll
                for (int h2 = 0; h2 < NH / 2; ++h2) { const int hh = whalf * (NH / 2) + h2;
                    const float cums = SM[SM_CUM + hh * 64 + s], dts = SM[SM_DT + hh * 64 + s];
#pragma unroll
                    for (int r = 0; r < 16; ++r) { const int t = stm * 32 + rowmap(r, lane);
                        float val = sc[r];
                        const float ex = (s <= t) ? SM[SM_CUM + hh * 64 + t] - cums : 0.f; val *= __expf(ex) * dts;
                        val = (s <= t) ? val : 0.f;
                        *(LAS bf16_t*)(lds + P_OFF + ((hh * 64 + t) * 72 + s) * 2) = f2bf(val); } }
            }
        }
        __syncthreads();
#pragma unroll
        for (int nt = 0; nt < NT; ++nt) { const int hh = (NH == 1) ? 0 : ((tnb + 4 * nt) >> 1);
#pragma unroll
            for (int ks = 0; ks < 4; ++ks) acc[nt] = __builtin_amdgcn_mfma_f32_32x32x16_bf16(frag(lds, P_OFF + hh * 9216, 72, tm * 32, ks, lane), frag(lds, L_VT, 72, (tnb + 4 * nt) * 32, ks, lane), acc[nt], 0, 0, 0); }
        const int ycol = (BR == 0) ? hu * 128 : (BR == 1) ? 512 + hu * 128 : (BR == 2) ? 1024 + hu * 256 : 1536 + hu * 128;
#pragma unroll
        for (int nt = 0; nt < NT; ++nt) { const int ct = tnb + 4 * nt, v = ct * 32 + (lane & 31);
            const float dsk = dskv[nt];
            float sq[16];
#pragma unroll
            for (int r = 0; r < 16; ++r) { const int t = tm * 32 + rowmap(r, lane);
                float val = acc[nt][r];
                if constexpr (BR == 2) { val = (val + dsk * bf2f(VT[v * 72 + t])) * silu_f(bf2f(gt[nt][r])); acc[nt][r] = val; }
                sq[r] = val * val; }
            const bool b4 = lane & 16, b3 = lane & 8, b2 = lane & 4, b1 = lane & 2;
#pragma unroll
            for (int i = 0; i < 8; ++i) { const float lo = sq[i], hi = sq[i + 8]; sq[i] = (b4 ? hi : lo) + __shfl_xor(b4 ? lo : hi, 16); }
#pragma unroll
            for (int i = 0; i < 4; ++i) { const float lo = sq[i], hi = sq[i + 4]; sq[i] = (b3 ? hi : lo) + __shfl_xor(b3 ? lo : hi, 8); }
#pragma unroll
            for (int i = 0; i < 2; ++i) { const float lo = sq[i], hi = sq[i + 2]; sq[i] = (b2 ? hi : lo) + __shfl_xor(b2 ? lo : hi, 4); }
            { const float lo = sq[0], hi = sq[1]; sq[0] = (b1 ? hi : lo) + __shfl_xor(b1 ? lo : hi, 2); }
            sq[0] += __shfl_xor(sq[0], 1);
            const int rr = (b4 ? 8 : 0) + (b3 ? 4 : 0) + (b2 ? 2 : 0) + (b1 ? 1 : 0);
            if ((lane & 1) == 0) SM[SM_RSS + ct * 64 + tm * 32 + rowmap(rr, lane)] = sq[0];
        }
        __syncthreads();
        if (tid < 64) { float tot = 0.f;
#pragma unroll
            for (int q = 0; q < NCT; ++q) tot += SM[SM_RSS + q * 64 + tid];
            SM[SM_SEG + tid] = rsqrtf(tot * (1.f / DV) + EPS); }
        __syncthreads();
        float rinv[16];
#pragma unroll
        for (int r = 0; r < 16; ++r) rinv[r] = SM[SM_SEG + tm * 32 + rowmap(r, lane)];
        __syncthreads();
#pragma unroll
        for (int nt = 0; nt < NT; ++nt) { const int ct = tnb + 4 * nt, v = ct * 32 + (lane & 31);
            const float gn = gnv[nt];
#pragma unroll
            for (int r = 0; r < 16; ++r) { const int t = tm * 32 + rowmap(r, lane);
                float o = acc[nt][r] * rinv[r] * gn;
                if constexpr (BR != 2) o *= silu_f(bf2f(gt[nt][r]));
                p.y[(size_t)(bc * 64 + t) * DI + ycol + v] = f2bf(o); }
        }
    }
    }
}

template <int PASS>
__device__ __forceinline__ void phase_mixer(const MixP& p, LAS unsigned char* lds) {
#pragma unroll 1
    for (int i = blockIdx.x; i < NUNITS; i += gridDim.x) {
        const int bc = i / 14, u = i % 14;
        if (u < 4) mixer_unit<0, PASS>(p, lds, bc, u);
        else if (u < 8) mixer_unit<1, PASS>(p, lds, bc, u - 4);
        else if (u < 10) mixer_unit<2, PASS>(p, lds, bc, u - 8);
        else mixer_unit<3, PASS>(p, lds, bc, u - 10);
    }
}

__device__ __forceinline__ void phase_scan(bf16_t* st, const float* dec) {
    const int gt = blockIdx.x * NTHR + opaque_tid();
    constexpr int VPB = ST_PER_BC / 4;
    if (gt >= 2 * VPB) return;
    const int bl = gt / VPB, e0 = (gt % VPB) * 4;
    int mode, didx = 0; float cfac = 0.f;
    if (e0 < 65536) { mode = 0; didx = (e0 >> 14) * 128 + (e0 & 127); }
    else if (e0 < 131072) { mode = 1; const int h = (e0 - 65536) >> 14; cfac = __expf(64.f * log1pf(-exp2f(-(5.f + (float)h)))); }
    else if (e0 < 196608) { mode = 2; const int r = e0 - 131072; didx = 768 + (r >> 15) * 4 + (((r & 32767) >> 7) >> 6); }
    else { mode = 0; const int r = e0 - 196608; didx = 512 + (r >> 13) * 64 + (r & 63); }
    float s0 = 0.f, s1 = 0.f, s2 = 0.f, s3 = 0.f;
    bf16_t* ptr = st + (size_t)bl * 64 * ST_PER_BC + e0;
    const float* dp = dec + (size_t)bl * 64 * 1024 + didx;
#pragma unroll 1
    for (int c0 = 0; c0 < 64; c0 += 8) {
        u32x2 hv[8]; f32x4 dv[8];
#pragma unroll
        for (int j = 0; j < 8; ++j) {
            hv[j] = *(const u32x2*)(ptr + (size_t)(c0 + j) * ST_PER_BC);
            if (mode == 0) dv[j] = *(const f32x4*)(dp + (size_t)(c0 + j) * 1024);
            else if (mode == 1) dv[j] = (f32x4){cfac, cfac, cfac, cfac};
            else { const float d = dp[(size_t)(c0 + j) * 1024]; dv[j] = (f32x4){d, d, d, d}; }
        }
        __builtin_amdgcn_sched_barrier(0);
#pragma unroll
        for (int j = 0; j < 8; ++j) {
            u32x2 w; w.x = pk2(s0, s1); w.y = pk2(s2, s3);
            *(u32x2*)(ptr + (size_t)(c0 + j) * ST_PER_BC) = w;
            s0 = s0 * dv[j][0] + __uint_as_float(hv[j].x << 16); s1 = s1 * dv[j][1] + __uint_as_float(hv[j].x & 0xffff0000u);
            s2 = s2 * dv[j][2] + __uint_as_float(hv[j].y << 16); s3 = s3 * dv[j][3] + __uint_as_float(hv[j].y & 0xffff0000u);
        }
    }
}


#define XB_TMO      128
#define XB_XCNT(j)  (256  + 64 * (j))
#define XB_XSUB(j)  (1280 + 64 * (j))
#define XB_XGEN(j)  (2304 + 64 * (j))
#define XB_TOP      3328
#define XB_TOPGEN   3392
#define XCD_BAR_WORDS 3456
#define XB_SPIN_CAP (1u << 18)
__device__ __forceinline__ unsigned xb_ld(unsigned* p)              { return __hip_atomic_load(p, __ATOMIC_RELAXED, __HIP_MEMORY_SCOPE_AGENT); }
__device__ __forceinline__ unsigned xb_add(unsigned* p, unsigned v) { return __hip_atomic_fetch_add(p, v, __ATOMIC_RELAXED, __HIP_MEMORY_SCOPE_AGENT); }
__device__ __forceinline__ unsigned xb_xcc_id() { return (unsigned)__builtin_amdgcn_s_getreg((3 << 11) | 20) & 0xFu; }
#define XB_SPIN(cond, bar) do { unsigned _sp = 0; while (cond) { __builtin_amdgcn_s_sleep(1); \
    if ((++_sp & 255u) == 0u) { if (xb_ld(&(bar)[XB_TMO])) break; if (_sp > XB_SPIN_CAP) { atomicAdd(&(bar)[XB_TMO], 1u); break; } } } } while (0)
struct XcdBarrier { unsigned* bar; unsigned x; volatile LAS unsigned* st; };
__device__ __forceinline__ XcdBarrier xcd_barrier_post(unsigned* bar, volatile LAS unsigned* st) {
    XcdBarrier b; b.bar = bar; b.x = xb_xcc_id(); b.st = st;
    if (threadIdx.x == 0) (void)xb_add(&bar[XB_XCNT(b.x)], 1u);
    return b;
}
__device__ __forceinline__ void xcd_barrier_complete(unsigned* bar, unsigned x, unsigned& nloc, unsigned& nx) {
    const unsigned G = gridDim.x * gridDim.y * gridDim.z;
    unsigned sum, cnt, mine, sp = 0u;
    for (;;) {
        sum = 0u; cnt = 0u; mine = 0u;
#pragma unroll
        for (unsigned j = 0; j < 16; ++j) { const unsigned c = xb_ld(&bar[XB_XCNT(j)]); sum += c; cnt += (c > 0u) ? 1u : 0u; mine = (j == x) ? c : mine; }
        if (sum == G) break;
        __builtin_amdgcn_s_sleep(1);
        if ((++sp & 255u) == 0u) { if (xb_ld(&bar[XB_TMO])) break; if (sp > XB_SPIN_CAP) { atomicAdd(&bar[XB_TMO], 1u); break; } }
    }
    nloc = mine > 0u ? mine : 1u; nx = cnt > 0u ? cnt : 1u;
}
__device__ __forceinline__ void xcd_barrier(const XcdBarrier& b) {
    asm volatile("s_waitcnt vmcnt(0)" ::: "memory");
    __syncthreads();
    if (threadIdx.x == 0) {
        unsigned* bar = b.bar;
        __builtin_amdgcn_s_waitcnt(0);
        unsigned nloc = b.st[0], nx = b.st[1];
        if (nloc == 0u) { xcd_barrier_complete(bar, b.x, nloc, nx); b.st[0] = nloc; b.st[1] = nx; }
        const unsigned old = xb_add(&bar[XB_XSUB(b.x)], 1u);
        const unsigned gen = old / nloc;
        if (old + 1u == (gen + 1u) * nloc) {
            __builtin_amdgcn_fence(__ATOMIC_RELEASE, "agent");
            asm volatile("s_waitcnt vmcnt(0)" ::: "memory");
            const unsigned og = xb_add(&bar[XB_TOP], 1u);
            const unsigned tg = og / nx;
            if (og + 1u == (tg + 1u) * nx) xb_add(&bar[XB_TOPGEN], 1u);
            else XB_SPIN(xb_ld(&bar[XB_TOPGEN]) == tg, bar);
            __builtin_amdgcn_fence(__ATOMIC_ACQUIRE, "agent");
            xb_add(&bar[XB_XGEN(b.x)], 1u);
            asm volatile("s_waitcnt vmcnt(0)" ::: "memory");
        } else {
            XB_SPIN(xb_ld(&bar[XB_XGEN(b.x)]) == gen, bar);
            __builtin_amdgcn_fence(__ATOMIC_ACQUIRE, "agent");
            asm volatile("s_waitcnt vmcnt(0)" ::: "memory");
        }
    }
    __syncthreads();
}

__global__ void __launch_bounds__(NTHR, 2) fwd_megakernel(Args a) {
    extern __shared__ __attribute__((aligned(16))) unsigned char shm[];
    LAS unsigned char* lds = (LAS unsigned char*)shm;
    cg::grid_group grid = cg::this_grid();
    unsigned char* ws = a.ws;
    const int G = gridDim.x;

    {
        volatile LAS unsigned* stw = (volatile LAS unsigned*)(lds + L_BARST);
        if (threadIdx.x < 2) stw[threadIdx.x] = 0u;
        __syncthreads();
    }
    const XcdBarrier gbar = xcd_barrier_post((unsigned*)(ws + WS_BAR), (volatile LAS unsigned*)(lds + L_BARST));
    for (int rep = 0; rep < REP_PREP; ++rep) { phase_prep(a, lds); if (rep == 0) grid.sync(); else xcd_barrier(gbar); }

    bf16_t* hbuf = (bf16_t*)(ws + WS_HY); bf16_t* ybuf = (bf16_t*)(ws + WS_HY);
    bf16_t* proj = (bf16_t*)(ws + WS_PROJ); bf16_t* st = (bf16_t*)(ws + WS_ST); float* dec = (float*)(ws + WS_DEC);
    const float* mod = (const float*)(ws + WS_MOD);

#pragma unroll 1
    for (int half = 0; half < 2; ++half) {
        const size_t xoff = (size_t)half * HROWS * DM;
#pragma unroll 1
        for (int l = 0; l < DEPTH; ++l) {
            const float* modl = mod + (size_t)l * 4 * 3072;
            bf16_t* slab = (bf16_t*)(ws + WS_PROJ);
            if (l == 0) { phase_norm<false>(a.x + xoff, nullptr, nullptr, nullptr, a.norm_g, modl, half, hbuf); if (half == 0) phase_wcvt(a, lds); }
            else phase_norm<false>(a.x + xoff, slab, mod + (size_t)(half * 2) * 3072 + 2048, a.out + xoff, a.norm_g + l * DM, modl, half, hbuf);
            xcd_barrier(gbar);
            for (int rep = 0; rep < REP_G1; ++rep) {
                pg8::Gemm g{hbuf, (const bf16_t*)(ws + WS_WIN) + (size_t)l * LDP * DM, HROWS, LDP, DM, DM};
                pg8::StaticOrder S; S.init(HROWS, LDP, G, (int)blockIdx.x);
                pg8::EpiProj E{proj, LDP};
                pg8::gemm_phase<pg8::EpiProj, pg8::StaticOrder>(lds, g, S, E);
                xcd_barrier(gbar);
            }
            MixP p;
            p.proj = proj; p.st = st; p.dec = dec; p.y = ybuf; p.rope = (const float2*)(ws + WS_ROPE);
            p.lbl = a.lb_logits; p.hgrn_g = a.hgrn_g + l * 512; p.ret_g = a.ret_g + l * 512; p.conv_w = a.conv_w + l * 4096; p.conv_b = a.conv_b + l * 1024;
            p.dt_bias = a.dt_bias + l * 8; p.a_log = a.a_log + l * 8; p.dskip = a.dskip + l * 8; p.ssm_g = a.ssm_g + l * 512;
            p.w2 = a.w_gk2 + l * 16 * 256; p.b2 = a.b_gk2 + l * 256; p.gla_g = a.gla_g + l * 512; p.layer = l;
            for (int rep = 0; rep < REP_M12; ++rep) { phase_mixer<1>(p, lds); xcd_barrier(gbar); phase_scan(st, dec); xcd_barrier(gbar); }
            for (int rep = 0; rep < REP_M3; ++rep) { phase_mixer<3>(p, lds); xcd_barrier(gbar); }
            for (int rep = 0; rep < REP_G2; ++rep) {
                pg8::Gemm g{ybuf, (const bf16_t*)(ws + WS_WOUT) + (size_t)l * DM * DI, HROWS, DM, DI / 2, DI};
                pg8::SplitOrder S; S.init(HROWS, DM, G, (int)blockIdx.x);
                pg8::EpiSlab E{slab};
                pg8::gemm_phase<pg8::EpiSlab, pg8::SplitOrder>(lds, g, S, E);
                xcd_barrier(gbar);
            }
        }
        phase_norm<true>(a.out + xoff, (const bf16_t*)(ws + WS_PROJ), mod + (size_t)(4 + half * 2) * 3072 + 2048, a.out + xoff, a.final_g, nullptr, half, nullptr);
    }
}

extern "C" void kernel_launch(void* const* d_in, const int* in_sizes, int n_in, void* d_out, int out_size, void* d_ws, size_t ws_size, hipStream_t stream) {
    static int grid = 0;
    if (grid == 0) {
        if (n_in != 20 || ws_size < WS_END) { fprintf(stderr, "kernel_launch: unexpected n_in %d / ws_size %zu (need %zu)\n", n_in, ws_size, (size_t)WS_END); grid = -1; return; }
        int dev = 0, cus = 0, per_cu = 0;
        hipGetDevice(&dev);
        hipDeviceGetAttribute(&cus, hipDeviceAttributeMultiprocessorCount, dev);
        if (hipFuncSetAttribute((const void*)fwd_megakernel, hipFuncAttributeMaxDynamicSharedMemorySize, LDS_BYTES) != hipSuccess) { fprintf(stderr, "kernel_launch: hipFuncSetAttribute failed\n"); grid = -1; return; }
        hipOccupancyMaxActiveBlocksPerMultiprocessor(&per_cu, (const void*)fwd_megakernel, NTHR, LDS_BYTES);
        if (per_cu < 1) { fprintf(stderr, "kernel_launch: occupancy query says %d blocks per CU\n", per_cu); per_cu = 1; }
        (void)hipGetLastError();
        grid = cus * per_cu;
    }
    if (grid < 0) return;
    Args a{};
    const float** f = (const float**)&a;
    for (int i = 0; i < 20; ++i) f[i] = (const float*)d_in[i];
    a.out = (float*)d_out; a.ws = (unsigned char*)d_ws;
    void* args[] = {&a};
    if (hipMemsetAsync((char*)d_ws + WS_BAR, 0, XCD_BAR_WORDS * 4, stream) != hipSuccess) { fprintf(stderr, "kernel_launch: memset of barrier words failed\n"); return; }
    hipError_t e = hipLaunchCooperativeKernel((const void*)fwd_megakernel, dim3(grid), dim3(NTHR), args, LDS_BYTES, stream);
    if (e != hipSuccess) fprintf(stderr, "cooperative launch failed: %s (grid %d)\n", hipGetErrorString(e), grid);
}
```

```cpp
#include <hip/hip_runtime.h>
#include <hip/hip_cooperative_groups.h>
#include <cstdio>
namespace cg = cooperative_groups;

#define LAS __attribute__((address_space(3)))
typedef unsigned short bf16_t;
typedef short bf16x8 __attribute__((ext_vector_type(8)));
typedef float f32x4 __attribute__((ext_vector_type(4)));
typedef float f32x16 __attribute__((ext_vector_type(16)));
typedef unsigned u32x4 __attribute__((ext_vector_type(4)));
typedef unsigned u32x2 __attribute__((ext_vector_type(2)));

#ifndef REP_PREP
#define REP_PREP 1
#endif
#ifndef REP_NORM
#define REP_NORM 1
#endif
#ifndef REP_G1
#define REP_G1 1
#endif
#ifndef REP_M12
#define REP_M12 1
#endif
#ifndef REP_M3
#define REP_M3 1
#endif
#ifndef REP_G2
#define REP_G2 1
#endif
#ifndef REP_UPREP
#define REP_UPREP 1
#endif
#ifndef REP_UCORE
#define REP_UCORE 1
#endif
constexpr int NB = 4, SEQ = 4096, DM = 1024, DEPTH = 2, DI = 2048;
constexpr int NIN = 7192, LDP = 7424;
constexpr int HROWS = 8192;
constexpr int NTHR = 512;
constexpr float EPS = 1e-6f;
constexpr int C_AQ = 0, C_AF = 512, C_AI = 1024, C_AG = 1536, C_RQ = 2048, C_RK = 2560, C_RV = 3072, C_RG = 3584,
              C_MZ = 4096, C_XBC = 4608, C_GQ = 5632, C_GK = 5888, C_GV = 6144, C_GG = 6656, C_DT = 7168, C_LR = 7176;
constexpr int ST_PER_BC = 229376;
constexpr size_t WS_WIN = 0;
constexpr size_t WS_WOUT = WS_WIN + 2ull * LDP * DM * 2;
constexpr size_t WS_MOD = WS_WOUT + 2ull * DM * DI * 2;
constexpr size_t WS_ROPE = WS_MOD + 2ull * 4 * 3072 * 4;
constexpr size_t WS_DEC = WS_ROPE + 4096ull * 64 * 8;
constexpr size_t WS_HY = WS_DEC + 128ull * 1024 * 4;
constexpr size_t WS_PROJ = WS_HY + (size_t)HROWS * DI * 2;
constexpr size_t WS_ST = WS_PROJ + (size_t)HROWS * LDP * 2;
constexpr size_t WS_BAR = WS_ST + 128ull * ST_PER_BC * 2;
constexpr size_t WS_END = WS_BAR + 3456 * 4;
constexpr int L_QI = 0, L_KI = 17408, L_VT = 34816, L_BIG = 71680, L_SM = 141312;
constexpr int SM_CUM = 0, SM_DT = 256, SM_SEG = 512, SM_REF = 1536, SM_CLAST = 1664, SM_RSS = 1792;
constexpr int L_BARST = L_SM + (1792 + 512) * 4;
constexpr int LDS_BYTES = L_BARST + 16;

constexpr int NCG = LDP / 128;
__device__ __forceinline__ size_t pidx(int row, int col) { return ((size_t)((row >> 6) * NCG + (col >> 7)) * 64 + (row & 63)) * 128 + (col & 127); }
__device__ __forceinline__ float bf2f(bf16_t v) { return __uint_as_float(((unsigned)v) << 16); }
__device__ __forceinline__ bf16_t f2bf(float f) { unsigned u = __float_as_uint(f); u += 0x7FFFu + ((u >> 16) & 1u); return (bf16_t)(u >> 16); }
typedef float f32x2_t __attribute__((ext_vector_type(2)));
typedef __bf16 bf16x2_t __attribute__((ext_vector_type(2)));
__device__ __forceinline__ unsigned pk2(float lo, float hi) { f32x2_t v = {lo, hi}; bf16x2_t b = __builtin_convertvector(v, bf16x2_t); return __builtin_bit_cast(unsigned, b); }
__device__ __forceinline__ int opaque_tid() { int t = threadIdx.x; asm volatile("" : "+v"(t)); return t; }
__device__ __forceinline__ float silu_f(float x) { return x * __builtin_amdgcn_rcpf(1.f + __expf(-x)); }
__device__ __forceinline__ float softplus_f(float x) { return fmaxf(x, 0.f) + __logf(1.f + __expf(-fabsf(x))); }
__device__ __forceinline__ float logsig_f(float x) { return fminf(x, 0.f) - __logf(1.f + __expf(-fabsf(x))); }

namespace pg8 {
constexpr int BM = 256, BK = 64, HALF = 128, HTB = HALF * BK * 2, STAGE_BYTES = 8 * HTB, NXCD = 8, WGM = 8;
__device__ __forceinline__ int lds_byte(int r, int c) { const int st = (r >> 4) * 2 + (c >> 5), rr = r & 15, cc = c & 31, ob = rr * 64 + cc * 2; return st * 1024 + (ob ^ (((ob >> 9) & 1) << 5)); }
__device__ __forceinline__ void stage_rc(int b, int& R, int& C) { const int st = b / 1024, sb = b % 1024, swz = sb ^ (((sb >> 9) & 1) << 5); R = (st >> 1) * 16 + swz / 64; C = (st & 1) * 32 + (swz % 64) / 2; }
__device__ __forceinline__ int perm32(int rho) { const int n = rho >> 4, i = rho & 15; return 8 * (i >> 2) + 4 * n + (i & 3); }
struct Unit { int pm, pn, kh; };
struct Gemm { const bf16_t* A; const bf16_t* Bt; int M, N, K, ld; };
struct StaticOrder {
    int nM, nN, nwg, G, c;
    __device__ void init(int M, int N, int G_, int c_) { nM = M / BM; nN = N / BM; nwg = nM * nN; G = G_; c = c_; }
    __device__ bool next(int i, Unit& u) const {
        const long L = (long)i * G + c; if (L >= nwg) return false;
        int wgid = (int)L; { const int q = nwg / NXCD, r = nwg % NXCD, xcd = wgid % NXCD, off = wgid / NXCD; wgid = (xcd < r ? xcd * (q + 1) : r * (q + 1) + (xcd - r) * q) + off; }
        const int nig = WGM * nN, gid = wgid / nig, fm = gid * WGM, gsz = (nM - fm) < WGM ? (nM - fm) : WGM;
        u.pm = fm + ((wgid % nig) % gsz); u.pn = (wgid % nig) / gsz; u.kh = 0; return true;
    }
};
struct SplitOrder {
    StaticOrder so;
    __device__ void init(int M, int N, int G_, int c_) { so.init(M, 2 * N, G_, c_); }
    __device__ bool next(int i, Unit& u) const { if (!so.next(i, u)) return false; u.kh = u.pn & 1; u.pn >>= 1; return true; }
};
struct EpiProj {
    static constexpr bool PERM = true;
    bf16_t* O; int ldc;
    __device__ __forceinline__ void operator()(const f32x4 (&acc)[2][2][4][2], const Unit& u, int wr, int wc, int fr, int fq) const {
        bf16_t* base = O + ((size_t)((u.pm * 4 + wr) * NCG + u.pn * 2) * 64 + fr) * 128 + wc * 32 + 8 * fq;
#pragma unroll
        for (int ai = 0; ai < 2; ++ai)
#pragma unroll
            for (int m = 0; m < 4; ++m)
#pragma unroll
                for (int bj = 0; bj < 2; ++bj) { const f32x4 v0 = acc[ai][bj][m][0], v1 = acc[ai][bj][m][1];
                    u32x4 w; w.x = pk2(v0[0], v0[1]); w.y = pk2(v0[2], v0[3]); w.z = pk2(v1[0], v1[1]); w.w = pk2(v1[2], v1[3]);
                    *(u32x4*)(base + (size_t)ai * (2 * NCG * 8192) + bj * 8192 + m * (16 * 128)) = w; }
    }
};
struct EpiRes {
    static constexpr bool PERM = false;
    const float* xin; float* xout; const float* gate;
    __device__ __forceinline__ void operator()(const f32x4 (&acc)[2][2][4][2], const Unit& u, int wr, int wc, int fr, int fq) const {
        const int row0 = u.pm * BM + wr * 64 + fr, col0 = u.pn * BM + wc * 32 + 4 * fq;
        const float* gp = gate + (size_t)(u.pm >> 4) * 3072 + col0;
        f32x4 gv[2][2];
#pragma unroll
        for (int bj = 0; bj < 2; ++bj)
#pragma unroll
            for (int n = 0; n < 2; ++n) gv[bj][n] = *(const f32x4*)(gp + bj * HALF + n * 16);
#pragma unroll
        for (int am = 0; am < 4; ++am) {
            const int ai = am >> 1, m0 = (am & 1) * 2;
            f32x4 xi[2][2][2];
#pragma unroll
            for (int m = 0; m < 2; ++m)
#pragma unroll
                for (int bj = 0; bj < 2; ++bj)
#pragma unroll
                    for (int n = 0; n < 2; ++n) xi[m][bj][n] = *(const f32x4*)(xin + (size_t)(row0 + ai * HALF + (m0 + m) * 16) * DM + col0 + bj * HALF + n * 16);
            __builtin_amdgcn_sched_barrier(0);
#pragma unroll
            for (int m = 0; m < 2; ++m)
#pragma unroll
                for (int bj = 0; bj < 2; ++bj)
#pragma unroll
                    for (int n = 0; n < 2; ++n) *(f32x4*)(xout + (size_t)(row0 + ai * HALF + (m0 + m) * 16) * DM + col0 + bj * HALF + n * 16) = xi[m][bj][n] + gv[bj][n] * acc[ai][bj][m0 + m][n];
        }
    }
};

struct EpiSlab {
    static constexpr bool PERM = true;
    bf16_t* slab;
    __device__ __forceinline__ void operator()(const f32x4 (&acc)[2][2][4][2], const Unit& u, int wr, int wc, int fr, int fq) const {
        const int row0 = u.pm * BM + wr * 64 + fr, col0 = u.pn * BM + wc * 32 + 8 * fq;
        bf16_t* base = slab + (size_t)u.kh * HROWS * DM;
#pragma unroll
        for (int ai = 0; ai < 2; ++ai)
#pragma unroll
            for (int m = 0; m < 4; ++m) { bf16_t* rowp = base + (size_t)(row0 + ai * HALF + m * 16) * DM + col0;
#pragma unroll
                for (int bj = 0; bj < 2; ++bj) { const f32x4 v0 = acc[ai][bj][m][0], v1 = acc[ai][bj][m][1];
                    u32x4 w; w.x = pk2(v0[0], v0[1]); w.y = pk2(v0[2], v0[3]); w.z = pk2(v1[0], v1[1]); w.w = pk2(v1[2], v1[3]);
                    *(u32x4*)(rowp + bj * HALF) = w; } }
    }
};

template <class Epi, class Sched>
__device__ __forceinline__ void gemm_phase(LAS unsigned char* lds, const Gemm g, const Sched& S, const Epi& E) {
    const int tid = opaque_tid(), wid = __builtin_amdgcn_readfirstlane(tid >> 6), lane = tid & 63, wr = wid >> 2, wc = wid & 3, fr = lane & 15, fq = lane >> 4;
    const int K = g.K, nt = K / BK, ld = g.ld;
    unsigned voffA[2], voffB[2];
#pragma unroll
    for (int i = 0; i < 2; ++i) { int R, C; stage_rc(tid * 16 + i * 8192, R, C); const int Rb = Epi::PERM ? ((R & ~31) + perm32(R & 31)) : R;
        voffA[i] = (unsigned)(R * ld + C) * 2u; voffB[i] = (unsigned)(Rb * ld + C) * 2u; }
    const size_t kstep = (size_t)(BK * 2);
    const size_t hstep = (size_t)HALF * ld * 2;
    const size_t tstep = 2 * hstep;
    const unsigned ldsw = (unsigned)wid * 1024u;
    const int aoff = lds_byte(wr * 64 + fr, fq * 8), boff = lds_byte(wc * 32 + fr, fq * 8);
#define PG8_SA(b, h) (((b) * 2 + (h)) * HTB)
#define PG8_SB(b, h) ((4 + (b) * 2 + (h)) * HTB)
#define PG8_STAGE(bufoff, gbase, voff) do { _Pragma("unroll") for (int _i = 0; _i < 2; ++_i) \
        __builtin_amdgcn_global_load_lds((const unsigned*)((const char*)(gbase) + (voff)[_i]), (LAS unsigned*)(lds + (bufoff) + ldsw + _i * 8192), 16, 0, 0); } while (0)
#define PG8_LDA(dst, b, h) do { _Pragma("unroll") for (int m = 0; m < 4; ++m) _Pragma("unroll") for (int k = 0; k < 2; ++k) dst[m][k] = *(const LAS bf16x8*)(lds + PG8_SA(b, h) + aoff + m * 2048 + k * 1024); } while (0)
#define PG8_LDB(dst, b, h) do { _Pragma("unroll") for (int n = 0; n < 2; ++n) _Pragma("unroll") for (int k = 0; k < 2; ++k) dst[n][k] = *(const LAS bf16x8*)(lds + PG8_SB(b, h) + boff + n * 2048 + k * 1024); } while (0)
#define PG8_MMA(ai, bj, At, Bt) do { __builtin_amdgcn_s_setprio(1); _Pragma("unroll") for (int m = 0; m < 4; ++m) _Pragma("unroll") for (int n = 0; n < 2; ++n) _Pragma("unroll") for (int k = 0; k < 2; ++k) \
        acc[ai][bj][m][n] = __builtin_amdgcn_mfma_f32_16x16x32_bf16(Bt[n][k], At[m][k], acc[ai][bj][m][n], 0, 0, 0); __builtin_amdgcn_s_setprio(0); } while (0)
#define PG8_WAIT_V(n) asm volatile("s_waitcnt vmcnt(" #n ")" ::: "memory")
#define PG8_WAIT_L(n) asm volatile("s_waitcnt lgkmcnt(" #n ")" ::: "memory")
#define PG8_BAR __builtin_amdgcn_s_barrier()
#define PG8_SCHED __builtin_amdgcn_sched_barrier(0)
    Unit cur, nxt; int ui = 0;
    if (!S.next(0, cur)) return;
    f32x4 acc[2][2][4][2];
#pragma unroll
    for (int a = 0; a < 2; ++a)
#pragma unroll
        for (int b = 0; b < 2; ++b)
#pragma unroll
            for (int m = 0; m < 4; ++m)
#pragma unroll
                for (int n = 0; n < 2; ++n) acc[a][b][m][n] = (f32x4){0.f, 0.f, 0.f, 0.f};
    bf16x8 At[4][2], B0[2][2], B1[2][2];
    const char* cA = (const char*)g.A + (size_t)cur.pm * tstep + (size_t)cur.kh * K * 2; const char* cB = (const char*)g.Bt + (size_t)cur.pn * tstep + (size_t)cur.kh * K * 2;
    PG8_STAGE(PG8_SB(0, 0), cB, voffB); PG8_STAGE(PG8_SA(0, 0), cA, voffA); PG8_STAGE(PG8_SB(0, 1), cB + hstep, voffB); PG8_STAGE(PG8_SA(0, 1), cA + hstep, voffA);
    if (wr == 1) PG8_BAR;
    PG8_WAIT_V(4); PG8_BAR;
    PG8_STAGE(PG8_SB(1, 0), cB + kstep, voffB); PG8_STAGE(PG8_SA(1, 0), cA + kstep, voffA); PG8_STAGE(PG8_SB(1, 1), cB + hstep + kstep, voffB);
    PG8_WAIT_V(6); PG8_BAR;
    for (;;) {
        const bool has_next = S.next(ui + 1, nxt);
        const char* nA = has_next ? (const char*)g.A + (size_t)nxt.pm * tstep + (size_t)nxt.kh * K * 2 : cA; const char* nB = has_next ? (const char*)g.Bt + (size_t)nxt.pn * tstep + (size_t)nxt.kh * K * 2 : cB;
        for (int t = 0; t < nt; t += 2) {
            const bool last = (t == nt - 2);
            const char* a1 = cA + (size_t)(t + 1) * kstep;
            const char* a2 = last ? nA : cA + (size_t)(t + 2) * kstep; const char* b2 = last ? nB : cB + (size_t)(t + 2) * kstep;
            const char* a3 = a2 + kstep; const char* b3 = b2 + kstep;
            PG8_LDB(B0, 0, 0); PG8_SCHED; PG8_LDA(At, 0, 0); PG8_STAGE(PG8_SA(1, 1), a1 + hstep, voffA);
            PG8_WAIT_L(8); PG8_BAR; PG8_WAIT_L(0); PG8_MMA(0, 0, At, B0); PG8_BAR; PG8_SCHED;
            PG8_LDB(B1, 0, 1); PG8_STAGE(PG8_SB(0, 0), b2, voffB);
            PG8_BAR; PG8_WAIT_L(0); PG8_MMA(0, 1, At, B1); PG8_BAR;
            PG8_LDA(At, 0, 1); PG8_STAGE(PG8_SA(0, 0), a2, voffA);
            PG8_BAR; PG8_WAIT_L(0); PG8_MMA(1, 0, At, B0); PG8_BAR; PG8_SCHED;
            PG8_STAGE(PG8_SB(0, 1), b2 + hstep, voffB);
            PG8_WAIT_V(6); PG8_BAR; PG8_MMA(1, 1, At, B1); PG8_BAR;
            PG8_LDB(B0, 1, 0); PG8_SCHED; PG8_LDA(At, 1, 0); PG8_STAGE(PG8_SA(0, 1), a2 + hstep, voffA);
            PG8_WAIT_L(8); PG8_BAR; PG8_WAIT_L(0); PG8_MMA(0, 0, At, B0); PG8_BAR; PG8_SCHED;
            PG8_LDB(B1, 1, 1); PG8_STAGE(PG8_SB(1, 0), b3, voffB);
            PG8_BAR; PG8_WAIT_L(0); PG8_MMA(0, 1, At, B1); PG8_BAR;
            PG8_LDA(At, 1, 1); PG8_STAGE(PG8_SA(1, 0), a3, voffA);
            PG8_BAR; PG8_WAIT_L(0); PG8_MMA(1, 0, At, B0); PG8_BAR; PG8_SCHED;
            PG8_STAGE(PG8_SB(1, 1), b3 + hstep, voffB);
            PG8_WAIT_V(6); PG8_BAR; PG8_MMA(1, 1, At, B1); PG8_BAR;
        }
        E(acc, cur, wr, wc, fr, fq);
        if (!has_next) break;
#pragma unroll
        for (int a = 0; a < 2; ++a)
#pragma unroll
            for (int b = 0; b < 2; ++b)
#pragma unroll
                for (int m = 0; m < 4; ++m)
#pragma unroll
                    for (int n = 0; n < 2; ++n) acc[a][b][m][n] = (f32x4){0.f, 0.f, 0.f, 0.f};
        cur = nxt; cA = nA; cB = nB; ++ui;
    }
    PG8_WAIT_V(0);
    if (wr == 0) PG8_BAR;
    PG8_BAR;
#undef PG8_SA
#undef PG8_SB
#undef PG8_STAGE
#undef PG8_LDA
#undef PG8_LDB
#undef PG8_MMA
#undef PG8_WAIT_V
#undef PG8_WAIT_L
#undef PG8_BAR
#undef PG8_SCHED
}
}

struct Args {
    const float* x; const float* c; const float* w_ada; const float* b_ada; const float* norm_g; const float* w_in;
    const float* lb_logits; const float* hgrn_g; const float* ret_g; const float* conv_w; const float* conv_b;
    const float* dt_bias; const float* a_log; const float* dskip; const float* ssm_g; const float* w_gk2; const float* b_gk2;
    const float* gla_g; const float* w_out; const float* final_g;
    float* out; unsigned char* ws;
};

__device__ __forceinline__ void transpose_cvt(const float* __restrict__ src, int K, int N, bf16_t* __restrict__ dst, int Npad, LAS unsigned char* lds, int gid, int gstride, bool perm) {
    LAS float* T = (LAS float*)lds;
    const int tid = opaque_tid(), ntk = K / 64, ntn = Npad / 256;
    for (int tile = gid; tile < ntk * ntn; tile += gstride) {
        const int tk = tile % ntk, tn = tile / ntk;
        float v[32];
#pragma unroll
        for (int i = 0; i < 32; ++i) { const int kk = (tid >> 8) + 2 * i, nn = tid & 255, n = tn * 256 + nn;
            const int ns = !perm ? n : (n < 5632) ? n : (n < 7168) ? n + 8 : (n < 7176) ? n - 7168 + 5632 : n;
            v[i] = (n < N) ? src[(size_t)(tk * 64 + kk) * N + ns] : 0.f; }
#pragma unroll
        for (int i = 0; i < 32; ++i) { const int kk = (tid >> 8) + 2 * i, nn = tid & 255; T[kk * 257 + nn] = v[i]; }
        __syncthreads();
#pragma unroll
        for (int i = 0; i < 16; ++i) { const int nn = (tid >> 5) + 16 * i, kk = (tid & 31) * 2;
            *(unsigned*)(dst + (size_t)(tn * 256 + nn) * K + tk * 64 + kk) = pk2(T[kk * 257 + nn], T[(kk + 1) * 257 + nn]); }
        __syncthreads();
    }
}

__device__ __forceinline__ void phase_wcvt(const Args& a, LAS unsigned char* lds) {
    const int G = gridDim.x, bid = blockIdx.x;
    unsigned char* ws = a.ws;
    for (int l = 0; l < DEPTH; ++l) {
        transpose_cvt(a.w_in + (size_t)l * DM * NIN, DM, NIN, (bf16_t*)(ws + WS_WIN) + (size_t)l * LDP * DM, LDP, lds, bid, G, true);
        transpose_cvt(a.w_out + (size_t)l * DI * DM, DI, DM, (bf16_t*)(ws + WS_WOUT) + (size_t)l * DM * DI, DM, lds, (bid + 128) % G, G, false);
    }
}
__device__ __forceinline__ void phase_prep(const Args& a, LAS unsigned char* lds) {
    const int tid = opaque_tid(), G = gridDim.x, bid = blockIdx.x;
    unsigned char* ws = a.ws;
    {
        LAS float* R = (LAS float*)lds;
        LAS float* CA = (LAS float*)(lds + 8192);
        float* mod = (float*)(ws + WS_MOD);
        const int jj = tid & 63, ks = tid >> 6;
        if (bid < DEPTH * 48) {
#pragma unroll
            for (int q = 0; q < 8; ++q) CA[tid + NTHR * q] = silu_f(a.c[tid + NTHR * q]);
            __syncthreads();
        }
        for (int item = bid; item < DEPTH * 48; item += G) {
            const int l = item / 48, j = (item % 48) * 64 + jj;
            float s0 = 0.f, s1 = 0.f, s2 = 0.f, s3 = 0.f;
            const float* w = a.w_ada + (size_t)l * DM * 3072 + j;
#pragma unroll 16
            for (int k = ks * 128; k < ks * 128 + 128; ++k) { const float wv = w[(size_t)k * 3072];
                s0 += CA[k] * wv; s1 += CA[DM + k] * wv; s2 += CA[2 * DM + k] * wv; s3 += CA[3 * DM + k] * wv; }
            R[(ks * 4 + 0) * 64 + jj] = s0; R[(ks * 4 + 1) * 64 + jj] = s1; R[(ks * 4 + 2) * 64 + jj] = s2; R[(ks * 4 + 3) * 64 + jj] = s3;
            __syncthreads();
            if (tid < 256) { const int b = tid >> 6; float s = a.b_ada[l * 3072 + j];
#pragma unroll
                for (int q = 0; q < 8; ++q) s += R[(q * 4 + b) * 64 + jj];
                mod[(size_t)(l * 4 + b) * 3072 + j] = s; }
            __syncthreads();
        }
    }
    {
        float2* rope = (float2*)(ws + WS_ROPE);
        for (int i = bid * NTHR + tid; i < 4096 * 64; i += G * NTHR) {
            const int pos = i >> 6, j = i & 63;
            const float invf = powf(10000.f, -(float)(2 * j) / 128.f);
            const float ang = (float)pos * invf;
            const float k = rintf(ang * 0.15915494309189535f);
            float r = fmaf(-k, 6.2831854820251465f, ang); r = fmaf(-k, -1.7484555e-07f, r);
            rope[i] = make_float2(__cosf(r), __sinf(r));
        }
    }
}

template <bool FINAL>
__device__ __forceinline__ void phase_norm(const float* __restrict__ xin  , const bf16_t* __restrict__ slab  ,
                                           const float* __restrict__ gate_prev  , float* xout  ,
                                           const float* __restrict__ g, const float* __restrict__ mod  , int half, bf16_t* __restrict__ hout) {
    const int tid = opaque_tid(), lane = tid & 63, wid = tid >> 6;
    const int gw = blockIdx.x * 8 + wid, nw = gridDim.x * 8;
    for (int row = gw; row < HROWS; row += nw) {
        const float* xr = xin + (size_t)row * DM;
        f32x4 v[4]; float ss = 0.f;
#pragma unroll
        for (int i = 0; i < 4; ++i) v[i] = *(const f32x4*)(xr + i * 256 + lane * 4);
        if (slab) {
            u32x2 a0[4], a1[4]; f32x4 gp[4];
#pragma unroll
            for (int i = 0; i < 4; ++i) { const int col = i * 256 + lane * 4;
                a0[i] = *(const u32x2*)(slab + (size_t)row * DM + col); a1[i] = *(const u32x2*)(slab + (size_t)(HROWS + row) * DM + col);
                gp[i] = *(const f32x4*)(gate_prev + (size_t)(row >> 12) * 3072 + col); }
#pragma unroll
            for (int i = 0; i < 4; ++i) {
                const f32x4 sa = {__uint_as_float(a0[i].x << 16) + __uint_as_float(a1[i].x << 16), __uint_as_float(a0[i].x & 0xffff0000u) + __uint_as_float(a1[i].x & 0xffff0000u),
                                  __uint_as_float(a0[i].y << 16) + __uint_as_float(a1[i].y << 16), __uint_as_float(a0[i].y & 0xffff0000u) + __uint_as_float(a1[i].y & 0xffff0000u)};
                v[i] = v[i] + gp[i] * sa; }
        }
        if (!FINAL && xout) {
#pragma unroll
            for (int i = 0; i < 4; ++i) *(f32x4*)(xout + (size_t)row * DM + i * 256 + lane * 4) = v[i];
        }
#pragma unroll
        for (int i = 0; i < 4; ++i) ss += v[i][0] * v[i][0] + v[i][1] * v[i][1] + v[i][2] * v[i][2] + v[i][3] * v[i][3];
#pragma unroll
        for (int o = 32; o > 0; o >>= 1) ss += __shfl_xor(ss, o);
        const float rinv = rsqrtf(ss * (1.f / DM) + EPS);
        if constexpr (FINAL) {
#pragma unroll
            for (int i = 0; i < 4; ++i) { const int col = i * 256 + lane * 4; const f32x4 gg = *(const f32x4*)(g + col);
                *(f32x4*)(xout + (size_t)row * DM + col) = v[i] * rinv * gg; }
        } else {
            const float* mb = mod + (size_t)(half * 2 + (row >> 12)) * 3072;
#pragma unroll
            for (int i = 0; i < 4; ++i) { const int col = i * 256 + lane * 4;
                const f32x4 gg = *(const f32x4*)(g + col), sh = *(const f32x4*)(mb + col), sc = *(const f32x4*)(mb + 1024 + col);
                float o0 = v[i][0] * rinv * gg[0] * (1.f + sc[0]) + sh[0], o1 = v[i][1] * rinv * gg[1] * (1.f + sc[1]) + sh[1];
                float o2 = v[i][2] * rinv * gg[2] * (1.f + sc[2]) + sh[2], o3 = v[i][3] * rinv * gg[3] * (1.f + sc[3]) + sh[3];
                u32x2 w; w.x = pk2(o0, o1); w.y = pk2(o2, o3);
                *(u32x2*)(hout + (size_t)row * DM + col) = w; }
        }
    }
}

struct MixP {
    const bf16_t* proj; bf16_t* st; float* dec; bf16_t* y; const float2* rope;
    const float* lbl; const float* hgrn_g; const float* ret_g; const float* conv_w; const float* conv_b; const float* dt_bias; const float* a_log;
    const float* dskip; const float* ssm_g; const float* w2; const float* b2; const float* gla_g; int layer;
};

__device__ __forceinline__ bf16x8 frag(LAS unsigned char* lds, int off, int ld, int r0, int ks, int lane) {
    return *(const LAS bf16x8*)(lds + off + (((r0 + (lane & 31)) * ld + 16 * ks + 8 * (lane >> 5)) << 1));
}
__device__ __forceinline__ int rowmap(int r, int lane) { return (r & 3) + 8 * (r >> 2) + 4 * (lane >> 5); }

__device__ __forceinline__ void conv16(LAS unsigned char* lds, int off, int ncols, int col, const float* cw, int seg, float (&out)[16]) {
    const LAS bf16_t* rp = (const LAS bf16_t*)(lds + off) + seg * 16 * ncols + col;
    float u[19];
#pragma unroll
    for (int k = 0; k < 19; ++k) u[k] = bf2f(rp[k * ncols]);
#pragma unroll
    for (int i = 0; i < 16; ++i) out[i] = silu_f(cw[4] + cw[0] * u[i] + cw[1] * u[i + 1] + cw[2] * u[i + 2] + cw[3] * u[i + 3]);
}
__device__ __forceinline__ void conv_w_load(const MixP& p, int chan, float* cw) {
    cw[0] = p.conv_w[chan]; cw[1] = p.conv_w[1024 + chan]; cw[2] = p.conv_w[2048 + chan]; cw[3] = p.conv_w[3072 + chan]; cw[4] = p.conv_b[chan];
}
template <int NCOLS, int NROWS> struct Stg { static constexpr int VPR = NCOLS / 8, NV = NROWS * VPR, NIT = (NV + NTHR - 1) / NTHR; };
template <int NCOLS, int NROWS>
__device__ __forceinline__ void stg_load(const bf16_t* proj, int grow0, int col0, int tid, int zrows, u32x4* r) {
    using S = Stg<NCOLS, NROWS>;
#pragma unroll
    for (int j = 0; j < S::NIT; ++j) { const int vi = tid + NTHR * j, row = vi / S::VPR, cv = vi % S::VPR;
        const bool ok = (vi < S::NV) && (row >= zrows);
        r[j] = ok ? *(const u32x4*)(proj + pidx(grow0 + row, col0 + cv * 8)) : (u32x4){0u, 0u, 0u, 0u}; }
}
template <int NCOLS, int NROWS>
__device__ __forceinline__ void stg_store(LAS unsigned char* lds, int off, int tid, const u32x4* r) {
    using S = Stg<NCOLS, NROWS>;
#pragma unroll
    for (int j = 0; j < S::NIT; ++j) { const int vi = tid + NTHR * j; if (vi < S::NV) *(LAS u32x4*)(lds + off + vi * 16) = r[j]; }
}
__device__ __forceinline__ void store16(LAS unsigned char* lds, int byteoff, const float (&v)[16]) {
    u32x4 a, b; a.x = pk2(v[0], v[1]); a.y = pk2(v[2], v[3]); a.z = pk2(v[4], v[5]); a.w = pk2(v[6], v[7]);
    b.x = pk2(v[8], v[9]); b.y = pk2(v[10], v[11]); b.z = pk2(v[12], v[13]); b.w = pk2(v[14], v[15]);
    *(LAS u32x4*)(lds + byteoff) = a; *(LAS u32x4*)(lds + byteoff + 16) = b;
}
__device__ __forceinline__ void store8(LAS unsigned char* lds, int byteoff, const float (&v)[8]) {
    u32x4 a; a.x = pk2(v[0], v[1]); a.y = pk2(v[2], v[3]); a.z = pk2(v[4], v[5]); a.w = pk2(v[6], v[7]);
    *(LAS u32x4*)(lds + byteoff) = a;
}

constexpr int NUNITS = 128 * 14;
struct Pref { u32x4 raw[11]; u32x4 st[8]; float aux[16]; };
template <int BR, int PASS>
__device__ __forceinline__ void load_A(const MixP& p, int bc, int hu, int tid, Pref& pf) {
    const bf16_t* P = p.proj; const int g0 = bc * 64;
    if constexpr (BR == 0) { stg_load<128, 64>(P, g0, C_AF + hu * 128, tid, 0, pf.raw + 0); stg_load<128, 64>(P, g0, C_AI + hu * 128, tid, 0, pf.raw + 2);
        if constexpr (PASS == 3) stg_load<128, 64>(P, g0, C_AQ + hu * 128, tid, 0, pf.raw + 4); }
    if constexpr (BR == 1) { stg_load<128, 64>(P, g0, C_RK + hu * 128, tid, 0, pf.raw + 0); stg_load<128, 64>(P, g0, C_RV + hu * 128, tid, 0, pf.raw + 2);
        if constexpr (PASS == 3) stg_load<128, 64>(P, g0, C_RQ + hu * 128, tid, 0, pf.raw + 4); }
    if constexpr (BR == 2) { const int zr = ((bc & 63) == 0) ? 3 : 0;
        stg_load<128, 67>(P, g0 - 3, C_XBC + 512 + hu * 128, tid, zr, pf.raw + 0); stg_load<256, 67>(P, g0 - 3, C_XBC + hu * 256, tid, zr, pf.raw + 3);
        if constexpr (PASS == 3) stg_load<128, 67>(P, g0 - 3, C_XBC + 768 + hu * 128, tid, zr, pf.raw + 8); }
    if constexpr (BR == 3) { stg_load<64, 64>(P, g0, C_GK + hu * 64, tid, 0, pf.raw + 0); stg_load<128, 64>(P, g0, C_GV + hu * 128, tid, 0, pf.raw + 1); stg_load<16, 64>(P, g0, C_LR, tid, 0, pf.raw + 3);
        if constexpr (PASS == 3) stg_load<64, 64>(P, g0, C_GQ + hu * 64, tid, 0, pf.raw + 4); }
}
template <int BR, int PASS>
__device__ __forceinline__ void load_B(const MixP& p, int bc, int hu, int tid, Pref& pf) {
    if constexpr (PASS == 3) {
        constexpr int DK = (BR == 3) ? 64 : 128, DV = (BR == 2) ? 256 : 128, NV = DV * DK / 8 / NTHR;
        const int st_off = (BR == 0) ? hu * 16384 : (BR == 1) ? 65536 + hu * 16384 : (BR == 2) ? 131072 + hu * 32768 : 196608 + hu * 8192;
        const bf16_t* stg = p.st + (size_t)bc * ST_PER_BC + st_off;
#pragma unroll
        for (int k = 0; k < NV; ++k) pf.st[k] = *(const u32x4*)(stg + (size_t)(tid + NTHR * k) * 8);
    }
    if constexpr (BR == 1) { const int j = tid & 63, seg = tid >> 6, chunk = bc & 63;
#pragma unroll
        for (int i = 0; i < 8; ++i) { const float2 c = p.rope[(chunk * 64 + seg * 8 + i) * 64 + j]; pf.aux[2 * i] = c.x; pf.aux[2 * i + 1] = c.y; } }
    if constexpr (BR == 2) { if (tid < 64) {
#pragma unroll
            for (int hh = 0; hh < 4; ++hh) pf.aux[hh] = bf2f(p.proj[pidx(bc * 64 + tid, C_DT + hu * 4 + hh)]); } }
    if constexpr (BR == 3) { const int cc = hu * 64 + (tid & 63);
#pragma unroll
        for (int r = 0; r < 16; ++r) pf.aux[r] = p.w2[r * 256 + cc]; }
}
template <int PASS>
__device__ __forceinline__ void load_A_any(const MixP& p, int i, int tid, Pref& pf) {
    const int bc = i / 14, u = i % 14;
    if (u < 4) load_A<0, PASS>(p, bc, u, tid, pf); else if (u < 8) load_A<1, PASS>(p, bc, u - 4, tid, pf);
    else if (u < 10) load_A<2, PASS>(p, bc, u - 8, tid, pf); else load_A<3, PASS>(p, bc, u - 10, tid, pf);
}
template <int PASS>
__device__ __forceinline__ void load_B_any(const MixP& p, int i, int tid, Pref& pf) {
    const int bc = i / 14, u = i % 14;
    if (u < 4) load_B<0, PASS>(p, bc, u, tid, pf); else if (u < 8) load_B<1, PASS>(p, bc, u - 4, tid, pf);
    else if (u < 10) load_B<2, PASS>(p, bc, u - 8, tid, pf); else load_B<3, PASS>(p, bc, u - 10, tid, pf);
}

template <int BR, int PASS>
__device__ __forceinline__ void mixer_unit(const MixP& p, LAS unsigned char* lds, int bc, int hu  ) {
    constexpr int DK = (BR == 3) ? 64 : 128, LDK = DK + 8, NH = (BR == 2) ? 4 : 1, DV = (BR == 2) ? 256 : 128, NT = DV / 128;
    constexpr bool VEC = (BR == 0 || BR == 3);
    const int tid = opaque_tid(), lane = tid & 63, wid = __builtin_amdgcn_readfirstlane(tid >> 6);
    const int chunk = bc & 63;
    const bf16_t* P = p.proj;
    LAS float* SM = (LAS float*)(lds + L_SM);
    LAS bf16_t* QI = (LAS bf16_t*)(lds + L_QI); LAS bf16_t* KI = (LAS bf16_t*)(lds + L_KI); LAS bf16_t* VT = (LAS bf16_t*)(lds + L_VT);
    const int st_off = (BR == 0) ? hu * 16384 : (BR == 1) ? 65536 + hu * 16384 : (BR == 2) ? 131072 + hu * 32768 : 196608 + hu * 8192;
    bf16_t* stg = p.st + (size_t)bc * ST_PER_BC + st_off;
    Pref pf;
    load_A<BR, PASS>(p, bc, hu, tid, pf);
    load_B<BR, PASS>(p, bc, hu, tid, pf);
    constexpr int NTG = (PASS == 3) ? NT : 1;
    const int gcol = (BR == 0) ? C_AG + hu * 128 : (BR == 1) ? C_RG + hu * 128 : (BR == 2) ? C_MZ + hu * 256 : C_GG + hu * 128;
    const float* gain = (BR == 0) ? p.hgrn_g + hu * 128 : (BR == 1) ? p.ret_g + hu * 128 : (BR == 2) ? p.ssm_g + hu * 256 : p.gla_g + hu * 128;
    bf16_t gt[NTG][16]; float gnv[NTG], dskv[NTG];
    float lb = 0.f, bb = 0.f, cwb[5], cwc[5], cwx[5], dtb[4], alg[4];
    if constexpr (BR == 0) { if (p.layer == 1) { const int cc = hu * 128 + (tid & 127); lb = 1.f / (1.f + __expf(p.lbl[cc] - p.lbl[512 + cc])); } }
    if constexpr (BR == 3) bb = p.b2[hu * 64 + (tid & 63)];
    if constexpr (BR == 2) { conv_w_load(p, 512 + hu * 128 + (tid & 127), cwb); if constexpr (PASS == 3) conv_w_load(p, 768 + hu * 128 + (tid & 127), cwc); conv_w_load(p, hu * 256 + (tid & 255), cwx);
#pragma unroll
        for (int hh = 0; hh < 4; ++hh) { dtb[hh] = p.dt_bias[hu * 4 + hh]; alg[hh] = p.a_log[hu * 4 + hh]; } }
    __builtin_amdgcn_sched_barrier(0);

    for (int urep = 0; urep < REP_UPREP; ++urep) {
    if constexpr (BR == 0) {
        constexpr int RQ = L_BIG, RF = (PASS == 3) ? L_BIG + 16384 : L_QI, RV = (PASS == 3) ? L_BIG + 32768 : L_QI + 16384;
        stg_store<128, 64>(lds, RF, tid, pf.raw + 0); stg_store<128, 64>(lds, RV, tid, pf.raw + 2);
        if constexpr (PASS == 3) stg_store<128, 64>(lds, RQ, tid, pf.raw + 4);
        __builtin_amdgcn_sched_barrier(0);
        const int d = tid & 127, seg = tid >> 7;
        __syncthreads();
        const LAS bf16_t* rF = (const LAS bf16_t*)(lds + RF) + seg * 16 * 128 + d;
        const LAS bf16_t* rQ = (const LAS bf16_t*)(lds + RQ) + seg * 16 * 128 + d;
        const LAS bf16_t* rV = (const LAS bf16_t*)(lds + RV) + seg * 16 * 128 + d;
        float cs[16], kk[16]; float run = 0.f;
#pragma unroll
        for (int i = 0; i < 16; ++i) { const float av = fmaxf(bf2f(rF[i * 128]), -60.f); const float e = __expf(-av), sg = __builtin_amdgcn_rcpf(1.f + e);
            const float f = lb + (1.f - lb) * sg; run += __logf(f); cs[i] = run; kk[i] = (1.f - lb) * e * sg; }
        SM[SM_SEG + seg * 128 + d] = run;
        __syncthreads();
        const float t0 = SM[SM_SEG + d], t1 = SM[SM_SEG + 128 + d], t2 = SM[SM_SEG + 256 + d], t3 = SM[SM_SEG + 384 + d];
        const float off = (seg == 0) ? 0.f : (seg == 1) ? t0 : (seg == 2) ? t0 + t1 : t0 + t1 + t2;
        const float ref = t0 + t1, clast = ref + t2 + t3;
        if (seg == 0) { SM[SM_REF + d] = ref; SM[SM_CLAST + d] = clast; }
        float kv[16];
#pragma unroll
        for (int i = 0; i < 16; ++i) { const float c = off + cs[i]; kv[i] = kk[i] * __expf(fminf(ref - c, 80.f));
            if constexpr (PASS == 3) { KI[(seg * 16 + i) * LDK + d] = f2bf(kv[i]);
                const float q = bf2f(rQ[i * 128]); QI[(seg * 16 + i) * LDK + d] = f2bf(silu_f(q) * __expf(fminf(c - ref, 80.f))); } }
        if constexpr (PASS == 1) store16(lds, L_BIG + (d * 72 + seg * 16) * 2, kv);
        unsigned vv[16];
#pragma unroll
        for (int i = 0; i < 16; ++i) vv[i] = rV[i * 128];
        u32x4 a, b; a.x = vv[0] | (vv[1] << 16); a.y = vv[2] | (vv[3] << 16); a.z = vv[4] | (vv[5] << 16); a.w = vv[6] | (vv[7] << 16);
        b.x = vv[8] | (vv[9] << 16); b.y = vv[10] | (vv[11] << 16); b.z = vv[12] | (vv[13] << 16); b.w = vv[14] | (vv[15] << 16);
        *(LAS u32x4*)(lds + L_VT + (d * 72 + seg * 16) * 2) = a; *(LAS u32x4*)(lds + L_VT + (d * 72 + seg * 16) * 2 + 16) = b;
    }
    if constexpr (BR == 1) {
        constexpr int RQ = L_BIG, RK = (PASS == 3) ? L_BIG + 16384 : L_QI, RV = (PASS == 3) ? L_BIG + 32768 : L_QI + 16384;
        const int j = tid & 63, seg = tid >> 6;
        float2 cssn[8];
#pragma unroll
        for (int i = 0; i < 8; ++i) cssn[i] = make_float2(pf.aux[2 * i], pf.aux[2 * i + 1]);
        stg_store<128, 64>(lds, RK, tid, pf.raw + 0); stg_store<128, 64>(lds, RV, tid, pf.raw + 2);
        if constexpr (PASS == 3) stg_store<128, 64>(lds, RQ, tid, pf.raw + 4);
        __builtin_amdgcn_sched_barrier(0);
        const float lg = log1pf(-exp2f(-(5.f + (float)hu)));
        if (tid < 64) { SM[SM_CUM + tid] = (float)(tid + 1) * lg; SM[SM_DT + tid] = 1.f; }
        __syncthreads();
        float k1[8], k2[8];
#pragma unroll
        for (int i = 0; i < 8; ++i) { const int t = seg * 8 + i;
            const LAS bf16_t* rk = (const LAS bf16_t*)(lds + RK) + t * 128 + j;
            const float ka = bf2f(rk[0]) * 0.08838834764831845f, kb = bf2f(rk[64]) * 0.08838834764831845f;
            k1[i] = ka * cssn[i].x - kb * cssn[i].y; k2[i] = ka * cssn[i].y + kb * cssn[i].x;
            if constexpr (PASS == 3) { const LAS bf16_t* rq = (const LAS bf16_t*)(lds + RQ) + t * 128 + j;
                const float qa = bf2f(rq[0]), qb = bf2f(rq[64]);
                QI[t * LDK + j] = f2bf(qa * cssn[i].x - qb * cssn[i].y); QI[t * LDK + j + 64] = f2bf(qa * cssn[i].y + qb * cssn[i].x);
                KI[t * LDK + j] = f2bf(k1[i]); KI[t * LDK + j + 64] = f2bf(k2[i]); } }
        if constexpr (PASS == 1) { store8(lds, L_BIG + (j * 72 + seg * 8) * 2, k1); store8(lds, L_BIG + ((j + 64) * 72 + seg * 8) * 2, k2); }
        const int v = tid & 127, s4 = tid >> 7; float vv[16];
#pragma unroll
        for (int i = 0; i < 16; ++i) { const int s = s4 * 16 + i; float x = bf2f(((const LAS bf16_t*)(lds + RV))[s * 128 + v]);
            if constexpr (PASS == 1) x *= __expf((float)(63 - s) * lg);
            vv[i] = x; }
        store16(lds, L_VT + (v * 72 + s4 * 16) * 2, vv);
    }
    if constexpr (BR == 2) {
        constexpr int RB = (PASS == 3) ? L_BIG : L_QI, RC = L_BIG + 17152, RX = (PASS == 3) ? L_BIG + 34304 : L_BIG + 18432;
        float dtr[4];
#pragma unroll
        for (int hh = 0; hh < 4; ++hh) dtr[hh] = pf.aux[hh];
        stg_store<128, 67>(lds, RB, tid, pf.raw + 0); stg_store<256, 67>(lds, RX, tid, pf.raw + 3);
        if constexpr (PASS == 3) stg_store<128, 67>(lds, RC, tid, pf.raw + 8);
        __builtin_amdgcn_sched_barrier(0);
        if (tid < 64) {
#pragma unroll
            for (int hh = 0; hh < 4; ++hh) {
                const float dt = softplus_f(dtr[hh] + dtb[hh]);
                float la = -dt * __expf(alg[hh]);
#pragma unroll
                for (int o = 1; o < 64; o <<= 1) { const float yv = __shfl_up(la, o); if (tid >= o) la += yv; }
                SM[SM_CUM + hh * 64 + tid] = la; SM[SM_DT + hh * 64 + tid] = dt; }
        }
        __syncthreads();
        { const int n = tid & 127, seg = tid >> 7; float o[16];
          conv16(lds, RB, 128, n, cwb, seg, o);
          if constexpr (PASS == 3) {
#pragma unroll
              for (int i = 0; i < 16; ++i) KI[(seg * 16 + i) * LDK + n] = f2bf(o[i]);
              conv16(lds, RC, 128, n, cwc, seg, o);
#pragma unroll
              for (int i = 0; i < 16; ++i) QI[(seg * 16 + i) * LDK + n] = f2bf(o[i]);
          } else store16(lds, L_BIG + (n * 72 + seg * 16) * 2, o);
        }
        { const int v = tid & 255, s2 = tid >> 8, hh = v >> 6;
#pragma unroll
          for (int r = 0; r < 2; ++r) { const int seg = s2 * 2 + r; float o[16];
              conv16(lds, RX, 256, v, cwx, seg, o);
              if constexpr (PASS == 1) { const float cl = SM[SM_CUM + hh * 64 + 63];
#pragma unroll
                  for (int i = 0; i < 16; ++i) { const int s = seg * 16 + i; o[i] *= __expf(cl - SM[SM_CUM + hh * 64 + s]) * SM[SM_DT + hh * 64 + s]; } }
              store16(lds, L_VT + (v * 72 + seg * 16) * 2, o); }
        }
    }
    if constexpr (BR == 3) {
        constexpr int RQ = L_BIG, RK = (PASS == 3) ? L_BIG + 8192 : L_QI, RV = (PASS == 3) ? L_BIG + 16384 : L_QI + 8192, RL = (PASS == 3) ? L_BIG + 32768 : L_QI + 24576;
        const int d = tid & 63, seg = tid >> 6, cc = hu * 64 + d;
        float w2r[16];
#pragma unroll
        for (int r = 0; r < 16; ++r) w2r[r] = pf.aux[r];
        stg_store<64, 64>(lds, RK, tid, pf.raw + 0); stg_store<128, 64>(lds, RV, tid, pf.raw + 1); stg_store<16, 64>(lds, RL, tid, pf.raw + 3);
        if constexpr (PASS == 3) stg_store<64, 64>(lds, RQ, tid, pf.raw + 4);
        __builtin_amdgcn_sched_barrier(0);
        __syncthreads();
        float cs[8]; float run = 0.f;
#pragma unroll
        for (int i = 0; i < 8; ++i) { const int t = seg * 8 + i; const LAS bf16x8* lp = (const LAS bf16x8*)(lds + RL + t * 32);
            const bf16x8 l0 = lp[0], l1 = lp[1]; float gk = bb;
#pragma unroll
            for (int r = 0; r < 8; ++r) { gk += w2r[r] * bf2f((bf16_t)l0[r]); gk += w2r[8 + r] * bf2f((bf16_t)l1[r]); }
            run += logsig_f(gk) * (1.f / 16.f); cs[i] = run; }
        SM[SM_SEG + seg * 64 + d] = run;
        __syncthreads();
        float off = 0.f, ref = 0.f, clast = 0.f;
#pragma unroll
        for (int s = 0; s < 8; ++s) { const float tv = SM[SM_SEG + s * 64 + d]; if (s < seg) off += tv; if (s < 4) ref += tv; clast += tv; }
        if (seg == 0) { SM[SM_REF + d] = ref; SM[SM_CLAST + d] = clast; }
        float kv[8];
#pragma unroll
        for (int i = 0; i < 8; ++i) { const int t = seg * 8 + i; const float c = off + cs[i];
            kv[i] = bf2f(((const LAS bf16_t*)(lds + RK))[t * 64 + d]) * __expf(fminf(ref - c, 80.f));
            if constexpr (PASS == 3) { KI[t * LDK + d] = f2bf(kv[i]); QI[t * LDK + d] = f2bf(bf2f(((const LAS bf16_t*)(lds + RQ))[t * 64 + d]) * 0.125f * __expf(fminf(c - ref, 80.f))); } }
        if constexpr (PASS == 1) store8(lds, L_BIG + (d * 72 + seg * 8) * 2, kv);
        const int v = tid & 127, s4 = tid >> 7; unsigned vv[16];
#pragma unroll
        for (int i = 0; i < 16; ++i) vv[i] = ((const LAS bf16_t*)(lds + RV))[(s4 * 16 + i) * 128 + v];
        u32x4 a, b; a.x = vv[0] | (vv[1] << 16); a.y = vv[2] | (vv[3] << 16); a.z = vv[4] | (vv[5] << 16); a.w = vv[6] | (vv[7] << 16);
        b.x = vv[8] | (vv[9] << 16); b.y = vv[10] | (vv[11] << 16); b.z = vv[12] | (vv[13] << 16); b.w = vv[14] | (vv[15] << 16);
        *(LAS u32x4*)(lds + L_VT + (v * 72 + s4 * 16) * 2) = a; *(LAS u32x4*)(lds + L_VT + (v * 72 + s4 * 16) * 2 + 16) = b;
    }
    __syncthreads();
    }
    for (int urep = 0; urep < REP_UCORE; ++urep) {
    if constexpr (PASS == 1) {
        constexpr int NTN = DV / 32, NTILES = (DK / 32) * NTN, NTL = NTILES / 8;
        f32x16 hacc[NTL];
#pragma unroll
        for (int i = 0; i < NTL; ++i) {
            const int ti = wid + 8 * i, tm = ti / NTN, tn = ti % NTN;
#pragma unroll
            for (int r = 0; r < 16; ++r) hacc[i][r] = 0.f;
#pragma unroll
            for (int ks = 0; ks < 4; ++ks) hacc[i] = __builtin_amdgcn_mfma_f32_32x32x16_bf16(frag(lds, L_BIG, 72, tm * 32, ks, lane), frag(lds, L_VT, 72, tn * 32, ks, lane), hacc[i], 0, 0, 0);
            if constexpr (VEC) {
#pragma unroll
                for (int r = 0; r < 16; ++r) { const int d = tm * 32 + rowmap(r, lane); hacc[i][r] *= __expf(SM[SM_CLAST + d] - SM[SM_REF + d]); }
            }
        }
        float decv = 0.f;
        if constexpr (BR == 0) { if (tid < 128) decv = __expf(SM[SM_CLAST + tid]); }
        if constexpr (BR == 3) { if (tid < 64) decv = __expf(SM[SM_CLAST + tid]); }
        if constexpr (BR == 2) { if (tid < 4) decv = __expf(SM[SM_CUM + tid * 64 + 63]); }
        __syncthreads();
#pragma unroll
        for (int i = 0; i < NTL; ++i) {
            const int ti = wid + 8 * i, tm = ti / NTN, tn = ti % NTN;
            const int v = tn * 32 + (lane & 31);
#pragma unroll
            for (int rg = 0; rg < 4; ++rg) { const int d0 = tm * 32 + 8 * rg + 4 * (lane >> 5);
                u32x2 w; w.x = pk2(hacc[i][rg * 4 + 0], hacc[i][rg * 4 + 1]); w.y = pk2(hacc[i][rg * 4 + 2], hacc[i][rg * 4 + 3]);
                *(u32x2*)(stg + (size_t)v * DK + d0) = w; }
        }
        float* dec = p.dec + (size_t)bc * 1024;
        if constexpr (BR == 0) { if (tid < 128) dec[hu * 128 + tid] = decv; }
        if constexpr (BR == 3) { if (tid < 64) dec[512 + hu * 64 + tid] = decv; }
        if constexpr (BR == 2) { if (tid < 4) dec[768 + hu * 4 + tid] = decv; }
    } else {
        constexpr int NCT = DV / 32;
    if constexpr (PASS == 3) {
#pragma unroll
            for (int nt = 0; nt < NT; ++nt) { const int ct = (wid & 3) + 4 * nt;
                gnv[nt] = gain[ct * 32 + (lane & 31)]; dskv[nt] = (BR == 2) ? p.dskip[hu * 4 + (ct >> 1)] : 0.f;
#pragma unroll
                for (int r = 0; r < 16; ++r) gt[nt][r] = P[pidx(bc * 64 + (wid >> 2) * 32 + rowmap(r, lane), gcol + ct * 32 + (lane & 31))]; }
        }
        __builtin_amdgcn_sched_barrier(0);
        {
            constexpr int NVEC = DV * DK / 8, VPR = DK / 8;
#pragma unroll
            for (int k = 0; k < NVEC / NTHR; ++k) { const int vi = tid + NTHR * k; const int v = vi / VPR, d0 = (vi % VPR) * 8;
                u32x4 raw = pf.st[k];
                if constexpr (VEC) { unsigned w[4] = {raw.x, raw.y, raw.z, raw.w};
#pragma unroll
                    for (int q = 0; q < 4; ++q) { const float lo = __uint_as_float(w[q] << 16) * __expf(SM[SM_REF + d0 + 2 * q]), hi = __uint_as_float(w[q] & 0xffff0000u) * __expf(SM[SM_REF + d0 + 2 * q + 1]);
                        w[q] = pk2(lo, hi); }
                    raw.x = w[0]; raw.y = w[1]; raw.z = w[2]; raw.w = w[3]; }
                *(LAS u32x4*)(lds + L_BIG + (v * LDK + d0) * 2) = raw; }
        }
        __builtin_amdgcn_sched_barrier(0);
        __syncthreads();
        const int tm = wid >> 2, tnb = wid & 3;
        f32x16 acc[NT];
#pragma unroll
        for (int nt = 0; nt < NT; ++nt)
#pragma unroll
            for (int r = 0; r < 16; ++r) acc[nt][r] = 0.f;
#pragma unroll
        for (int ks = 0; ks < DK / 16; ++ks) { const bf16x8 af = frag(lds, L_QI, LDK, tm * 32, ks, lane);
#pragma unroll
            for (int nt = 0; nt < NT; ++nt) acc[nt] = __builtin_amdgcn_mfma_f32_32x32x16_bf16(af, frag(lds, L_BIG, LDK, (tnb + 4 * nt) * 32, ks, lane), acc[nt], 0, 0, 0); }
        if constexpr (!VEC) {
#pragma unroll
            for (int nt = 0; nt < NT; ++nt) { const int hh = (NH == 1) ? 0 : ((tnb + 4 * nt) >> 1);
#pragma unroll
                for (int r = 0; r < 16; ++r) acc[nt][r] *= __expf(SM[SM_CUM + hh * 64 + tm * 32 + rowmap(r, lane)]); }
        }
        constexpr int P_OFF = (NH == 1) ? L_BIG + 34816 : L_BIG;
        f32x16 sc;
#pragma unroll
        for (int r = 0; r < 16; ++r) sc[r] = 0.f;
        const int w4 = wid & 3, stm = w4 >> 1, stn = w4 & 1, whalf = wid >> 2;
#pragma unroll
        for (int ks = 0; ks < DK / 16; ++ks) sc = __builtin_amdgcn_mfma_f32_32x32x16_bf16(frag(lds, L_QI, LDK, stm * 32, ks, lane), frag(lds, L_KI, LDK, stn * 32, ks, lane), sc, 0, 0, 0);
        if constexpr (NH != 1) __syncthreads();
        {
            const int s = stn * 32 + (lane & 31);
            if constexpr (NH == 1) {
                float cums = 0.f, dts = 1.f;
                if constexpr (!VEC) { cums = SM[SM_CUM + s]; dts = SM[SM_DT + s]; }
#pragma unroll
                for (int r8 = 0; r8 < 8; ++r8) { const int rlo = r8, rhi = r8 + 8; const int r = whalf ? rhi : rlo; const int t = stm * 32 + (whalf ? rowmap(rhi, lane) : rowmap(rlo, lane));
                    float val = whalf ? sc[rhi] : sc[rlo]; (void)r;
                    if constexpr (!VEC) { const float ex = (s <= t) ? SM[SM_CUM + t] - cums : 0.f; val *= __expf(ex) * dts; }
                    val = (s <= t) ? val : 0.f;
                    *(LAS bf16_t*)(lds + P_OFF + (t * 72 + s) * 2) = f2bf(val); }
            } else {
#pragma unroll
                for (int h2 = 0; h2 < NH / 2; ++h2) { const int hh = whalf * (NH / 2) + h2;
                    const float cums = SM[SM_CUM + hh * 64 + s], dts = SM[SM_DT + hh * 64 + s];
#pragma unroll
                    for (int r = 0; r < 16; ++r) { const int t = stm * 32 + rowmap(r, lane);
                        float val = sc[r];
                        const float ex = (s <= t) ? SM[SM_CUM + hh * 64 + t] - cums : 0.f; val *= __expf(ex) * dts;
                        val = (s <= t) ? val : 0.f;
                        *(LAS bf16_t*)(lds + P_OFF + ((hh * 64 + t) * 72 + s) * 2) = f2bf(val); } }
            }
        }
        __syncthreads();
#pragma unroll
        for (int nt = 0; nt < NT; ++nt) { const int hh = (NH == 1) ? 0 : ((tnb + 4 * nt) >> 1);
#pragma unroll
            for (int ks = 0; ks < 4; ++ks) acc[nt] = __builtin_amdgcn_mfma_f32_32x32x16_bf16(frag(lds, P_OFF + hh * 9216, 72, tm * 32, ks, lane), frag(lds, L_VT, 72, (tnb + 4 * nt) * 32, ks, lane), acc[nt], 0, 0, 0); }
        const int ycol = (BR == 0) ? hu * 128 : (BR == 1) ? 512 + hu * 128 : (BR == 2) ? 1024 + hu * 256 : 1536 + hu * 128;
#pragma unroll
        for (int nt = 0; nt < NT; ++nt) { const int ct = tnb + 4 * nt, v = ct * 32 + (lane & 31);
            const float dsk = dskv[nt];
            float sq[16];
#pragma unroll
            for (int r = 0; r < 16; ++r) { const int t = tm * 32 + rowmap(r, lane);
                float val = acc[nt][r];
                if constexpr (BR == 2) { val = (val + dsk * bf2f(VT[v * 72 + t])) * silu_f(bf2f(gt[nt][r])); acc[nt][r] = val; }
                sq[r] = val * val; }
            const bool b4 = lane & 16, b3 = lane & 8, b2 = lane & 4, b1 = lane & 2;
#pragma unroll
            for (int i = 0; i < 8; ++i) { const float lo = sq[i], hi = sq[i + 8]; sq[i] = (b4 ? hi : lo) + __shfl_xor(b4 ? lo : hi, 16); }
#pragma unroll
            for (int i = 0; i < 4; ++i) { const float lo = sq[i], hi = sq[i + 4]; sq[i] = (b3 ? hi : lo) + __shfl_xor(b3 ? lo : hi, 8); }
#pragma unroll
            for (int i = 0; i < 2; ++i) { const float lo = sq[i], hi = sq[i + 2]; sq[i] = (b2 ? hi : lo) + __shfl_xor(b2 ? lo : hi, 4); }
            { const float lo = sq[0], hi = sq[1]; sq[0] = (b1 ? hi : lo) + __shfl_xor(b1 ? lo : hi, 2); }
            sq[0] += __shfl_xor(sq[0], 1);
            const int rr = (b4 ? 8 : 0) + (b3 ? 4 : 0) + (b2 ? 2 : 0) + (b1 ? 1 : 0);
            if ((lane & 1) == 0) SM[SM_RSS + ct * 64 + tm * 32 + rowmap(rr, lane)] = sq[0];
        }
        __syncthreads();
        if (tid < 64) { float tot = 0.f;
#pragma unroll
            for (int q = 0; q < NCT; ++q) tot += SM[SM_RSS + q * 64 + tid];
            SM[SM_SEG + tid] = rsqrtf(tot * (1.f / DV) + EPS); }
        __syncthreads();
        float rinv[16];
#pragma unroll
        for (int r = 0; r < 16; ++r) rinv[r] = SM[SM_SEG + tm * 32 + rowmap(r, lane)];
        __syncthreads();
#pragma unroll
        for (int nt = 0; nt < NT; ++nt) { const int ct = tnb + 4 * nt, v = ct * 32 + (lane & 31);
            const float gn = gnv[nt];
#pragma unroll
            for (int r = 0; r < 16; ++r) { const int t = tm * 32 + rowmap(r, lane);
                float o = acc[nt][r] * rinv[r] * gn;
                if constexpr (BR != 2) o *= silu_f(bf2f(gt[nt][r]));
                p.y[(size_t)(bc * 64 + t) * DI + ycol + v] = f2bf(o); }
        }
    }
    }
}

template <int PASS>
__device__ __forceinline__ void phase_mixer(const MixP& p, LAS unsigned char* lds) {
#pragma unroll 1
    for (int i = blockIdx.x; i < NUNITS; i += gridDim.x) {
        const int bc = i / 14, u = i % 14;
        if (u < 4) mixer_unit<0, PASS>(p, lds, bc, u);
        else if (u < 8) mixer_unit<1, PASS>(p, lds, bc, u - 4);
        else if (u < 10) mixer_unit<2, PASS>(p, lds, bc, u - 8);
        else mixer_unit<3, PASS>(p, lds, bc, u - 10);
    }
}

__device__ __forceinline__ void phase_scan(bf16_t* st, const float* dec) {
    constexpr int VPB = ST_PER_BC / 4;
#pragma unroll 1
    for (int gt = blockIdx.x * NTHR + opaque_tid(); gt < 2 * VPB; gt += gridDim.x * NTHR) {
    const int bl = gt / VPB, e0 = (gt % VPB) * 4;
    int mode, didx = 0; float cfac = 0.f;
    if (e0 < 65536) { mode = 0; didx = (e0 >> 14) * 128 + (e0 & 127); }
    else if (e0 < 131072) { mode = 1; const int h = (e0 - 65536) >> 14; cfac = __expf(64.f * log1pf(-exp2f(-(5.f + (float)h)))); }
    else if (e0 < 196608) { mode = 2; const int r = e0 - 131072; didx = 768 + (r >> 15) * 4 + (((r & 32767) >> 7) >> 6); }
    else { mode = 0; const int r = e0 - 196608; didx = 512 + (r >> 13) * 64 + (r & 63); }
    float s0 = 0.f, s1 = 0.f, s2 = 0.f, s3 = 0.f;
    bf16_t* ptr = st + (size_t)bl * 64 * ST_PER_BC + e0;
    const float* dp = dec + (size_t)bl * 64 * 1024 + didx;
#pragma unroll 1
    for (int c0 = 0; c0 < 64; c0 += 8) {
        u32x2 hv[8]; f32x4 dv[8];
#pragma unroll
        for (int j = 0; j < 8; ++j) {
            hv[j] = *(const u32x2*)(ptr + (size_t)(c0 + j) * ST_PER_BC);
            if (mode == 0) dv[j] = *(const f32x4*)(dp + (size_t)(c0 + j) * 1024);
            else if (mode == 1) dv[j] = (f32x4){cfac, cfac, cfac, cfac};
            else { const float d = dp[(size_t)(c0 + j) * 1024]; dv[j] = (f32x4){d, d, d, d}; }
        }
        __builtin_amdgcn_sched_barrier(0);
#pragma unroll
        for (int j = 0; j < 8; ++j) {
            u32x2 w; w.x = pk2(s0, s1); w.y = pk2(s2, s3);
            *(u32x2*)(ptr + (size_t)(c0 + j) * ST_PER_BC) = w;
            s0 = s0 * dv[j][0] + __uint_as_float(hv[j].x << 16); s1 = s1 * dv[j][1] + __uint_as_float(hv[j].x & 0xffff0000u);
            s2 = s2 * dv[j][2] + __uint_as_float(hv[j].y << 16); s3 = s3 * dv[j][3] + __uint_as_float(hv[j].y & 0xffff0000u);
        }
    }
    }
}

#define XB_TMO      128
#define XB_XCNT(j)  (256  + 64 * (j))
#define XB_XSUB(j)  (1280 + 64 * (j))
#define XB_XGEN(j)  (2304 + 64 * (j))
#define XB_TOP      3328
#define XB_TOPGEN   3392
#define XCD_BAR_WORDS 3456
#define XB_SPIN_CAP (1u << 18)
__device__ __forceinline__ unsigned xb_ld(unsigned* p)              { return __hip_atomic_load(p, __ATOMIC_RELAXED, __HIP_MEMORY_SCOPE_AGENT); }
__device__ __forceinline__ unsigned xb_add(unsigned* p, unsigned v) { return __hip_atomic_fetch_add(p, v, __ATOMIC_RELAXED, __HIP_MEMORY_SCOPE_AGENT); }
__device__ __forceinline__ unsigned xb_xcc_id() { return (unsigned)__builtin_amdgcn_s_getreg((3 << 11) | 20) & 0xFu; }
#define XB_SPIN(cond, bar) do { unsigned _sp = 0; while (cond) { __builtin_amdgcn_s_sleep(1); \
    if ((++_sp & 255u) == 0u) { if (xb_ld(&(bar)[XB_TMO])) break; if (_sp > XB_SPIN_CAP) { atomicAdd(&(bar)[XB_TMO], 1u); break; } } } } while (0)
struct XcdBarrier { unsigned* bar; unsigned x; volatile LAS unsigned* st; };
__device__ __forceinline__ XcdBarrier xcd_barrier_post(unsigned* bar, volatile LAS unsigned* st) {
    XcdBarrier b; b.bar = bar; b.x = xb_xcc_id(); b.st = st;
    if (threadIdx.x == 0) (void)xb_add(&bar[XB_XCNT(b.x)], 1u);
    return b;
}
__device__ __forceinline__ void xcd_barrier_complete(unsigned* bar, unsigned x, unsigned& nloc, unsigned& nx) {
    const unsigned G = gridDim.x * gridDim.y * gridDim.z;
    unsigned sum, cnt, mine, sp = 0u;
    for (;;) {
        sum = 0u; cnt = 0u; mine = 0u;
#pragma unroll
        for (unsigned j = 0; j < 16; ++j) { const unsigned c = xb_ld(&bar[XB_XCNT(j)]); sum += c; cnt += (c > 0u) ? 1u : 0u; mine = (j == x) ? c : mine; }
        if (sum == G) break;
        __builtin_amdgcn_s_sleep(1);
        if ((++sp & 255u) == 0u) { if (xb_ld(&bar[XB_TMO])) break; if (sp > XB_SPIN_CAP) { atomicAdd(&bar[XB_TMO], 1u); break; } }
    }
    nloc = mine > 0u ? mine : 1u; nx = cnt > 0u ? cnt : 1u;
}
__device__ __forceinline__ void xcd_barrier(const XcdBarrier& b) {
    asm volatile("s_waitcnt vmcnt(0)" ::: "memory");
    __syncthreads();
    if (threadIdx.x == 0) {
        unsigned* bar = b.bar;
        __builtin_amdgcn_s_waitcnt(0);
        unsigned nloc = b.st[0], nx = b.st[1];
        if (nloc == 0u) { xcd_barrier_complete(bar, b.x, nloc, nx); b.st[0] = nloc; b.st[1] = nx; }
        const unsigned old = xb_add(&bar[XB_XSUB(b.x)], 1u);
        const unsigned gen = old / nloc;
        if (old + 1u == (gen + 1u) * nloc) {
            __builtin_amdgcn_fence(__ATOMIC_RELEASE, "agent");
            asm volatile("s_waitcnt vmcnt(0)" ::: "memory");
            const unsigned og = xb_add(&bar[XB_TOP], 1u);
            const unsigned tg = og / nx;
            if (og + 1u == (tg + 1u) * nx) xb_add(&bar[XB_TOPGEN], 1u);
            else XB_SPIN(xb_ld(&bar[XB_TOPGEN]) == tg, bar);
            __builtin_amdgcn_fence(__ATOMIC_ACQUIRE, "agent");
            xb_add(&bar[XB_XGEN(b.x)], 1u);
            asm volatile("s_waitcnt vmcnt(0)" ::: "memory");
        } else {
            XB_SPIN(xb_ld(&bar[XB_XGEN(b.x)]) == gen, bar);
            __builtin_amdgcn_fence(__ATOMIC_ACQUIRE, "agent");
            asm volatile("s_waitcnt vmcnt(0)" ::: "memory");
        }
    }
    __syncthreads();
}

__global__ void __launch_bounds__(NTHR, 2) fwd_megakernel(Args a) {
    extern __shared__ __attribute__((aligned(16))) unsigned char shm[];
    LAS unsigned char* lds = (LAS unsigned char*)shm;
    cg::grid_group grid = cg::this_grid();
    unsigned char* ws = a.ws;
    const int G = gridDim.x;

    {
        volatile LAS unsigned* stw = (volatile LAS unsigned*)(lds + L_BARST);
        if (threadIdx.x < 2) stw[threadIdx.x] = 0u;
        __syncthreads();
    }
    const XcdBarrier gbar = xcd_barrier_post((unsigned*)(ws + WS_BAR), (volatile LAS unsigned*)(lds + L_BARST));
    for (int rep = 0; rep < REP_PREP; ++rep) { phase_prep(a, lds); if (rep == 0) grid.sync(); else xcd_barrier(gbar); }

    bf16_t* hbuf = (bf16_t*)(ws + WS_HY); bf16_t* ybuf = (bf16_t*)(ws + WS_HY);
    bf16_t* proj = (bf16_t*)(ws + WS_PROJ); bf16_t* st = (bf16_t*)(ws + WS_ST); float* dec = (float*)(ws + WS_DEC);
    const float* mod = (const float*)(ws + WS_MOD);

#pragma unroll 1
    for (int half = 0; half < 2; ++half) {
        const size_t xoff = (size_t)half * HROWS * DM;
#pragma unroll 1
        for (int l = 0; l < DEPTH; ++l) {
            const float* modl = mod + (size_t)l * 4 * 3072;
            bf16_t* slab = (bf16_t*)(ws + WS_PROJ);
            if (l == 0) { phase_norm<false>(a.x + xoff, nullptr, nullptr, nullptr, a.norm_g, modl, half, hbuf); if (half == 0) phase_wcvt(a, lds); }
            else phase_norm<false>(a.x + xoff, slab, mod + (size_t)(half * 2) * 3072 + 2048, a.out + xoff, a.norm_g + l * DM, modl, half, hbuf);
            xcd_barrier(gbar);
            for (int rep = 0; rep < REP_G1; ++rep) {
                pg8::Gemm g{hbuf, (const bf16_t*)(ws + WS_WIN) + (size_t)l * LDP * DM, HROWS, LDP, DM, DM};
                pg8::StaticOrder S; S.init(HROWS, LDP, G, (int)blockIdx.x);
                pg8::EpiProj E{proj, LDP};
                pg8::gemm_phase<pg8::EpiProj, pg8::StaticOrder>(lds, g, S, E);
                xcd_barrier(gbar);
            }
            MixP p;
            p.proj = proj; p.st = st; p.dec = dec; p.y = ybuf; p.rope = (const float2*)(ws + WS_ROPE);
            p.lbl = a.lb_logits; p.hgrn_g = a.hgrn_g + l * 512; p.ret_g = a.ret_g + l * 512; p.conv_w = a.conv_w + l * 4096; p.conv_b = a.conv_b + l * 1024;
            p.dt_bias = a.dt_bias + l * 8; p.a_log = a.a_log + l * 8; p.dskip = a.dskip + l * 8; p.ssm_g = a.ssm_g + l * 512;
            p.w2 = a.w_gk2 + l * 16 * 256; p.b2 = a.b_gk2 + l * 256; p.gla_g = a.gla_g + l * 512; p.layer = l;
            for (int rep = 0; rep < REP_M12; ++rep) { phase_mixer<1>(p, lds); xcd_barrier(gbar); phase_scan(st, dec); xcd_barrier(gbar); }
            for (int rep = 0; rep < REP_M3; ++rep) { phase_mixer<3>(p, lds); xcd_barrier(gbar); }
            for (int rep = 0; rep < REP_G2; ++rep) {
                pg8::Gemm g{ybuf, (const bf16_t*)(ws + WS_WOUT) + (size_t)l * DM * DI, HROWS, DM, DI / 2, DI};
                pg8::SplitOrder S; S.init(HROWS, DM, G, (int)blockIdx.x);
                pg8::EpiSlab E{slab};
                pg8::gemm_phase<pg8::EpiSlab, pg8::SplitOrder>(lds, g, S, E);
                xcd_barrier(gbar);
            }
        }
        phase_norm<true>(a.out + xoff, (const bf16_t*)(ws + WS_PROJ), mod + (size_t)(4 + half * 2) * 3072 + 2048, a.out + xoff, a.final_g, nullptr, half, nullptr);
    }
}

extern "C" void kernel_launch(void* const* d_in, const int* in_sizes, int n_in, void* d_out, int out_size, void* d_ws, size_t ws_size, hipStream_t stream) {
    static int grid = 0;
    if (grid == 0) {
        if (n_in != 20 || ws_size < WS_END) { fprintf(stderr, "kernel_launch: unexpected n_in %d / ws_size %zu (need %zu)\n", n_in, ws_size, (size_t)WS_END); grid = -1; return; }
        int dev = 0, cus = 0, per_cu = 0;
        hipGetDevice(&dev);
        hipDeviceGetAttribute(&cus, hipDeviceAttributeMultiprocessorCount, dev);
        if (hipFuncSetAttribute((const void*)fwd_megakernel, hipFuncAttributeMaxDynamicSharedMemorySize, LDS_BYTES) != hipSuccess) { fprintf(stderr, "kernel_launch: hipFuncSetAttribute failed\n"); grid = -1; return; }
        hipOccupancyMaxActiveBlocksPerMultiprocessor(&per_cu, (const void*)fwd_megakernel, NTHR, LDS_BYTES);
        if (per_cu < 1) { fprintf(stderr, "kernel_launch: occupancy query says %d blocks per CU\n", per_cu); per_cu = 1; }
        (void)hipGetLastError();
        grid = cus * per_cu;
    }
    if (grid < 0) return;
    Args a{};
    const float** f = (const float**)&a;
    for (int i = 0; i < 20; ++i) f[i] = (const float*)d_in[i];
    a.out = (float*)d_out; a.ws = (unsigned char*)d_ws;
    void* args[] = {&a};
    if (hipMemsetAsync((char*)d_ws + WS_BAR, 0, XCD_BAR_WORDS * 4, stream) != hipSuccess) { fprintf(stderr, "kernel_launch: memset of barrier words failed\n"); return; }
    hipError_t e = hipLaunchCooperativeKernel((const void*)fwd_megakernel, dim3(grid), dim3(NTHR), args, LDS_BYTES, stream);
    if (e != hipSuccess) fprintf(stderr, "cooperative launch failed: %s (grid %d)\n", hipGetErrorString(e), grid);
}
```

```cpp
#include <hip/hip_runtime.h>
#include <hip/hip_cooperative_groups.h>
#include <cstdio>
namespace cg = cooperative_groups;

#define LAS __attribute__((address_space(3)))
typedef unsigned short bf16_t;
typedef short bf16x8 __attribute__((ext_vector_type(8)));
typedef float f32x4 __attribute__((ext_vector_type(4)));
typedef float f32x16 __attribute__((ext_vector_type(16)));
typedef unsigned u32x4 __attribute__((ext_vector_type(4)));
typedef unsigned u32x2 __attribute__((ext_vector_type(2)));

#ifndef REP_PREP
#define REP_PREP 1
#endif
#ifndef REP_NORM
#define REP_NORM 1
#endif
#ifndef REP_G1
#define REP_G1 1
#endif
#ifndef REP_M12
#define REP_M12 1
#endif
#ifndef REP_M3
#define REP_M3 1
#endif
#ifndef REP_G2
#define REP_G2 1
#endif
#ifndef REP_UPREP
#define REP_UPREP 1
#endif
#ifndef REP_UCORE
#define REP_UCORE 1
#endif
constexpr int NB = 4, SEQ = 4096, DM = 1024, DEPTH = 2, DI = 2048;
constexpr int NIN = 7192, LDP = 7424;
constexpr int HROWS = 8192;
constexpr int NTHR = 512;
constexpr float EPS = 1e-6f;
constexpr int C_AQ = 0, C_AF = 512, C_AI = 1024, C_AG = 1536, C_RQ = 2048, C_RK = 2560, C_RV = 3072, C_RG = 3584,
              C_MZ = 4096, C_XBC = 4608, C_GQ = 5632, C_GK = 5888, C_GV = 6144, C_GG = 6656, C_DT = 7168, C_LR = 7176;
constexpr int ST_PER_BC = 229376;
constexpr size_t WS_WIN = 0;
constexpr size_t WS_WOUT = WS_WIN + 2ull * LDP * DM * 2;
constexpr size_t WS_MOD = WS_WOUT + 2ull * DM * DI * 2;
constexpr size_t WS_ROPE = WS_MOD + 2ull * 4 * 3072 * 4;
constexpr size_t WS_DEC = WS_ROPE + 4096ull * 64 * 8;
constexpr size_t WS_HY = WS_DEC + 128ull * 1024 * 4;
constexpr size_t WS_PROJ = WS_HY + (size_t)HROWS * DI * 2;
constexpr size_t WS_ST = WS_PROJ + (size_t)HROWS * LDP * 2;
constexpr size_t WS_BAR = WS_ST + 128ull * ST_PER_BC * 2;
constexpr size_t WS_END = WS_BAR + 3456 * 4;
constexpr int L_QI = 0, L_KI = 17408, L_VT = 34816, L_BIG = 71680, L_SM = 141312;
constexpr int SM_CUM = 0, SM_DT = 256, SM_SEG = 512, SM_REF = 1536, SM_CLAST = 1664, SM_RSS = 1792;
constexpr int L_BARST = L_SM + (1792 + 512) * 4;
constexpr int LDS_BYTES = L_BARST + 16;

constexpr int NCG = LDP / 128;
__device__ __forceinline__ size_t pidx(int row, int col) { return ((size_t)((row >> 6) * NCG + (col >> 7)) * 64 + (row & 63)) * 128 + (col & 127); }
__device__ __forceinline__ float bf2f(bf16_t v) { return __uint_as_float(((unsigned)v) << 16); }
__device__ __forceinline__ bf16_t f2bf(float f) { unsigned u = __float_as_uint(f); u += 0x7FFFu + ((u >> 16) & 1u); return (bf16_t)(u >> 16); }
typedef float f32x2_t __attribute__((ext_vector_type(2)));
typedef __bf16 bf16x2_t __attribute__((ext_vector_type(2)));
__device__ __forceinline__ unsigned pk2(float lo, float hi) { f32x2_t v = {lo, hi}; bf16x2_t b = __builtin_convertvector(v, bf16x2_t); return __builtin_bit_cast(unsigned, b); }
__device__ __forceinline__ int opaque_tid() { int t = threadIdx.x; asm volatile("" : "+v"(t)); return t; }
__device__ __forceinline__ float silu_f(float x) { return x * __builtin_amdgcn_rcpf(1.f + __expf(-x)); }
__device__ __forceinline__ float softplus_f(float x) { return fmaxf(x, 0.f) + __logf(1.f + __expf(-fabsf(x))); }
__device__ __forceinline__ float logsig_f(float x) { return fminf(x, 0.f) - __logf(1.f + __expf(-fabsf(x))); }

namespace pg8 {
constexpr int BM = 256, BK = 64, HALF = 128, HTB = HALF * BK * 2, STAGE_BYTES = 8 * HTB, NXCD = 8, WGM = 8;
__device__ __forceinline__ int lds_byte(int r, int c) { const int st = (r >> 4) * 2 + (c >> 5), rr = r & 15, cc = c & 31, ob = rr * 64 + cc * 2; return st * 1024 + (ob ^ (((ob >> 9) & 1) << 5)); }
__device__ __forceinline__ void stage_rc(int b, int& R, int& C) { const int st = b / 1024, sb = b % 1024, swz = sb ^ (((sb >> 9) & 1) << 5); R = (st >> 1) * 16 + swz / 64; C = (st & 1) * 32 + (swz % 64) / 2; }
__device__ __forceinline__ int perm32(int rho) { const int n = rho >> 4, i = rho & 15; return 8 * (i >> 2) + 4 * n + (i & 3); }
struct Unit { int pm, pn, kh; };
struct Gemm { const bf16_t* A; const bf16_t* Bt; int M, N, K, ld; };
struct StaticOrder {
    int nM, nN, nwg, G, c;
    __device__ void init(int M, int N, int G_, int c_) { nM = M / BM; nN = N / BM; nwg = nM * nN; G = G_; c = c_; }
    __device__ bool next(int i, Unit& u) const {
        const long L = (long)i * G + c; if (L >= nwg) return false;
        int wgid = (int)L; { const int q = nwg / NXCD, r = nwg % NXCD, xcd = wgid % NXCD, off = wgid / NXCD; wgid = (xcd < r ? xcd * (q + 1) : r * (q + 1) + (xcd - r) * q) + off; }
        const int nig = WGM * nN, gid = wgid / nig, fm = gid * WGM, gsz = (nM - fm) < WGM ? (nM - fm) : WGM;
        u.pm = fm + ((wgid % nig) % gsz); u.pn = (wgid % nig) / gsz; u.kh = 0; return true;
    }
};
struct SplitOrder {
    StaticOrder so;
    __device__ void init(int M, int N, int G_, int c_) { so.init(M, 2 * N, G_, c_); }
    __device__ bool next(int i, Unit& u) const { if (!so.next(i, u)) return false; u.kh = u.pn & 1; u.pn >>= 1; return true; }
};
struct EpiProj {
    static constexpr bool PERM = true;
    bf16_t* O; int ldc;
    __device__ __forceinline__ void operator()(const f32x4 (&acc)[2][2][4][2], const Unit& u, int wr, int wc, int fr, int fq) const {
        bf16_t* base = O + ((size_t)((u.pm * 4 + wr) * NCG + u.pn * 2) * 64 + fr) * 128 + wc * 32 + 8 * fq;
#pragma unroll
        for (int ai = 0; ai < 2; ++ai)
#pragma unroll
            for (int m = 0; m < 4; ++m)
#pragma unroll
                for (int bj = 0; bj < 2; ++bj) { const f32x4 v0 = acc[ai][bj][m][0], v1 = acc[ai][bj][m][1];
                    u32x4 w; w.x = pk2(v0[0], v0[1]); w.y = pk2(v0[2], v0[3]); w.z = pk2(v1[0], v1[1]); w.w = pk2(v1[2], v1[3]);
                    *(u32x4*)(base + (size_t)ai * (2 * NCG * 8192) + bj * 8192 + m * (16 * 128)) = w; }
    }
};
struct EpiRes {
    static constexpr bool PERM = false;
    const float* xin; float* xout; const float* gate;
    __device__ __forceinline__ void operator()(const f32x4 (&acc)[2][2][4][2], const Unit& u, int wr, int wc, int fr, int fq) const {
        const int row0 = u.pm * BM + wr * 64 + fr, col0 = u.pn * BM + wc * 32 + 4 * fq;
        const float* gp = gate + (size_t)(u.pm >> 4) * 3072 + col0;
        f32x4 gv[2][2];
#pragma unroll
        for (int bj = 0; bj < 2; ++bj)
#pragma unroll
            for (int n = 0; n < 2; ++n) gv[bj][n] = *(const f32x4*)(gp + bj * HALF + n * 16);
#pragma unroll
        for (int am = 0; am < 4; ++am) {
            const int ai = am >> 1, m0 = (am & 1) * 2;
            f32x4 xi[2][2][2];
#pragma unroll
            for (int m = 0; m < 2; ++m)
#pragma unroll
                for (int bj = 0; bj < 2; ++bj)
#pragma unroll
                    for (int n = 0; n < 2; ++n) xi[m][bj][n] = *(const f32x4*)(xin + (size_t)(row0 + ai * HALF + (m0 + m) * 16) * DM + col0 + bj * HALF + n * 16);
            __builtin_amdgcn_sched_barrier(0);
#pragma unroll
            for (int m = 0; m < 2; ++m)
#pragma unroll
                for (int bj = 0; bj < 2; ++bj)
#pragma unroll
                    for (int n = 0; n < 2; ++n) *(f32x4*)(xout + (size_t)(row0 + ai * HALF + (m0 + m) * 16) * DM + col0 + bj * HALF + n * 16) = xi[m][bj][n] + gv[bj][n] * acc[ai][bj][m0 + m][n];
        }
    }
};

struct EpiSlab {
    static constexpr bool PERM = true;
    bf16_t* slab;
    __device__ __forceinline__ void operator()(const f32x4 (&acc)[2][2][4][2], const Unit& u, int wr, int wc, int fr, int fq) const {
        const int row0 = u.pm * BM + wr * 64 + fr, col0 = u.pn * BM + wc * 32 + 8 * fq;
        bf16_t* base = slab + (size_t)u.kh * HROWS * DM;
#pragma unroll
        for (int ai = 0; ai < 2; ++ai)
#pragma unroll
            for (int m = 0; m < 4; ++m) { bf16_t* rowp = base + (size_t)(row0 + ai * HALF + m * 16) * DM + col0;
#pragma unroll
                for (int bj = 0; bj < 2; ++bj) { const f32x4 v0 = acc[ai][bj][m][0], v1 = acc[ai][bj][m][1];
                    u32x4 w; w.x = pk2(v0[0], v0[1]); w.y = pk2(v0[2], v0[3]); w.z = pk2(v1[0], v1[1]); w.w = pk2(v1[2], v1[3]);
                    *(u32x4*)(rowp + bj * HALF) = w; } }
    }
};

template <class Epi, class Sched, bool ALIGN_EPI = true, bool SP2 = true>
__device__ __forceinline__ void gemm_phase(LAS unsigned char* lds, const Gemm g, const Sched& S, const Epi& E) {
    const int tid = opaque_tid(), wid = __builtin_amdgcn_readfirstlane(tid >> 6), lane = tid & 63, wr = wid >> 2, wc = wid & 3, fr = lane & 15, fq = lane >> 4;
    const int K = g.K, nt = K / BK, ld = g.ld;
    unsigned voffA[2], voffB[2];
#pragma unroll
    for (int i = 0; i < 2; ++i) { int R, C; stage_rc(tid * 16 + i * 8192, R, C); const int Rb = Epi::PERM ? ((R & ~31) + perm32(R & 31)) : R;
        voffA[i] = (unsigned)(R * ld + C) * 2u; voffB[i] = (unsigned)(Rb * ld + C) * 2u; }
    const size_t kstep = (size_t)(BK * 2);
    const size_t hstep = (size_t)HALF * ld * 2;
    const size_t tstep = 2 * hstep;
    const unsigned ldsw = (unsigned)wid * 1024u;
    const int aoff = lds_byte(wr * 64 + fr, fq * 8), boff = lds_byte(wc * 32 + fr, fq * 8);
#define PG8_SA(b, h) (((b) * 2 + (h)) * HTB)
#define PG8_SB(b, h) ((4 + (b) * 2 + (h)) * HTB)
#define PG8_STAGE(bufoff, gbase, voff) do { _Pragma("unroll") for (int _i = 0; _i < 2; ++_i) \
        __builtin_amdgcn_global_load_lds((const unsigned*)((const char*)(gbase) + (voff)[_i]), (LAS unsigned*)(lds + (bufoff) + ldsw + _i * 8192), 16, 0, 0); } while (0)
#define PG8_LDA(dst, b, h) do { _Pragma("unroll") for (int m = 0; m < 4; ++m) _Pragma("unroll") for (int k = 0; k < 2; ++k) dst[m][k] = *(const LAS bf16x8*)(lds + PG8_SA(b, h) + aoff + m * 2048 + k * 1024); } while (0)
#define PG8_LDB(dst, b, h) do { _Pragma("unroll") for (int n = 0; n < 2; ++n) _Pragma("unroll") for (int k = 0; k < 2; ++k) dst[n][k] = *(const LAS bf16x8*)(lds + PG8_SB(b, h) + boff + n * 2048 + k * 1024); } while (0)
#define PG8_MMA(ai, bj, At, Bt) do { __builtin_amdgcn_s_setprio(1); _Pragma("unroll") for (int m = 0; m < 4; ++m) _Pragma("unroll") for (int n = 0; n < 2; ++n) _Pragma("unroll") for (int k = 0; k < 2; ++k) \
        acc[ai][bj][m][n] = __builtin_amdgcn_mfma_f32_16x16x32_bf16(Bt[n][k], At[m][k], acc[ai][bj][m][n], 0, 0, 0); __builtin_amdgcn_s_setprio(0); } while (0)
#define PG8_WAIT_V(n) asm volatile("s_waitcnt vmcnt(" #n ")" ::: "memory")
#define PG8_WAIT_L(n) asm volatile("s_waitcnt lgkmcnt(" #n ")" ::: "memory")
#define PG8_BAR __builtin_amdgcn_s_barrier()
#define PG8_SCHED __builtin_amdgcn_sched_barrier(0)
    Unit cur, nxt; int ui = 0;
    if (!S.next(0, cur)) return;
    f32x4 acc[2][2][4][2];
#pragma unroll
    for (int a = 0; a < 2; ++a)
#pragma unroll
        for (int b = 0; b < 2; ++b)
#pragma unroll
            for (int m = 0; m < 4; ++m)
#pragma unroll
                for (int n = 0; n < 2; ++n) acc[a][b][m][n] = (f32x4){0.f, 0.f, 0.f, 0.f};
    bf16x8 At[4][2], B0[2][2], B1[2][2];
    const char* cA = (const char*)g.A + (size_t)cur.pm * tstep + (size_t)cur.kh * K * 2; const char* cB = (const char*)g.Bt + (size_t)cur.pn * tstep + (size_t)cur.kh * K * 2;
    if constexpr (SP2) {
        PG8_STAGE(PG8_SB(0, 0), cB, voffB); PG8_STAGE(PG8_SB(0, 1), cB + hstep, voffB); PG8_STAGE(PG8_SA(0, 0), cA, voffA); PG8_STAGE(PG8_SA(0, 1), cA + hstep, voffA);
        if (wr == 1) PG8_BAR;
        PG8_WAIT_V(2); PG8_BAR;
        PG8_STAGE(PG8_SB(1, 0), cB + kstep, voffB); PG8_STAGE(PG8_SA(1, 0), cA + kstep, voffA); PG8_STAGE(PG8_SB(1, 1), cB + hstep + kstep, voffB);
        PG8_WAIT_V(6); PG8_BAR;
    } else {
        PG8_STAGE(PG8_SB(0, 0), cB, voffB); PG8_STAGE(PG8_SA(0, 0), cA, voffA); PG8_STAGE(PG8_SB(0, 1), cB + hstep, voffB); PG8_STAGE(PG8_SA(0, 1), cA + hstep, voffA);
        if (wr == 1) PG8_BAR;
        PG8_WAIT_V(4); PG8_BAR;
        PG8_STAGE(PG8_SB(1, 0), cB + kstep, voffB); PG8_STAGE(PG8_SA(1, 0), cA + kstep, voffA); PG8_STAGE(PG8_SB(1, 1), cB + hstep + kstep, voffB);
        PG8_WAIT_V(6); PG8_BAR;
    }
    for (;;) {
        const bool has_next = S.next(ui + 1, nxt);
        const char* nA = has_next ? (const char*)g.A + (size_t)nxt.pm * tstep + (size_t)nxt.kh * K * 2 : cA; const char* nB = has_next ? (const char*)g.Bt + (size_t)nxt.pn * tstep + (size_t)nxt.kh * K * 2 : cB;
        for (int t = 0; t < nt; t += 2) {
            const bool last = (t == nt - 2);
            const char* a1 = cA + (size_t)(t + 1) * kstep;
            const char* a2 = last ? nA : cA + (size_t)(t + 2) * kstep; const char* b2 = last ? nB : cB + (size_t)(t + 2) * kstep;
            const char* a3 = a2 + kstep; const char* b3 = b2 + kstep;
            if constexpr (SP2) {
            PG8_LDB(B0, 0, 0); PG8_LDB(B1, 0, 1); PG8_SCHED; PG8_LDA(At, 0, 0); PG8_STAGE(PG8_SA(1, 1), a1 + hstep, voffA);
            PG8_WAIT_V(8); PG8_WAIT_L(0); PG8_BAR; PG8_MMA(0, 0, At, B0); PG8_MMA(0, 1, At, B1); PG8_BAR; PG8_SCHED;
            PG8_LDA(At, 0, 1); PG8_STAGE(PG8_SB(0, 0), b2, voffB); PG8_STAGE(PG8_SB(0, 1), b2 + hstep, voffB); PG8_STAGE(PG8_SA(0, 0), a2, voffA);
            PG8_WAIT_V(8); PG8_WAIT_L(0); PG8_BAR; PG8_MMA(1, 0, At, B0); PG8_MMA(1, 1, At, B1); PG8_BAR; PG8_SCHED;
            PG8_LDB(B0, 1, 0); PG8_LDB(B1, 1, 1); PG8_SCHED; PG8_LDA(At, 1, 0); PG8_STAGE(PG8_SA(0, 1), a2 + hstep, voffA);
            PG8_WAIT_V(8); PG8_WAIT_L(0); PG8_BAR; PG8_MMA(0, 0, At, B0); PG8_MMA(0, 1, At, B1); PG8_BAR; PG8_SCHED;
            PG8_LDA(At, 1, 1); PG8_STAGE(PG8_SB(1, 0), b3, voffB); PG8_STAGE(PG8_SB(1, 1), b3 + hstep, voffB); PG8_STAGE(PG8_SA(1, 0), a3, voffA);
            PG8_WAIT_V(8); PG8_WAIT_L(0); PG8_BAR; PG8_MMA(1, 0, At, B0); PG8_MMA(1, 1, At, B1); PG8_BAR; PG8_SCHED;
            } else {
            PG8_LDB(B0, 0, 0); PG8_SCHED; PG8_LDA(At, 0, 0); PG8_STAGE(PG8_SA(1, 1), a1 + hstep, voffA);
            PG8_WAIT_L(8); PG8_BAR; PG8_WAIT_L(0); PG8_MMA(0, 0, At, B0); PG8_BAR; PG8_SCHED;
            PG8_LDB(B1, 0, 1); PG8_STAGE(PG8_SB(0, 0), b2, voffB);
            PG8_BAR; PG8_WAIT_L(0); PG8_MMA(0, 1, At, B1); PG8_BAR;
            PG8_LDA(At, 0, 1); PG8_STAGE(PG8_SA(0, 0), a2, voffA);
            PG8_BAR; PG8_WAIT_L(0); PG8_MMA(1, 0, At, B0); PG8_BAR; PG8_SCHED;
            PG8_STAGE(PG8_SB(0, 1), b2 + hstep, voffB);
            PG8_WAIT_V(6); PG8_BAR; PG8_MMA(1, 1, At, B1); PG8_BAR;
            PG8_LDB(B0, 1, 0); PG8_SCHED; PG8_LDA(At, 1, 0); PG8_STAGE(PG8_SA(0, 1), a2 + hstep, voffA);
            PG8_WAIT_L(8); PG8_BAR; PG8_WAIT_L(0); PG8_MMA(0, 0, At, B0); PG8_BAR; PG8_SCHED;
            PG8_LDB(B1, 1, 1); PG8_STAGE(PG8_SB(1, 0), b3, voffB);
            PG8_BAR; PG8_WAIT_L(0); PG8_MMA(0, 1, At, B1); PG8_BAR;
            PG8_LDA(At, 1, 1); PG8_STAGE(PG8_SA(1, 0), a3, voffA);
            PG8_BAR; PG8_WAIT_L(0); PG8_MMA(1, 0, At, B0); PG8_BAR; PG8_SCHED;
            PG8_STAGE(PG8_SB(1, 1), b3 + hstep, voffB);
            PG8_WAIT_V(6); PG8_BAR; PG8_MMA(1, 1, At, B1); PG8_BAR;
            }
        }
        if constexpr (ALIGN_EPI) { if (wr == 0) PG8_BAR; }
        E(acc, cur, wr, wc, fr, fq);
        if (!has_next) break;
#pragma unroll
        for (int a = 0; a < 2; ++a)
#pragma unroll
            for (int b = 0; b < 2; ++b)
#pragma unroll
                for (int m = 0; m < 4; ++m)
#pragma unroll
                    for (int n = 0; n < 2; ++n) acc[a][b][m][n] = (f32x4){0.f, 0.f, 0.f, 0.f};
        cur = nxt; cA = nA; cB = nB; ++ui;
        if constexpr (ALIGN_EPI) { if (wr == 1) PG8_BAR; }
    }
    PG8_WAIT_V(0);
    if constexpr (!ALIGN_EPI) { if (wr == 0) PG8_BAR; }
    PG8_BAR;
#undef PG8_SA
#undef PG8_SB
#undef PG8_STAGE
#undef PG8_LDA
#undef PG8_LDB
#undef PG8_MMA
#undef PG8_WAIT_V
#undef PG8_WAIT_L
#undef PG8_BAR
#undef PG8_SCHED
}
}

struct Args {
    const float* x; const float* c; const float* w_ada; const float* b_ada; const float* norm_g; const float* w_in;
    const float* lb_logits; const float* hgrn_g; const float* ret_g; const float* conv_w; const float* conv_b;
    const float* dt_bias; const float* a_log; const float* dskip; const float* ssm_g; const float* w_gk2; const float* b_gk2;
    const float* gla_g; const float* w_out; const float* final_g;
    float* out; unsigned char* ws;
};

__device__ __forceinline__ void transpose_cvt(const float* __restrict__ src, int K, int N, bf16_t* __restrict__ dst, int Npad, LAS unsigned char* lds, int gid, int gstride, bool perm) {
    LAS float* T = (LAS float*)lds;
    const int tid = opaque_tid(), ntk = K / 64, ntn = Npad / 256;
    for (int tile = gid; tile < ntk * ntn; tile += gstride) {
        const int tk = tile % ntk, tn = tile / ntk;
        float v[32];
#pragma unroll
        for (int i = 0; i < 32; ++i) { const int kk = (tid >> 8) + 2 * i, nn = tid & 255, n = tn * 256 + nn;
            const int ns = !perm ? n : (n < 5632) ? n : (n < 7168) ? n + 8 : (n < 7176) ? n - 7168 + 5632 : n;
            v[i] = (n < N) ? src[(size_t)(tk * 64 + kk) * N + ns] : 0.f; }
#pragma unroll
        for (int i = 0; i < 32; ++i) { const int kk = (tid >> 8) + 2 * i, nn = tid & 255; T[kk * 257 + nn] = v[i]; }
        __syncthreads();
#pragma unroll
        for (int i = 0; i < 16; ++i) { const int nn = (tid >> 5) + 16 * i, kk = (tid & 31) * 2;
            *(unsigned*)(dst + (size_t)(tn * 256 + nn) * K + tk * 64 + kk) = pk2(T[kk * 257 + nn], T[(kk + 1) * 257 + nn]); }
        __syncthreads();
    }
}

__device__ __forceinline__ void phase_wcvt(const Args& a, LAS unsigned char* lds) {
    const int G = gridDim.x, bid = blockIdx.x;
    unsigned char* ws = a.ws;
    for (int l = 0; l < DEPTH; ++l) {
        transpose_cvt(a.w_in + (size_t)l * DM * NIN, DM, NIN, (bf16_t*)(ws + WS_WIN) + (size_t)l * LDP * DM, LDP, lds, bid, G, true);
        transpose_cvt(a.w_out + (size_t)l * DI * DM, DI, DM, (bf16_t*)(ws + WS_WOUT) + (size_t)l * DM * DI, DM, lds, (bid + 128) % G, G, false);
    }
}
__device__ __forceinline__ void phase_prep(const Args& a, LAS unsigned char* lds) {
    const int tid = opaque_tid(), G = gridDim.x, bid = blockIdx.x;
    unsigned char* ws = a.ws;
    {
        LAS float* R = (LAS float*)lds;
        LAS float* CA = (LAS float*)(lds + 8192);
        float* mod = (float*)(ws + WS_MOD);
        const int jj = tid & 63, ks = tid >> 6;
        if (bid < DEPTH * 48) {
#pragma unroll
            for (int q = 0; q < 8; ++q) CA[tid + NTHR * q] = silu_f(a.c[tid + NTHR * q]);
            __syncthreads();
        }
        for (int item = bid; item < DEPTH * 48; item += G) {
            const int l = item / 48, j = (item % 48) * 64 + jj;
            float s0 = 0.f, s1 = 0.f, s2 = 0.f, s3 = 0.f;
            const float* w = a.w_ada + (size_t)l * DM * 3072 + j;
#pragma unroll 16
            for (int k = ks * 128; k < ks * 128 + 128; ++k) { const float wv = w[(size_t)k * 3072];
                s0 += CA[k] * wv; s1 += CA[DM + k] * wv; s2 += CA[2 * DM + k] * wv; s3 += CA[3 * DM + k] * wv; }
            R[(ks * 4 + 0) * 64 + jj] = s0; R[(ks * 4 + 1) * 64 + jj] = s1; R[(ks * 4 + 2) * 64 + jj] = s2; R[(ks * 4 + 3) * 64 + jj] = s3;
            __syncthreads();
            if (tid < 256) { const int b = tid >> 6; float s = a.b_ada[l * 3072 + j];
#pragma unroll
                for (int q = 0; q < 8; ++q) s += R[(q * 4 + b) * 64 + jj];
                mod[(size_t)(l * 4 + b) * 3072 + j] = s; }
            __syncthreads();
        }
    }
    {
        float2* rope = (float2*)(ws + WS_ROPE);
        for (int i = bid * NTHR + tid; i < 4096 * 64; i += G * NTHR) {
            const int pos = i >> 6, j = i & 63;
            const float invf = powf(10000.f, -(float)(2 * j) / 128.f);
            const float ang = (float)pos * invf;
            const float k = rintf(ang * 0.15915494309189535f);
            float r = fmaf(-k, 6.2831854820251465f, ang); r = fmaf(-k, -1.7484555e-07f, r);
            rope[i] = make_float2(__cosf(r), __sinf(r));
        }
    }
}

template <bool FINAL>
__device__ __forceinline__ void phase_norm(const float* __restrict__ xin  , const bf16_t* __restrict__ slab  ,
                                           const float* __restrict__ gate_prev  , float* xout  ,
                                           const float* __restrict__ g, const float* __restrict__ mod  , int half, bf16_t* __restrict__ hout) {
    const int tid = opaque_tid(), lane = tid & 63, wid = tid >> 6;
    const int gw = blockIdx.x * 8 + wid, nw = gridDim.x * 8;
    for (int row = gw; row < HROWS; row += nw) {
        const float* xr = xin + (size_t)row * DM;
        f32x4 v[4]; float ss = 0.f;
#pragma unroll
        for (int i = 0; i < 4; ++i) v[i] = *(const f32x4*)(xr + i * 256 + lane * 4);
        if (slab) {
            u32x2 a0[4], a1[4]; f32x4 gp[4];
#pragma unroll
            for (int i = 0; i < 4; ++i) { const int col = i * 256 + lane * 4;
                a0[i] = *(const u32x2*)(slab + (size_t)row * DM + col); a1[i] = *(const u32x2*)(slab + (size_t)(HROWS + row) * DM + col);
                gp[i] = *(const f32x4*)(gate_prev + (size_t)(row >> 12) * 3072 + col); }
#pragma unroll
            for (int i = 0; i < 4; ++i) {
                const f32x4 sa = {__uint_as_float(a0[i].x << 16) + __uint_as_float(a1[i].x << 16), __uint_as_float(a0[i].x & 0xffff0000u) + __uint_as_float(a1[i].x & 0xffff0000u),
                                  __uint_as_float(a0[i].y << 16) + __uint_as_float(a1[i].y << 16), __uint_as_float(a0[i].y & 0xffff0000u) + __uint_as_float(a1[i].y & 0xffff0000u)};
                v[i] = v[i] + gp[i] * sa; }
        }
        if (!FINAL && xout) {
#pragma unroll
            for (int i = 0; i < 4; ++i) *(f32x4*)(xout + (size_t)row * DM + i * 256 + lane * 4) = v[i];
        }
#pragma unroll
        for (int i = 0; i < 4; ++i) ss += v[i][0] * v[i][0] + v[i][1] * v[i][1] + v[i][2] * v[i][2] + v[i][3] * v[i][3];
#pragma unroll
        for (int o = 32; o > 0; o >>= 1) ss += __shfl_xor(ss, o);
        const float rinv = rsqrtf(ss * (1.f / DM) + EPS);
        if constexpr (FINAL) {
#pragma unroll
            for (int i = 0; i < 4; ++i) { const int col = i * 256 + lane * 4; const f32x4 gg = *(const f32x4*)(g + col);
                *(f32x4*)(xout + (size_t)row * DM + col) = v[i] * rinv * gg; }
        } else {
            const float* mb = mod + (size_t)(half * 2 + (row >> 12)) * 3072;
#pragma unroll
            for (int i = 0; i < 4; ++i) { const int col = i * 256 + lane * 4;
                const f32x4 gg = *(const f32x4*)(g + col), sh = *(const f32x4*)(mb + col), sc = *(const f32x4*)(mb + 1024 + col);
                float o0 = v[i][0] * rinv * gg[0] * (1.f + sc[0]) + sh[0], o1 = v[i][1] * rinv * gg[1] * (1.f + sc[1]) + sh[1];
                float o2 = v[i][2] * rinv * gg[2] * (1.f + sc[2]) + sh[2], o3 = v[i][3] * rinv * gg[3] * (1.f + sc[3]) + sh[3];
                u32x2 w; w.x = pk2(o0, o1); w.y = pk2(o2, o3);
                *(u32x2*)(hout + (size_t)row * DM + col) = w; }
        }
    }
}

struct MixP {
    const bf16_t* proj; bf16_t* st; float* dec; bf16_t* y; const float2* rope;
    const float* lbl; const float* hgrn_g; const float* ret_g; const float* conv_w; const float* conv_b; const float* dt_bias; const float* a_log;
    const float* dskip; const float* ssm_g; const float* w2; const float* b2; const float* gla_g; int layer;
};

__device__ __forceinline__ bf16x8 frag(LAS unsigned char* lds, int off, int ld, int r0, int ks, int lane) {
    return *(const LAS bf16x8*)(lds + off + (((r0 + (lane & 31)) * ld + 16 * ks + 8 * (lane >> 5)) << 1));
}
__device__ __forceinline__ int rowmap(int r, int lane) { return (r & 3) + 8 * (r >> 2) + 4 * (lane >> 5); }

__device__ __forceinline__ void conv16(LAS unsigned char* lds, int off, int ncols, int col, const float* cw, int seg, float (&out)[16]) {
    const LAS bf16_t* rp = (const LAS bf16_t*)(lds + off) + seg * 16 * ncols + col;
    float u[19];
#pragma unroll
    for (int k = 0; k < 19; ++k) u[k] = bf2f(rp[k * ncols]);
#pragma unroll
    for (int i = 0; i < 16; ++i) out[i] = silu_f(cw[4] + cw[0] * u[i] + cw[1] * u[i + 1] + cw[2] * u[i + 2] + cw[3] * u[i + 3]);
}
__device__ __forceinline__ void conv_w_load(const MixP& p, int chan, float* cw) {
    cw[0] = p.conv_w[chan]; cw[1] = p.conv_w[1024 + chan]; cw[2] = p.conv_w[2048 + chan]; cw[3] = p.conv_w[3072 + chan]; cw[4] = p.conv_b[chan];
}
template <int NCOLS, int NROWS> struct Stg { static constexpr int VPR = NCOLS / 8, NV = NROWS * VPR, NIT = (NV + NTHR - 1) / NTHR; };
template <int NCOLS, int NROWS>
__device__ __forceinline__ void stg_load(const bf16_t* proj, int grow0, int col0, int tid, int zrows, u32x4* r) {
    using S = Stg<NCOLS, NROWS>;
#pragma unroll
    for (int j = 0; j < S::NIT; ++j) { const int vi = tid + NTHR * j, row = vi / S::VPR, cv = vi % S::VPR;
        const bool ok = (vi < S::NV) && (row >= zrows);
        r[j] = ok ? *(const u32x4*)(proj + pidx(grow0 + row, col0 + cv * 8)) : (u32x4){0u, 0u, 0u, 0u}; }
}
template <int NCOLS, int NROWS>
__device__ __forceinline__ void stg_store(LAS unsigned char* lds, int off, int tid, const u32x4* r) {
    using S = Stg<NCOLS, NROWS>;
#pragma unroll
    for (int j = 0; j < S::NIT; ++j) { const int vi = tid + NTHR * j; if (vi < S::NV) *(LAS u32x4*)(lds + off + vi * 16) = r[j]; }
}
__device__ __forceinline__ void store16(LAS unsigned char* lds, int byteoff, const float (&v)[16]) {
    u32x4 a, b; a.x = pk2(v[0], v[1]); a.y = pk2(v[2], v[3]); a.z = pk2(v[4], v[5]); a.w = pk2(v[6], v[7]);
    b.x = pk2(v[8], v[9]); b.y = pk2(v[10], v[11]); b.z = pk2(v[12], v[13]); b.w = pk2(v[14], v[15]);
    *(LAS u32x4*)(lds + byteoff) = a; *(LAS u32x4*)(lds + byteoff + 16) = b;
}
__device__ __forceinline__ void store8(LAS unsigned char* lds, int byteoff, const float (&v)[8]) {
    u32x4 a; a.x = pk2(v[0], v[1]); a.y = pk2(v[2], v[3]); a.z = pk2(v[4], v[5]); a.w = pk2(v[6], v[7]);
    *(LAS u32x4*)(lds + byteoff) = a;
}

constexpr int NUNITS = 128 * 14;
struct Pref { u32x4 raw[11]; u32x4 st[8]; float aux[16]; };
template <int BR, int PASS>
__device__ __forceinline__ void load_A(const MixP& p, int bc, int hu, int tid, Pref& pf) {
    const bf16_t* P = p.proj; const int g0 = bc * 64;
    if constexpr (BR == 0) { stg_load<128, 64>(P, g0, C_AF + hu * 128, tid, 0, pf.raw + 0); stg_load<128, 64>(P, g0, C_AI + hu * 128, tid, 0, pf.raw + 2);
        if constexpr (PASS == 3) stg_load<128, 64>(P, g0, C_AQ + hu * 128, tid, 0, pf.raw + 4); }
    if constexpr (BR == 1) { stg_load<128, 64>(P, g0, C_RK + hu * 128, tid, 0, pf.raw + 0); stg_load<128, 64>(P, g0, C_RV + hu * 128, tid, 0, pf.raw + 2);
        if constexpr (PASS == 3) stg_load<128, 64>(P, g0, C_RQ + hu * 128, tid, 0, pf.raw + 4); }
    if constexpr (BR == 2) { const int zr = ((bc & 63) == 0) ? 3 : 0;
        stg_load<128, 67>(P, g0 - 3, C_XBC + 512 + hu * 128, tid, zr, pf.raw + 0); stg_load<256, 67>(P, g0 - 3, C_XBC + hu * 256, tid, zr, pf.raw + 3);
        if constexpr (PASS == 3) stg_load<128, 67>(P, g0 - 3, C_XBC + 768 + hu * 128, tid, zr, pf.raw + 8); }
    if constexpr (BR == 3) { stg_load<64, 64>(P, g0, C_GK + hu * 64, tid, 0, pf.raw + 0); stg_load<128, 64>(P, g0, C_GV + hu * 128, tid, 0, pf.raw + 1); stg_load<16, 64>(P, g0, C_LR, tid, 0, pf.raw + 3);
        if constexpr (PASS == 3) stg_load<64, 64>(P, g0, C_GQ + hu * 64, tid, 0, pf.raw + 4); }
}
template <int BR, int PASS>
__device__ __forceinline__ void load_B(const MixP& p, int bc, int hu, int tid, Pref& pf) {
    if constexpr (PASS == 3) {
        constexpr int DK = (BR == 3) ? 64 : 128, DV = (BR == 2) ? 256 : 128, NV = DV * DK / 8 / NTHR;
        const int st_off = (BR == 0) ? hu * 16384 : (BR == 1) ? 65536 + hu * 16384 : (BR == 2) ? 131072 + hu * 32768 : 196608 + hu * 8192;
        const bf16_t* stg = p.st + (size_t)bc * ST_PER_BC + st_off;
#pragma unroll
        for (int k = 0; k < NV; ++k) pf.st[k] = *(const u32x4*)(stg + (size_t)(tid + NTHR * k) * 8);
    }
    if constexpr (BR == 1) { const int j = tid & 63, seg = tid >> 6, chunk = bc & 63;
#pragma unroll
        for (int i = 0; i < 8; ++i) { const float2 c = p.rope[(chunk * 64 + seg * 8 + i) * 64 + j]; pf.aux[2 * i] = c.x; pf.aux[2 * i + 1] = c.y; } }
    if constexpr (BR == 2) { if (tid < 64) {
#pragma unroll
            for (int hh = 0; hh < 4; ++hh) pf.aux[hh] = bf2f(p.proj[pidx(bc * 64 + tid, C_DT + hu * 4 + hh)]); } }
    if constexpr (BR == 3) { const int cc = hu * 64 + (tid & 63);
#pragma unroll
        for (int r = 0; r < 16; ++r) pf.aux[r] = p.w2[r * 256 + cc]; }
}
template <int PASS>
__device__ __forceinline__ void load_A_any(const MixP& p, int i, int tid, Pref& pf) {
    const int bc = i / 14, u = i % 14;
    if (u < 4) load_A<0, PASS>(p, bc, u, tid, pf); else if (u < 8) load_A<1, PASS>(p, bc, u - 4, tid, pf);
    else if (u < 10) load_A<2, PASS>(p, bc, u - 8, tid, pf); else load_A<3, PASS>(p, bc, u - 10, tid, pf);
}
template <int PASS>
__device__ __forceinline__ void load_B_any(const MixP& p, int i, int tid, Pref& pf) {
    const int bc = i / 14, u = i % 14;
    if (u < 4) load_B<0, PASS>(p, bc, u, tid, pf); else if (u < 8) load_B<1, PASS>(p, bc, u - 4, tid, pf);
    else if (u < 10) load_B<2, PASS>(p, bc, u - 8, tid, pf); else load_B<3, PASS>(p, bc, u - 10, tid, pf);
}

template <int BR, int PASS>
__device__ __forceinline__ void mixer_unit(const MixP& p, LAS unsigned char* lds, int bc, int hu  ) {
    constexpr int DK = (BR == 3) ? 64 : 128, LDK = DK + 8, NH = (BR == 2) ? 4 : 1, DV = (BR == 2) ? 256 : 128, NT = DV / 128;
    constexpr bool VEC = (BR == 0 || BR == 3);
    const int tid = opaque_tid(), lane = tid & 63, wid = __builtin_amdgcn_readfirstlane(tid >> 6);
    const int chunk = bc & 63;
    const bf16_t* P = p.proj;
    LAS float* SM = (LAS float*)(lds + L_SM);
    LAS bf16_t* QI = (LAS bf16_t*)(lds + L_QI); LAS bf16_t* KI = (LAS bf16_t*)(lds + L_KI); LAS bf16_t* VT = (LAS bf16_t*)(lds + L_VT);
    const int st_off = (BR == 0) ? hu * 16384 : (BR == 1) ? 65536 + hu * 16384 : (BR == 2) ? 131072 + hu * 32768 : 196608 + hu * 8192;
    bf16_t* stg = p.st + (size_t)bc * ST_PER_BC + st_off;
    Pref pf;
    load_A<BR, PASS>(p, bc, hu, tid, pf);
    load_B<BR, PASS>(p, bc, hu, tid, pf);
    constexpr int NTG = (PASS == 3) ? NT : 1;
    const int gcol = (BR == 0) ? C_AG + hu * 128 : (BR == 1) ? C_RG + hu * 128 : (BR == 2) ? C_MZ + hu * 256 : C_GG + hu * 128;
    const float* gain = (BR == 0) ? p.hgrn_g + hu * 128 : (BR == 1) ? p.ret_g + hu * 128 : (BR == 2) ? p.ssm_g + hu * 256 : p.gla_g + hu * 128;
    bf16_t gt[NTG][16]; float gnv[NTG], dskv[NTG];
    float lb = 0.f, bb = 0.f, cwb[5], cwc[5], cwx[5], dtb[4], alg[4];
    if constexpr (BR == 0) { if (p.layer == 1) { const int cc = hu * 128 + (tid & 127); lb = 1.f / (1.f + __expf(p.lbl[cc] - p.lbl[512 + cc])); } }
    if constexpr (BR == 3) bb = p.b2[hu * 64 + (tid & 63)];
    if constexpr (BR == 2) { conv_w_load(p, 512 + hu * 128 + (tid & 127), cwb); if constexpr (PASS == 3) conv_w_load(p, 768 + hu * 128 + (tid & 127), cwc); conv_w_load(p, hu * 256 + (tid & 255), cwx);
#pragma unroll
        for (int hh = 0; hh < 4; ++hh) { dtb[hh] = p.dt_bias[hu * 4 + hh]; alg[hh] = p.a_log[hu * 4 + hh]; } }
    __builtin_amdgcn_sched_barrier(0);

    for (int urep = 0; urep < REP_UPREP; ++urep) {
    if constexpr (BR == 0) {
        constexpr int RQ = L_BIG, RF = (PASS == 3) ? L_BIG + 16384 : L_QI, RV = (PASS == 3) ? L_BIG + 32768 : L_QI + 16384;
        stg_store<128, 64>(lds, RF, tid, pf.raw + 0); stg_store<128, 64>(lds, RV, tid, pf.raw + 2);
        if constexpr (PASS == 3) stg_store<128, 64>(lds, RQ, tid, pf.raw + 4);
        __builtin_amdgcn_sched_barrier(0);
        const int d = tid & 127, seg = tid >> 7;
        __syncthreads();
        const LAS bf16_t* rF = (const LAS bf16_t*)(lds + RF) + seg * 16 * 128 + d;
        const LAS bf16_t* rQ = (const LAS bf16_t*)(lds + RQ) + seg * 16 * 128 + d;
        const LAS bf16_t* rV = (const LAS bf16_t*)(lds + RV) + seg * 16 * 128 + d;
        float cs[16], kk[16]; float run = 0.f;
#pragma unroll
        for (int i = 0; i < 16; ++i) { const float av = fmaxf(bf2f(rF[i * 128]), -60.f); const float e = __expf(-av), sg = __builtin_amdgcn_rcpf(1.f + e);
            const float f = lb + (1.f - lb) * sg; run += __logf(f); cs[i] = run; kk[i] = (1.f - lb) * e * sg; }
        SM[SM_SEG + seg * 128 + d] = run;
        __syncthreads();
        const float t0 = SM[SM_SEG + d], t1 = SM[SM_SEG + 128 + d], t2 = SM[SM_SEG + 256 + d], t3 = SM[SM_SEG + 384 + d];
        const float off = (seg == 0) ? 0.f : (seg == 1) ? t0 : (seg == 2) ? t0 + t1 : t0 + t1 + t2;
        const float ref = t0 + t1, clast = ref + t2 + t3;
        if (seg == 0) { SM[SM_REF + d] = ref; SM[SM_CLAST + d] = clast; }
        float kv[16];
#pragma unroll
        for (int i = 0; i < 16; ++i) { const float c = off + cs[i]; kv[i] = kk[i] * __expf(fminf(ref - c, 80.f));
            if constexpr (PASS == 3) { KI[(seg * 16 + i) * LDK + d] = f2bf(kv[i]);
                const float q = bf2f(rQ[i * 128]); QI[(seg * 16 + i) * LDK + d] = f2bf(silu_f(q) * __expf(fminf(c - ref, 80.f))); } }
        if constexpr (PASS == 1) store16(lds, L_BIG + (d * 72 + seg * 16) * 2, kv);
        unsigned vv[16];
#pragma unroll
        for (int i = 0; i < 16; ++i) vv[i] = rV[i * 128];
        u32x4 a, b; a.x = vv[0] | (vv[1] << 16); a.y = vv[2] | (vv[3] << 16); a.z = vv[4] | (vv[5] << 16); a.w = vv[6] | (vv[7] << 16);
        b.x = vv[8] | (vv[9] << 16); b.y = vv[10] | (vv[11] << 16); b.z = vv[12] | (vv[13] << 16); b.w = vv[14] | (vv[15] << 16);
        *(LAS u32x4*)(lds + L_VT + (d * 72 + seg * 16) * 2) = a; *(LAS u32x4*)(lds + L_VT + (d * 72 + seg * 16) * 2 + 16) = b;
    }
    if constexpr (BR == 1) {
        constexpr int RQ = L_BIG, RK = (PASS == 3) ? L_BIG + 16384 : L_QI, RV = (PASS == 3) ? L_BIG + 32768 : L_QI + 16384;
        const int j = tid & 63, seg = tid >> 6;
        float2 cssn[8];
#pragma unroll
        for (int i = 0; i < 8; ++i) cssn[i] = make_float2(pf.aux[2 * i], pf.aux[2 * i + 1]);
        stg_store<128, 64>(lds, RK, tid, pf.raw + 0); stg_store<128, 64>(lds, RV, tid, pf.raw + 2);
        if constexpr (PASS == 3) stg_store<128, 64>(lds, RQ, tid, pf.raw + 4);
        __builtin_amdgcn_sched_barrier(0);
        const float lg = log1pf(-exp2f(-(5.f + (float)hu)));
        if (tid < 64) { SM[SM_CUM + tid] = (float)(tid + 1) * lg; SM[SM_DT + tid] = 1.f; }
        __syncthreads();
        float k1[8], k2[8];
#pragma unroll
        for (int i = 0; i < 8; ++i) { const int t = seg * 8 + i;
            const LAS bf16_t* rk = (const LAS bf16_t*)(lds + RK) + t * 128 + j;
            const float ka = bf2f(rk[0]) * 0.08838834764831845f, kb = bf2f(rk[64]) * 0.08838834764831845f;
            k1[i] = ka * cssn[i].x - kb * cssn[i].y; k2[i] = ka * cssn[i].y + kb * cssn[i].x;
            if constexpr (PASS == 3) { const LAS bf16_t* rq = (const LAS bf16_t*)(lds + RQ) + t * 128 + j;
                const float qa = bf2f(rq[0]), qb = bf2f(rq[64]);
                QI[t * LDK + j] = f2bf(qa * cssn[i].x - qb * cssn[i].y); QI[t * LDK + j + 64] = f2bf(qa * cssn[i].y + qb * cssn[i].x);
                KI[t * LDK + j] = f2bf(k1[i]); KI[t * LDK + j + 64] = f2bf(k2[i]); } }
        if constexpr (PASS == 1) { store8(lds, L_BIG + (j * 72 + seg * 8) * 2, k1); store8(lds, L_BIG + ((j + 64) * 72 + seg * 8) * 2, k2); }
        const int v = tid & 127, s4 = tid >> 7; float vv[16];
#pragma unroll
        for (int i = 0; i < 16; ++i) { const int s = s4 * 16 + i; float x = bf2f(((const LAS bf16_t*)(lds + RV))[s * 128 + v]);
            if constexpr (PASS == 1) x *= __expf((float)(63 - s) * lg);
            vv[i] = x; }
        store16(lds, L_VT + (v * 72 + s4 * 16) * 2, vv);
    }
    if constexpr (BR == 2) {
        constexpr int RB = (PASS == 3) ? L_BIG : L_QI, RC = L_BIG + 17152, RX = (PASS == 3) ? L_BIG + 34304 : L_BIG + 18432;
        float dtr[4];
#pragma unroll
        for (int hh = 0; hh < 4; ++hh) dtr[hh] = pf.aux[hh];
        stg_store<128, 67>(lds, RB, tid, pf.raw + 0); stg_store<256, 67>(lds, RX, tid, pf.raw + 3);
        if constexpr (PASS == 3) stg_store<128, 67>(lds, RC, tid, pf.raw + 8);
        __builtin_amdgcn_sched_barrier(0);
        if (tid < 64) {
#pragma unroll
            for (int hh = 0; hh < 4; ++hh) {
                const float dt = softplus_f(dtr[hh] + dtb[hh]);
                float la = -dt * __expf(alg[hh]);
#pragma unroll
                for (int o = 1; o < 64; o <<= 1) { const float yv = __shfl_up(la, o); if (tid >= o) la += yv; }
                SM[SM_CUM + hh * 64 + tid] = la; SM[SM_DT + hh * 64 + tid] = dt; }
        }
        __syncthreads();
        { const int n = tid & 127, seg = tid >> 7; float o[16];
          conv16(lds, RB, 128, n, cwb, seg, o);
          if constexpr (PASS == 3) {
#pragma unroll
              for (int i = 0; i < 16; ++i) KI[(seg * 16 + i) * LDK + n] = f2bf(o[i]);
              conv16(lds, RC, 128, n, cwc, seg, o);
#pragma unroll
              for (int i = 0; i < 16; ++i) QI[(seg * 16 + i) * LDK + n] = f2bf(o[i]);
          } else store16(lds, L_BIG + (n * 72 + seg * 16) * 2, o);
        }
        { const int v = tid & 255, s2 = tid >> 8, hh = v >> 6;
#pragma unroll
          for (int r = 0; r < 2; ++r) { const int seg = s2 * 2 + r; float o[16];
              conv16(lds, RX, 256, v, cwx, seg, o);
              if constexpr (PASS == 1) { const float cl = SM[SM_CUM + hh * 64 + 63];
#pragma unroll
                  for (int i = 0; i < 16; ++i) { const int s = seg * 16 + i; o[i] *= __expf(cl - SM[SM_CUM + hh * 64 + s]) * SM[SM_DT + hh * 64 + s]; } }
              store16(lds, L_VT + (v * 72 + seg * 16) * 2, o); }
        }
    }
    if constexpr (BR == 3) {
        constexpr int RQ = L_BIG, RK = (PASS == 3) ? L_BIG + 8192 : L_QI, RV = (PASS == 3) ? L_BIG + 16384 : L_QI + 8192, RL = (PASS == 3) ? L_BIG + 32768 : L_QI + 24576;
        const int d = tid & 63, seg = tid >> 6, cc = hu * 64 + d;
        float w2r[16];
#pragma unroll
        for (int r = 0; r < 16; ++r) w2r[r] = pf.aux[r];
        stg_store<64, 64>(lds, RK, tid, pf.raw + 0); stg_store<128, 64>(lds, RV, tid, pf.raw + 1); stg_store<16, 64>(lds, RL, tid, pf.raw + 3);
        if constexpr (PASS == 3) stg_store<64, 64>(lds, RQ, tid, pf.raw + 4);
        __builtin_amdgcn_sched_barrier(0);
        __syncthreads();
        float cs[8]; float run = 0.f;
#pragma unroll
        for (int i = 0; i < 8; ++i) { const int t = seg * 8 + i; const LAS bf16x8* lp = (const LAS bf16x8*)(lds + RL + t * 32);
            const bf16x8 l0 = lp[0], l1 = lp[1]; float gk = bb;
#pragma unroll
            for (int r = 0; r < 8; ++r) { gk += w2r[r] * bf2f((bf16_t)l0[r]); gk += w2r[8 + r] * bf2f((bf16_t)l1[r]); }
            run += logsig_f(gk) * (1.f / 16.f); cs[i] = run; }
        SM[SM_SEG + seg * 64 + d] = run;
        __syncthreads();
        float off = 0.f, ref = 0.f, clast = 0.f;
#pragma unroll
        for (int s = 0; s < 8; ++s) { const float tv = SM[SM_SEG + s * 64 + d]; if (s < seg) off += tv; if (s < 4) ref += tv; clast += tv; }
        if (seg == 0) { SM[SM_REF + d] = ref; SM[SM_CLAST + d] = clast; }
        float kv[8];
#pragma unroll
        for (int i = 0; i < 8; ++i) { const int t = seg * 8 + i; const float c = off + cs[i];
            kv[i] = bf2f(((const LAS bf16_t*)(lds + RK))[t * 64 + d]) * __expf(fminf(ref - c, 80.f));
            if constexpr (PASS == 3) { KI[t * LDK + d] = f2bf(kv[i]); QI[t * LDK + d] = f2bf(bf2f(((const LAS bf16_t*)(lds + RQ))[t * 64 + d]) * 0.125f * __expf(fminf(c - ref, 80.f))); } }
        if constexpr (PASS == 1) store8(lds, L_BIG + (d * 72 + seg * 8) * 2, kv);
        const int v = tid & 127, s4 = tid >> 7; unsigned vv[16];
#pragma unroll
        for (int i = 0; i < 16; ++i) vv[i] = ((const LAS bf16_t*)(lds + RV))[(s4 * 16 + i) * 128 + v];
        u32x4 a, b; a.x = vv[0] | (vv[1] << 16); a.y = vv[2] | (vv[3] << 16); a.z = vv[4] | (vv[5] << 16); a.w = vv[6] | (vv[7] << 16);
        b.x = vv[8] | (vv[9] << 16); b.y = vv[10] | (vv[11] << 16); b.z = vv[12] | (vv[13] << 16); b.w = vv[14] | (vv[15] << 16);
        *(LAS u32x4*)(lds + L_VT + (v * 72 + s4 * 16) * 2) = a; *(LAS u32x4*)(lds + L_VT + (v * 72 + s4 * 16) * 2 + 16) = b;
    }
    __syncthreads();
    }
    for (int urep = 0; urep < REP_UCORE; ++urep) {
    if constexpr (PASS == 1) {
        constexpr int NTN = DV / 32, NTILES = (DK / 32) * NTN, NTL = NTILES / 8;
        f32x16 hacc[NTL];
#pragma unroll
        for (int i = 0; i < NTL; ++i) {
            const int ti = wid + 8 * i, tm = ti / NTN, tn = ti % NTN;
#pragma unroll
            for (int r = 0; r < 16; ++r) hacc[i][r] = 0.f;
#pragma unroll
            for (int ks = 0; ks < 4; ++ks) hacc[i] = __builtin_amdgcn_mfma_f32_32x32x16_bf16(frag(lds, L_BIG, 72, tm * 32, ks, lane), frag(lds, L_VT, 72, tn * 32, ks, lane), hacc[i], 0, 0, 0);
            if constexpr (VEC) {
#pragma unroll
                for (int r = 0; r < 16; ++r) { const int d = tm * 32 + rowmap(r, lane); hacc[i][r] *= __expf(SM[SM_CLAST + d] - SM[SM_REF + d]); }
            }
        }
        float decv = 0.f;
        if constexpr (BR == 0) { if (tid < 128) decv = __expf(SM[SM_CLAST + tid]); }
        if constexpr (BR == 3) { if (tid < 64) decv = __expf(SM[SM_CLAST + tid]); }
        if constexpr (BR == 2) { if (tid < 4) decv = __expf(SM[SM_CUM + tid * 64 + 63]); }
        __syncthreads();
#pragma unroll
        for (int i = 0; i < NTL; ++i) {
            const int ti = wid + 8 * i, tm = ti / NTN, tn = ti % NTN;
            const int v = tn * 32 + (lane & 31);
#pragma unroll
            for (int rg = 0; rg < 4; ++rg) { const int d0 = tm * 32 + 8 * rg + 4 * (lane >> 5);
                u32x2 w; w.x = pk2(hacc[i][rg * 4 + 0], hacc[i][rg * 4 + 1]); w.y = pk2(hacc[i][rg * 4 + 2], hacc[i][rg * 4 + 3]);
                *(u32x2*)(stg + (size_t)v * DK + d0) = w; }
        }
        float* dec = p.dec + (size_t)bc * 1024;
        if constexpr (BR == 0) { if (tid < 128) dec[hu * 128 + tid] = decv; }
        if constexpr (BR == 3) { if (tid < 64) dec[512 + hu * 64 + tid] = decv; }
        if constexpr (BR == 2) { if (tid < 4) dec[768 + hu * 4 + tid] = decv; }
    } else {
        constexpr int NCT = DV / 32;
    if constexpr (PASS == 3) {
#pragma unroll
            for (int nt = 0; nt < NT; ++nt) { const int ct = (wid & 3) + 4 * nt;
                gnv[nt] = gain[ct * 32 + (lane & 31)]; dskv[nt] = (BR == 2) ? p.dskip[hu * 4 + (ct >> 1)] : 0.f;
#pragma unroll
                for (int r = 0; r < 16; ++r) gt[nt][r] = P[pidx(bc * 64 + (wid >> 2) * 32 + rowmap(r, lane), gcol + ct * 32 + (lane & 31))]; }
        }
        __builtin_amdgcn_sched_barrier(0);
        {
            constexpr int NVEC = DV * DK / 8, VPR = DK / 8;
#pragma unroll
            for (int k = 0; k < NVEC / NTHR; ++k) { const int vi = tid + NTHR * k; const int v = vi / VPR, d0 = (vi % VPR) * 8;
                u32x4 raw = pf.st[k];
                if constexpr (VEC) { unsigned w[4] = {raw.x, raw.y, raw.z, raw.w};
#pragma unroll
                    for (int q = 0; q < 4; ++q) { const float lo = __uint_as_float(w[q] << 16) * __expf(SM[SM_REF + d0 + 2 * q]), hi = __uint_as_float(w[q] & 0xffff0000u) * __expf(SM[SM_REF + d0 + 2 * q + 1]);
                        w[q] = pk2(lo, hi); }
                    raw.x = w[0]; raw.y = w[1]; raw.z = w[2]; raw.w = w[3]; }
                *(LAS u32x4*)(lds + L_BIG + (v * LDK + d0) * 2) = raw; }
        }
        __builtin_amdgcn_sched_barrier(0);
        __syncthreads();
        const int tm = wid >> 2, tnb = wid & 3;
        f32x16 acc[NT];
#pragma unroll
        for (int nt = 0; nt < NT; ++nt)
#pragma unroll
            for (int r = 0; r < 16; ++r) acc[nt][r] = 0.f;
#pragma unroll
        for (int ks = 0; ks < DK / 16; ++ks) { const bf16x8 af = frag(lds, L_QI, LDK, tm * 32, ks, lane);
#pragma unroll
            for (int nt = 0; nt < NT; ++nt) acc[nt] = __builtin_amdgcn_mfma_f32_32x32x16_bf16(af, frag(lds, L_BIG, LDK, (tnb + 4 * nt) * 32, ks, lane), acc[nt], 0, 0, 0); }
        if constexpr (!VEC) {
#pragma unroll
            for (int nt = 0; nt < NT; ++nt) { const int hh = (NH == 1) ? 0 : ((tnb + 4 * nt) >> 1);
#pragma unroll
                for (int r = 0; r < 16; ++r) acc[nt][r] *= __expf(SM[SM_CUM + hh * 64 + tm * 32 + rowmap(r, lane)]); }
        }
        constexpr int P_OFF = (NH == 1) ? L_BIG + 34816 : L_BIG;
        f32x16 sc;
#pragma unroll
        for (int r = 0; r < 16; ++r) sc[r] = 0.f;
        const int w4 = wid & 3, stm = w4 >> 1, stn = w4 & 1, whalf = wid >> 2;
#pragma unroll
        for (int ks = 0; ks < DK / 16; ++ks) sc = __builtin_amdgcn_mfma_f32_32x32x16_bf16(frag(lds, L_QI, LDK, stm * 32, ks, lane), frag(lds, L_KI, LDK, stn * 32, ks, lane), sc, 0, 0, 0);
        if constexpr (NH != 1) __syncthreads();
        {
            const int s = stn * 32 + (lane & 31);
            if constexpr (NH == 1) {
                float cums = 0.f, dts = 1.f;
                if constexpr (!VEC) { cums = SM[SM_CUM + s]; dts = SM[SM_DT + s]; }
#pragma unroll
                for (int r8 = 0; r8 < 8; ++r8) { const int rlo = r8, rhi = r8 + 8; const int r = whalf ? rhi : rlo; const int t = stm * 32 + (whalf ? rowmap(rhi, lane) : rowmap(rlo, lane));
                    float val = whalf ? sc[rhi] : sc[rlo]; (void)r;
                    if constexpr (!VEC) { const float ex = (s <= t) ? SM[SM_CUM + t] - cums : 0.f; val *= __expf(ex) * dts; }
                    val = (s <= t) ? val : 0.f;
                    *(LAS bf16_t*)(lds + P_OFF + (t * 72 + s) * 2) = f2bf(val); }
            } else {
#pragma unroll
                for (int h2 = 0; h2 < NH / 2; ++h2) { const int hh = whalf * (NH / 2) + h2;
                    const float cums = SM[SM_CUM + hh * 64 + s], dts = SM[SM_DT + hh * 64 + s];
#pragma unroll
                    for (int r = 0; r < 16; ++r) { const int t = stm * 32 + rowmap(r, lane);
                        float val = sc[r];
                        const float ex = (s <= t) ? SM[SM_CUM + hh * 64 + t] - cums : 0.f; val *= __expf(ex) * dts;
                        val = (s <= t) ? val : 0.f;
                        *(LAS bf16_t*)(lds + P_OFF + ((hh * 64 + t) * 72 + s) * 2) = f2bf(val); } }
            }
        }
        __syncthreads();
#pragma unroll
        for (int nt = 0; nt < NT; ++nt) { const int hh = (NH == 1) ? 0 : ((tnb + 4 * nt) >> 1);
#pragma unroll
            for (int ks = 0; ks < 4; ++ks) acc[nt] = __builtin_amdgcn_mfma_f32_32x32x16_bf16(frag(lds, P_OFF + hh * 9216, 72, tm * 32, ks, lane), frag(lds, L_VT, 72, (tnb + 4 * nt) * 32, ks, lane), acc[nt], 0, 0, 0); }
        const int ycol = (BR == 0) ? hu * 128 : (BR == 1) ? 512 + hu * 128 : (BR == 2) ? 1024 + hu * 256 : 1536 + hu * 128;
#pragma unroll
        for (int nt = 0; nt < NT; ++nt) { const int ct = tnb + 4 * nt, v = ct * 32 + (lane & 31);
            const float dsk = dskv[nt];
            float sq[16];
#pragma unroll
            for (int r = 0; r < 16; ++r) { const int t = tm * 32 + rowmap(r, lane);
                float val = acc[nt][r];
                if constexpr (BR == 2) { val = (val + dsk * bf2f(VT[v * 72 + t])) * silu_f(bf2f(gt[nt][r])); acc[nt][r] = val; }
                sq[r] = val * val; }
            const bool b4 = lane & 16, b3 = lane & 8, b2 = lane & 4, b1 = lane & 2;
#pragma unroll
            for (int i = 0; i < 8; ++i) { const float lo = sq[i], hi = sq[i + 8]; sq[i] = (b4 ? hi : lo) + __shfl_xor(b4 ? lo : hi, 16); }
#pragma unroll
            for (int i = 0; i < 4; ++i) { const float lo = sq[i], hi = sq[i + 4]; sq[i] = (b3 ? hi : lo) + __shfl_xor(b3 ? lo : hi, 8); }
#pragma unroll
            for (int i = 0; i < 2; ++i) { const float lo = sq[i], hi = sq[i + 2]; sq[i] = (b2 ? hi : lo) + __shfl_xor(b2 ? lo : hi, 4); }
            { const float lo = sq[0], hi = sq[1]; sq[0] = (b1 ? hi : lo) + __shfl_xor(b1 ? lo : hi, 2); }
            sq[0] += __shfl_xor(sq[0], 1);
            const int rr = (b4 ? 8 : 0) + (b3 ? 4 : 0) + (b2 ? 2 : 0) + (b1 ? 1 : 0);
            if ((lane & 1) == 0) SM[SM_RSS + ct * 64 + tm * 32 + rowmap(rr, lane)] = sq[0];
        }
        __syncthreads();
        if (tid < 64) { float tot = 0.f;
#pragma unroll
            for (int q = 0; q < NCT; ++q) tot += SM[SM_RSS + q * 64 + tid];
            SM[SM_SEG + tid] = rsqrtf(tot * (1.f / DV) + EPS); }
        __syncthreads();
        float rinv[16];
#pragma unroll
        for (int r = 0; r < 16; ++r) rinv[r] = SM[SM_SEG + tm * 32 + rowmap(r, lane)];
        __syncthreads();
#pragma unroll
        for (int nt = 0; nt < NT; ++nt) { const int ct = tnb + 4 * nt, v = ct * 32 + (lane & 31);
            const float gn = gnv[nt];
#pragma unroll
            for (int r = 0; r < 16; ++r) { const int t = tm * 32 + rowmap(r, lane);
                float o = acc[nt][r] * rinv[r] * gn;
                if constexpr (BR != 2) o *= silu_f(bf2f(gt[nt][r]));
                p.y[(size_t)(bc * 64 + t) * DI + ycol + v] = f2bf(o); }
        }
    }
    }
}

template <int PASS>
__device__ __forceinline__ void phase_mixer(const MixP& p, LAS unsigned char* lds) {
#pragma unroll 1
    for (int i = blockIdx.x; i < NUNITS; i += gridDim.x) {
        const int bc = i / 14, u = i % 14;
        if (u < 4) mixer_unit<0, PASS>(p, lds, bc, u);
        else if (u < 8) mixer_unit<1, PASS>(p, lds, bc, u - 4);
        else if (u < 10) mixer_unit<2, PASS>(p, lds, bc, u - 8);
        else mixer_unit<3, PASS>(p, lds, bc, u - 10);
    }
}

__device__ __forceinline__ void phase_scan(bf16_t* st, const float* dec) {
    constexpr int VPB = ST_PER_BC / 4;
#pragma unroll 1
    for (int gt = blockIdx.x * NTHR + opaque_tid(); gt < 2 * VPB; gt += gridDim.x * NTHR) {
    const int bl = gt / VPB, e0 = (gt % VPB) * 4;
    int mode, didx = 0; float cfac = 0.f;
    if (e0 < 65536) { mode = 0; didx = (e0 >> 14) * 128 + (e0 & 127); }
    else if (e0 < 131072) { mode = 1; const int h = (e0 - 65536) >> 14; cfac = __expf(64.f * log1pf(-exp2f(-(5.f + (float)h)))); }
    else if (e0 < 196608) { mode = 2; const int r = e0 - 131072; didx = 768 + (r >> 15) * 4 + (((r & 32767) >> 7) >> 6); }
    else { mode = 0; const int r = e0 - 196608; didx = 512 + (r >> 13) * 64 + (r & 63); }
    float s0 = 0.f, s1 = 0.f, s2 = 0.f, s3 = 0.f;
    bf16_t* ptr = st + (size_t)bl * 64 * ST_PER_BC + e0;
    const float* dp = dec + (size_t)bl * 64 * 1024 + didx;
#pragma unroll 1
    for (int c0 = 0; c0 < 64; c0 += 8) {
        u32x2 hv[8]; f32x4 dv[8];
#pragma unroll
        for (int j = 0; j < 8; ++j) {
            hv[j] = *(const u32x2*)(ptr + (size_t)(c0 + j) * ST_PER_BC);
            if (mode == 0) dv[j] = *(const f32x4*)(dp + (size_t)(c0 + j) * 1024);
            else if (mode == 1) dv[j] = (f32x4){cfac, cfac, cfac, cfac};
            else { const float d = dp[(size_t)(c0 + j) * 1024]; dv[j] = (f32x4){d, d, d, d}; }
        }
        __builtin_amdgcn_sched_barrier(0);
#pragma unroll
        for (int j = 0; j < 8; ++j) {
            u32x2 w; w.x = pk2(s0, s1); w.y = pk2(s2, s3);
            *(u32x2*)(ptr + (size_t)(c0 + j) * ST_PER_BC) = w;
            s0 = s0 * dv[j][0] + __uint_as_float(hv[j].x << 16); s1 = s1 * dv[j][1] + __uint_as_float(hv[j].x & 0xffff0000u);
            s2 = s2 * dv[j][2] + __uint_as_float(hv[j].y << 16); s3 = s3 * dv[j][3] + __uint_as_float(hv[j].y & 0xffff0000u);
        }
    }
    }
}

#define XB_TMO      128
#define XB_XCNT(j)  (256  + 64 * (j))
#define XB_XSUB(j)  (1280 + 64 * (j))
#define XB_XGEN(j)  (2304 + 64 * (j))
#define XB_TOP      3328
#define XB_TOPGEN   3392
#define XCD_BAR_WORDS 3456
#define XB_SPIN_CAP (1u << 18)
__device__ __forceinline__ unsigned xb_ld(unsigned* p)              { return __hip_atomic_load(p, __ATOMIC_RELAXED, __HIP_MEMORY_SCOPE_AGENT); }
__device__ __forceinline__ unsigned xb_add(unsigned* p, unsigned v) { return __hip_atomic_fetch_add(p, v, __ATOMIC_RELAXED, __HIP_MEMORY_SCOPE_AGENT); }
__device__ __forceinline__ unsigned xb_xcc_id() { return (unsigned)__builtin_amdgcn_s_getreg((3 << 11) | 20) & 0xFu; }
#define XB_SPIN(cond, bar) do { unsigned _sp = 0; while (cond) { __builtin_amdgcn_s_sleep(1); \
    if ((++_sp & 255u) == 0u) { if (xb_ld(&(bar)[XB_TMO])) break; if (_sp > XB_SPIN_CAP) { atomicAdd(&(bar)[XB_TMO], 1u); break; } } } } while (0)
struct XcdBarrier { unsigned* bar; unsigned x; volatile LAS unsigned* st; };
__device__ __forceinline__ XcdBarrier xcd_barrier_post(unsigned* bar, volatile LAS unsigned* st) {
    XcdBarrier b; b.bar = bar; b.x = xb_xcc_id(); b.st = st;
    if (threadIdx.x == 0) (void)xb_add(&bar[XB_XCNT(b.x)], 1u);
    return b;
}
__device__ __forceinline__ void xcd_barrier_complete(unsigned* bar, unsigned x, unsigned& nloc, unsigned& nx) {
    const unsigned G = gridDim.x * gridDim.y * gridDim.z;
    unsigned sum, cnt, mine, sp = 0u;
    for (;;) {
        sum = 0u; cnt = 0u; mine = 0u;
#pragma unroll
        for (unsigned j = 0; j < 16; ++j) { const unsigned c = xb_ld(&bar[XB_XCNT(j)]); sum += c; cnt += (c > 0u) ? 1u : 0u; mine = (j == x) ? c : mine; }
        if (sum == G) break;
        __builtin_amdgcn_s_sleep(1);
        if ((++sp & 255u) == 0u) { if (xb_ld(&bar[XB_TMO])) break; if (sp > XB_SPIN_CAP) { atomicAdd(&bar[XB_TMO], 1u); break; } }
    }
    nloc = mine > 0u ? mine : 1u; nx = cnt > 0u ? cnt : 1u;
}
__device__ __forceinline__ void xcd_barrier(const XcdBarrier& b) {
    asm volatile("s_waitcnt vmcnt(0)" ::: "memory");
    __syncthreads();
    if (threadIdx.x == 0) {
        unsigned* bar = b.bar;
        __builtin_amdgcn_s_waitcnt(0);
        unsigned nloc = b.st[0], nx = b.st[1];
        if (nloc == 0u) { xcd_barrier_complete(bar, b.x, nloc, nx); b.st[0] = nloc; b.st[1] = nx; }
        const unsigned old = xb_add(&bar[XB_XSUB(b.x)], 1u);
        const unsigned gen = old / nloc;
        if (old + 1u == (gen + 1u) * nloc) {
            __builtin_amdgcn_fence(__ATOMIC_RELEASE, "agent");
            asm volatile("s_waitcnt vmcnt(0)" ::: "memory");
            const unsigned og = xb_add(&bar[XB_TOP], 1u);
            const unsigned tg = og / nx;
            if (og + 1u == (tg + 1u) * nx) xb_add(&bar[XB_TOPGEN], 1u);
            else XB_SPIN(xb_ld(&bar[XB_TOPGEN]) == tg, bar);
            __builtin_amdgcn_fence(__ATOMIC_ACQUIRE, "agent");
            xb_add(&bar[XB_XGEN(b.x)], 1u);
            asm volatile("s_waitcnt vmcnt(0)" ::: "memory");
        } else {
            XB_SPIN(xb_ld(&bar[XB_XGEN(b.x)]) == gen, bar);
            __builtin_amdgcn_fence(__ATOMIC_ACQUIRE, "agent");
            asm volatile("s_waitcnt vmcnt(0)" ::: "memory");
        }
    }
    __syncthreads();
}

__global__ void __launch_bounds__(NTHR, 2) fwd_megakernel(Args a) {
    extern __shared__ __attribute__((aligned(16))) unsigned char shm[];
    LAS unsigned char* lds = (LAS unsigned char*)shm;
    cg::grid_group grid = cg::this_grid();
    unsigned char* ws = a.ws;
    const int G = gridDim.x;

    {
        volatile LAS unsigned* stw = (volatile LAS unsigned*)(lds + L_BARST);
        if (threadIdx.x < 2) stw[threadIdx.x] = 0u;
        __syncthreads();
    }
    const XcdBarrier gbar = xcd_barrier_post((unsigned*)(ws + WS_BAR), (volatile LAS unsigned*)(lds + L_BARST));
    for (int rep = 0; rep < REP_PREP; ++rep) { phase_prep(a, lds); if (rep == 0) grid.sync(); else xcd_barrier(gbar); }

    bf16_t* hbuf = (bf16_t*)(ws + WS_HY); bf16_t* ybuf = (bf16_t*)(ws + WS_HY);
    bf16_t* proj = (bf16_t*)(ws + WS_PROJ); bf16_t* st = (bf16_t*)(ws + WS_ST); float* dec = (float*)(ws + WS_DEC);
    const float* mod = (const float*)(ws + WS_MOD);

#pragma unroll 1
    for (int half = 0; half < 2; ++half) {
        const size_t xoff = (size_t)half * HROWS * DM;
#pragma unroll 1
        for (int l = 0; l < DEPTH; ++l) {
            const float* modl = mod + (size_t)l * 4 * 3072;
            bf16_t* slab = (bf16_t*)(ws + WS_PROJ);
            if (l == 0) { phase_norm<false>(a.x + xoff, nullptr, nullptr, nullptr, a.norm_g, modl, half, hbuf); if (half == 0) phase_wcvt(a, lds); }
            else phase_norm<false>(a.x + xoff, slab, mod + (size_t)(half * 2) * 3072 + 2048, a.out + xoff, a.norm_g + l * DM, modl, half, hbuf);
            xcd_barrier(gbar);
            for (int rep = 0; rep < REP_G1; ++rep) {
                pg8::Gemm g{hbuf, (const bf16_t*)(ws + WS_WIN) + (size_t)l * LDP * DM, HROWS, LDP, DM, DM};
                pg8::StaticOrder S; S.init(HROWS, LDP, G, (int)blockIdx.x);
                pg8::EpiProj E{proj, LDP};
                pg8::gemm_phase<pg8::EpiProj, pg8::StaticOrder>(lds, g, S, E);
                xcd_barrier(gbar);
            }
            MixP p;
            p.proj = proj; p.st = st; p.dec = dec; p.y = ybuf; p.rope = (const float2*)(ws + WS_ROPE);
            p.lbl = a.lb_logits; p.hgrn_g = a.hgrn_g + l * 512; p.ret_g = a.ret_g + l * 512; p.conv_w = a.conv_w + l * 4096; p.conv_b = a.conv_b + l * 1024;
            p.dt_bias = a.dt_bias + l * 8; p.a_log = a.a_log + l * 8; p.dskip = a.dskip + l * 8; p.ssm_g = a.ssm_g + l * 512;
            p.w2 = a.w_gk2 + l * 16 * 256; p.b2 = a.b_gk2 + l * 256; p.gla_g = a.gla_g + l * 512; p.layer = l;
            for (int rep = 0; rep < REP_M12; ++rep) { phase_mixer<1>(p, lds); xcd_barrier(gbar); phase_scan(st, dec); xcd_barrier(gbar); }
            for (int rep = 0; rep < REP_M3; ++rep) { phase_mixer<3>(p, lds); xcd_barrier(gbar); }
            for (int rep = 0; rep < REP_G2; ++rep) {
                pg8::Gemm g{ybuf, (const bf16_t*)(ws + WS_WOUT) + (size_t)l * DM * DI, HROWS, DM, DI / 2, DI};
                pg8::SplitOrder S; S.init(HROWS, DM, G, (int)blockIdx.x);
                pg8::EpiSlab E{slab};
                pg8::gemm_phase<pg8::EpiSlab, pg8::SplitOrder>(lds, g, S, E);
                xcd_barrier(gbar);
            }
        }
        phase_norm<true>(a.out + xoff, (const bf16_t*)(ws + WS_PROJ), mod + (size_t)(4 + half * 2) * 3072 + 2048, a.out + xoff, a.final_g, nullptr, half, nullptr);
    }
}

extern "C" void kernel_launch(void* const* d_in, const int* in_sizes, int n_in, void* d_out, int out_size, void* d_ws, size_t ws_size, hipStream_t stream) {
    static int grid = 0;
    if (grid == 0) {
        if (n_in != 20 || ws_size < WS_END) { fprintf(stderr, "kernel_launch: unexpected n_in %d / ws_size %zu (need %zu)\n", n_in, ws_size, (size_t)WS_END); grid = -1; return; }
        int dev = 0, cus = 0, per_cu = 0;
        hipGetDevice(&dev);
        hipDeviceGetAttribute(&cus, hipDeviceAttributeMultiprocessorCount, dev);
        if (hipFuncSetAttribute((const void*)fwd_megakernel, hipFuncAttributeMaxDynamicSharedMemorySize, LDS_BYTES) != hipSuccess) { fprintf(stderr, "kernel_launch: hipFuncSetAttribute failed\n"); grid = -1; return; }
        hipOccupancyMaxActiveBlocksPerMultiprocessor(&per_cu, (const void*)fwd_megakernel, NTHR, LDS_BYTES);
        if (per_cu < 1) { fprintf(stderr, "kernel_launch: occupancy query says %d blocks per CU\n", per_cu); per_cu = 1; }
        (void)hipGetLastError();
        grid = cus * per_cu;
    }
    if (grid < 0) return;
    Args a{};
    const float** f = (const float**)&a;
    for (int i = 0; i < 20; ++i) f[i] = (const float*)d_in[i];
    a.out = (float*)d_out; a.ws = (unsigned char*)d_ws;
    void* args[] = {&a};
    if (hipMemsetAsync((char*)d_ws + WS_BAR, 0, XCD_BAR_WORDS * 4, stream) != hipSuccess) { fprintf(stderr, "kernel_launch: memset of barrier words failed\n"); return; }
    hipError_t e = hipLaunchCooperativeKernel((const void*)fwd_megakernel, dim3(grid), dim3(NTHR), args, LDS_BYTES, stream);
    if (e != hipSuccess) fprintf(stderr, "cooperative launch failed: %s (grid %d)\n", hipGetErrorString(e), grid);
}
```

```cpp
#include <hip/hip_runtime.h>
#include <hip/hip_cooperative_groups.h>
#include <cstdio>
namespace cg = cooperative_groups;

#define LAS __attribute__((address_space(3)))
typedef unsigned short bf16_t;
typedef short bf16x8 __attribute__((ext_vector_type(8)));
typedef float f32x4 __attribute__((ext_vector_type(4)));
typedef float f32x16 __attribute__((ext_vector_type(16)));
typedef unsigned u32x4 __attribute__((ext_vector_type(4)));
typedef unsigned u32x2 __attribute__((ext_vector_type(2)));

#ifndef REP_PREP
#define REP_PREP 1
#endif
#ifndef REP_NORM
#define REP_NORM 1
#endif
#ifndef REP_G1
#define REP_G1 1
#endif
#ifndef REP_M12
#define REP_M12 1
#endif
#ifndef REP_M3
#define REP_M3 1
#endif
#ifndef REP_G2
#define REP_G2 1
#endif
#ifndef REP_UPREP
#define REP_UPREP 1
#endif
#ifndef REP_UCORE
#define REP_UCORE 1
#endif
constexpr int NB = 4, SEQ = 4096, DM = 1024, DEPTH = 2, DI = 2048;
constexpr int NIN = 7192, LDP = 7424;
constexpr int HROWS = 8192;
constexpr int NTHR = 512;
constexpr float EPS = 1e-6f;
constexpr int C_AQ = 0, C_AF = 512, C_AI = 1024, C_AG = 1536, C_RQ = 2048, C_RK = 2560, C_RV = 3072, C_RG = 3584,
              C_MZ = 4096, C_XBC = 4608, C_GQ = 5632, C_GK = 5888, C_GV = 6144, C_GG = 6656, C_DT = 7168, C_LR = 7176;
constexpr int ST_PER_BC = 229376;
constexpr size_t WS_WIN = 0;
constexpr size_t WS_WOUT = WS_WIN + 2ull * LDP * DM * 2;
constexpr size_t WS_MOD = WS_WOUT + 2ull * DM * DI * 2;
constexpr size_t WS_ROPE = WS_MOD + 2ull * 4 * 3072 * 4;
constexpr size_t WS_DEC = WS_ROPE + 4096ull * 64 * 8;
constexpr size_t WS_HY = WS_DEC + 128ull * 1024 * 4;
constexpr size_t WS_PROJ = WS_HY + (size_t)HROWS * DI * 2;
constexpr size_t WS_ST = WS_PROJ + (size_t)HROWS * LDP * 2;
constexpr size_t WS_BAR = WS_ST + 128ull * ST_PER_BC * 2;
constexpr size_t WS_END = WS_BAR + 3456 * 4;
constexpr int L_QI = 0, L_KI = 17408, L_VT = 34816, L_BIG = 71680, L_SM = 141312;
constexpr int SM_CUM = 0, SM_DT = 256, SM_SEG = 512, SM_REF = 1536, SM_CLAST = 1664, SM_RSS = 1792;
constexpr int L_BARST = L_SM + (1792 + 512) * 4;
constexpr int LDS_BYTES = L_BARST + 16;

constexpr int NCG = LDP / 128;
__device__ __forceinline__ size_t pidx(int row, int col) { return ((size_t)((row >> 6) * NCG + (col >> 7)) * 64 + (row & 63)) * 128 + (col & 127); }
__device__ __forceinline__ float bf2f(bf16_t v) { return __uint_as_float(((unsigned)v) << 16); }
__device__ __forceinline__ bf16_t f2bf(float f) { unsigned u = __float_as_uint(f); u += 0x7FFFu + ((u >> 16) & 1u); return (bf16_t)(u >> 16); }
typedef float f32x2_t __attribute__((ext_vector_type(2)));
typedef __bf16 bf16x2_t __attribute__((ext_vector_type(2)));
__device__ __forceinline__ unsigned pk2(float lo, float hi) { f32x2_t v = {lo, hi}; bf16x2_t b = __builtin_convertvector(v, bf16x2_t); return __builtin_bit_cast(unsigned, b); }
__device__ __forceinline__ int opaque_tid() { int t = threadIdx.x; asm volatile("" : "+v"(t)); return t; }
__device__ __forceinline__ float silu_f(float x) { return x * __builtin_amdgcn_rcpf(1.f + __expf(-x)); }
__device__ __forceinline__ float softplus_f(float x) { return fmaxf(x, 0.f) + __logf(1.f + __expf(-fabsf(x))); }
__device__ __forceinline__ float logsig_f(float x) { return fminf(x, 0.f) - __logf(1.f + __expf(-fabsf(x))); }

namespace pg8 {
constexpr int BM = 256, BK = 64, HALF = 128, HTB = HALF * BK * 2, STAGE_BYTES = 8 * HTB, NXCD = 8, WGM = 8;
__device__ __forceinline__ int lds_byte(int r, int c) { const int st = (r >> 4) * 2 + (c >> 5), rr = r & 15, cc = c & 31, ob = rr * 64 + cc * 2; return st * 1024 + (ob ^ (((ob >> 9) & 1) << 5)); }
__device__ __forceinline__ void stage_rc(int b, int& R, int& C) { const int st = b / 1024, sb = b % 1024, swz = sb ^ (((sb >> 9) & 1) << 5); R = (st >> 1) * 16 + swz / 64; C = (st & 1) * 32 + (swz % 64) / 2; }
__device__ __forceinline__ int perm32(int rho) { const int n = rho >> 4, i = rho & 15; return 8 * (i >> 2) + 4 * n + (i & 3); }
struct Unit { int pm, pn, kh; };
struct Gemm { const bf16_t* A; const bf16_t* Bt; int M, N, K, ld; };
struct StaticOrder {
    int nM, nN, nwg, G, c;
    __device__ void init(int M, int N, int G_, int c_) { nM = M / BM; nN = N / BM; nwg = nM * nN; G = G_; c = c_; }
    __device__ bool next(int i, Unit& u) const {
        const long L = (long)i * G + c; if (L >= nwg) return false;
        int wgid = (int)L; { const int q = nwg / NXCD, r = nwg % NXCD, xcd = wgid % NXCD, off = wgid / NXCD; wgid = (xcd < r ? xcd * (q + 1) : r * (q + 1) + (xcd - r) * q) + off; }
        const int nig = WGM * nN, gid = wgid / nig, fm = gid * WGM, gsz = (nM - fm) < WGM ? (nM - fm) : WGM;
        u.pm = fm + ((wgid % nig) % gsz); u.pn = (wgid % nig) / gsz; u.kh = 0; return true;
    }
};
struct SplitOrder {
    StaticOrder so;
    __device__ void init(int M, int N, int G_, int c_) { so.init(M, 2 * N, G_, c_); }
    __device__ bool next(int i, Unit& u) const { if (!so.next(i, u)) return false; u.kh = u.pn & 1; u.pn >>= 1; return true; }
};
struct EpiProj {
    static constexpr bool PERM = true;
    bf16_t* O; int ldc;
    __device__ __forceinline__ void operator()(const f32x4 (&acc)[2][2][4][2], const Unit& u, int wr, int wc, int fr, int fq) const {
        bf16_t* base = O + ((size_t)((u.pm * 4 + wr) * NCG + u.pn * 2) * 64 + fr) * 128 + wc * 32 + 8 * fq;
#pragma unroll
        for (int ai = 0; ai < 2; ++ai)
#pragma unroll
            for (int m = 0; m < 4; ++m)
#pragma unroll
                for (int bj = 0; bj < 2; ++bj) { const f32x4 v0 = acc[ai][bj][m][0], v1 = acc[ai][bj][m][1];
                    u32x4 w; w.x = pk2(v0[0], v0[1]); w.y = pk2(v0[2], v0[3]); w.z = pk2(v1[0], v1[1]); w.w = pk2(v1[2], v1[3]);
                    *(u32x4*)(base + (size_t)ai * (2 * NCG * 8192) + bj * 8192 + m * (16 * 128)) = w; }
    }
};
struct EpiRes {
    static constexpr bool PERM = false;
    const float* xin; float* xout; const float* gate;
    __device__ __forceinline__ void operator()(const f32x4 (&acc)[2][2][4][2], const Unit& u, int wr, int wc, int fr, int fq) const {
        const int row0 = u.pm * BM + wr * 64 + fr, col0 = u.pn * BM + wc * 32 + 4 * fq;
        const float* gp = gate + (size_t)(u.pm >> 4) * 3072 + col0;
        f32x4 gv[2][2];
#pragma unroll
        for (int bj = 0; bj < 2; ++bj)
#pragma unroll
            for (int n = 0; n < 2; ++n) gv[bj][n] = *(const f32x4*)(gp + bj * HALF + n * 16);
#pragma unroll
        for (int am = 0; am < 4; ++am) {
            const int ai = am >> 1, m0 = (am & 1) * 2;
            f32x4 xi[2][2][2];
#pragma unroll
            for (int m = 0; m < 2; ++m)
#pragma unroll
                for (int bj = 0; bj < 2; ++bj)
#pragma unroll
                    for (int n = 0; n < 2; ++n) xi[m][bj][n] = *(const f32x4*)(xin + (size_t)(row0 + ai * HALF + (m0 + m) * 16) * DM + col0 + bj * HALF + n * 16);
            __builtin_amdgcn_sched_barrier(0);
#pragma unroll
            for (int m = 0; m < 2; ++m)
#pragma unroll
                for (int bj = 0; bj < 2; ++bj)
#pragma unroll
                    for (int n = 0; n < 2; ++n) *(f32x4*)(xout + (size_t)(row0 + ai * HALF + (m0 + m) * 16) * DM + col0 + bj * HALF + n * 16) = xi[m][bj][n] + gv[bj][n] * acc[ai][bj][m0 + m][n];
        }
    }
};

struct EpiSlab {
    static constexpr bool PERM = true;
    bf16_t* slab;
    __device__ __forceinline__ void operator()(const f32x4 (&acc)[2][2][4][2], const Unit& u, int wr, int wc, int fr, int fq) const {
        const int row0 = u.pm * BM + wr * 64 + fr, col0 = u.pn * BM + wc * 32 + 8 * fq;
        bf16_t* base = slab + (size_t)u.kh * HROWS * DM;
#pragma unroll
        for (int ai = 0; ai < 2; ++ai)
#pragma unroll
            for (int m = 0; m < 4; ++m) { bf16_t* rowp = base + (size_t)(row0 + ai * HALF + m * 16) * DM + col0;
#pragma unroll
                for (int bj = 0; bj < 2; ++bj) { const f32x4 v0 = acc[ai][bj][m][0], v1 = acc[ai][bj][m][1];
                    u32x4 w; w.x = pk2(v0[0], v0[1]); w.y = pk2(v0[2], v0[3]); w.z = pk2(v1[0], v1[1]); w.w = pk2(v1[2], v1[3]);
                    *(u32x4*)(rowp + bj * HALF) = w; } }
    }
};

template <class Epi, class Sched, bool ALIGN_EPI = true, bool SP2 = true>
__device__ __forceinline__ void gemm_phase(LAS unsigned char* lds, const Gemm g, const Sched& S, const Epi& E) {
    const int tid = opaque_tid(), wid = __builtin_amdgcn_readfirstlane(tid >> 6), lane = tid & 63, wr = wid >> 2, wc = wid & 3, fr = lane & 15, fq = lane >> 4;
    const int K = g.K, nt = K / BK, ld = g.ld;
    unsigned voffA[2], voffB[2];
#pragma unroll
    for (int i = 0; i < 2; ++i) { int R, C; stage_rc(tid * 16 + i * 8192, R, C); const int Rb = Epi::PERM ? ((R & ~31) + perm32(R & 31)) : R;
        voffA[i] = (unsigned)(R * ld + C) * 2u; voffB[i] = (unsigned)(Rb * ld + C) * 2u; }
    const size_t kstep = (size_t)(BK * 2);
    const size_t hstep = (size_t)HALF * ld * 2;
    const size_t tstep = 2 * hstep;
    const unsigned ldsw = (unsigned)wid * 1024u;
    const int aoff = lds_byte(wr * 64 + fr, fq * 8), boff = lds_byte(wc * 32 + fr, fq * 8);
#define PG8_SA(b, h) (((b) * 2 + (h)) * HTB)
#define PG8_SB(b, h) ((4 + (b) * 2 + (h)) * HTB)
#define PG8_STAGE(bufoff, gbase, voff) do { _Pragma("unroll") for (int _i = 0; _i < 2; ++_i) \
        __builtin_amdgcn_global_load_lds((const unsigned*)((const char*)(gbase) + (voff)[_i]), (LAS unsigned*)(lds + (bufoff) + ldsw + _i * 8192), 16, 0, 0); } while (0)
#define PG8_LDA(dst, b, h) do { _Pragma("unroll") for (int m = 0; m < 4; ++m) _Pragma("unroll") for (int k = 0; k < 2; ++k) dst[m][k] = *(const LAS bf16x8*)(lds + PG8_SA(b, h) + aoff + m * 2048 + k * 1024); } while (0)
#define PG8_LDB(dst, b, h) do { _Pragma("unroll") for (int n = 0; n < 2; ++n) _Pragma("unroll") for (int k = 0; k < 2; ++k) dst[n][k] = *(const LAS bf16x8*)(lds + PG8_SB(b, h) + boff + n * 2048 + k * 1024); } while (0)
#define PG8_MMA(ai, bj, At, Bt) do { __builtin_amdgcn_s_setprio(1); _Pragma("unroll") for (int m = 0; m < 4; ++m) _Pragma("unroll") for (int n = 0; n < 2; ++n) _Pragma("unroll") for (int k = 0; k < 2; ++k) \
        acc[ai][bj][m][n] = __builtin_amdgcn_mfma_f32_16x16x32_bf16(Bt[n][k], At[m][k], acc[ai][bj][m][n], 0, 0, 0); __builtin_amdgcn_s_setprio(0); } while (0)
#define PG8_WAIT_V(n) asm volatile("s_waitcnt vmcnt(" #n ")" ::: "memory")
#define PG8_WAIT_L(n) asm volatile("s_waitcnt lgkmcnt(" #n ")" ::: "memory")
#define PG8_BAR __builtin_amdgcn_s_barrier()
#define PG8_SCHED __builtin_amdgcn_sched_barrier(0)
    Unit cur, nxt; int ui = 0;
    if (!S.next(0, cur)) return;
    f32x4 acc[2][2][4][2];
#pragma unroll
    for (int a = 0; a < 2; ++a)
#pragma unroll
        for (int b = 0; b < 2; ++b)
#pragma unroll
            for (int m = 0; m < 4; ++m)
#pragma unroll
                for (int n = 0; n < 2; ++n) acc[a][b][m][n] = (f32x4){0.f, 0.f, 0.f, 0.f};
    bf16x8 At[4][2], B0[2][2], B1[2][2];
    const char* cA = (const char*)g.A + (size_t)cur.pm * tstep + (size_t)cur.kh * K * 2; const char* cB = (const char*)g.Bt + (size_t)cur.pn * tstep + (size_t)cur.kh * K * 2;
    if constexpr (SP2) {
        PG8_STAGE(PG8_SB(0, 0), cB, voffB); PG8_STAGE(PG8_SB(0, 1), cB + hstep, voffB); PG8_STAGE(PG8_SA(0, 0), cA, voffA); PG8_STAGE(PG8_SA(0, 1), cA + hstep, voffA);
        if (wr == 1) PG8_BAR;
        PG8_WAIT_V(2); PG8_BAR;
        PG8_STAGE(PG8_SB(1, 0), cB + kstep, voffB); PG8_STAGE(PG8_SA(1, 0), cA + kstep, voffA); PG8_STAGE(PG8_SB(1, 1), cB + hstep + kstep, voffB);
        PG8_WAIT_V(6); PG8_BAR;
    } else {
        PG8_STAGE(PG8_SB(0, 0), cB, voffB); PG8_STAGE(PG8_SA(0, 0), cA, voffA); PG8_STAGE(PG8_SB(0, 1), cB + hstep, voffB); PG8_STAGE(PG8_SA(0, 1), cA + hstep, voffA);
        if (wr == 1) PG8_BAR;
        PG8_WAIT_V(4); PG8_BAR;
        PG8_STAGE(PG8_SB(1, 0), cB + kstep, voffB); PG8_STAGE(PG8_SA(1, 0), cA + kstep, voffA); PG8_STAGE(PG8_SB(1, 1), cB + hstep + kstep, voffB);
        PG8_WAIT_V(6); PG8_BAR;
    }
    for (;;) {
        const bool has_next = S.next(ui + 1, nxt);
        const char* nA = has_next ? (const char*)g.A + (size_t)nxt.pm * tstep + (size_t)nxt.kh * K * 2 : cA; const char* nB = has_next ? (const char*)g.Bt + (size_t)nxt.pn * tstep + (size_t)nxt.kh * K * 2 : cB;
        for (int t = 0; t < nt; t += 2) {
            const bool last = (t == nt - 2);
            const char* a1 = cA + (size_t)(t + 1) * kstep;
            const char* a2 = last ? nA : cA + (size_t)(t + 2) * kstep; const char* b2 = last ? nB : cB + (size_t)(t + 2) * kstep;
            const char* a3 = a2 + kstep; const char* b3 = b2 + kstep;
            if constexpr (SP2) {
            PG8_LDB(B0, 0, 0); PG8_LDB(B1, 0, 1); PG8_SCHED; PG8_LDA(At, 0, 0); PG8_STAGE(PG8_SA(1, 1), a1 + hstep, voffA);
            PG8_WAIT_V(8); PG8_WAIT_L(0); PG8_BAR; PG8_MMA(0, 0, At, B0); PG8_MMA(0, 1, At, B1); PG8_BAR; PG8_SCHED;
            PG8_LDA(At, 0, 1); PG8_STAGE(PG8_SB(0, 0), b2, voffB); PG8_STAGE(PG8_SB(0, 1), b2 + hstep, voffB); PG8_STAGE(PG8_SA(0, 0), a2, voffA);
            PG8_WAIT_V(8); PG8_WAIT_L(0); PG8_BAR; PG8_MMA(1, 0, At, B0); PG8_MMA(1, 1, At, B1); PG8_BAR; PG8_SCHED;
            PG8_LDB(B0, 1, 0); PG8_LDB(B1, 1, 1); PG8_SCHED; PG8_LDA(At, 1, 0); PG8_STAGE(PG8_SA(0, 1), a2 + hstep, voffA);
            PG8_WAIT_V(8); PG8_WAIT_L(0); PG8_BAR; PG8_MMA(0, 0, At, B0); PG8_MMA(0, 1, At, B1); PG8_BAR; PG8_SCHED;
            PG8_LDA(At, 1, 1); PG8_STAGE(PG8_SB(1, 0), b3, voffB); PG8_STAGE(PG8_SB(1, 1), b3 + hstep, voffB); PG8_STAGE(PG8_SA(1, 0), a3, voffA);
            PG8_WAIT_V(8); PG8_WAIT_L(0); PG8_BAR; PG8_MMA(1, 0, At, B0); PG8_MMA(1, 1, At, B1); PG8_BAR; PG8_SCHED;
            } else {
            PG8_LDB(B0, 0, 0); PG8_SCHED; PG8_LDA(At, 0, 0); PG8_STAGE(PG8_SA(1, 1), a1 + hstep, voffA);
            PG8_WAIT_L(8); PG8_BAR; PG8_WAIT_L(0); PG8_MMA(0, 0, At, B0); PG8_BAR; PG8_SCHED;
            PG8_LDB(B1, 0, 1); PG8_STAGE(PG8_SB(0, 0), b2, voffB);
            PG8_BAR; PG8_WAIT_L(0); PG8_MMA(0, 1, At, B1); PG8_BAR;
            PG8_LDA(At, 0, 1); PG8_STAGE(PG8_SA(0, 0), a2, voffA);
            PG8_BAR; PG8_WAIT_L(0); PG8_MMA(1, 0, At, B0); PG8_BAR; PG8_SCHED;
            PG8_STAGE(PG8_SB(0, 1), b2 + hstep, voffB);
            PG8_WAIT_V(6); PG8_BAR; PG8_MMA(1, 1, At, B1); PG8_BAR;
            PG8_LDB(B0, 1, 0); PG8_SCHED; PG8_LDA(At, 1, 0); PG8_STAGE(PG8_SA(0, 1), a2 + hstep, voffA);
            PG8_WAIT_L(8); PG8_BAR; PG8_WAIT_L(0); PG8_MMA(0, 0, At, B0); PG8_BAR; PG8_SCHED;
            PG8_LDB(B1, 1, 1); PG8_STAGE(PG8_SB(1, 0), b3, voffB);
            PG8_BAR; PG8_WAIT_L(0); PG8_MMA(0, 1, At, B1); PG8_BAR;
            PG8_LDA(At, 1, 1); PG8_STAGE(PG8_SA(1, 0), a3, voffA);
            PG8_BAR; PG8_WAIT_L(0); PG8_MMA(1, 0, At, B0); PG8_BAR; PG8_SCHED;
            PG8_STAGE(PG8_SB(1, 1), b3 + hstep, voffB);
            PG8_WAIT_V(6); PG8_BAR; PG8_MMA(1, 1, At, B1); PG8_BAR;
            }
        }
        if constexpr (ALIGN_EPI) { if (wr == 0) PG8_BAR; }
        E(acc, cur, wr, wc, fr, fq);
        if (!has_next) break;
#pragma unroll
        for (int a = 0; a < 2; ++a)
#pragma unroll
            for (int b = 0; b < 2; ++b)
#pragma unroll
                for (int m = 0; m < 4; ++m)
#pragma unroll
                    for (int n = 0; n < 2; ++n) acc[a][b][m][n] = (f32x4){0.f, 0.f, 0.f, 0.f};
        cur = nxt; cA = nA; cB = nB; ++ui;
        if constexpr (ALIGN_EPI) { if (wr == 1) PG8_BAR; }
    }
    PG8_WAIT_V(0);
    if constexpr (!ALIGN_EPI) { if (wr == 0) PG8_BAR; }
    PG8_BAR;
#undef PG8_SA
#undef PG8_SB
#undef PG8_STAGE
#undef PG8_LDA
#undef PG8_LDB
#undef PG8_MMA
#undef PG8_WAIT_V
#undef PG8_WAIT_L
#undef PG8_BAR
#undef PG8_SCHED
}
}

struct Args {
    const float* x; const float* c; const float* w_ada; const float* b_ada; const float* norm_g; const float* w_in;
    const float* lb_logits; const float* hgrn_g; const float* ret_g; const float* conv_w; const float* conv_b;
    const float* dt_bias; const float* a_log; const float* dskip; const float* ssm_g; const float* w_gk2; const float* b_gk2;
    const float* gla_g; const float* w_out; const float* final_g;
    float* out; unsigned char* ws;
};

__device__ __forceinline__ void transpose_cvt(const float* __restrict__ src, int K, int N, bf16_t* __restrict__ dst, int Npad, LAS unsigned char* lds, int gid, int gstride, bool perm) {
    LAS float* T = (LAS float*)lds;
    const int tid = opaque_tid(), ntk = K / 64, ntn = Npad / 256;
    for (int tile = gid; tile < ntk * ntn; tile += gstride) {
        const int tk = tile % ntk, tn = tile / ntk;
        float v[32];
#pragma unroll
        for (int i = 0; i < 32; ++i) { const int kk = (tid >> 8) + 2 * i, nn = tid & 255, n = tn * 256 + nn;
            const int ns = !perm ? n : (n < 5632) ? n : (n < 7168) ? n + 8 : (n < 7176) ? n - 7168 + 5632 : n;
            v[i] = (n < N) ? src[(size_t)(tk * 64 + kk) * N + ns] : 0.f; }
#pragma unroll
        for (int i = 0; i < 32; ++i) { const int kk = (tid >> 8) + 2 * i, nn = tid & 255; T[kk * 257 + nn] = v[i]; }
        __syncthreads();
#pragma unroll
        for (int i = 0; i < 16; ++i) { const int nn = (tid >> 5) + 16 * i, kk = (tid & 31) * 2;
            *(unsigned*)(dst + (size_t)(tn * 256 + nn) * K + tk * 64 + kk) = pk2(T[kk * 257 + nn], T[(kk + 1) * 257 + nn]); }
        __syncthreads();
    }
}

__device__ __forceinline__ void phase_wcvt(const Args& a, LAS unsigned char* lds) {
    const int G = gridDim.x, bid = blockIdx.x;
    unsigned char* ws = a.ws;
    for (int l = 0; l < DEPTH; ++l) {
        transpose_cvt(a.w_in + (size_t)l * DM * NIN, DM, NIN, (bf16_t*)(ws + WS_WIN) + (size_t)l * LDP * DM, LDP, lds, bid, G, true);
        transpose_cvt(a.w_out + (size_t)l * DI * DM, DI, DM, (bf16_t*)(ws + WS_WOUT) + (size_t)l * DM * DI, DM, lds, (bid + 128) % G, G, false);
    }
}
__device__ __forceinline__ void phase_prep(const Args& a, LAS unsigned char* lds) {
    const int tid = opaque_tid(), G = gridDim.x, bid = blockIdx.x;
    unsigned char* ws = a.ws;
    {
        LAS float* R = (LAS float*)lds;
        LAS float* CA = (LAS float*)(lds + 8192);
        float* mod = (float*)(ws + WS_MOD);
        const int jj = tid & 63, ks = tid >> 6;
        if (bid < DEPTH * 48) {
#pragma unroll
            for (int q = 0; q < 8; ++q) CA[tid + NTHR * q] = silu_f(a.c[tid + NTHR * q]);
            __syncthreads();
        }
        for (int item = bid; item < DEPTH * 48; item += G) {
            const int l = item / 48, j = (item % 48) * 64 + jj;
            float s0 = 0.f, s1 = 0.f, s2 = 0.f, s3 = 0.f;
            const float* w = a.w_ada + (size_t)l * DM * 3072 + j;
#pragma unroll 16
            for (int k = ks * 128; k < ks * 128 + 128; ++k) { const float wv = w[(size_t)k * 3072];
                s0 += CA[k] * wv; s1 += CA[DM + k] * wv; s2 += CA[2 * DM + k] * wv; s3 += CA[3 * DM + k] * wv; }
            R[(ks * 4 + 0) * 64 + jj] = s0; R[(ks * 4 + 1) * 64 + jj] = s1; R[(ks * 4 + 2) * 64 + jj] = s2; R[(ks * 4 + 3) * 64 + jj] = s3;
            __syncthreads();
            if (tid < 256) { const int b = tid >> 6; float s = a.b_ada[l * 3072 + j];
#pragma unroll
                for (int q = 0; q < 8; ++q) s += R[(q * 4 + b) * 64 + jj];
                mod[(size_t)(l * 4 + b) * 3072 + j] = s; }
            __syncthreads();
        }
    }
    {
        float2* rope = (float2*)(ws + WS_ROPE);
        for (int i = bid * NTHR + tid; i < 4096 * 64; i += G * NTHR) {
            const int pos = i >> 6, j = i & 63;
            const float invf = powf(10000.f, -(float)(2 * j) / 128.f);
            const float ang = (float)pos * invf;
            const float k = rintf(ang * 0.15915494309189535f);
            float r = fmaf(-k, 6.2831854820251465f, ang); r = fmaf(-k, -1.7484555e-07f, r);
            rope[i] = make_float2(__cosf(r), __sinf(r));
        }
    }
}

template <bool FINAL>
__device__ __forceinline__ void phase_norm(const float* __restrict__ xin  , const bf16_t* __restrict__ slab  ,
                                           const float* __restrict__ gate_prev  , float* xout  ,
                                           const float* __restrict__ g, const float* __restrict__ mod  , int half, bf16_t* __restrict__ hout) {
    const int tid = opaque_tid(), lane = tid & 63, wid = tid >> 6;
    const int gw = blockIdx.x * 8 + wid, nw = gridDim.x * 8;
    for (int row = gw; row < HROWS; row += nw) {
        const float* xr = xin + (size_t)row * DM;
        f32x4 v[4]; float ss = 0.f;
#pragma unroll
        for (int i = 0; i < 4; ++i) v[i] = *(const f32x4*)(xr + i * 256 + lane * 4);
        if (slab) {
            u32x2 a0[4], a1[4]; f32x4 gp[4];
#pragma unroll
            for (int i = 0; i < 4; ++i) { const int col = i * 256 + lane * 4;
                a0[i] = *(const u32x2*)(slab + (size_t)row * DM + col); a1[i] = *(const u32x2*)(slab + (size_t)(HROWS + row) * DM + col);
                gp[i] = *(const f32x4*)(gate_prev + (size_t)(row >> 12) * 3072 + col); }
#pragma unroll
            for (int i = 0; i < 4; ++i) {
                const f32x4 sa = {__uint_as_float(a0[i].x << 16) + __uint_as_float(a1[i].x << 16), __uint_as_float(a0[i].x & 0xffff0000u) + __uint_as_float(a1[i].x & 0xffff0000u),
                                  __uint_as_float(a0[i].y << 16) + __uint_as_float(a1[i].y << 16), __uint_as_float(a0[i].y & 0xffff0000u) + __uint_as_float(a1[i].y & 0xffff0000u)};
                v[i] = v[i] + gp[i] * sa; }
        }
        if (!FINAL && xout) {
#pragma unroll
            for (int i = 0; i < 4; ++i) *(f32x4*)(xout + (size_t)row * DM + i * 256 + lane * 4) = v[i];
        }
#pragma unroll
        for (int i = 0; i < 4; ++i) ss += v[i][0] * v[i][0] + v[i][1] * v[i][1] + v[i][2] * v[i][2] + v[i][3] * v[i][3];
#pragma unroll
        for (int o = 32; o > 0; o >>= 1) ss += __shfl_xor(ss, o);
        const float rinv = rsqrtf(ss * (1.f / DM) + EPS);
        if constexpr (FINAL) {
#pragma unroll
            for (int i = 0; i < 4; ++i) { const int col = i * 256 + lane * 4; const f32x4 gg = *(const f32x4*)(g + col);
                *(f32x4*)(xout + (size_t)row * DM + col) = v[i] * rinv * gg; }
        } else {
            const float* mb = mod + (size_t)(half * 2 + (row >> 12)) * 3072;
#pragma unroll
            for (int i = 0; i < 4; ++i) { const int col = i * 256 + lane * 4;
                const f32x4 gg = *(const f32x4*)(g + col), sh = *(const f32x4*)(mb + col), sc = *(const f32x4*)(mb + 1024 + col);
                float o0 = v[i][0] * rinv * gg[0] * (1.f + sc[0]) + sh[0], o1 = v[i][1] * rinv * gg[1] * (1.f + sc[1]) + sh[1];
                float o2 = v[i][2] * rinv * gg[2] * (1.f + sc[2]) + sh[2], o3 = v[i][3] * rinv * gg[3] * (1.f + sc[3]) + sh[3];
                u32x2 w; w.x = pk2(o0, o1); w.y = pk2(o2, o3);
                *(u32x2*)(hout + (size_t)row * DM + col) = w; }
        }
    }
}

struct MixP {
    const bf16_t* proj; bf16_t* st; float* dec; bf16_t* y; const float2* rope;
    const float* lbl; const float* hgrn_g; const float* ret_g; const float* conv_w; const float* conv_b; const float* dt_bias; const float* a_log;
    const float* dskip; const float* ssm_g; const float* w2; const float* b2; const float* gla_g; int layer;
};

__device__ __forceinline__ bf16x8 frag(LAS unsigned char* lds, int off, int ld, int r0, int ks, int lane) {
    return *(const LAS bf16x8*)(lds + off + (((r0 + (lane & 31)) * ld + 16 * ks + 8 * (lane >> 5)) << 1));
}
__device__ __forceinline__ int rowmap(int r, int lane) { return (r & 3) + 8 * (r >> 2) + 4 * (lane >> 5); }

__device__ __forceinline__ void conv16(LAS unsigned char* lds, int off, int ncols, int col, const float* cw, int seg, float (&out)[16]) {
    const LAS bf16_t* rp = (const LAS bf16_t*)(lds + off) + seg * 16 * ncols + col;
    float u[19];
#pragma unroll
    for (int k = 0; k < 19; ++k) u[k] = bf2f(rp[k * ncols]);
#pragma unroll
    for (int i = 0; i < 16; ++i) out[i] = silu_f(cw[4] + cw[0] * u[i] + cw[1] * u[i + 1] + cw[2] * u[i + 2] + cw[3] * u[i + 3]);
}
__device__ __forceinline__ void conv_w_load(const MixP& p, int chan, float* cw) {
    cw[0] = p.conv_w[chan]; cw[1] = p.conv_w[1024 + chan]; cw[2] = p.conv_w[2048 + chan]; cw[3] = p.conv_w[3072 + chan]; cw[4] = p.conv_b[chan];
}
template <int NCOLS, int NROWS> struct Stg { static constexpr int VPR = NCOLS / 8, NV = NROWS * VPR, NIT = (NV + NTHR - 1) / NTHR; };
template <int NCOLS, int NROWS>
__device__ __forceinline__ void stg_load(const bf16_t* proj, int grow0, int col0, int tid, int zrows, u32x4* r) {
    using S = Stg<NCOLS, NROWS>;
#pragma unroll
    for (int j = 0; j < S::NIT; ++j) { const int vi = tid + NTHR * j, row = vi / S::VPR, cv = vi % S::VPR;
        const bool ok = (vi < S::NV) && (row >= zrows);
        r[j] = ok ? *(const u32x4*)(proj + pidx(grow0 + row, col0 + cv * 8)) : (u32x4){0u, 0u, 0u, 0u}; }
}
template <int NCOLS, int NROWS>
__device__ __forceinline__ void stg_store(LAS unsigned char* lds, int off, int tid, const u32x4* r) {
    using S = Stg<NCOLS, NROWS>;
#pragma unroll
    for (int j = 0; j < S::NIT; ++j) { const int vi = tid + NTHR * j; if (vi < S::NV) *(LAS u32x4*)(lds + off + vi * 16) = r[j]; }
}
__device__ __forceinline__ void store16(LAS unsigned char* lds, int byteoff, const float (&v)[16]) {
    u32x4 a, b; a.x = pk2(v[0], v[1]); a.y = pk2(v[2], v[3]); a.z = pk2(v[4], v[5]); a.w = pk2(v[6], v[7]);
    b.x = pk2(v[8], v[9]); b.y = pk2(v[10], v[11]); b.z = pk2(v[12], v[13]); b.w = pk2(v[14], v[15]);
    *(LAS u32x4*)(lds + byteoff) = a; *(LAS u32x4*)(lds + byteoff + 16) = b;
}
__device__ __forceinline__ void store8(LAS unsigned char* lds, int byteoff, const float (&v)[8]) {
    u32x4 a; a.x = pk2(v[0], v[1]); a.y = pk2(v[2], v[3]); a.z = pk2(v[4], v[5]); a.w = pk2(v[6], v[7]);
    *(LAS u32x4*)(lds + byteoff) = a;
}

constexpr int NUNITS = 128 * 14;
struct Pref { u32x4 raw[11]; u32x4 st[8]; float aux[16]; };
template <int BR, int PASS>
__device__ __forceinline__ void load_A(const MixP& p, int bc, int hu, int tid, Pref& pf) {
    const bf16_t* P = p.proj; const int g0 = bc * 64;
    if constexpr (BR == 0) { stg_load<128, 64>(P, g0, C_AF + hu * 128, tid, 0, pf.raw + 0); stg_load<128, 64>(P, g0, C_AI + hu * 128, tid, 0, pf.raw + 2);
        if constexpr (PASS == 3) stg_load<128, 64>(P, g0, C_AQ + hu * 128, tid, 0, pf.raw + 4); }
    if constexpr (BR == 1) { stg_load<128, 64>(P, g0, C_RK + hu * 128, tid, 0, pf.raw + 0); stg_load<128, 64>(P, g0, C_RV + hu * 128, tid, 0, pf.raw + 2);
        if constexpr (PASS == 3) stg_load<128, 64>(P, g0, C_RQ + hu * 128, tid, 0, pf.raw + 4); }
    if constexpr (BR == 2) { const int zr = ((bc & 63) == 0) ? 3 : 0;
        stg_load<128, 67>(P, g0 - 3, C_XBC + 512 + hu * 128, tid, zr, pf.raw + 0); stg_load<256, 67>(P, g0 - 3, C_XBC + hu * 256, tid, zr, pf.raw + 3);
        if constexpr (PASS == 3) stg_load<128, 67>(P, g0 - 3, C_XBC + 768 + hu * 128, tid, zr, pf.raw + 8); }
    if constexpr (BR == 3) { stg_load<64, 64>(P, g0, C_GK + hu * 64, tid, 0, pf.raw + 0); stg_load<128, 64>(P, g0, C_GV + hu * 128, tid, 0, pf.raw + 1); stg_load<16, 64>(P, g0, C_LR, tid, 0, pf.raw + 3);
        if constexpr (PASS == 3) stg_load<64, 64>(P, g0, C_GQ + hu * 64, tid, 0, pf.raw + 4); }
}
template <int BR, int PASS>
__device__ __forceinline__ void load_B(const MixP& p, int bc, int hu, int tid, Pref& pf) {
    if constexpr (PASS == 3) {
        constexpr int DK = (BR == 3) ? 64 : 128, DV = (BR == 2) ? 256 : 128, NV = DV * DK / 8 / NTHR;
        const int st_off = (BR == 0) ? hu * 16384 : (BR == 1) ? 65536 + hu * 16384 : (BR == 2) ? 131072 + hu * 32768 : 196608 + hu * 8192;
        const bf16_t* stg = p.st + (size_t)bc * ST_PER_BC + st_off;
#pragma unroll
        for (int k = 0; k < NV; ++k) pf.st[k] = *(const u32x4*)(stg + (size_t)(tid + NTHR * k) * 8);
    }
    if constexpr (BR == 1) { const int j = tid & 63, seg = tid >> 6, chunk = bc & 63;
#pragma unroll
        for (int i = 0; i < 8; ++i) { const float2 c = p.rope[(chunk * 64 + seg * 8 + i) * 64 + j]; pf.aux[2 * i] = c.x; pf.aux[2 * i + 1] = c.y; } }
    if constexpr (BR == 2) { if (tid < 64) {
#pragma unroll
            for (int hh = 0; hh < 4; ++hh) pf.aux[hh] = bf2f(p.proj[pidx(bc * 64 + tid, C_DT + hu * 4 + hh)]); } }
    if constexpr (BR == 3) { const int cc = hu * 64 + (tid & 63);
#pragma unroll
        for (int r = 0; r < 16; ++r) pf.aux[r] = p.w2[r * 256 + cc]; }
}
template <int PASS>
__device__ __forceinline__ void load_A_any(const MixP& p, int i, int tid, Pref& pf) {
    const int bc = i / 14, u = i % 14;
    if (u < 4) load_A<0, PASS>(p, bc, u, tid, pf); else if (u < 8) load_A<1, PASS>(p, bc, u - 4, tid, pf);
    else if (u < 10) load_A<2, PASS>(p, bc, u - 8, tid, pf); else load_A<3, PASS>(p, bc, u - 10, tid, pf);
}
template <int PASS>
__device__ __forceinline__ void load_B_any(const MixP& p, int i, int tid, Pref& pf) {
    const int bc = i / 14, u = i % 14;
    if (u < 4) load_B<0, PASS>(p, bc, u, tid, pf); else if (u < 8) load_B<1, PASS>(p, bc, u - 4, tid, pf);
    else if (u < 10) load_B<2, PASS>(p, bc, u - 8, tid, pf); else load_B<3, PASS>(p, bc, u - 10, tid, pf);
}

template <int BR, int PASS>
__device__ __forceinline__ void mixer_unit(const MixP& p, LAS unsigned char* lds, int bc, int hu  ) {
    constexpr int DK = (BR == 3) ? 64 : 128, LDK = DK + 8, NH = (BR == 2) ? 4 : 1, DV = (BR == 2) ? 256 : 128, NT = DV / 128;
    constexpr bool VEC = (BR == 0 || BR == 3);
    const int tid = opaque_tid(), lane = tid & 63, wid = __builtin_amdgcn_readfirstlane(tid >> 6);
    const int chunk = bc & 63;
    const bf16_t* P = p.proj;
    LAS float* SM = (LAS float*)(lds + L_SM);
    LAS bf16_t* QI = (LAS bf16_t*)(lds + L_QI); LAS bf16_t* KI = (LAS bf16_t*)(lds + L_KI); LAS bf16_t* VT = (LAS bf16_t*)(lds + L_VT);
    const int st_off = (BR == 0) ? hu * 16384 : (BR == 1) ? 65536 + hu * 16384 : (BR == 2) ? 131072 + hu * 32768 : 196608 + hu * 8192;
    bf16_t* stg = p.st + (size_t)bc * ST_PER_BC + st_off;
    Pref pf;
    load_A<BR, PASS>(p, bc, hu, tid, pf);
    load_B<BR, PASS>(p, bc, hu, tid, pf);
    constexpr int NTG = (PASS == 3) ? NT : 1;
    const int gcol = (BR == 0) ? C_AG + hu * 128 : (BR == 1) ? C_RG + hu * 128 : (BR == 2) ? C_MZ + hu * 256 : C_GG + hu * 128;
    const float* gain = (BR == 0) ? p.hgrn_g + hu * 128 : (BR == 1) ? p.ret_g + hu * 128 : (BR == 2) ? p.ssm_g + hu * 256 : p.gla_g + hu * 128;
    bf16_t gt[NTG][16]; float gnv[NTG], dskv[NTG];
    float lb = 0.f, bb = 0.f, cwb[5], cwc[5], cwx[5], dtb[4], alg[4];
    if constexpr (BR == 0) { if (p.layer == 1) { const int cc = hu * 128 + (tid & 127); lb = 1.f / (1.f + __expf(p.lbl[cc] - p.lbl[512 + cc])); } }
    if constexpr (BR == 3) bb = p.b2[hu * 64 + (tid & 63)];
    if constexpr (BR == 2) { conv_w_load(p, 512 + hu * 128 + (tid & 127), cwb); if constexpr (PASS == 3) conv_w_load(p, 768 + hu * 128 + (tid & 127), cwc); conv_w_load(p, hu * 256 + (tid & 255), cwx);
#pragma unroll
        for (int hh = 0; hh < 4; ++hh) { dtb[hh] = p.dt_bias[hu * 4 + hh]; alg[hh] = p.a_log[hu * 4 + hh]; } }
    __builtin_amdgcn_sched_barrier(0);

    for (int urep = 0; urep < REP_UPREP; ++urep) {
    if constexpr (BR == 0) {
        constexpr int RQ = L_BIG, RF = (PASS == 3) ? L_BIG + 16384 : L_QI, RV = (PASS == 3) ? L_BIG + 32768 : L_QI + 16384;
        stg_store<128, 64>(lds, RF, tid, pf.raw + 0); stg_store<128, 64>(lds, RV, tid, pf.raw + 2);
        if constexpr (PASS == 3) stg_store<128, 64>(lds, RQ, tid, pf.raw + 4);
        __builtin_amdgcn_sched_barrier(0);
        const int d = tid & 127, seg = tid >> 7;
        __syncthreads();
        const LAS bf16_t* rF = (const LAS bf16_t*)(lds + RF) + seg * 16 * 128 + d;
        const LAS bf16_t* rQ = (const LAS bf16_t*)(lds + RQ) + seg * 16 * 128 + d;
        const LAS bf16_t* rV = (const LAS bf16_t*)(lds + RV) + seg * 16 * 128 + d;
        float cs[16], kk[16]; float run = 0.f;
#pragma unroll
        for (int i = 0; i < 16; ++i) { const float av = fmaxf(bf2f(rF[i * 128]), -60.f); const float e = __expf(-av), sg = __builtin_amdgcn_rcpf(1.f + e);
            const float f = lb + (1.f - lb) * sg; run += __logf(f); cs[i] = run; kk[i] = (1.f - lb) * e * sg; }
        SM[SM_SEG + seg * 128 + d] = run;
        __syncthreads();
        const float t0 = SM[SM_SEG + d], t1 = SM[SM_SEG + 128 + d], t2 = SM[SM_SEG + 256 + d], t3 = SM[SM_SEG + 384 + d];
        const float off = (seg == 0) ? 0.f : (seg == 1) ? t0 : (seg == 2) ? t0 + t1 : t0 + t1 + t2;
        const float ref = t0 + t1, clast = ref + t2 + t3;
        if (seg == 0) { SM[SM_REF + d] = ref; SM[SM_CLAST + d] = clast; }
        float kv[16];
#pragma unroll
        for (int i = 0; i < 16; ++i) { const float c = off + cs[i]; kv[i] = kk[i] * __expf(fminf(ref - c, 80.f));
            if constexpr (PASS == 3) { KI[(seg * 16 + i) * LDK + d] = f2bf(kv[i]);
                const float q = bf2f(rQ[i * 128]); QI[(seg * 16 + i) * LDK + d] = f2bf(silu_f(q) * __expf(fminf(c - ref, 80.f))); } }
        if constexpr (PASS == 1) store16(lds, L_BIG + (d * 72 + seg * 16) * 2, kv);
        unsigned vv[16];
#pragma unroll
        for (int i = 0; i < 16; ++i) vv[i] = rV[i * 128];
        u32x4 a, b; a.x = vv[0] | (vv[1] << 16); a.y = vv[2] | (vv[3] << 16); a.z = vv[4] | (vv[5] << 16); a.w = vv[6] | (vv[7] << 16);
        b.x = vv[8] | (vv[9] << 16); b.y = vv[10] | (vv[11] << 16); b.z = vv[12] | (vv[13] << 16); b.w = vv[14] | (vv[15] << 16);
        *(LAS u32x4*)(lds + L_VT + (d * 72 + seg * 16) * 2) = a; *(LAS u32x4*)(lds + L_VT + (d * 72 + seg * 16) * 2 + 16) = b;
    }
    if constexpr (BR == 1) {
        constexpr int RQ = L_BIG, RK = (PASS == 3) ? L_BIG + 16384 : L_QI, RV = (PASS == 3) ? L_BIG + 32768 : L_QI + 16384;
        const int j = tid & 63, seg = tid >> 6;
        float2 cssn[8];
#pragma unroll
        for (int i = 0; i < 8; ++i) cssn[i] = make_float2(pf.aux[2 * i], pf.aux[2 * i + 1]);
        stg_store<128, 64>(lds, RK, tid, pf.raw + 0); stg_store<128, 64>(lds, RV, tid, pf.raw + 2);
        if constexpr (PASS == 3) stg_store<128, 64>(lds, RQ, tid, pf.raw + 4);
        __builtin_amdgcn_sched_barrier(0);
        const float lg = log1pf(-exp2f(-(5.f + (float)hu)));
        if (tid < 64) { SM[SM_CUM + tid] = (float)(tid + 1) * lg; SM[SM_DT + tid] = 1.f; }
        __syncthreads();
        float k1[8], k2[8];
#pragma unroll
        for (int i = 0; i < 8; ++i) { const int t = seg * 8 + i;
            const LAS bf16_t* rk = (const LAS bf16_t*)(lds + RK) + t * 128 + j;
            const float ka = bf2f(rk[0]) * 0.08838834764831845f, kb = bf2f(rk[64]) * 0.08838834764831845f;
            k1[i] = ka * cssn[i].x - kb * cssn[i].y; k2[i] = ka * cssn[i].y + kb * cssn[i].x;
            if constexpr (PASS == 3) { const LAS bf16_t* rq = (const LAS bf16_t*)(lds + RQ) + t * 128 + j;
                const float qa = bf2f(rq[0]), qb = bf2f(rq[64]);
                QI[t * LDK + j] = f2bf(qa * cssn[i].x - qb * cssn[i].y); QI[t * LDK + j + 64] = f2bf(qa * cssn[i].y + qb * cssn[i].x);
                KI[t * LDK + j] = f2bf(k1[i]); KI[t * LDK + j + 64] = f2bf(k2[i]); } }
        if constexpr (PASS == 1) { store8(lds, L_BIG + (j * 72 + seg * 8) * 2, k1); store8(lds, L_BIG + ((j + 64) * 72 + seg * 8) * 2, k2); }
        const int v = tid & 127, s4 = tid >> 7; float vv[16];
#pragma unroll
        for (int i = 0; i < 16; ++i) { const int s = s4 * 16 + i; float x = bf2f(((const LAS bf16_t*)(lds + RV))[s * 128 + v]);
            if constexpr (PASS == 1) x *= __expf((float)(63 - s) * lg);
            vv[i] = x; }
        store16(lds, L_VT + (v * 72 + s4 * 16) * 2, vv);
    }
    if constexpr (BR == 2) {
        constexpr int RB = (PASS == 3) ? L_BIG : L_QI, RC = L_BIG + 17152, RX = (PASS == 3) ? L_BIG + 34304 : L_BIG + 18432;
        float dtr[4];
#pragma unroll
        for (int hh = 0; hh < 4; ++hh) dtr[hh] = pf.aux[hh];
        stg_store<128, 67>(lds, RB, tid, pf.raw + 0); stg_store<256, 67>(lds, RX, tid, pf.raw + 3);
        if constexpr (PASS == 3) stg_store<128, 67>(lds, RC, tid, pf.raw + 8);
        __builtin_amdgcn_sched_barrier(0);
        if (tid < 64) {
#pragma unroll
            for (int hh = 0; hh < 4; ++hh) {
                const float dt = softplus_f(dtr[hh] + dtb[hh]);
                float la = -dt * __expf(alg[hh]);
#pragma unroll
                for (int o = 1; o < 64; o <<= 1) { const float yv = __shfl_up(la, o); if (tid >= o) la += yv; }
                SM[SM_CUM + hh * 64 + tid] = la; SM[SM_DT + hh * 64 + tid] = dt; }
        }
        __syncthreads();
        { const int n = tid & 127, seg = tid >> 7; float o[16];
          conv16(lds, RB, 128, n, cwb, seg, o);
          if constexpr (PASS == 3) {
#pragma unroll
              for (int i = 0; i < 16; ++i) KI[(seg * 16 + i) * LDK + n] = f2bf(o[i]);
              conv16(lds, RC, 128, n, cwc, seg, o);
#pragma unroll
              for (int i = 0; i < 16; ++i) QI[(seg * 16 + i) * LDK + n] = f2bf(o[i]);
          } else store16(lds, L_BIG + (n * 72 + seg * 16) * 2, o);
        }
        { const int v = tid & 255, s2 = tid >> 8, hh = v >> 6;
#pragma unroll
          for (int r = 0; r < 2; ++r) { const int seg = s2 * 2 + r; float o[16];
              conv16(lds, RX, 256, v, cwx, seg, o);
              if constexpr (PASS == 1) { const float cl = SM[SM_CUM + hh * 64 + 63];
#pragma unroll
                  for (int i = 0; i < 16; ++i) { const int s = seg * 16 + i; o[i] *= __expf(cl - SM[SM_CUM + hh * 64 + s]) * SM[SM_DT + hh * 64 + s]; } }
              store16(lds, L_VT + (v * 72 + seg * 16) * 2, o); }
        }
    }
    if constexpr (BR == 3) {
        constexpr int RQ = L_BIG, RK = (PASS == 3) ? L_BIG + 8192 : L_QI, RV = (PASS == 3) ? L_BIG + 16384 : L_QI + 8192, RL = (PASS == 3) ? L_BIG + 32768 : L_QI + 24576;
        const int d = tid & 63, seg = tid >> 6, cc = hu * 64 + d;
        float w2r[16];
#pragma unroll
        for (int r = 0; r < 16; ++r) w2r[r] = pf.aux[r];
        stg_store<64, 64>(lds, RK, tid, pf.raw + 0); stg_store<128, 64>(lds, RV, tid, pf.raw + 1); stg_store<16, 64>(lds, RL, tid, pf.raw + 3);
        if constexpr (PASS == 3) stg_store<64, 64>(lds, RQ, tid, pf.raw + 4);
        __builtin_amdgcn_sched_barrier(0);
        __syncthreads();
        float cs[8]; float run = 0.f;
#pragma unroll
        for (int i = 0; i < 8; ++i) { const int t = seg * 8 + i; const LAS bf16x8* lp = (const LAS bf16x8*)(lds + RL + t * 32);
            const bf16x8 l0 = lp[0], l1 = lp[1]; float gk = bb;
#pragma unroll
            for (int r = 0; r < 8; ++r) { gk += w2r[r] * bf2f((bf16_t)l0[r]); gk += w2r[8 + r] * bf2f((bf16_t)l1[r]); }
            run += logsig_f(gk) * (1.f / 16.f); cs[i] = run; }
        SM[SM_SEG + seg * 64 + d] = run;
        __syncthreads();
        float off = 0.f, ref = 0.f, clast = 0.f;
#pragma unroll
        for (int s = 0; s < 8; ++s) { const float tv = SM[SM_SEG + s * 64 + d]; if (s < seg) off += tv; if (s < 4) ref += tv; clast += tv; }
        if (seg == 0) { SM[SM_REF + d] = ref; SM[SM_CLAST + d] = clast; }
        float kv[8];
#pragma unroll
        for (int i = 0; i < 8; ++i) { const int t = seg * 8 + i; const float c = off + cs[i];
            kv[i] = bf2f(((const LAS bf16_t*)(lds + RK))[t * 64 + d]) * __expf(fminf(ref - c, 80.f));
            if constexpr (PASS == 3) { KI[t * LDK + d] = f2bf(kv[i]); QI[t * LDK + d] = f2bf(bf2f(((const LAS bf16_t*)(lds + RQ))[t * 64 + d]) * 0.125f * __expf(fminf(c - ref, 80.f))); } }
        if constexpr (PASS == 1) store8(lds, L_BIG + (d * 72 + seg * 8) * 2, kv);
        const int v = tid & 127, s4 = tid >> 7; unsigned vv[16];
#pragma unroll
        for (int i = 0; i < 16; ++i) vv[i] = ((const LAS bf16_t*)(lds + RV))[(s4 * 16 + i) * 128 + v];
        u32x4 a, b; a.x = vv[0] | (vv[1] << 16); a.y = vv[2] | (vv[3] << 16); a.z = vv[4] | (vv[5] << 16); a.w = vv[6] | (vv[7] << 16);
        b.x = vv[8] | (vv[9] << 16); b.y = vv[10] | (vv[11] << 16); b.z = vv[12] | (vv[13] << 16); b.w = vv[14] | (vv[15] << 16);
        *(LAS u32x4*)(lds + L_VT + (v * 72 + s4 * 16) * 2) = a; *(LAS u32x4*)(lds + L_VT + (v * 72 + s4 * 16) * 2 + 16) = b;
    }
    __syncthreads();
    }
    for (int urep = 0; urep < REP_UCORE; ++urep) {
    if constexpr (PASS == 1) {
        constexpr int NTN = DV / 32, NTILES = (DK / 32) * NTN, NTL = NTILES / 8;
        f32x16 hacc[NTL];
#pragma unroll
        for (int i = 0; i < NTL; ++i) {
            const int ti = wid + 8 * i, tm = ti / NTN, tn = ti % NTN;
#pragma unroll
            for (int r = 0; r < 16; ++r) hacc[i][r] = 0.f;
#pragma unroll
            for (int ks = 0; ks < 4; ++ks) hacc[i] = __builtin_amdgcn_mfma_f32_32x32x16_bf16(frag(lds, L_BIG, 72, tm * 32, ks, lane), frag(lds, L_VT, 72, tn * 32, ks, lane), hacc[i], 0, 0, 0);
            if constexpr (VEC) {
#pragma unroll
                for (int r = 0; r < 16; ++r) { const int d = tm * 32 + rowmap(r, lane); hacc[i][r] *= __expf(SM[SM_CLAST + d] - SM[SM_REF + d]); }
            }
        }
        float decv = 0.f;
        if constexpr (BR == 0) { if (tid < 128) decv = __expf(SM[SM_CLAST + tid]); }
        if constexpr (BR == 3) { if (tid < 64) decv = __expf(SM[SM_CLAST + tid]); }
        if constexpr (BR == 2) { if (tid < 4) decv = __expf(SM[SM_CUM + tid * 64 + 63]); }
        __syncthreads();
#pragma unroll
        for (int i = 0; i < NTL; ++i) {
            const int ti = wid + 8 * i, tm = ti / NTN, tn = ti % NTN;
            const int v = tn * 32 + (lane & 31);
#pragma unroll
            for (int rg = 0; rg < 4; ++rg) { const int d0 = tm * 32 + 8 * rg + 4 * (lane >> 5);
                u32x2 w; w.x = pk2(hacc[i][rg * 4 + 0], hacc[i][rg * 4 + 1]); w.y = pk2(hacc[i][rg * 4 + 2], hacc[i][rg * 4 + 3]);
                *(u32x2*)(stg + (size_t)v * DK + d0) = w; }
        }
        float* dec = p.dec + (size_t)bc * 1024;
        if constexpr (BR == 0) { if (tid < 128) dec[hu * 128 + tid] = decv; }
        if constexpr (BR == 3) { if (tid < 64) dec[512 + hu * 64 + tid] = decv; }
        if constexpr (BR == 2) { if (tid < 4) dec[768 + hu * 4 + tid] = decv; }
    } else {
        constexpr int NCT = DV / 32;
    if constexpr (PASS == 3) {
#pragma unroll
            for (int nt = 0; nt < NT; ++nt) { const int ct = (wid & 3) + 4 * nt;
                gnv[nt] = gain[ct * 32 + (lane & 31)]; dskv[nt] = (BR == 2) ? p.dskip[hu * 4 + (ct >> 1)] : 0.f;
#pragma unroll
                for (int r = 0; r < 16; ++r) gt[nt][r] = P[pidx(bc * 64 + (wid >> 2) * 32 + rowmap(r, lane), gcol + ct * 32 + (lane & 31))]; }
        }
        __builtin_amdgcn_sched_barrier(0);
        {
            constexpr int NVEC = DV * DK / 8, VPR = DK / 8;
#pragma unroll
            for (int k = 0; k < NVEC / NTHR; ++k) { const int vi = tid + NTHR * k; const int v = vi / VPR, d0 = (vi % VPR) * 8;
                u32x4 raw = pf.st[k];
                if constexpr (VEC) { unsigned w[4] = {raw.x, raw.y, raw.z, raw.w};
#pragma unroll
                    for (int q = 0; q < 4; ++q) { const float lo = __uint_as_float(w[q] << 16) * __expf(SM[SM_REF + d0 + 2 * q]), hi = __uint_as_float(w[q] & 0xffff0000u) * __expf(SM[SM_REF + d0 + 2 * q + 1]);
                        w[q] = pk2(lo, hi); }
                    raw.x = w[0]; raw.y = w[1]; raw.z = w[2]; raw.w = w[3]; }
                *(LAS u32x4*)(lds + L_BIG + (v * LDK + d0) * 2) = raw; }
        }
        __builtin_amdgcn_sched_barrier(0);
        __syncthreads();
        const int tm = wid >> 2, tnb = wid & 3;
        f32x16 acc[NT];
#pragma unroll
        for (int nt = 0; nt < NT; ++nt)
#pragma unroll
            for (int r = 0; r < 16; ++r) acc[nt][r] = 0.f;
#pragma unroll
        for (int ks = 0; ks < DK / 16; ++ks) { const bf16x8 af = frag(lds, L_QI, LDK, tm * 32, ks, lane);
#pragma unroll
            for (int nt = 0; nt < NT; ++nt) acc[nt] = __builtin_amdgcn_mfma_f32_32x32x16_bf16(af, frag(lds, L_BIG, LDK, (tnb + 4 * nt) * 32, ks, lane), acc[nt], 0, 0, 0); }
        if constexpr (!VEC) {
#pragma unroll
            for (int nt = 0; nt < NT; ++nt) { const int hh = (NH == 1) ? 0 : ((tnb + 4 * nt) >> 1);
#pragma unroll
                for (int r = 0; r < 16; ++r) acc[nt][r] *= __expf(SM[SM_CUM + hh * 64 + tm * 32 + rowmap(r, lane)]); }
        }
        constexpr int P_OFF = (NH == 1) ? L_BIG + 34816 : L_BIG;
        f32x16 sc;
#pragma unroll
        for (int r = 0; r < 16; ++r) sc[r] = 0.f;
        const int w4 = wid & 3, stm = w4 >> 1, stn = w4 & 1, whalf = wid >> 2;
#pragma unroll
        for (int ks = 0; ks < DK / 16; ++ks) sc = __builtin_amdgcn_mfma_f32_32x32x16_bf16(frag(lds, L_QI, LDK, stm * 32, ks, lane), frag(lds, L_KI, LDK, stn * 32, ks, lane), sc, 0, 0, 0);
        if constexpr (NH != 1) __syncthreads();
        {
            const int s = stn * 32 + (lane & 31);
            if constexpr (NH == 1) {
                float cums = 0.f, dts = 1.f;
                if constexpr (!VEC) { cums = SM[SM_CUM + s]; dts = SM[SM_DT + s]; }
#pragma unroll
                for (int r8 = 0; r8 < 8; ++r8) { const int rlo = r8, rhi = r8 + 8; const int r = whalf ? rhi : rlo; const int t = stm * 32 + (whalf ? rowmap(rhi, lane) : rowmap(rlo, lane));
                    float val = whalf ? sc[rhi] : sc[rlo]; (void)r;
                    if constexpr (!VEC) { const float ex = (s <= t) ? SM[SM_CUM + t] - cums : 0.f; val *= __expf(ex) * dts; }
                    val = (s <= t) ? val : 0.f;
                    *(LAS bf16_t*)(lds + P_OFF + (t * 72 + s) * 2) = f2bf(val); }
            } else {
#pragma unroll
                for (int h2 = 0; h2 < NH / 2; ++h2) { const int hh = whalf * (NH / 2) + h2;
                    const float cums = SM[SM_CUM + hh * 64 + s], dts = SM[SM_DT + hh * 64 + s];
#pragma unroll
                    for (int r = 0; r < 16; ++r) { const int t = stm * 32 + rowmap(r, lane);
                        float val = sc[r];
                        const float ex = (s <= t) ? SM[SM_CUM + hh * 64 + t] - cums : 0.f; val *= __expf(ex) * dts;
                        val = (s <= t) ? val : 0.f;
                        *(LAS bf16_t*)(lds + P_OFF + ((hh * 64 + t) * 72 + s) * 2) = f2bf(val); } }
            }
        }
        __syncthreads();
#pragma unroll
        for (int nt = 0; nt < NT; ++nt) { const int hh = (NH == 1) ? 0 : ((tnb + 4 * nt) >> 1);
#pragma unroll
            for (int ks = 0; ks < 4; ++ks) acc[nt] = __builtin_amdgcn_mfma_f32_32x32x16_bf16(frag(lds, P_OFF + hh * 9216, 72, tm * 32, ks, lane), frag(lds, L_VT, 72, (tnb + 4 * nt) * 32, ks, lane), acc[nt], 0, 0, 0); }
        const int ycol = (BR == 0) ? hu * 128 : (BR == 1) ? 512 + hu * 128 : (BR == 2) ? 1024 + hu * 256 : 1536 + hu * 128;
#pragma unroll
        for (int nt = 0; nt < NT; ++nt) { const int ct = tnb + 4 * nt, v = ct * 32 + (lane & 31);
            const float dsk = dskv[nt];
            float sq[16];
#pragma unroll
            for (int r = 0; r < 16; ++r) { const int t = tm * 32 + rowmap(r, lane);
                float val = acc[nt][r];
                if constexpr (BR == 2) { val = (val + dsk * bf2f(VT[v * 72 + t])) * silu_f(bf2f(gt[nt][r])); acc[nt][r] = val; }
                sq[r] = val * val; }
            const bool b4 = lane & 16, b3 = lane & 8, b2 = lane & 4, b1 = lane & 2;
#pragma unroll
            for (int i = 0; i < 8; ++i) { const float lo = sq[i], hi = sq[i + 8]; sq[i] = (b4 ? hi : lo) + __shfl_xor(b4 ? lo : hi, 16); }
#pragma unroll
            for (int i = 0; i < 4; ++i) { const float lo = sq[i], hi = sq[i + 4]; sq[i] = (b3 ? hi : lo) + __shfl_xor(b3 ? lo : hi, 8); }
#pragma unroll
            for (int i = 0; i < 2; ++i) { const float lo = sq[i], hi = sq[i + 2]; sq[i] = (b2 ? hi : lo) + __shfl_xor(b2 ? lo : hi, 4); }
            { const float lo = sq[0], hi = sq[1]; sq[0] = (b1 ? hi : lo) + __shfl_xor(b1 ? lo : hi, 2); }
            sq[0] += __shfl_xor(sq[0], 1);
            const int rr = (b4 ? 8 : 0) + (b3 ? 4 : 0) + (b2 ? 2 : 0) + (b1 ? 1 : 0);
            if ((lane & 1) == 0) SM[SM_RSS + ct * 64 + tm * 32 + rowmap(rr, lane)] = sq[0];
        }
        __syncthreads();
        if (tid < 64) { float tot = 0.f;
#pragma unroll
            for (int q = 0; q < NCT; ++q) tot += SM[SM_RSS + q * 64 + tid];
            SM[SM_SEG + tid] = rsqrtf(tot * (1.f / DV) + EPS); }
        __syncthreads();
        float rinv[16];
#pragma unroll
        for (int r = 0; r < 16; ++r) rinv[r] = SM[SM_SEG + tm * 32 + rowmap(r, lane)];
        __syncthreads();
#pragma unroll
        for (int nt = 0; nt < NT; ++nt) { const int ct = tnb + 4 * nt, v = ct * 32 + (lane & 31);
            const float gn = gnv[nt];
#pragma unroll
            for (int r = 0; r < 16; ++r) { const int t = tm * 32 + rowmap(r, lane);
                float o = acc[nt][r] * rinv[r] * gn;
                if constexpr (BR != 2) o *= silu_f(bf2f(gt[nt][r]));
                p.y[(size_t)(bc * 64 + t) * DI + ycol + v] = f2bf(o); }
        }
    }
    }
}

template <int PASS>
__device__ __forceinline__ void phase_mixer(const MixP& p, LAS unsigned char* lds) {
#pragma unroll 1
    for (int i = blockIdx.x; i < NUNITS; i += gridDim.x) {
        const int bc = i / 14, u = i % 14;
        if (u < 4) mixer_unit<0, PASS>(p, lds, bc, u);
        else if (u < 8) mixer_unit<1, PASS>(p, lds, bc, u - 4);
        else if (u < 10) mixer_unit<2, PASS>(p, lds, bc, u - 8);
        else mixer_unit<3, PASS>(p, lds, bc, u - 10);
    }
}

__device__ __forceinline__ void phase_scan(bf16_t* st, const float* dec, LAS unsigned char* lds) {
    constexpr int BPB = ST_PER_BC / 2048;
    LAS float* D = (LAS float*)lds;
    const int tid = opaque_tid();
#pragma unroll 1
    for (int blk = blockIdx.x; blk < 2 * BPB; blk += gridDim.x) {
        const int bl = blk / BPB, eb = (blk % BPB) * 2048, e0 = eb + tid * 4;
        const float* dpb = dec + (size_t)bl * 64 * 1024;
        int mode, dsel = 0;
        if (eb < 65536) { mode = 0; const int dbase = (eb >> 14) * 128;
            for (int k = tid; k < 64 * 32; k += NTHR) { const int c = k >> 5, q = k & 31; *(LAS f32x4*)(D + c * 128 + q * 4) = *(const f32x4*)(dpb + (size_t)c * 1024 + dbase + q * 4); }
            dsel = e0 & 127; }
        else if (eb < 131072) { mode = 1; }
        else if (eb < 196608) { mode = 2; const int r = eb - 131072; const int g = r >> 15;
            const int head = g * 4 + (((r & 32767) >> 7) >> 6);
            if (tid < 64) D[tid] = dpb[(size_t)tid * 1024 + 768 + head]; }
        else { mode = 3; const int r = eb - 196608; const int dbase = 512 + (r >> 13) * 64;
            for (int k = tid; k < 64 * 16; k += NTHR) { const int c = k >> 4, q = k & 15; *(LAS f32x4*)(D + c * 64 + q * 4) = *(const f32x4*)(dpb + (size_t)c * 1024 + dbase + q * 4); }
            dsel = e0 & 63; }
        float cfac = 0.f;
        if (mode == 1) { const int h = (eb - 65536) >> 14; cfac = __expf(64.f * log1pf(-exp2f(-(5.f + (float)h)))); }
        __syncthreads();
        float s0 = 0.f, s1 = 0.f, s2 = 0.f, s3 = 0.f;
        bf16_t* ptr = st + (size_t)bl * 64 * ST_PER_BC + e0;
#pragma unroll 1
        for (int c0 = 0; c0 < 64; c0 += 8) {
            u32x2 hv[8];
#pragma unroll
            for (int j = 0; j < 8; ++j) hv[j] = *(const u32x2*)(ptr + (size_t)(c0 + j) * ST_PER_BC);
            __builtin_amdgcn_sched_barrier(0);
#pragma unroll
            for (int j = 0; j < 8; ++j) {
                f32x4 dv;
                if (mode == 0) dv = *(const LAS f32x4*)(D + (c0 + j) * 128 + dsel);
                else if (mode == 3) dv = *(const LAS f32x4*)(D + (c0 + j) * 64 + dsel);
                else if (mode == 1) dv = (f32x4){cfac, cfac, cfac, cfac};
                else { const float d = D[c0 + j]; dv = (f32x4){d, d, d, d}; }
                u32x2 w; w.x = pk2(s0, s1); w.y = pk2(s2, s3);
                *(u32x2*)(ptr + (size_t)(c0 + j) * ST_PER_BC) = w;
                s0 = s0 * dv[0] + __uint_as_float(hv[j].x << 16); s1 = s1 * dv[1] + __uint_as_float(hv[j].x & 0xffff0000u);
                s2 = s2 * dv[2] + __uint_as_float(hv[j].y << 16); s3 = s3 * dv[3] + __uint_as_float(hv[j].y & 0xffff0000u);
            }
        }
        __syncthreads();
    }
}

#define XB_TMO      128
#define XB_XCNT(j)  (256  + 64 * (j))
#define XB_XSUB(j)  (1280 + 64 * (j))
#define XB_XGEN(j)  (2304 + 64 * (j))
#define XB_TOP      3328
#define XB_TOPGEN   3392
#define XCD_BAR_WORDS 3456
#define XB_SPIN_CAP (1u << 18)
__device__ __forceinline__ unsigned xb_ld(unsigned* p)              { return __hip_atomic_load(p, __ATOMIC_RELAXED, __HIP_MEMORY_SCOPE_AGENT); }
__device__ __forceinline__ unsigned xb_add(unsigned* p, unsigned v) { return __hip_atomic_fetch_add(p, v, __ATOMIC_RELAXED, __HIP_MEMORY_SCOPE_AGENT); }
__device__ __forceinline__ unsigned xb_xcc_id() { return (unsigned)__builtin_amdgcn_s_getreg((3 << 11) | 20) & 0xFu; }
#define XB_SPIN(cond, bar) do { unsigned _sp = 0; while (cond) { __builtin_amdgcn_s_sleep(1); \
    if ((++_sp & 255u) == 0u) { if (xb_ld(&(bar)[XB_TMO])) break; if (_sp > XB_SPIN_CAP) { atomicAdd(&(bar)[XB_TMO], 1u); break; } } } } while (0)
struct XcdBarrier { unsigned* bar; unsigned x; volatile LAS unsigned* st; };
__device__ __forceinline__ XcdBarrier xcd_barrier_post(unsigned* bar, volatile LAS unsigned* st) {
    XcdBarrier b; b.bar = bar; b.x = xb_xcc_id(); b.st = st;
    if (threadIdx.x == 0) (void)xb_add(&bar[XB_XCNT(b.x)], 1u);
    return b;
}
__device__ __forceinline__ void xcd_barrier_complete(unsigned* bar, unsigned x, unsigned& nloc, unsigned& nx) {
    const unsigned G = gridDim.x * gridDim.y * gridDim.z;
    unsigned sum, cnt, mine, sp = 0u;
    for (;;) {
        sum = 0u; cnt = 0u; mine = 0u;
#pragma unroll
        for (unsigned j = 0; j < 16; ++j) { const unsigned c = xb_ld(&bar[XB_XCNT(j)]); sum += c; cnt += (c > 0u) ? 1u : 0u; mine = (j == x) ? c : mine; }
        if (sum == G) break;
        __builtin_amdgcn_s_sleep(1);
        if ((++sp & 255u) == 0u) { if (xb_ld(&bar[XB_TMO])) break; if (sp > XB_SPIN_CAP) { atomicAdd(&bar[XB_TMO], 1u); break; } }
    }
    nloc = mine > 0u ? mine : 1u; nx = cnt > 0u ? cnt : 1u;
}
__device__ __forceinline__ void xcd_barrier(const XcdBarrier& b) {
    asm volatile("s_waitcnt vmcnt(0)" ::: "memory");
    __syncthreads();
    if (threadIdx.x == 0) {
        unsigned* bar = b.bar;
        __builtin_amdgcn_s_waitcnt(0);
        unsigned nloc = b.st[0], nx = b.st[1];
        if (nloc == 0u) { xcd_barrier_complete(bar, b.x, nloc, nx); b.st[0] = nloc; b.st[1] = nx; }
        const unsigned old = xb_add(&bar[XB_XSUB(b.x)], 1u);
        const unsigned gen = old / nloc;
        if (old + 1u == (gen + 1u) * nloc) {
            __builtin_amdgcn_fence(__ATOMIC_RELEASE, "agent");
            asm volatile("s_waitcnt vmcnt(0)" ::: "memory");
            const unsigned og = xb_add(&bar[XB_TOP], 1u);
            const unsigned tg = og / nx;
            if (og + 1u == (tg + 1u) * nx) xb_add(&bar[XB_TOPGEN], 1u);
            else XB_SPIN(xb_ld(&bar[XB_TOPGEN]) == tg, bar);
            __builtin_amdgcn_fence(__ATOMIC_ACQUIRE, "agent");
            xb_add(&bar[XB_XGEN(b.x)], 1u);
            asm volatile("s_waitcnt vmcnt(0)" ::: "memory");
        } else {
            XB_SPIN(xb_ld(&bar[XB_XGEN(b.x)]) == gen, bar);
            __builtin_amdgcn_fence(__ATOMIC_ACQUIRE, "agent");
            asm volatile("s_waitcnt vmcnt(0)" ::: "memory");
        }
    }
    __syncthreads();
}

__global__ void __launch_bounds__(NTHR, 2) fwd_megakernel(Args a) {
    extern __shared__ __attribute__((aligned(16))) unsigned char shm[];
    LAS unsigned char* lds = (LAS unsigned char*)shm;
    cg::grid_group grid = cg::this_grid();
    unsigned char* ws = a.ws;
    const int G = gridDim.x;

    {
        volatile LAS unsigned* stw = (volatile LAS unsigned*)(lds + L_BARST);
        if (threadIdx.x < 2) stw[threadIdx.x] = 0u;
        __syncthreads();
    }
    const XcdBarrier gbar = xcd_barrier_post((unsigned*)(ws + WS_BAR), (volatile LAS unsigned*)(lds + L_BARST));
    for (int rep = 0; rep < REP_PREP; ++rep) { phase_prep(a, lds); if (rep == 0) grid.sync(); else xcd_barrier(gbar); }

    bf16_t* hbuf = (bf16_t*)(ws + WS_HY); bf16_t* ybuf = (bf16_t*)(ws + WS_HY);
    bf16_t* proj = (bf16_t*)(ws + WS_PROJ); bf16_t* st = (bf16_t*)(ws + WS_ST); float* dec = (float*)(ws + WS_DEC);
    const float* mod = (const float*)(ws + WS_MOD);

#pragma unroll 1
    for (int half = 0; half < 2; ++half) {
        const size_t xoff = (size_t)half * HROWS * DM;
#pragma unroll 1
        for (int l = 0; l < DEPTH; ++l) {
            const float* modl = mod + (size_t)l * 4 * 3072;
            bf16_t* slab = (bf16_t*)(ws + WS_PROJ);
            if (l == 0) { phase_norm<false>(a.x + xoff, nullptr, nullptr, nullptr, a.norm_g, modl, half, hbuf); if (half == 0) phase_wcvt(a, lds); }
            else phase_norm<false>(a.x + xoff, slab, mod + (size_t)(half * 2) * 3072 + 2048, a.out + xoff, a.norm_g + l * DM, modl, half, hbuf);
            xcd_barrier(gbar);
            for (int rep = 0; rep < REP_G1; ++rep) {
                pg8::Gemm g{hbuf, (const bf16_t*)(ws + WS_WIN) + (size_t)l * LDP * DM, HROWS, LDP, DM, DM};
                pg8::StaticOrder S; S.init(HROWS, LDP, G, (int)blockIdx.x);
                pg8::EpiProj E{proj, LDP};
                pg8::gemm_phase<pg8::EpiProj, pg8::StaticOrder>(lds, g, S, E);
                xcd_barrier(gbar);
            }
            MixP p;
            p.proj = proj; p.st = st; p.dec = dec; p.y = ybuf; p.rope = (const float2*)(ws + WS_ROPE);
            p.lbl = a.lb_logits; p.hgrn_g = a.hgrn_g + l * 512; p.ret_g = a.ret_g + l * 512; p.conv_w = a.conv_w + l * 4096; p.conv_b = a.conv_b + l * 1024;
            p.dt_bias = a.dt_bias + l * 8; p.a_log = a.a_log + l * 8; p.dskip = a.dskip + l * 8; p.ssm_g = a.ssm_g + l * 512;
            p.w2 = a.w_gk2 + l * 16 * 256; p.b2 = a.b_gk2 + l * 256; p.gla_g = a.gla_g + l * 512; p.layer = l;
            for (int rep = 0; rep < REP_M12; ++rep) { phase_mixer<1>(p, lds); xcd_barrier(gbar); phase_scan(st, dec, lds); xcd_barrier(gbar); }
            for (int rep = 0; rep < REP_M3; ++rep) { phase_mixer<3>(p, lds); xcd_barrier(gbar); }
            for (int rep = 0; rep < REP_G2; ++rep) {
                pg8::Gemm g{ybuf, (const bf16_t*)(ws + WS_WOUT) + (size_t)l * DM * DI, HROWS, DM, DI / 2, DI};
                pg8::SplitOrder S; S.init(HROWS, DM, G, (int)blockIdx.x);
                pg8::EpiSlab E{slab};
                pg8::gemm_phase<pg8::EpiSlab, pg8::SplitOrder>(lds, g, S, E);
                xcd_barrier(gbar);
            }
        }
        phase_norm<true>(a.out + xoff, (const bf16_t*)(ws + WS_PROJ), mod + (size_t)(4 + half * 2) * 3072 + 2048, a.out + xoff, a.final_g, nullptr, half, nullptr);
    }
}

extern "C" void kernel_launch(void* const* d_in, const int* in_sizes, int n_in, void* d_out, int out_size, void* d_ws, size_t ws_size, hipStream_t stream) {
    static int grid = 0;
    if (grid == 0) {
        if (n_in != 20 || ws_size < WS_END) { fprintf(stderr, "kernel_launch: unexpected n_in %d / ws_size %zu (need %zu)\n", n_in, ws_size, (size_t)WS_END); grid = -1; return; }
        int dev = 0, cus = 0, per_cu = 0;
        hipGetDevice(&dev);
        hipDeviceGetAttribute(&cus, hipDeviceAttributeMultiprocessorCount, dev);
        if (hipFuncSetAttribute((const void*)fwd_megakernel, hipFuncAttributeMaxDynamicSharedMemorySize, LDS_BYTES) != hipSuccess) { fprintf(stderr, "kernel_launch: hipFuncSetAttribute failed\n"); grid = -1; return; }
        hipOccupancyMaxActiveBlocksPerMultiprocessor(&per_cu, (const void*)fwd_megakernel, NTHR, LDS_BYTES);
        if (per_cu < 1) { fprintf(stderr, "kernel_launch: occupancy query says %d blocks per CU\n", per_cu); per_cu = 1; }
        (void)hipGetLastError();
        grid = cus * per_cu;
    }
    if (grid < 0) return;
    Args a{};
    const float** f = (const float**)&a;
    for (int i = 0; i < 20; ++i) f[i] = (const float*)d_in[i];
    a.out = (float*)d_out; a.ws = (unsigned char*)d_ws;
    void* args[] = {&a};
    if (hipMemsetAsync((char*)d_ws + WS_BAR, 0, XCD_BAR_WORDS * 4, stream) != hipSuccess) { fprintf(stderr, "kernel_launch: memset of barrier words failed\n"); return; }
    hipError_t e = hipLaunchCooperativeKernel((const void*)fwd_megakernel, dim3(grid), dim3(NTHR), args, LDS_BYTES, stream);
    if (e != hipSuccess) fprintf(stderr, "cooperative launch failed: %s (grid %d)\n", hipGetErrorString(e), grid);
}
```

```cpp
#include <hip/hip_runtime.h>
#include <hip/hip_cooperative_groups.h>
#include <cstdio>
namespace cg = cooperative_groups;

#define LAS __attribute__((address_space(3)))
typedef unsigned short bf16_t;
typedef short bf16x8 __attribute__((ext_vector_type(8)));
typedef float f32x4 __attribute__((ext_vector_type(4)));
typedef float f32x16 __attribute__((ext_vector_type(16)));
typedef unsigned u32x4 __attribute__((ext_vector_type(4)));
typedef unsigned u32x2 __attribute__((ext_vector_type(2)));

#ifndef REP_PREP
#define REP_PREP 1
#endif
#ifndef REP_NORM
#define REP_NORM 1
#endif
#ifndef REP_G1
#define REP_G1 1
#endif
#ifndef REP_M12
#define REP_M12 1
#endif
#ifndef REP_M3
#define REP_M3 1
#endif
#ifndef REP_G2
#define REP_G2 1
#endif
#ifndef REP_UPREP
#define REP_UPREP 1
#endif
#ifndef REP_UCORE
#define REP_UCORE 1
#endif
constexpr int NB = 4, SEQ = 4096, DM = 1024, DEPTH = 2, DI = 2048;
constexpr int NIN = 7192, LDP = 7424;
constexpr int HROWS = 8192;
constexpr int NTHR = 512;
constexpr float EPS = 1e-6f;
constexpr int C_AQ = 0, C_AF = 512, C_AI = 1024, C_AG = 1536, C_RQ = 2048, C_RK = 2560, C_RV = 3072, C_RG = 3584,
              C_MZ = 4096, C_XBC = 4608, C_GQ = 5632, C_GK = 5888, C_GV = 6144, C_GG = 6656, C_DT = 7168, C_LR = 7176;
constexpr int ST_PER_BC = 229376;
constexpr size_t WS_WIN = 0;
constexpr size_t WS_WOUT = WS_WIN + 2ull * LDP * DM * 2;
constexpr size_t WS_MOD = WS_WOUT + 2ull * DM * DI * 2;
constexpr size_t WS_ROPE = WS_MOD + 2ull * 4 * 3072 * 4;
constexpr size_t WS_DEC = WS_ROPE + 4096ull * 64 * 8;
constexpr size_t WS_HY = WS_DEC + 128ull * 1024 * 4;
constexpr size_t WS_PROJ = WS_HY + (size_t)HROWS * DI * 2;
constexpr size_t WS_ST = WS_PROJ + (size_t)HROWS * LDP * 2;
constexpr size_t WS_BAR = WS_ST + 128ull * ST_PER_BC * 2;
constexpr size_t WS_END = WS_BAR + 3456 * 4;
constexpr int L_QI = 0, L_KI = 17408, L_VT = 34816, L_BIG = 71680, L_SM = 141312;
constexpr int SM_CUM = 0, SM_DT = 256, SM_SEG = 512, SM_REF = 1536, SM_CLAST = 1664, SM_RSS = 1792;
constexpr int L_BARST = L_SM + (1792 + 512) * 4;
constexpr int LDS_BYTES = L_BARST + 16;

constexpr int NCG = LDP / 128;
__device__ __forceinline__ size_t pidx(int row, int col) { return ((size_t)((row >> 6) * NCG + (col >> 7)) * 64 + (row & 63)) * 128 + (col & 127); }
__device__ __forceinline__ float bf2f(bf16_t v) { return __uint_as_float(((unsigned)v) << 16); }
__device__ __forceinline__ bf16_t f2bf(float f) { unsigned u = __float_as_uint(f); u += 0x7FFFu + ((u >> 16) & 1u); return (bf16_t)(u >> 16); }
typedef float f32x2_t __attribute__((ext_vector_type(2)));
typedef __bf16 bf16x2_t __attribute__((ext_vector_type(2)));
__device__ __forceinline__ unsigned pk2(float lo, float hi) { f32x2_t v = {lo, hi}; bf16x2_t b = __builtin_convertvector(v, bf16x2_t); return __builtin_bit_cast(unsigned, b); }
__device__ __forceinline__ int opaque_tid() { int t = threadIdx.x; asm volatile("" : "+v"(t)); return t; }
__device__ __forceinline__ float silu_f(float x) { return x * __builtin_amdgcn_rcpf(1.f + __expf(-x)); }
__device__ __forceinline__ float softplus_f(float x) { return fmaxf(x, 0.f) + __logf(1.f + __expf(-fabsf(x))); }
__device__ __forceinline__ float logsig_f(float x) { return fminf(x, 0.f) - __logf(1.f + __expf(-fabsf(x))); }

namespace pg8 {
constexpr int BM = 256, BK = 64, HALF = 128, HTB = HALF * BK * 2, STAGE_BYTES = 8 * HTB, NXCD = 8, WGM = 8;
__device__ __forceinline__ int lds_byte(int r, int c) { const int st = (r >> 4) * 2 + (c >> 5), rr = r & 15, cc = c & 31, ob = rr * 64 + cc * 2; return st * 1024 + (ob ^ (((ob >> 9) & 1) << 5)); }
__device__ __forceinline__ void stage_rc(int b, int& R, int& C) { const int st = b / 1024, sb = b % 1024, swz = sb ^ (((sb >> 9) & 1) << 5); R = (st >> 1) * 16 + swz / 64; C = (st & 1) * 32 + (swz % 64) / 2; }
__device__ __forceinline__ int perm32(int rho) { const int n = rho >> 4, i = rho & 15; return 8 * (i >> 2) + 4 * n + (i & 3); }
struct Unit { int pm, pn, kh; };
struct Gemm { const bf16_t* A; const bf16_t* Bt; int M, N, K, ld; };
struct StaticOrder {
    int nM, nN, nwg, G, c;
    __device__ void init(int M, int N, int G_, int c_) { nM = M / BM; nN = N / BM; nwg = nM * nN; G = G_; c = c_; }
    __device__ bool next(int i, Unit& u) const {
        const long L = (long)i * G + c; if (L >= nwg) return false;
        int wgid = (int)L; { const int q = nwg / NXCD, r = nwg % NXCD, xcd = wgid % NXCD, off = wgid / NXCD; wgid = (xcd < r ? xcd * (q + 1) : r * (q + 1) + (xcd - r) * q) + off; }
        const int nig = WGM * nN, gid = wgid / nig, fm = gid * WGM, gsz = (nM - fm) < WGM ? (nM - fm) : WGM;
        u.pm = fm + ((wgid % nig) % gsz); u.pn = (wgid % nig) / gsz; u.kh = 0; return true;
    }
};
struct SplitOrder {
    StaticOrder so;
    __device__ void init(int M, int N, int G_, int c_) { so.init(M, 2 * N, G_, c_); }
    __device__ bool next(int i, Unit& u) const { if (!so.next(i, u)) return false; u.kh = u.pn & 1; u.pn >>= 1; return true; }
};
struct EpiProj {
    static constexpr bool PERM = true;
    bf16_t* O; int ldc;
    __device__ __forceinline__ void operator()(const f32x4 (&acc)[2][2][4][2], const Unit& u, int wr, int wc, int fr, int fq) const {
        bf16_t* base = O + ((size_t)((u.pm * 4 + wr) * NCG + u.pn * 2) * 64 + fr) * 128 + wc * 32 + 8 * fq;
#pragma unroll
        for (int ai = 0; ai < 2; ++ai)
#pragma unroll
            for (int m = 0; m < 4; ++m)
#pragma unroll
                for (int bj = 0; bj < 2; ++bj) { const f32x4 v0 = acc[ai][bj][m][0], v1 = acc[ai][bj][m][1];
                    u32x4 w; w.x = pk2(v0[0], v0[1]); w.y = pk2(v0[2], v0[3]); w.z = pk2(v1[0], v1[1]); w.w = pk2(v1[2], v1[3]);
                    *(u32x4*)(base + (size_t)ai * (2 * NCG * 8192) + bj * 8192 + m * (16 * 128)) = w; }
    }
};
struct EpiRes {
    static constexpr bool PERM = false;
    const float* xin; float* xout; const float* gate;
    __device__ __forceinline__ void operator()(const f32x4 (&acc)[2][2][4][2], const Unit& u, int wr, int wc, int fr, int fq) const {
        const int row0 = u.pm * BM + wr * 64 + fr, col0 = u.pn * BM + wc * 32 + 4 * fq;
        const float* gp = gate + (size_t)(u.pm >> 4) * 3072 + col0;
        f32x4 gv[2][2];
#pragma unroll
        for (int bj = 0; bj < 2; ++bj)
#pragma unroll
            for (int n = 0; n < 2; ++n) gv[bj][n] = *(const f32x4*)(gp + bj * HALF + n * 16);
#pragma unroll
        for (int am = 0; am < 4; ++am) {
            const int ai = am >> 1, m0 = (am & 1) * 2;
            f32x4 xi[2][2][2];
#pragma unroll
            for (int m = 0; m < 2; ++m)
#pragma unroll
                for (int bj = 0; bj < 2; ++bj)
#pragma unroll
                    for (int n = 0; n < 2; ++n) xi[m][bj][n] = *(const f32x4*)(xin + (size_t)(row0 + ai * HALF + (m0 + m) * 16) * DM + col0 + bj * HALF + n * 16);
            __builtin_amdgcn_sched_barrier(0);
#pragma unroll
            for (int m = 0; m < 2; ++m)
#pragma unroll
                for (int bj = 0; bj < 2; ++bj)
#pragma unroll
                    for (int n = 0; n < 2; ++n) *(f32x4*)(xout + (size_t)(row0 + ai * HALF + (m0 + m) * 16) * DM + col0 + bj * HALF + n * 16) = xi[m][bj][n] + gv[bj][n] * acc[ai][bj][m0 + m][n];
        }
    }
};

struct EpiSlab {
    static constexpr bool PERM = true;
    bf16_t* slab;
    __device__ __forceinline__ void operator()(const f32x4 (&acc)[2][2][4][2], const Unit& u, int wr, int wc, int fr, int fq) const {
        const int row0 = u.pm * BM + wr * 64 + fr, col0 = u.pn * BM + wc * 32 + 8 * fq;
        bf16_t* base = slab + (size_t)u.kh * HROWS * DM;
#pragma unroll
        for (int ai = 0; ai < 2; ++ai)
#pragma unroll
            for (int m = 0; m < 4; ++m) { bf16_t* rowp = base + (size_t)(row0 + ai * HALF + m * 16) * DM + col0;
#pragma unroll
                for (int bj = 0; bj < 2; ++bj) { const f32x4 v0 = acc[ai][bj][m][0], v1 = acc[ai][bj][m][1];
                    u32x4 w; w.x = pk2(v0[0], v0[1]); w.y = pk2(v0[2], v0[3]); w.z = pk2(v1[0], v1[1]); w.w = pk2(v1[2], v1[3]);
                    *(u32x4*)(rowp + bj * HALF) = w; } }
    }
};

template <class Epi, class Sched, bool ALIGN_EPI = true, bool SP2 = true>
__device__ __forceinline__ void gemm_phase(LAS unsigned char* lds, const Gemm g, const Sched& S, const Epi& E) {
    const int tid = opaque_tid(), wid = __builtin_amdgcn_readfirstlane(tid >> 6), lane = tid & 63, wr = wid >> 2, wc = wid & 3, fr = lane & 15, fq = lane >> 4;
    const int K = g.K, nt = K / BK, ld = g.ld;
    unsigned voffA[2], voffB[2];
#pragma unroll
    for (int i = 0; i < 2; ++i) { int R, C; stage_rc(tid * 16 + i * 8192, R, C); const int Rb = Epi::PERM ? ((R & ~31) + perm32(R & 31)) : R;
        voffA[i] = (unsigned)(R * ld + C) * 2u; voffB[i] = (unsigned)(Rb * ld + C) * 2u; }
    const size_t kstep = (size_t)(BK * 2);
    const size_t hstep = (size_t)HALF * ld * 2;
    const size_t tstep = 2 * hstep;
    const unsigned ldsw = (unsigned)wid * 1024u;
    const int aoff = lds_byte(wr * 64 + fr, fq * 8), boff = lds_byte(wc * 32 + fr, fq * 8);
#define PG8_SA(b, h) (((b) * 2 + (h)) * HTB)
#define PG8_SB(b, h) ((4 + (b) * 2 + (h)) * HTB)
#define PG8_STAGE(bufoff, gbase, voff) do { _Pragma("unroll") for (int _i = 0; _i < 2; ++_i) \
        __builtin_amdgcn_global_load_lds((const unsigned*)((const char*)(gbase) + (voff)[_i]), (LAS unsigned*)(lds + (bufoff) + ldsw + _i * 8192), 16, 0, 0); } while (0)
#define PG8_LDA(dst, b, h) do { _Pragma("unroll") for (int m = 0; m < 4; ++m) _Pragma("unroll") for (int k = 0; k < 2; ++k) dst[m][k] = *(const LAS bf16x8*)(lds + PG8_SA(b, h) + aoff + m * 2048 + k * 1024); } while (0)
#define PG8_LDB(dst, b, h) do { _Pragma("unroll") for (int n = 0; n < 2; ++n) _Pragma("unroll") for (int k = 0; k < 2; ++k) dst[n][k] = *(const LAS bf16x8*)(lds + PG8_SB(b, h) + boff + n * 2048 + k * 1024); } while (0)
#define PG8_MMA(ai, bj, At, Bt) do { __builtin_amdgcn_s_setprio(1); _Pragma("unroll") for (int m = 0; m < 4; ++m) _Pragma("unroll") for (int n = 0; n < 2; ++n) _Pragma("unroll") for (int k = 0; k < 2; ++k) \
        acc[ai][bj][m][n] = __builtin_amdgcn_mfma_f32_16x16x32_bf16(Bt[n][k], At[m][k], acc[ai][bj][m][n], 0, 0, 0); __builtin_amdgcn_s_setprio(0); } while (0)
#define PG8_WAIT_V(n) asm volatile("s_waitcnt vmcnt(" #n ")" ::: "memory")
#define PG8_WAIT_L(n) asm volatile("s_waitcnt lgkmcnt(" #n ")" ::: "memory")
#define PG8_BAR __builtin_amdgcn_s_barrier()
#define PG8_SCHED __builtin_amdgcn_sched_barrier(0)
    Unit cur, nxt; int ui = 0;
    if (!S.next(0, cur)) return;
    f32x4 acc[2][2][4][2];
#pragma unroll
    for (int a = 0; a < 2; ++a)
#pragma unroll
        for (int b = 0; b < 2; ++b)
#pragma unroll
            for (int m = 0; m < 4; ++m)
#pragma unroll
                for (int n = 0; n < 2; ++n) acc[a][b][m][n] = (f32x4){0.f, 0.f, 0.f, 0.f};
    bf16x8 At[4][2], B0[2][2], B1[2][2];
    const char* cA = (const char*)g.A + (size_t)cur.pm * tstep + (size_t)cur.kh * K * 2; const char* cB = (const char*)g.Bt + (size_t)cur.pn * tstep + (size_t)cur.kh * K * 2;
    if constexpr (SP2) {
        PG8_STAGE(PG8_SB(0, 0), cB, voffB); PG8_STAGE(PG8_SB(0, 1), cB + hstep, voffB); PG8_STAGE(PG8_SA(0, 0), cA, voffA); PG8_STAGE(PG8_SA(0, 1), cA + hstep, voffA);
        if (wr == 1) PG8_BAR;
        PG8_WAIT_V(2); PG8_BAR;
        PG8_STAGE(PG8_SB(1, 0), cB + kstep, voffB); PG8_STAGE(PG8_SA(1, 0), cA + kstep, voffA); PG8_STAGE(PG8_SB(1, 1), cB + hstep + kstep, voffB);
        PG8_WAIT_V(6); PG8_BAR;
    } else {
        PG8_STAGE(PG8_SB(0, 0), cB, voffB); PG8_STAGE(PG8_SA(0, 0), cA, voffA); PG8_STAGE(PG8_SB(0, 1), cB + hstep, voffB); PG8_STAGE(PG8_SA(0, 1), cA + hstep, voffA);
        if (wr == 1) PG8_BAR;
        PG8_WAIT_V(4); PG8_BAR;
        PG8_STAGE(PG8_SB(1, 0), cB + kstep, voffB); PG8_STAGE(PG8_SA(1, 0), cA + kstep, voffA); PG8_STAGE(PG8_SB(1, 1), cB + hstep + kstep, voffB);
        PG8_WAIT_V(6); PG8_BAR;
    }
    for (;;) {
        const bool has_next = S.next(ui + 1, nxt);
        const char* nA = has_next ? (const char*)g.A + (size_t)nxt.pm * tstep + (size_t)nxt.kh * K * 2 : cA; const char* nB = has_next ? (const char*)g.Bt + (size_t)nxt.pn * tstep + (size_t)nxt.kh * K * 2 : cB;
        for (int t = 0; t < nt; t += 2) {
            const bool last = (t == nt - 2);
            const char* a1 = cA + (size_t)(t + 1) * kstep;
            const char* a2 = last ? nA : cA + (size_t)(t + 2) * kstep; const char* b2 = last ? nB : cB + (size_t)(t + 2) * kstep;
            const char* a3 = a2 + kstep; const char* b3 = b2 + kstep;
            if constexpr (SP2) {
            PG8_LDB(B0, 0, 0); PG8_LDB(B1, 0, 1); PG8_SCHED; PG8_LDA(At, 0, 0); PG8_STAGE(PG8_SA(1, 1), a1 + hstep, voffA);
            PG8_WAIT_V(8); PG8_WAIT_L(0); PG8_BAR; PG8_MMA(0, 0, At, B0); PG8_MMA(0, 1, At, B1); PG8_BAR; PG8_SCHED;
            PG8_LDA(At, 0, 1); PG8_STAGE(PG8_SB(0, 0), b2, voffB); PG8_STAGE(PG8_SB(0, 1), b2 + hstep, voffB); PG8_STAGE(PG8_SA(0, 0), a2, voffA);
            PG8_WAIT_V(8); PG8_WAIT_L(0); PG8_BAR; PG8_MMA(1, 0, At, B0); PG8_MMA(1, 1, At, B1); PG8_BAR; PG8_SCHED;
            PG8_LDB(B0, 1, 0); PG8_LDB(B1, 1, 1); PG8_SCHED; PG8_LDA(At, 1, 0); PG8_STAGE(PG8_SA(0, 1), a2 + hstep, voffA);
            PG8_WAIT_V(8); PG8_WAIT_L(0); PG8_BAR; PG8_MMA(0, 0, At, B0); PG8_MMA(0, 1, At, B1); PG8_BAR; PG8_SCHED;
            PG8_LDA(At, 1, 1); PG8_STAGE(PG8_SB(1, 0), b3, voffB); PG8_STAGE(PG8_SB(1, 1), b3 + hstep, voffB); PG8_STAGE(PG8_SA(1, 0), a3, voffA);
            PG8_WAIT_V(8); PG8_WAIT_L(0); PG8_BAR; PG8_MMA(1, 0, At, B0); PG8_MMA(1, 1, At, B1); PG8_BAR; PG8_SCHED;
            } else {
            PG8_LDB(B0, 0, 0); PG8_SCHED; PG8_LDA(At, 0, 0); PG8_STAGE(PG8_SA(1, 1), a1 + hstep, voffA);
            PG8_WAIT_L(8); PG8_BAR; PG8_WAIT_L(0); PG8_MMA(0, 0, At, B0); PG8_BAR; PG8_SCHED;
            PG8_LDB(B1, 0, 1); PG8_STAGE(PG8_SB(0, 0), b2, voffB);
            PG8_BAR; PG8_WAIT_L(0); PG8_MMA(0, 1, At, B1); PG8_BAR;
            PG8_LDA(At, 0, 1); PG8_STAGE(PG8_SA(0, 0), a2, voffA);
            PG8_BAR; PG8_WAIT_L(0); PG8_MMA(1, 0, At, B0); PG8_BAR; PG8_SCHED;
            PG8_STAGE(PG8_SB(0, 1), b2 + hstep, voffB);
            PG8_WAIT_V(6); PG8_BAR; PG8_MMA(1, 1, At, B1); PG8_BAR;
            PG8_LDB(B0, 1, 0); PG8_SCHED; PG8_LDA(At, 1, 0); PG8_STAGE(PG8_SA(0, 1), a2 + hstep, voffA);
            PG8_WAIT_L(8); PG8_BAR; PG8_WAIT_L(0); PG8_MMA(0, 0, At, B0); PG8_BAR; PG8_SCHED;
            PG8_LDB(B1, 1, 1); PG8_STAGE(PG8_SB(1, 0), b3, voffB);
            PG8_BAR; PG8_WAIT_L(0); PG8_MMA(0, 1, At, B1); PG8_BAR;
            PG8_LDA(At, 1, 1); PG8_STAGE(PG8_SA(1, 0), a3, voffA);
            PG8_BAR; PG8_WAIT_L(0); PG8_MMA(1, 0, At, B0); PG8_BAR; PG8_SCHED;
            PG8_STAGE(PG8_SB(1, 1), b3 + hstep, voffB);
            PG8_WAIT_V(6); PG8_BAR; PG8_MMA(1, 1, At, B1); PG8_BAR;
            }
        }
        if constexpr (ALIGN_EPI) { if (wr == 0) PG8_BAR; }
        E(acc, cur, wr, wc, fr, fq);
        if (!has_next) break;
#pragma unroll
        for (int a = 0; a < 2; ++a)
#pragma unroll
            for (int b = 0; b < 2; ++b)
#pragma unroll
                for (int m = 0; m < 4; ++m)
#pragma unroll
                    for (int n = 0; n < 2; ++n) acc[a][b][m][n] = (f32x4){0.f, 0.f, 0.f, 0.f};
        cur = nxt; cA = nA; cB = nB; ++ui;
        if constexpr (ALIGN_EPI) { if (wr == 1) PG8_BAR; }
    }
    PG8_WAIT_V(0);
    if constexpr (!ALIGN_EPI) { if (wr == 0) PG8_BAR; }
    PG8_BAR;
#undef PG8_SA
#undef PG8_SB
#undef PG8_STAGE
#undef PG8_LDA
#undef PG8_LDB
#undef PG8_MMA
#undef PG8_WAIT_V
#undef PG8_WAIT_L
#undef PG8_BAR
#undef PG8_SCHED
}
}

struct Args {
    const float* x; const float* c; const float* w_ada; const float* b_ada; const float* norm_g; const float* w_in;
    const float* lb_logits; const float* hgrn_g; const float* ret_g; const float* conv_w; const float* conv_b;
    const float* dt_bias; const float* a_log; const float* dskip; const float* ssm_g; const float* w_gk2; const float* b_gk2;
    const float* gla_g; const float* w_out; const float* final_g;
    float* out; unsigned char* ws;
};

__device__ __forceinline__ void transpose_cvt(const float* __restrict__ src, int K, int N, bf16_t* __restrict__ dst, int Npad, LAS unsigned char* lds, int gid, int gstride, bool perm) {
    LAS float* T = (LAS float*)lds;
    const int tid = opaque_tid(), ntk = K / 64, ntn = Npad / 256;
    for (int tile = gid; tile < ntk * ntn; tile += gstride) {
        const int tk = tile % ntk, tn = tile / ntk;
        float v[32];
#pragma unroll
        for (int i = 0; i < 32; ++i) { const int kk = (tid >> 8) + 2 * i, nn = tid & 255, n = tn * 256 + nn;
            const int ns = !perm ? n : (n < 5632) ? n : (n < 7168) ? n + 8 : (n < 7176) ? n - 7168 + 5632 : n;
            v[i] = (n < N) ? src[(size_t)(tk * 64 + kk) * N + ns] : 0.f; }
#pragma unroll
        for (int i = 0; i < 32; ++i) { const int kk = (tid >> 8) + 2 * i, nn = tid & 255; T[kk * 257 + nn] = v[i]; }
        __syncthreads();
#pragma unroll
        for (int i = 0; i < 16; ++i) { const int nn = (tid >> 5) + 16 * i, kk = (tid & 31) * 2;
            *(unsigned*)(dst + (size_t)(tn * 256 + nn) * K + tk * 64 + kk) = pk2(T[kk * 257 + nn], T[(kk + 1) * 257 + nn]); }
        __syncthreads();
    }
}

__device__ __forceinline__ void phase_wcvt(const Args& a, LAS unsigned char* lds) {
    const int G = gridDim.x, bid = blockIdx.x;
    unsigned char* ws = a.ws;
    for (int l = 0; l < DEPTH; ++l) {
        transpose_cvt(a.w_in + (size_t)l * DM * NIN, DM, NIN, (bf16_t*)(ws + WS_WIN) + (size_t)l * LDP * DM, LDP, lds, bid, G, true);
        transpose_cvt(a.w_out + (size_t)l * DI * DM, DI, DM, (bf16_t*)(ws + WS_WOUT) + (size_t)l * DM * DI, DM, lds, (bid + 128) % G, G, false);
    }
}
__device__ __forceinline__ void phase_prep(const Args& a, LAS unsigned char* lds) {
    const int tid = opaque_tid(), G = gridDim.x, bid = blockIdx.x;
    unsigned char* ws = a.ws;
    {
        LAS float* R = (LAS float*)lds;
        LAS float* CA = (LAS float*)(lds + 8192);
        float* mod = (float*)(ws + WS_MOD);
        const int jj = tid & 63, ks = tid >> 6;
        if (bid < DEPTH * 48) {
#pragma unroll
            for (int q = 0; q < 8; ++q) CA[tid + NTHR * q] = silu_f(a.c[tid + NTHR * q]);
            __syncthreads();
        }
        for (int item = bid; item < DEPTH * 48; item += G) {
            const int l = item / 48, j = (item % 48) * 64 + jj;
            float s0 = 0.f, s1 = 0.f, s2 = 0.f, s3 = 0.f;
            const float* w = a.w_ada + (size_t)l * DM * 3072 + j;
#pragma unroll 16
            for (int k = ks * 128; k < ks * 128 + 128; ++k) { const float wv = w[(size_t)k * 3072];
                s0 += CA[k] * wv; s1 += CA[DM + k] * wv; s2 += CA[2 * DM + k] * wv; s3 += CA[3 * DM + k] * wv; }
            R[(ks * 4 + 0) * 64 + jj] = s0; R[(ks * 4 + 1) * 64 + jj] = s1; R[(ks * 4 + 2) * 64 + jj] = s2; R[(ks * 4 + 3) * 64 + jj] = s3;
            __syncthreads();
            if (tid < 256) { const int b = tid >> 6; float s = a.b_ada[l * 3072 + j];
#pragma unroll
                for (int q = 0; q < 8; ++q) s += R[(q * 4 + b) * 64 + jj];
                mod[(size_t)(l * 4 + b) * 3072 + j] = s; }
            __syncthreads();
        }
    }
    {
        float2* rope = (float2*)(ws + WS_ROPE);
        for (int i = bid * NTHR + tid; i < 4096 * 64; i += G * NTHR) {
            const int pos = i >> 6, j = i & 63;
            const float invf = powf(10000.f, -(float)(2 * j) / 128.f);
            const float ang = (float)pos * invf;
            const float k = rintf(ang * 0.15915494309189535f);
            float r = fmaf(-k, 6.2831854820251465f, ang); r = fmaf(-k, -1.7484555e-07f, r);
            rope[i] = make_float2(__cosf(r), __sinf(r));
        }
    }
}

template <bool FINAL>
__device__ __forceinline__ void phase_norm(const float* __restrict__ xin  , const bf16_t* __restrict__ slab  ,
                                           const float* __restrict__ gate_prev  , float* xout  ,
                                           const float* __restrict__ g, const float* __restrict__ mod  , int half, bf16_t* __restrict__ hout) {
    const int tid = opaque_tid(), lane = tid & 63, wid = tid >> 6;
    const int gw = blockIdx.x * 8 + wid, nw = gridDim.x * 8;
    f32x4 gg[4], sh[4], sc[4], gp[4];
#pragma unroll
    for (int i = 0; i < 4; ++i) { gg[i] = *(const f32x4*)(g + i * 256 + lane * 4); sh[i] = gg[i]; sc[i] = gg[i]; gp[i] = gg[i]; }
    int curb = -1;
    for (int row = gw; row < HROWS; row += nw) {
        const int b = row >> 12;
        if (b != curb) { curb = b;
#pragma unroll
            for (int i = 0; i < 4; ++i) { const int col = i * 256 + lane * 4;
                if constexpr (!FINAL) { const float* mb = mod + (size_t)(half * 2 + b) * 3072; sh[i] = *(const f32x4*)(mb + col); sc[i] = *(const f32x4*)(mb + 1024 + col); }
                if (slab) gp[i] = *(const f32x4*)(gate_prev + (size_t)b * 3072 + col); } }
        const float* xr = xin + (size_t)row * DM;
        f32x4 v[4]; float ss = 0.f;
#pragma unroll
        for (int i = 0; i < 4; ++i) v[i] = *(const f32x4*)(xr + i * 256 + lane * 4);
        if (slab) {
            u32x2 a0[4], a1[4];
#pragma unroll
            for (int i = 0; i < 4; ++i) { const int col = i * 256 + lane * 4;
                a0[i] = *(const u32x2*)(slab + (size_t)row * DM + col); a1[i] = *(const u32x2*)(slab + (size_t)(HROWS + row) * DM + col); }
#pragma unroll
            for (int i = 0; i < 4; ++i) {
                const f32x4 sa = {__uint_as_float(a0[i].x << 16) + __uint_as_float(a1[i].x << 16), __uint_as_float(a0[i].x & 0xffff0000u) + __uint_as_float(a1[i].x & 0xffff0000u),
                                  __uint_as_float(a0[i].y << 16) + __uint_as_float(a1[i].y << 16), __uint_as_float(a0[i].y & 0xffff0000u) + __uint_as_float(a1[i].y & 0xffff0000u)};
                v[i] = v[i] + gp[i] * sa; }
        }
        if (!FINAL && xout) {
#pragma unroll
            for (int i = 0; i < 4; ++i) *(f32x4*)(xout + (size_t)row * DM + i * 256 + lane * 4) = v[i];
        }
#pragma unroll
        for (int i = 0; i < 4; ++i) ss += v[i][0] * v[i][0] + v[i][1] * v[i][1] + v[i][2] * v[i][2] + v[i][3] * v[i][3];
#pragma unroll
        for (int o = 32; o > 0; o >>= 1) ss += __shfl_xor(ss, o);
        const float rinv = rsqrtf(ss * (1.f / DM) + EPS);
        if constexpr (FINAL) {
#pragma unroll
            for (int i = 0; i < 4; ++i) { const int col = i * 256 + lane * 4;
                *(f32x4*)(xout + (size_t)row * DM + col) = v[i] * rinv * gg[i]; }
        } else {
#pragma unroll
            for (int i = 0; i < 4; ++i) { const int col = i * 256 + lane * 4;
                float o0 = v[i][0] * rinv * gg[i][0] * (1.f + sc[i][0]) + sh[i][0], o1 = v[i][1] * rinv * gg[i][1] * (1.f + sc[i][1]) + sh[i][1];
                float o2 = v[i][2] * rinv * gg[i][2] * (1.f + sc[i][2]) + sh[i][2], o3 = v[i][3] * rinv * gg[i][3] * (1.f + sc[i][3]) + sh[i][3];
                u32x2 w; w.x = pk2(o0, o1); w.y = pk2(o2, o3);
                *(u32x2*)(hout + (size_t)row * DM + col) = w; }
        }
    }
}

struct MixP {
    const bf16_t* proj; bf16_t* st; float* dec; bf16_t* y; const float2* rope;
    const float* lbl; const float* hgrn_g; const float* ret_g; const float* conv_w; const float* conv_b; const float* dt_bias; const float* a_log;
    const float* dskip; const float* ssm_g; const float* w2; const float* b2; const float* gla_g; int layer;
};

__device__ __forceinline__ bf16x8 frag(LAS unsigned char* lds, int off, int ld, int r0, int ks, int lane) {
    return *(const LAS bf16x8*)(lds + off + (((r0 + (lane & 31)) * ld + 16 * ks + 8 * (lane >> 5)) << 1));
}
__device__ __forceinline__ int rowmap(int r, int lane) { return (r & 3) + 8 * (r >> 2) + 4 * (lane >> 5); }

__device__ __forceinline__ void conv16(LAS unsigned char* lds, int off, int ncols, int col, const float* cw, int seg, float (&out)[16]) {
    const LAS bf16_t* rp = (const LAS bf16_t*)(lds + off) + seg * 16 * ncols + col;
    float u[19];
#pragma unroll
    for (int k = 0; k < 19; ++k) u[k] = bf2f(rp[k * ncols]);
#pragma unroll
    for (int i = 0; i < 16; ++i) out[i] = silu_f(cw[4] + cw[0] * u[i] + cw[1] * u[i + 1] + cw[2] * u[i + 2] + cw[3] * u[i + 3]);
}
__device__ __forceinline__ void conv_w_load(const MixP& p, int chan, float* cw) {
    cw[0] = p.conv_w[chan]; cw[1] = p.conv_w[1024 + chan]; cw[2] = p.conv_w[2048 + chan]; cw[3] = p.conv_w[3072 + chan]; cw[4] = p.conv_b[chan];
}
template <int NCOLS, int NROWS> struct Stg { static constexpr int VPR = NCOLS / 8, NV = NROWS * VPR, NIT = (NV + NTHR - 1) / NTHR; };
template <int NCOLS, int NROWS>
__device__ __forceinline__ void stg_load(const bf16_t* proj, int grow0, int col0, int tid, int zrows, u32x4* r) {
    using S = Stg<NCOLS, NROWS>;
#pragma unroll
    for (int j = 0; j < S::NIT; ++j) { const int vi = tid + NTHR * j, row = vi / S::VPR, cv = vi % S::VPR;
        const bool ok = (vi < S::NV) && (row >= zrows);
        r[j] = ok ? *(const u32x4*)(proj + pidx(grow0 + row, col0 + cv * 8)) : (u32x4){0u, 0u, 0u, 0u}; }
}
template <int NCOLS, int NROWS>
__device__ __forceinline__ void stg_store(LAS unsigned char* lds, int off, int tid, const u32x4* r) {
    using S = Stg<NCOLS, NROWS>;
#pragma unroll
    for (int j = 0; j < S::NIT; ++j) { const int vi = tid + NTHR * j; if (vi < S::NV) *(LAS u32x4*)(lds + off + vi * 16) = r[j]; }
}
__device__ __forceinline__ void store16(LAS unsigned char* lds, int byteoff, const float (&v)[16]) {
    u32x4 a, b; a.x = pk2(v[0], v[1]); a.y = pk2(v[2], v[3]); a.z = pk2(v[4], v[5]); a.w = pk2(v[6], v[7]);
    b.x = pk2(v[8], v[9]); b.y = pk2(v[10], v[11]); b.z = pk2(v[12], v[13]); b.w = pk2(v[14], v[15]);
    *(LAS u32x4*)(lds + byteoff) = a; *(LAS u32x4*)(lds + byteoff + 16) = b;
}
__device__ __forceinline__ void store8(LAS unsigned char* lds, int byteoff, const float (&v)[8]) {
    u32x4 a; a.x = pk2(v[0], v[1]); a.y = pk2(v[2], v[3]); a.z = pk2(v[4], v[5]); a.w = pk2(v[6], v[7]);
    *(LAS u32x4*)(lds + byteoff) = a;
}

constexpr int NUNITS = 128 * 14;
struct Pref { u32x4 raw[11]; u32x4 st[8]; float aux[16]; };
template <int BR, int PASS>
__device__ __forceinline__ void load_A(const MixP& p, int bc, int hu, int tid, Pref& pf) {
    const bf16_t* P = p.proj; const int g0 = bc * 64;
    if constexpr (BR == 0) { stg_load<128, 64>(P, g0, C_AF + hu * 128, tid, 0, pf.raw + 0); stg_load<128, 64>(P, g0, C_AI + hu * 128, tid, 0, pf.raw + 2);
        if constexpr (PASS == 3) stg_load<128, 64>(P, g0, C_AQ + hu * 128, tid, 0, pf.raw + 4); }
    if constexpr (BR == 1) { stg_load<128, 64>(P, g0, C_RK + hu * 128, tid, 0, pf.raw + 0); stg_load<128, 64>(P, g0, C_RV + hu * 128, tid, 0, pf.raw + 2);
        if constexpr (PASS == 3) stg_load<128, 64>(P, g0, C_RQ + hu * 128, tid, 0, pf.raw + 4); }
    if constexpr (BR == 2) { const int zr = ((bc & 63) == 0) ? 3 : 0;
        stg_load<128, 67>(P, g0 - 3, C_XBC + 512 + hu * 128, tid, zr, pf.raw + 0); stg_load<256, 67>(P, g0 - 3, C_XBC + hu * 256, tid, zr, pf.raw + 3);
        if constexpr (PASS == 3) stg_load<128, 67>(P, g0 - 3, C_XBC + 768 + hu * 128, tid, zr, pf.raw + 8); }
    if constexpr (BR == 3) { stg_load<64, 64>(P, g0, C_GK + hu * 64, tid, 0, pf.raw + 0); stg_load<128, 64>(P, g0, C_GV + hu * 128, tid, 0, pf.raw + 1); stg_load<16, 64>(P, g0, C_LR, tid, 0, pf.raw + 3);
        if constexpr (PASS == 3) stg_load<64, 64>(P, g0, C_GQ + hu * 64, tid, 0, pf.raw + 4); }
}
template <int BR, int PASS>
__device__ __forceinline__ void load_B(const MixP& p, int bc, int hu, int tid, Pref& pf) {
    if constexpr (PASS == 3) {
        constexpr int DK = (BR == 3) ? 64 : 128, DV = (BR == 2) ? 256 : 128, NV = DV * DK / 8 / NTHR;
        const int st_off = (BR == 0) ? hu * 16384 : (BR == 1) ? 65536 + hu * 16384 : (BR == 2) ? 131072 + hu * 32768 : 196608 + hu * 8192;
        const bf16_t* stg = p.st + (size_t)bc * ST_PER_BC + st_off;
#pragma unroll
        for (int k = 0; k < NV; ++k) pf.st[k] = *(const u32x4*)(stg + (size_t)(tid + NTHR * k) * 8);
    }
    if constexpr (BR == 1) { const int j = tid & 63, seg = tid >> 6, chunk = bc & 63;
#pragma unroll
        for (int i = 0; i < 8; ++i) { const float2 c = p.rope[(chunk * 64 + seg * 8 + i) * 64 + j]; pf.aux[2 * i] = c.x; pf.aux[2 * i + 1] = c.y; } }
    if constexpr (BR == 2) { if (tid < 64) {
#pragma unroll
            for (int hh = 0; hh < 4; ++hh) pf.aux[hh] = bf2f(p.proj[pidx(bc * 64 + tid, C_DT + hu * 4 + hh)]); } }
    if constexpr (BR == 3) { const int cc = hu * 64 + (tid & 63);
#pragma unroll
        for (int r = 0; r < 16; ++r) pf.aux[r] = p.w2[r * 256 + cc]; }
}
template <int PASS>
__device__ __forceinline__ void load_A_any(const MixP& p, int i, int tid, Pref& pf) {
    const int bc = i / 14, u = i % 14;
    if (u < 4) load_A<0, PASS>(p, bc, u, tid, pf); else if (u < 8) load_A<1, PASS>(p, bc, u - 4, tid, pf);
    else if (u < 10) load_A<2, PASS>(p, bc, u - 8, tid, pf); else load_A<3, PASS>(p, bc, u - 10, tid, pf);
}
template <int PASS>
__device__ __forceinline__ void load_B_any(const MixP& p, int i, int tid, Pref& pf) {
    const int bc = i / 14, u = i % 14;
    if (u < 4) load_B<0, PASS>(p, bc, u, tid, pf); else if (u < 8) load_B<1, PASS>(p, bc, u - 4, tid, pf);
    else if (u < 10) load_B<2, PASS>(p, bc, u - 8, tid, pf); else load_B<3, PASS>(p, bc, u - 10, tid, pf);
}

template <int BR, int PASS>
__device__ __forceinline__ void mixer_unit(const MixP& p, LAS unsigned char* lds, int bc, int hu  ) {
    constexpr int DK = (BR == 3) ? 64 : 128, LDK = DK + 8, NH = (BR == 2) ? 4 : 1, DV = (BR == 2) ? 256 : 128, NT = DV / 128;
    constexpr bool VEC = (BR == 0 || BR == 3);
    const int tid = opaque_tid(), lane = tid & 63, wid = __builtin_amdgcn_readfirstlane(tid >> 6);
    const int chunk = bc & 63;
    const bf16_t* P = p.proj;
    LAS float* SM = (LAS float*)(lds + L_SM);
    LAS bf16_t* QI = (LAS bf16_t*)(lds + L_QI); LAS bf16_t* KI = (LAS bf16_t*)(lds + L_KI); LAS bf16_t* VT = (LAS bf16_t*)(lds + L_VT);
    const int st_off = (BR == 0) ? hu * 16384 : (BR == 1) ? 65536 + hu * 16384 : (BR == 2) ? 131072 + hu * 32768 : 196608 + hu * 8192;
    bf16_t* stg = p.st + (size_t)bc * ST_PER_BC + st_off;
    Pref pf;
    load_A<BR, PASS>(p, bc, hu, tid, pf);
    load_B<BR, PASS>(p, bc, hu, tid, pf);
    constexpr int NTG = (PASS == 3) ? NT : 1;
    const int gcol = (BR == 0) ? C_AG + hu * 128 : (BR == 1) ? C_RG + hu * 128 : (BR == 2) ? C_MZ + hu * 256 : C_GG + hu * 128;
    const float* gain = (BR == 0) ? p.hgrn_g + hu * 128 : (BR == 1) ? p.ret_g + hu * 128 : (BR == 2) ? p.ssm_g + hu * 256 : p.gla_g + hu * 128;
    bf16_t gt[NTG][16]; float gnv[NTG], dskv[NTG];
    float lb = 0.f, bb = 0.f, cwb[5], cwc[5], cwx[5], dtb[4], alg[4];
    if constexpr (BR == 0) { if (p.layer == 1) { const int cc = hu * 128 + (tid & 127); lb = 1.f / (1.f + __expf(p.lbl[cc] - p.lbl[512 + cc])); } }
    if constexpr (BR == 3) bb = p.b2[hu * 64 + (tid & 63)];
    if constexpr (BR == 2) { conv_w_load(p, 512 + hu * 128 + (tid & 127), cwb); if constexpr (PASS == 3) conv_w_load(p, 768 + hu * 128 + (tid & 127), cwc); conv_w_load(p, hu * 256 + (tid & 255), cwx);
#pragma unroll
        for (int hh = 0; hh < 4; ++hh) { dtb[hh] = p.dt_bias[hu * 4 + hh]; alg[hh] = p.a_log[hu * 4 + hh]; } }
    __builtin_amdgcn_sched_barrier(0);

    for (int urep = 0; urep < REP_UPREP; ++urep) {
    if constexpr (BR == 0) {
        constexpr int RQ = L_BIG, RF = (PASS == 3) ? L_BIG + 16384 : L_QI, RV = (PASS == 3) ? L_BIG + 32768 : L_QI + 16384;
        stg_store<128, 64>(lds, RF, tid, pf.raw + 0); stg_store<128, 64>(lds, RV, tid, pf.raw + 2);
        if constexpr (PASS == 3) stg_store<128, 64>(lds, RQ, tid, pf.raw + 4);
        __builtin_amdgcn_sched_barrier(0);
        const int d = tid & 127, seg = tid >> 7;
        __syncthreads();
        const LAS bf16_t* rF = (const LAS bf16_t*)(lds + RF) + seg * 16 * 128 + d;
        const LAS bf16_t* rQ = (const LAS bf16_t*)(lds + RQ) + seg * 16 * 128 + d;
        const LAS bf16_t* rV = (const LAS bf16_t*)(lds + RV) + seg * 16 * 128 + d;
        float cs[16], kk[16]; float run = 0.f;
#pragma unroll
        for (int i = 0; i < 16; ++i) { const float av = fmaxf(bf2f(rF[i * 128]), -60.f); const float e = __expf(-av), sg = __builtin_amdgcn_rcpf(1.f + e);
            const float f = lb + (1.f - lb) * sg; run += __logf(f); cs[i] = run; kk[i] = (1.f - lb) * e * sg; }
        SM[SM_SEG + seg * 128 + d] = run;
        __syncthreads();
        const float t0 = SM[SM_SEG + d], t1 = SM[SM_SEG + 128 + d], t2 = SM[SM_SEG + 256 + d], t3 = SM[SM_SEG + 384 + d];
        const float off = (seg == 0) ? 0.f : (seg == 1) ? t0 : (seg == 2) ? t0 + t1 : t0 + t1 + t2;
        const float ref = t0 + t1, clast = ref + t2 + t3;
        if (seg == 0) { SM[SM_REF + d] = ref; SM[SM_CLAST + d] = clast; }
        float kv[16];
#pragma unroll
        for (int i = 0; i < 16; ++i) { const float c = off + cs[i]; kv[i] = kk[i] * __expf(fminf(ref - c, 80.f));
            if constexpr (PASS == 3) { KI[(seg * 16 + i) * LDK + d] = f2bf(kv[i]);
                const float q = bf2f(rQ[i * 128]); QI[(seg * 16 + i) * LDK + d] = f2bf(silu_f(q) * __expf(fminf(c - ref, 80.f))); } }
        if constexpr (PASS == 1) store16(lds, L_BIG + (d * 72 + seg * 16) * 2, kv);
        unsigned vv[16];
#pragma unroll
        for (int i = 0; i < 16; ++i) vv[i] = rV[i * 128];
        u32x4 a, b; a.x = vv[0] | (vv[1] << 16); a.y = vv[2] | (vv[3] << 16); a.z = vv[4] | (vv[5] << 16); a.w = vv[6] | (vv[7] << 16);
        b.x = vv[8] | (vv[9] << 16); b.y = vv[10] | (vv[11] << 16); b.z = vv[12] | (vv[13] << 16); b.w = vv[14] | (vv[15] << 16);
        *(LAS u32x4*)(lds + L_VT + (d * 72 + seg * 16) * 2) = a; *(LAS u32x4*)(lds + L_VT + (d * 72 + seg * 16) * 2 + 16) = b;
    }
    if constexpr (BR == 1) {
        constexpr int RQ = L_BIG, RK = (PASS == 3) ? L_BIG + 16384 : L_QI, RV = (PASS == 3) ? L_BIG + 32768 : L_QI + 16384;
        const int j = tid & 63, seg = tid >> 6;
        float2 cssn[8];
#pragma unroll
        for (int i = 0; i < 8; ++i) cssn[i] = make_float2(pf.aux[2 * i], pf.aux[2 * i + 1]);
        stg_store<128, 64>(lds, RK, tid, pf.raw + 0); stg_store<128, 64>(lds, RV, tid, pf.raw + 2);
        if constexpr (PASS == 3) stg_store<128, 64>(lds, RQ, tid, pf.raw + 4);
        __builtin_amdgcn_sched_barrier(0);
        const float lg = log1pf(-exp2f(-(5.f + (float)hu)));
        if (tid < 64) { SM[SM_CUM + tid] = (float)(tid + 1) * lg; SM[SM_DT + tid] = 1.f; }
        __syncthreads();
        float k1[8], k2[8];
#pragma unroll
        for (int i = 0; i < 8; ++i) { const int t = seg * 8 + i;
            const LAS bf16_t* rk = (const LAS bf16_t*)(lds + RK) + t * 128 + j;
            const float ka = bf2f(rk[0]) * 0.08838834764831845f, kb = bf2f(rk[64]) * 0.08838834764831845f;
            k1[i] = ka * cssn[i].x - kb * cssn[i].y; k2[i] = ka * cssn[i].y + kb * cssn[i].x;
            if constexpr (PASS == 3) { const LAS bf16_t* rq = (const LAS bf16_t*)(lds + RQ) + t * 128 + j;
                const float qa = bf2f(rq[0]), qb = bf2f(rq[64]);
                QI[t * LDK + j] = f2bf(qa * cssn[i].x - qb * cssn[i].y); QI[t * LDK + j + 64] = f2bf(qa * cssn[i].y + qb * cssn[i].x);
                KI[t * LDK + j] = f2bf(k1[i]); KI[t * LDK + j + 64] = f2bf(k2[i]); } }
        if constexpr (PASS == 1) { store8(lds, L_BIG + (j * 72 + seg * 8) * 2, k1); store8(lds, L_BIG + ((j + 64) * 72 + seg * 8) * 2, k2); }
        const int v = tid & 127, s4 = tid >> 7; float vv[16];
#pragma unroll
        for (int i = 0; i < 16; ++i) { const int s = s4 * 16 + i; float x = bf2f(((const LAS bf16_t*)(lds + RV))[s * 128 + v]);
            if constexpr (PASS == 1) x *= __expf((float)(63 - s) * lg);
            vv[i] = x; }
        store16(lds, L_VT + (v * 72 + s4 * 16) * 2, vv);
    }
    if constexpr (BR == 2) {
        constexpr int RB = (PASS == 3) ? L_BIG : L_QI, RC = L_BIG + 17152, RX = (PASS == 3) ? L_BIG + 34304 : L_BIG + 18432;
        float dtr[4];
#pragma unroll
        for (int hh = 0; hh < 4; ++hh) dtr[hh] = pf.aux[hh];
        stg_store<128, 67>(lds, RB, tid, pf.raw + 0); stg_store<256, 67>(lds, RX, tid, pf.raw + 3);
        if constexpr (PASS == 3) stg_store<128, 67>(lds, RC, tid, pf.raw + 8);
        __builtin_amdgcn_sched_barrier(0);
        if (tid < 64) {
#pragma unroll
            for (int hh = 0; hh < 4; ++hh) {
                const float dt = softplus_f(dtr[hh] + dtb[hh]);
                float la = -dt * __expf(alg[hh]);
#pragma unroll
                for (int o = 1; o < 64; o <<= 1) { const float yv = __shfl_up(la, o); if (tid >= o) la += yv; }
                SM[SM_CUM + hh * 64 + tid] = la; SM[SM_DT + hh * 64 + tid] = dt; }
        }
        __syncthreads();
        { const int n = tid & 127, seg = tid >> 7; float o[16];
          conv16(lds, RB, 128, n, cwb, seg, o);
          if constexpr (PASS == 3) {
#pragma unroll
              for (int i = 0; i < 16; ++i) KI[(seg * 16 + i) * LDK + n] = f2bf(o[i]);
              conv16(lds, RC, 128, n, cwc, seg, o);
#pragma unroll
              for (int i = 0; i < 16; ++i) QI[(seg * 16 + i) * LDK + n] = f2bf(o[i]);
          } else store16(lds, L_BIG + (n * 72 + seg * 16) * 2, o);
        }
        { const int v = tid & 255, s2 = tid >> 8, hh = v >> 6;
#pragma unroll
          for (int r = 0; r < 2; ++r) { const int seg = s2 * 2 + r; float o[16];
              conv16(lds, RX, 256, v, cwx, seg, o);
              if constexpr (PASS == 1) { const float cl = SM[SM_CUM + hh * 64 + 63];
#pragma unroll
                  for (int i = 0; i < 16; ++i) { const int s = seg * 16 + i; o[i] *= __expf(cl - SM[SM_CUM + hh * 64 + s]) * SM[SM_DT + hh * 64 + s]; } }
              store16(lds, L_VT + (v * 72 + seg * 16) * 2, o); }
        }
    }
    if constexpr (BR == 3) {
        constexpr int RQ = L_BIG, RK = (PASS == 3) ? L_BIG + 8192 : L_QI, RV = (PASS == 3) ? L_BIG + 16384 : L_QI + 8192, RL = (PASS == 3) ? L_BIG + 32768 : L_QI + 24576;
        const int d = tid & 63, seg = tid >> 6, cc = hu * 64 + d;
        float w2r[16];
#pragma unroll
        for (int r = 0; r < 16; ++r) w2r[r] = pf.aux[r];
        stg_store<64, 64>(lds, RK, tid, pf.raw + 0); stg_store<128, 64>(lds, RV, tid, pf.raw + 1); stg_store<16, 64>(lds, RL, tid, pf.raw + 3);
        if constexpr (PASS == 3) stg_store<64, 64>(lds, RQ, tid, pf.raw + 4);
        __builtin_amdgcn_sched_barrier(0);
        __syncthreads();
        float cs[8]; float run = 0.f;
#pragma unroll
        for (int i = 0; i < 8; ++i) { const int t = seg * 8 + i; const LAS bf16x8* lp = (const LAS bf16x8*)(lds + RL + t * 32);
            const bf16x8 l0 = lp[0], l1 = lp[1]; float gk = bb;
#pragma unroll
            for (int r = 0; r < 8; ++r) { gk += w2r[r] * bf2f((bf16_t)l0[r]); gk += w2r[8 + r] * bf2f((bf16_t)l1[r]); }
            run += logsig_f(gk) * (1.f / 16.f); cs[i] = run; }
        SM[SM_SEG + seg * 64 + d] = run;
        __syncthreads();
        float off = 0.f, ref = 0.f, clast = 0.f;
#pragma unroll
        for (int s = 0; s < 8; ++s) { const float tv = SM[SM_SEG + s * 64 + d]; if (s < seg) off += tv; if (s < 4) ref += tv; clast += tv; }
        if (seg == 0) { SM[SM_REF + d] = ref; SM[SM_CLAST + d] = clast; }
        float kv[8];
#pragma unroll
        for (int i = 0; i < 8; ++i) { const int t = seg * 8 + i; const float c = off + cs[i];
            kv[i] = bf2f(((const LAS bf16_t*)(lds + RK))[t * 64 + d]) * __expf(fminf(ref - c, 80.f));
            if constexpr (PASS == 3) { KI[t * LDK + d] = f2bf(kv[i]); QI[t * LDK + d] = f2bf(bf2f(((const LAS bf16_t*)(lds + RQ))[t * 64 + d]) * 0.125f * __expf(fminf(c - ref, 80.f))); } }
        if constexpr (PASS == 1) store8(lds, L_BIG + (d * 72 + seg * 8) * 2, kv);
        const int v = tid & 127, s4 = tid >> 7; unsigned vv[16];
#pragma unroll
        for (int i = 0; i < 16; ++i) vv[i] = ((const LAS bf16_t*)(lds + RV))[(s4 * 16 + i) * 128 + v];
        u32x4 a, b; a.x = vv[0] | (vv[1] << 16); a.y = vv[2] | (vv[3] << 16); a.z = vv[4] | (vv[5] << 16); a.w = vv[6] | (vv[7] << 16);
        b.x = vv[8] | (vv[9] << 16); b.y = vv[10] | (vv[11] << 16); b.z = vv[12] | (vv[13] << 16); b.w = vv[14] | (vv[15] << 16);
        *(LAS u32x4*)(lds + L_VT + (v * 72 + s4 * 16) * 2) = a; *(LAS u32x4*)(lds + L_VT + (v * 72 + s4 * 16) * 2 + 16) = b;
    }
    __syncthreads();
    }
    for (int urep = 0; urep < REP_UCORE; ++urep) {
    if constexpr (PASS == 1) {
        constexpr int NTN = DV / 32, NTILES = (DK / 32) * NTN, NTL = NTILES / 8;
        f32x16 hacc[NTL];
#pragma unroll
        for (int i = 0; i < NTL; ++i) {
            const int ti = wid + 8 * i, tm = ti / NTN, tn = ti % NTN;
#pragma unroll
            for (int r = 0; r < 16; ++r) hacc[i][r] = 0.f;
#pragma unroll
            for (int ks = 0; ks < 4; ++ks) hacc[i] = __builtin_amdgcn_mfma_f32_32x32x16_bf16(frag(lds, L_BIG, 72, tm * 32, ks, lane), frag(lds, L_VT, 72, tn * 32, ks, lane), hacc[i], 0, 0, 0);
            if constexpr (VEC) {
#pragma unroll
                for (int r = 0; r < 16; ++r) { const int d = tm * 32 + rowmap(r, lane); hacc[i][r] *= __expf(SM[SM_CLAST + d] - SM[SM_REF + d]); }
            }
        }
        float decv = 0.f;
        if constexpr (BR == 0) { if (tid < 128) decv = __expf(SM[SM_CLAST + tid]); }
        if constexpr (BR == 3) { if (tid < 64) decv = __expf(SM[SM_CLAST + tid]); }
        if constexpr (BR == 2) { if (tid < 4) decv = __expf(SM[SM_CUM + tid * 64 + 63]); }
        __syncthreads();
        constexpr int LDH = DK + 8, H_OFF = (BR == 2) ? L_BIG : L_VT;
#pragma unroll
        for (int i = 0; i < NTL; ++i) {
            const int ti = wid + 8 * i, tm = ti / NTN, tn = ti % NTN;
            const int v = tn * 32 + (lane & 31);
#pragma unroll
            for (int rg = 0; rg < 4; ++rg) { const int d0 = tm * 32 + 8 * rg + 4 * (lane >> 5);
                u32x2 w; w.x = pk2(hacc[i][rg * 4 + 0], hacc[i][rg * 4 + 1]); w.y = pk2(hacc[i][rg * 4 + 2], hacc[i][rg * 4 + 3]);
                *(LAS u32x2*)(lds + H_OFF + (v * LDH + d0) * 2) = w; }
        }
        __syncthreads();
#pragma unroll
        for (int k = 0; k < DV * DK / 8 / NTHR; ++k) { const int vi = tid + NTHR * k, v = vi / (DK / 8), c = vi % (DK / 8);
            const u32x4 w = *(const LAS u32x4*)(lds + H_OFF + (v * LDH + c * 8) * 2);
            *(u32x4*)(stg + (size_t)vi * 8) = w; }
        float* dec = p.dec + (size_t)bc * 1024;
        if constexpr (BR == 0) { if (tid < 128) dec[hu * 128 + tid] = decv; }
        if constexpr (BR == 3) { if (tid < 64) dec[512 + hu * 64 + tid] = decv; }
        if constexpr (BR == 2) { if (tid < 4) dec[768 + hu * 4 + tid] = decv; }
    } else {
        constexpr int NCT = DV / 32;
    if constexpr (PASS == 3) {
#pragma unroll
            for (int nt = 0; nt < NT; ++nt) { const int ct = (wid & 3) + 4 * nt;
                gnv[nt] = gain[ct * 32 + (lane & 31)]; dskv[nt] = (BR == 2) ? p.dskip[hu * 4 + (ct >> 1)] : 0.f;
#pragma unroll
                for (int r = 0; r < 16; ++r) gt[nt][r] = P[pidx(bc * 64 + (wid >> 2) * 32 + rowmap(r, lane), gcol + ct * 32 + (lane & 31))]; }
        }
        __builtin_amdgcn_sched_barrier(0);
        {
            constexpr int NVEC = DV * DK / 8, VPR = DK / 8;
#pragma unroll
            for (int k = 0; k < NVEC / NTHR; ++k) { const int vi = tid + NTHR * k; const int v = vi / VPR, d0 = (vi % VPR) * 8;
                u32x4 raw = pf.st[k];
                if constexpr (VEC) { unsigned w[4] = {raw.x, raw.y, raw.z, raw.w};
#pragma unroll
                    for (int q = 0; q < 4; ++q) { const float lo = __uint_as_float(w[q] << 16) * __expf(SM[SM_REF + d0 + 2 * q]), hi = __uint_as_float(w[q] & 0xffff0000u) * __expf(SM[SM_REF + d0 + 2 * q + 1]);
                        w[q] = pk2(lo, hi); }
                    raw.x = w[0]; raw.y = w[1]; raw.z = w[2]; raw.w = w[3]; }
                *(LAS u32x4*)(lds + L_BIG + (v * LDK + d0) * 2) = raw; }
        }
        __builtin_amdgcn_sched_barrier(0);
        __syncthreads();
        const int tm = wid >> 2, tnb = wid & 3;
        f32x16 acc[NT];
#pragma unroll
        for (int nt = 0; nt < NT; ++nt)
#pragma unroll
            for (int r = 0; r < 16; ++r) acc[nt][r] = 0.f;
#pragma unroll
        for (int ks = 0; ks < DK / 16; ++ks) { const bf16x8 af = frag(lds, L_QI, LDK, tm * 32, ks, lane);
#pragma unroll
            for (int nt = 0; nt < NT; ++nt) acc[nt] = __builtin_amdgcn_mfma_f32_32x32x16_bf16(af, frag(lds, L_BIG, LDK, (tnb + 4 * nt) * 32, ks, lane), acc[nt], 0, 0, 0); }
        if constexpr (!VEC) {
#pragma unroll
            for (int nt = 0; nt < NT; ++nt) { const int hh = (NH == 1) ? 0 : ((tnb + 4 * nt) >> 1);
#pragma unroll
                for (int r = 0; r < 16; ++r) acc[nt][r] *= __expf(SM[SM_CUM + hh * 64 + tm * 32 + rowmap(r, lane)]); }
        }
        constexpr int P_OFF = (NH == 1) ? L_BIG + 34816 : L_BIG;
        f32x16 sc;
#pragma unroll
        for (int r = 0; r < 16; ++r) sc[r] = 0.f;
        const int w4 = wid & 3, stm = w4 >> 1, stn = w4 & 1, whalf = wid >> 2;
#pragma unroll
        for (int ks = 0; ks < DK / 16; ++ks) sc = __builtin_amdgcn_mfma_f32_32x32x16_bf16(frag(lds, L_QI, LDK, stm * 32, ks, lane), frag(lds, L_KI, LDK, stn * 32, ks, lane), sc, 0, 0, 0);
        if constexpr (NH != 1) __syncthreads();
        {
            const int s = stn * 32 + (lane & 31);
            if constexpr (NH == 1) {
                float cums = 0.f, dts = 1.f;
                if constexpr (!VEC) { cums = SM[SM_CUM + s]; dts = SM[SM_DT + s]; }
#pragma unroll
                for (int r8 = 0; r8 < 8; ++r8) { const int rlo = r8, rhi = r8 + 8; const int r = whalf ? rhi : rlo; const int t = stm * 32 + (whalf ? rowmap(rhi, lane) : rowmap(rlo, lane));
                    float val = whalf ? sc[rhi] : sc[rlo]; (void)r;
                    if constexpr (!VEC) { const float ex = (s <= t) ? SM[SM_CUM + t] - cums : 0.f; val *= __expf(ex) * dts; }
                    val = (s <= t) ? val : 0.f;
                    *(LAS bf16_t*)(lds + P_OFF + (t * 72 + s) * 2) = f2bf(val); }
            } else {
#pragma unroll
                for (int h2 = 0; h2 < NH / 2; ++h2) { const int hh = whalf * (NH / 2) + h2;
                    const float cums = SM[SM_CUM + hh * 64 + s], dts = SM[SM_DT + hh * 64 + s];
#pragma unroll
                    for (int r = 0; r < 16; ++r) { const int t = stm * 32 + rowmap(r, lane);
                        float val = sc[r];
                        const float ex = (s <= t) ? SM[SM_CUM + hh * 64 + t] - cums : 0.f; val *= __expf(ex) * dts;
                        val = (s <= t) ? val : 0.f;
                        *(LAS bf16_t*)(lds + P_OFF + ((hh * 64 + t) * 72 + s) * 2) = f2bf(val); } }
            }
        }
        __syncthreads();
#pragma unroll
        for (int nt = 0; nt < NT; ++nt) { const int hh = (NH == 1) ? 0 : ((tnb + 4 * nt) >> 1);
#pragma unroll
            for (int ks = 0; ks < 4; ++ks) acc[nt] = __builtin_amdgcn_mfma_f32_32x32x16_bf16(frag(lds, P_OFF + hh * 9216, 72, tm * 32, ks, lane), frag(lds, L_VT, 72, (tnb + 4 * nt) * 32, ks, lane), acc[nt], 0, 0, 0); }
        const int ycol = (BR == 0) ? hu * 128 : (BR == 1) ? 512 + hu * 128 : (BR == 2) ? 1024 + hu * 256 : 1536 + hu * 128;
#pragma unroll
        for (int nt = 0; nt < NT; ++nt) { const int ct = tnb + 4 * nt, v = ct * 32 + (lane & 31);
            const float dsk = dskv[nt];
            float sq[16];
#pragma unroll
            for (int r = 0; r < 16; ++r) { const int t = tm * 32 + rowmap(r, lane);
                float val = acc[nt][r];
                if constexpr (BR == 2) { val = (val + dsk * bf2f(VT[v * 72 + t])) * silu_f(bf2f(gt[nt][r])); acc[nt][r] = val; }
                sq[r] = val * val; }
            const bool b4 = lane & 16, b3 = lane & 8, b2 = lane & 4, b1 = lane & 2;
#pragma unroll
            for (int i = 0; i < 8; ++i) { const float lo = sq[i], hi = sq[i + 8]; sq[i] = (b4 ? hi : lo) + __shfl_xor(b4 ? lo : hi, 16); }
#pragma unroll
            for (int i = 0; i < 4; ++i) { const float lo = sq[i], hi = sq[i + 4]; sq[i] = (b3 ? hi : lo) + __shfl_xor(b3 ? lo : hi, 8); }
#pragma unroll
            for (int i = 0; i < 2; ++i) { const float lo = sq[i], hi = sq[i + 2]; sq[i] = (b2 ? hi : lo) + __shfl_xor(b2 ? lo : hi, 4); }
            { const float lo = sq[0], hi = sq[1]; sq[0] = (b1 ? hi : lo) + __shfl_xor(b1 ? lo : hi, 2); }
            sq[0] += __shfl_xor(sq[0], 1);
            const int rr = (b4 ? 8 : 0) + (b3 ? 4 : 0) + (b2 ? 2 : 0) + (b1 ? 1 : 0);
            if ((lane & 1) == 0) SM[SM_RSS + ct * 64 + tm * 32 + rowmap(rr, lane)] = sq[0];
        }
        __syncthreads();
        if (tid < 64) { float tot = 0.f;
#pragma unroll
            for (int q = 0; q < NCT; ++q) tot += SM[SM_RSS + q * 64 + tid];
            SM[SM_SEG + tid] = rsqrtf(tot * (1.f / DV) + EPS); }
        __syncthreads();
        float rinv[16];
#pragma unroll
        for (int r = 0; r < 16; ++r) rinv[r] = SM[SM_SEG + tm * 32 + rowmap(r, lane)];
        __syncthreads();
#pragma unroll
        for (int nt = 0; nt < NT; ++nt) { const int ct = tnb + 4 * nt, v = ct * 32 + (lane & 31);
            const float gn = gnv[nt];
#pragma unroll
            for (int r = 0; r < 16; ++r) { const int t = tm * 32 + rowmap(r, lane);
                float o = acc[nt][r] * rinv[r] * gn;
                if constexpr (BR != 2) o *= silu_f(bf2f(gt[nt][r]));
                p.y[(size_t)(bc * 64 + t) * DI + ycol + v] = f2bf(o); }
        }
    }
    }
}

template <int PASS>
__device__ __forceinline__ void phase_mixer(const MixP& p, LAS unsigned char* lds) {
#pragma unroll 1
    for (int i = blockIdx.x; i < NUNITS; i += gridDim.x) {
        const int bc = i / 14, u = i % 14;
        if (u < 4) mixer_unit<0, PASS>(p, lds, bc, u);
        else if (u < 8) mixer_unit<1, PASS>(p, lds, bc, u - 4);
        else if (u < 10) mixer_unit<2, PASS>(p, lds, bc, u - 8);
        else mixer_unit<3, PASS>(p, lds, bc, u - 10);
    }
}

__device__ __forceinline__ void phase_scan(bf16_t* st, const float* dec, LAS unsigned char* lds) {
    constexpr int BPB = ST_PER_BC / 2048;
    LAS float* D = (LAS float*)lds;
    const int tid = opaque_tid();
#pragma unroll 1
    for (int blk = blockIdx.x; blk < 2 * BPB; blk += gridDim.x) {
        const int bl = blk / BPB, eb = (blk % BPB) * 2048, e0 = eb + tid * 4;
        const float* dpb = dec + (size_t)bl * 64 * 1024;
        int mode, dsel = 0;
        if (eb < 65536) { mode = 0; const int dbase = (eb >> 14) * 128;
            for (int k = tid; k < 64 * 32; k += NTHR) { const int c = k >> 5, q = k & 31; *(LAS f32x4*)(D + c * 128 + q * 4) = *(const f32x4*)(dpb + (size_t)c * 1024 + dbase + q * 4); }
            dsel = e0 & 127; }
        else if (eb < 131072) { mode = 1; }
        else if (eb < 196608) { mode = 2; const int r = eb - 131072; const int g = r >> 15;
            const int head = g * 4 + (((r & 32767) >> 7) >> 6);
            if (tid < 64) D[tid] = dpb[(size_t)tid * 1024 + 768 + head]; }
        else { mode = 3; const int r = eb - 196608; const int dbase = 512 + (r >> 13) * 64;
            for (int k = tid; k < 64 * 16; k += NTHR) { const int c = k >> 4, q = k & 15; *(LAS f32x4*)(D + c * 64 + q * 4) = *(const f32x4*)(dpb + (size_t)c * 1024 + dbase + q * 4); }
            dsel = e0 & 63; }
        float cfac = 0.f;
        if (mode == 1) { const int h = (eb - 65536) >> 14; cfac = __expf(64.f * log1pf(-exp2f(-(5.f + (float)h)))); }
        __syncthreads();
        float s0 = 0.f, s1 = 0.f, s2 = 0.f, s3 = 0.f;
        bf16_t* ptr = st + (size_t)bl * 64 * ST_PER_BC + e0;
#pragma unroll 1
        for (int c0 = 0; c0 < 64; c0 += 8) {
            u32x2 hv[8];
#pragma unroll
            for (int j = 0; j < 8; ++j) hv[j] = *(const u32x2*)(ptr + (size_t)(c0 + j) * ST_PER_BC);
            __builtin_amdgcn_sched_barrier(0);
#pragma unroll
            for (int j = 0; j < 8; ++j) {
                f32x4 dv;
                if (mode == 0) dv = *(const LAS f32x4*)(D + (c0 + j) * 128 + dsel);
                else if (mode == 3) dv = *(const LAS f32x4*)(D + (c0 + j) * 64 + dsel);
                else if (mode == 1) dv = (f32x4){cfac, cfac, cfac, cfac};
                else { const float d = D[c0 + j]; dv = (f32x4){d, d, d, d}; }
                u32x2 w; w.x = pk2(s0, s1); w.y = pk2(s2, s3);
                *(u32x2*)(ptr + (size_t)(c0 + j) * ST_PER_BC) = w;
                s0 = s0 * dv[0] + __uint_as_float(hv[j].x << 16); s1 = s1 * dv[1] + __uint_as_float(hv[j].x & 0xffff0000u);
                s2 = s2 * dv[2] + __uint_as_float(hv[j].y << 16); s3 = s3 * dv[3] + __uint_as_float(hv[j].y & 0xffff0000u);
            }
        }
        __syncthreads();
    }
}

#define XB_TMO      128
#define XB_XCNT(j)  (256  + 64 * (j))
#define XB_XSUB(j)  (1280 + 64 * (j))
#define XB_XGEN(j)  (2304 + 64 * (j))
#define XB_TOP      3328
#define XB_TOPGEN   3392
#define XCD_BAR_WORDS 3456
#define XB_SPIN_CAP (1u << 18)
__device__ __forceinline__ unsigned xb_ld(unsigned* p)              { return __hip_atomic_load(p, __ATOMIC_RELAXED, __HIP_MEMORY_SCOPE_AGENT); }
__device__ __forceinline__ unsigned xb_add(unsigned* p, unsigned v) { return __hip_atomic_fetch_add(p, v, __ATOMIC_RELAXED, __HIP_MEMORY_SCOPE_AGENT); }
__device__ __forceinline__ unsigned xb_xcc_id() { return (unsigned)__builtin_amdgcn_s_getreg((3 << 11) | 20) & 0xFu; }
#define XB_SPIN(cond, bar) do { unsigned _sp = 0; while (cond) { __builtin_amdgcn_s_sleep(1); \
    if ((++_sp & 255u) == 0u) { if (xb_ld(&(bar)[XB_TMO])) break; if (_sp > XB_SPIN_CAP) { atomicAdd(&(bar)[XB_TMO], 1u); break; } } } } while (0)
struct XcdBarrier { unsigned* bar; unsigned x; volatile LAS unsigned* st; };
__device__ __forceinline__ XcdBarrier xcd_barrier_post(unsigned* bar, volatile LAS unsigned* st) {
    XcdBarrier b; b.bar = bar; b.x = xb_xcc_id(); b.st = st;
    if (threadIdx.x == 0) (void)xb_add(&bar[XB_XCNT(b.x)], 1u);
    return b;
}
__device__ __forceinline__ void xcd_barrier_complete(unsigned* bar, unsigned x, unsigned& nloc, unsigned& nx) {
    const unsigned G = gridDim.x * gridDim.y * gridDim.z;
    unsigned sum, cnt, mine, sp = 0u;
    for (;;) {
        sum = 0u; cnt = 0u; mine = 0u;
#pragma unroll
        for (unsigned j = 0; j < 16; ++j) { const unsigned c = xb_ld(&bar[XB_XCNT(j)]); sum += c; cnt += (c > 0u) ? 1u : 0u; mine = (j == x) ? c : mine; }
        if (sum == G) break;
        __builtin_amdgcn_s_sleep(1);
        if ((++sp & 255u) == 0u) { if (xb_ld(&bar[XB_TMO])) break; if (sp > XB_SPIN_CAP) { atomicAdd(&bar[XB_TMO], 1u); break; } }
    }
    nloc = mine > 0u ? mine : 1u; nx = cnt > 0u ? cnt : 1u;
}
__device__ __forceinline__ void xcd_barrier(const XcdBarrier& b) {
    asm volatile("s_waitcnt vmcnt(0)" ::: "memory");
    __syncthreads();
    if (threadIdx.x == 0) {
        unsigned* bar = b.bar;
        __builtin_amdgcn_s_waitcnt(0);
        unsigned nloc = b.st[0], nx = b.st[1];
        if (nloc == 0u) { xcd_barrier_complete(bar, b.x, nloc, nx); b.st[0] = nloc; b.st[1] = nx; }
        const unsigned old = xb_add(&bar[XB_XSUB(b.x)], 1u);
        const unsigned gen = old / nloc;
        if (old + 1u == (gen + 1u) * nloc) {
            __builtin_amdgcn_fence(__ATOMIC_RELEASE, "agent");
            asm volatile("s_waitcnt vmcnt(0)" ::: "memory");
            const unsigned og = xb_add(&bar[XB_TOP], 1u);
            const unsigned tg = og / nx;
            if (og + 1u == (tg + 1u) * nx) xb_add(&bar[XB_TOPGEN], 1u);
            else XB_SPIN(xb_ld(&bar[XB_TOPGEN]) == tg, bar);
            __builtin_amdgcn_fence(__ATOMIC_ACQUIRE, "agent");
            xb_add(&bar[XB_XGEN(b.x)], 1u);
            asm volatile("s_waitcnt vmcnt(0)" ::: "memory");
        } else {
            XB_SPIN(xb_ld(&bar[XB_XGEN(b.x)]) == gen, bar);
            __builtin_amdgcn_fence(__ATOMIC_ACQUIRE, "agent");
            asm volatile("s_waitcnt vmcnt(0)" ::: "memory");
        }
    }
    __syncthreads();
}

__global__ void __launch_bounds__(NTHR, 2) fwd_megakernel(Args a) {
    extern __shared__ __attribute__((aligned(16))) unsigned char shm[];
    LAS unsigned char* lds = (LAS unsigned char*)shm;
    cg::grid_group grid = cg::this_grid();
    unsigned char* ws = a.ws;
    const int G = gridDim.x;

    {
        volatile LAS unsigned* stw = (volatile LAS unsigned*)(lds + L_BARST);
        if (threadIdx.x < 2) stw[threadIdx.x] = 0u;
        __syncthreads();
    }
    const XcdBarrier gbar = xcd_barrier_post((unsigned*)(ws + WS_BAR), (volatile LAS unsigned*)(lds + L_BARST));
    for (int rep = 0; rep < REP_PREP; ++rep) { phase_prep(a, lds); if (rep == 0) grid.sync(); else xcd_barrier(gbar); }

    bf16_t* hbuf = (bf16_t*)(ws + WS_HY); bf16_t* ybuf = (bf16_t*)(ws + WS_HY);
    bf16_t* proj = (bf16_t*)(ws + WS_PROJ); bf16_t* st = (bf16_t*)(ws + WS_ST); float* dec = (float*)(ws + WS_DEC);
    const float* mod = (const float*)(ws + WS_MOD);

#pragma unroll 1
    for (int half = 0; half < 2; ++half) {
        const size_t xoff = (size_t)half * HROWS * DM;
#pragma unroll 1
        for (int l = 0; l < DEPTH; ++l) {
            const float* modl = mod + (size_t)l * 4 * 3072;
            bf16_t* slab = (bf16_t*)(ws + WS_PROJ);
            if (l == 0) { phase_norm<false>(a.x + xoff, nullptr, nullptr, nullptr, a.norm_g, modl, half, hbuf); if (half == 0) phase_wcvt(a, lds); }
            else phase_norm<false>(a.x + xoff, slab, mod + (size_t)(half * 2) * 3072 + 2048, a.out + xoff, a.norm_g + l * DM, modl, half, hbuf);
            xcd_barrier(gbar);
            for (int rep = 0; rep < REP_G1; ++rep) {
                pg8::Gemm g{hbuf, (const bf16_t*)(ws + WS_WIN) + (size_t)l * LDP * DM, HROWS, LDP, DM, DM};
                pg8::StaticOrder S; S.init(HROWS, LDP, G, (int)blockIdx.x);
                pg8::EpiProj E{proj, LDP};
                pg8::gemm_phase<pg8::EpiProj, pg8::StaticOrder>(lds, g, S, E);
                xcd_barrier(gbar);
            }
            MixP p;
            p.proj = proj; p.st = st; p.dec = dec; p.y = ybuf; p.rope = (const float2*)(ws + WS_ROPE);
            p.lbl = a.lb_logits; p.hgrn_g = a.hgrn_g + l * 512; p.ret_g = a.ret_g + l * 512; p.conv_w = a.conv_w + l * 4096; p.conv_b = a.conv_b + l * 1024;
            p.dt_bias = a.dt_bias + l * 8; p.a_log = a.a_log + l * 8; p.dskip = a.dskip + l * 8; p.ssm_g = a.ssm_g + l * 512;
            p.w2 = a.w_gk2 + l * 16 * 256; p.b2 = a.b_gk2 + l * 256; p.gla_g = a.gla_g + l * 512; p.layer = l;
            for (int rep = 0; rep < REP_M12; ++rep) { phase_mixer<1>(p, lds); xcd_barrier(gbar); phase_scan(st, dec, lds); xcd_barrier(gbar); }
            for (int rep = 0; rep < REP_M3; ++rep) { phase_mixer<3>(p, lds); xcd_barrier(gbar); }
            for (int rep = 0; rep < REP_G2; ++rep) {
                pg8::Gemm g{ybuf, (const bf16_t*)(ws + WS_WOUT) + (size_t)l * DM * DI, HROWS, DM, DI / 2, DI};
                pg8::SplitOrder S; S.init(HROWS, DM, G, (int)blockIdx.x);
                pg8::EpiSlab E{slab};
                pg8::gemm_phase<pg8::EpiSlab, pg8::SplitOrder>(lds, g, S, E);
                xcd_barrier(gbar);
            }
        }
        phase_norm<true>(a.out + xoff, (const bf16_t*)(ws + WS_PROJ), mod + (size_t)(4 + half * 2) * 3072 + 2048, a.out + xoff, a.final_g, nullptr, half, nullptr);
    }
}

extern "C" void kernel_launch(void* const* d_in, const int* in_sizes, int n_in, void* d_out, int out_size, void* d_ws, size_t ws_size, hipStream_t stream) {
    static int grid = 0;
    if (grid == 0) {
        if (n_in != 20 || ws_size < WS_END) { fprintf(stderr, "kernel_launch: unexpected n_in %d / ws_size %zu (need %zu)\n", n_in, ws_size, (size_t)WS_END); grid = -1; return; }
        int dev = 0, cus = 0, per_cu = 0;
        hipGetDevice(&dev);
        hipDeviceGetAttribute(&cus, hipDeviceAttributeMultiprocessorCount, dev);
        if (hipFuncSetAttribute((const void*)fwd_megakernel, hipFuncAttributeMaxDynamicSharedMemorySize, LDS_BYTES) != hipSuccess) { fprintf(stderr, "kernel_launch: hipFuncSetAttribute failed\n"); grid = -1; return; }
        hipOccupancyMaxActiveBlocksPerMultiprocessor(&per_cu, (const void*)fwd_megakernel, NTHR, LDS_BYTES);
        if (per_cu < 1) { fprintf(stderr, "kernel_launch: occupancy query says %d blocks per CU\n", per_cu); per_cu = 1; }
        (void)hipGetLastError();
        grid = cus * per_cu;
    }
    if (grid < 0) return;
    Args a{};
    const float** f = (const float**)&a;
    for (int i = 0; i < 20; ++i) f[i] = (const float*)d_in[i];
    a.out = (float*)d_out; a.ws = (unsigned char*)d_ws;
    void* args[] = {&a};
    if (hipMemsetAsync((char*)d_ws + WS_BAR, 0, XCD_BAR_WORDS * 4, stream) != hipSuccess) { fprintf(stderr, "kernel_launch: memset of barrier words failed\n"); return; }
    hipError_t e = hipLaunchCooperativeKernel((const void*)fwd_megakernel, dim3(grid), dim3(NTHR), args, LDS_BYTES, stream);
    if (e != hipSuccess) fprintf(stderr, "cooperative launch failed: %s (grid %d)\n", hipGetErrorString(e), grid);
}
```

```cpp
#include <hip/hip_runtime.h>
#include <hip/hip_cooperative_groups.h>
#include <cstdio>
namespace cg = cooperative_groups;

#define LAS __attribute__((address_space(3)))
typedef unsigned short bf16_t;
typedef short bf16x8 __attribute__((ext_vector_type(8)));
typedef float f32x4 __attribute__((ext_vector_type(4)));
typedef float f32x16 __attribute__((ext_vector_type(16)));
typedef unsigned u32x4 __attribute__((ext_vector_type(4)));
typedef unsigned u32x2 __attribute__((ext_vector_type(2)));

#ifndef REP_PREP
#define REP_PREP 1
#endif
#ifndef REP_NORM
#define REP_NORM 1
#endif
#ifndef REP_G1
#define REP_G1 1
#endif
#ifndef REP_M12
#define REP_M12 1
#endif
#ifndef REP_M3
#define REP_M3 1
#endif
#ifndef REP_G2
#define REP_G2 1
#endif
#ifndef REP_UPREP
#define REP_UPREP 1
#endif
#ifndef REP_UCORE
#define REP_UCORE 1
#endif
constexpr int NB = 4, SEQ = 4096, DM = 1024, DEPTH = 2, DI = 2048;
constexpr int NIN = 7192, LDP = 7424;
constexpr int HROWS = 8192;
constexpr int NTHR = 512;
constexpr float EPS = 1e-6f;
constexpr int C_AQ = 0, C_AF = 512, C_AI = 1024, C_AG = 1536, C_RQ = 2048, C_RK = 2560, C_RV = 3072, C_RG = 3584,
              C_MZ = 4096, C_XBC = 4608, C_GQ = 5632, C_GK = 5888, C_GV = 6144, C_GG = 6656, C_DT = 7168, C_LR = 7176;
constexpr int ST_PER_BC = 229376;
constexpr size_t WS_WIN = 0;
constexpr size_t WS_WOUT = WS_WIN + 2ull * LDP * DM * 2;
constexpr size_t WS_MOD = WS_WOUT + 2ull * DM * DI * 2;
constexpr size_t WS_ROPE = WS_MOD + 2ull * 4 * 3072 * 4;
constexpr size_t WS_DEC = WS_ROPE + 4096ull * 64 * 8;
constexpr size_t WS_HY = WS_DEC + 128ull * 1024 * 4;
constexpr size_t WS_PROJ = WS_HY + (size_t)HROWS * DI * 2;
constexpr size_t WS_ST = WS_PROJ + (size_t)HROWS * LDP * 2;
constexpr size_t WS_BAR = WS_ST + 128ull * ST_PER_BC * 2;
constexpr size_t WS_END = WS_BAR + 3456 * 4;
constexpr int L_QI = 0, L_KI = 17408, L_VT = 34816, L_BIG = 71680, L_SM = 141312;
constexpr int SM_CUM = 0, SM_DT = 256, SM_SEG = 512, SM_REF = 1536, SM_CLAST = 1664, SM_RSS = 1792;
constexpr int L_BARST = L_SM + (1792 + 512) * 4;
constexpr int LDS_BYTES = L_BARST + 16;

constexpr int NCG = LDP / 128;
__device__ __forceinline__ size_t pidx(int row, int col) { return ((size_t)((row >> 6) * NCG + (col >> 7)) * 64 + (row & 63)) * 128 + (col & 127); }
__device__ __forceinline__ float bf2f(bf16_t v) { return __uint_as_float(((unsigned)v) << 16); }
__device__ __forceinline__ bf16_t f2bf(float f) { unsigned u = __float_as_uint(f); u += 0x7FFFu + ((u >> 16) & 1u); return (bf16_t)(u >> 16); }
typedef float f32x2_t __attribute__((ext_vector_type(2)));
typedef __bf16 bf16x2_t __attribute__((ext_vector_type(2)));
__device__ __forceinline__ unsigned pk2(float lo, float hi) { f32x2_t v = {lo, hi}; bf16x2_t b = __builtin_convertvector(v, bf16x2_t); return __builtin_bit_cast(unsigned, b); }
__device__ __forceinline__ int opaque_tid() { int t = threadIdx.x; asm volatile("" : "+v"(t)); return t; }
__device__ __forceinline__ float silu_f(float x) { return x * __builtin_amdgcn_rcpf(1.f + __expf(-x)); }
__device__ __forceinline__ float softplus_f(float x) { return fmaxf(x, 0.f) + __logf(1.f + __expf(-fabsf(x))); }
__device__ __forceinline__ float logsig_f(float x) { return fminf(x, 0.f) - __logf(1.f + __expf(-fabsf(x))); }

namespace pg8 {
constexpr int BM = 256, BK = 64, HALF = 128, HTB = HALF * BK * 2, STAGE_BYTES = 8 * HTB, NXCD = 8, WGM = 8;
__device__ __forceinline__ int lds_byte(int r, int c) { const int st = (r >> 4) * 2 + (c >> 5), rr = r & 15, cc = c & 31, ob = rr * 64 + cc * 2; return st * 1024 + (ob ^ (((ob >> 9) & 1) << 5)); }
__device__ __forceinline__ void stage_rc(int b, int& R, int& C) { const int st = b / 1024, sb = b % 1024, swz = sb ^ (((sb >> 9) & 1) << 5); R = (st >> 1) * 16 + swz / 64; C = (st & 1) * 32 + (swz % 64) / 2; }
__device__ __forceinline__ int perm32(int rho) { const int n = rho >> 4, i = rho & 15; return 8 * (i >> 2) + 4 * n + (i & 3); }
struct Unit { int pm, pn, kh; };
struct Gemm { const bf16_t* A; const bf16_t* Bt; int M, N, K, ld; };
struct StaticOrder {
    int nM, nN, nwg, G, c;
    __device__ void init(int M, int N, int G_, int c_) { nM = M / BM; nN = N / BM; nwg = nM * nN; G = G_; c = c_; }
    __device__ bool next(int i, Unit& u) const {
        const long L = (long)i * G + c; if (L >= nwg) return false;
        int wgid = (int)L; { const int q = nwg / NXCD, r = nwg % NXCD, xcd = wgid % NXCD, off = wgid / NXCD; wgid = (xcd < r ? xcd * (q + 1) : r * (q + 1) + (xcd - r) * q) + off; }
        const int nig = WGM * nN, gid = wgid / nig, fm = gid * WGM, gsz = (nM - fm) < WGM ? (nM - fm) : WGM;
        u.pm = fm + ((wgid % nig) % gsz); u.pn = (wgid % nig) / gsz; u.kh = 0; return true;
    }
};
struct SplitOrder {
    StaticOrder so;
    __device__ void init(int M, int N, int G_, int c_) { so.init(M, 2 * N, G_, c_); }
    __device__ bool next(int i, Unit& u) const { if (!so.next(i, u)) return false; u.kh = u.pn & 1; u.pn >>= 1; return true; }
};
struct EpiProj {
    static constexpr bool PERM = true;
    bf16_t* O; int ldc;
    __device__ __forceinline__ void operator()(const f32x4 (&acc)[2][2][4][2], const Unit& u, int wr, int wc, int fr, int fq) const {
        bf16_t* base = O + ((size_t)((u.pm * 4 + wr) * NCG + u.pn * 2) * 64 + fr) * 128 + wc * 32 + 8 * fq;
#pragma unroll
        for (int ai = 0; ai < 2; ++ai)
#pragma unroll
            for (int m = 0; m < 4; ++m)
#pragma unroll
                for (int bj = 0; bj < 2; ++bj) { const f32x4 v0 = acc[ai][bj][m][0], v1 = acc[ai][bj][m][1];
                    u32x4 w; w.x = pk2(v0[0], v0[1]); w.y = pk2(v0[2], v0[3]); w.z = pk2(v1[0], v1[1]); w.w = pk2(v1[2], v1[3]);
                    *(u32x4*)(base + (size_t)ai * (2 * NCG * 8192) + bj * 8192 + m * (16 * 128)) = w; }
    }
};
struct EpiRes {
    static constexpr bool PERM = false;
    const float* xin; float* xout; const float* gate;
    __device__ __forceinline__ void operator()(const f32x4 (&acc)[2][2][4][2], const Unit& u, int wr, int wc, int fr, int fq) const {
        const int row0 = u.pm * BM + wr * 64 + fr, col0 = u.pn * BM + wc * 32 + 4 * fq;
        const float* gp = gate + (size_t)(u.pm >> 4) * 3072 + col0;
        f32x4 gv[2][2];
#pragma unroll
        for (int bj = 0; bj < 2; ++bj)
#pragma unroll
            for (int n = 0; n < 2; ++n) gv[bj][n] = *(const f32x4*)(gp + bj * HALF + n * 16);
#pragma unroll
        for (int am = 0; am < 4; ++am) {
            const int ai = am >> 1, m0 = (am & 1) * 2;
            f32x4 xi[2][2][2];
#pragma unroll
            for (int m = 0; m < 2; ++m)
#pragma unroll
                for (int bj = 0; bj < 2; ++bj)
#pragma unroll
                    for (int n = 0; n < 2; ++n) xi[m][bj][n] = *(const f32x4*)(xin + (size_t)(row0 + ai * HALF + (m0 + m) * 16) * DM + col0 + bj * HALF + n * 16);
            __builtin_amdgcn_sched_barrier(0);
#pragma unroll
            for (int m = 0; m < 2; ++m)
#pragma unroll
                for (int bj = 0; bj < 2; ++bj)
#pragma unroll
                    for (int n = 0; n < 2; ++n) *(f32x4*)(xout + (size_t)(row0 + ai * HALF + (m0 + m) * 16) * DM + col0 + bj * HALF + n * 16) = xi[m][bj][n] + gv[bj][n] * acc[ai][bj][m0 + m][n];
        }
    }
};

struct EpiSlab {
    static constexpr bool PERM = true;
    bf16_t* slab;
    __device__ __forceinline__ void operator()(const f32x4 (&acc)[2][2][4][2], const Unit& u, int wr, int wc, int fr, int fq) const {
        const int row0 = u.pm * BM + wr * 64 + fr, col0 = u.pn * BM + wc * 32 + 8 * fq;
        bf16_t* base = slab + (size_t)u.kh * HROWS * DM;
#pragma unroll
        for (int ai = 0; ai < 2; ++ai)
#pragma unroll
            for (int m = 0; m < 4; ++m) { bf16_t* rowp = base + (size_t)(row0 + ai * HALF + m * 16) * DM + col0;
#pragma unroll
                for (int bj = 0; bj < 2; ++bj) { const f32x4 v0 = acc[ai][bj][m][0], v1 = acc[ai][bj][m][1];
                    u32x4 w; w.x = pk2(v0[0], v0[1]); w.y = pk2(v0[2], v0[3]); w.z = pk2(v1[0], v1[1]); w.w = pk2(v1[2], v1[3]);
                    *(u32x4*)(rowp + bj * HALF) = w; } }
    }
};

template <class Epi, class Sched, bool ALIGN_EPI = true, bool SP2 = true>
__device__ __forceinline__ void gemm_phase(LAS unsigned char* lds, const Gemm g, const Sched& S, const Epi& E) {
    const int tid = opaque_tid(), wid = __builtin_amdgcn_readfirstlane(tid >> 6), lane = tid & 63, wr = wid >> 2, wc = wid & 3, fr = lane & 15, fq = lane >> 4;
    const int K = g.K, nt = K / BK, ld = g.ld;
    unsigned voffA[2], voffB[2];
#pragma unroll
    for (int i = 0; i < 2; ++i) { int R, C; stage_rc(tid * 16 + i * 8192, R, C); const int Rb = Epi::PERM ? ((R & ~31) + perm32(R & 31)) : R;
        voffA[i] = (unsigned)(R * ld + C) * 2u; voffB[i] = (unsigned)(Rb * ld + C) * 2u; }
    const size_t kstep = (size_t)(BK * 2);
    const size_t hstep = (size_t)HALF * ld * 2;
    const size_t tstep = 2 * hstep;
    const unsigned ldsw = (unsigned)wid * 1024u;
    const int aoff = lds_byte(wr * 64 + fr, fq * 8), boff = lds_byte(wc * 32 + fr, fq * 8);
#define PG8_SA(b, h) (((b) * 2 + (h)) * HTB)
#define PG8_SB(b, h) ((4 + (b) * 2 + (h)) * HTB)
#define PG8_STAGE(bufoff, gbase, voff) do { _Pragma("unroll") for (int _i = 0; _i < 2; ++_i) \
        __builtin_amdgcn_global_load_lds((const unsigned*)((const char*)(gbase) + (voff)[_i]), (LAS unsigned*)(lds + (bufoff) + ldsw + _i * 8192), 16, 0, 0); } while (0)
#define PG8_LDA(dst, b, h) do { _Pragma("unroll") for (int m = 0; m < 4; ++m) _Pragma("unroll") for (int k = 0; k < 2; ++k) dst[m][k] = *(const LAS bf16x8*)(lds + PG8_SA(b, h) + aoff + m * 2048 + k * 1024); } while (0)
#define PG8_LDB(dst, b, h) do { _Pragma("unroll") for (int n = 0; n < 2; ++n) _Pragma("unroll") for (int k = 0; k < 2; ++k) dst[n][k] = *(const LAS bf16x8*)(lds + PG8_SB(b, h) + boff + n * 2048 + k * 1024); } while (0)
#define PG8_MMA(ai, bj, At, Bt) do { __builtin_amdgcn_s_setprio(1); _Pragma("unroll") for (int m = 0; m < 4; ++m) _Pragma("unroll") for (int n = 0; n < 2; ++n) _Pragma("unroll") for (int k = 0; k < 2; ++k) \
        acc[ai][bj][m][n] = __builtin_amdgcn_mfma_f32_16x16x32_bf16(Bt[n][k], At[m][k], acc[ai][bj][m][n], 0, 0, 0); __builtin_amdgcn_s_setprio(0); } while (0)
#define PG8_WAIT_V(n) asm volatile("s_waitcnt vmcnt(" #n ")" ::: "memory")
#define PG8_WAIT_L(n) asm volatile("s_waitcnt lgkmcnt(" #n ")" ::: "memory")
#define PG8_BAR __builtin_amdgcn_s_barrier()
#define PG8_SCHED __builtin_amdgcn_sched_barrier(0)
    Unit cur, nxt; int ui = 0;
    if (!S.next(0, cur)) return;
    f32x4 acc[2][2][4][2];
#pragma unroll
    for (int a = 0; a < 2; ++a)
#pragma unroll
        for (int b = 0; b < 2; ++b)
#pragma unroll
            for (int m = 0; m < 4; ++m)
#pragma unroll
                for (int n = 0; n < 2; ++n) acc[a][b][m][n] = (f32x4){0.f, 0.f, 0.f, 0.f};
    bf16x8 At[4][2], B0[2][2], B1[2][2];
    const char* cA = (const char*)g.A + (size_t)cur.pm * tstep + (size_t)cur.kh * K * 2; const char* cB = (const char*)g.Bt + (size_t)cur.pn * tstep + (size_t)cur.kh * K * 2;
    if constexpr (SP2) {
        PG8_STAGE(PG8_SB(0, 0), cB, voffB); PG8_STAGE(PG8_SB(0, 1), cB + hstep, voffB); PG8_STAGE(PG8_SA(0, 0), cA, voffA); PG8_STAGE(PG8_SA(0, 1), cA + hstep, voffA);
        if (wr == 1) PG8_BAR;
        PG8_WAIT_V(2); PG8_BAR;
        PG8_STAGE(PG8_SB(1, 0), cB + kstep, voffB); PG8_STAGE(PG8_SA(1, 0), cA + kstep, voffA); PG8_STAGE(PG8_SB(1, 1), cB + hstep + kstep, voffB);
        PG8_WAIT_V(6); PG8_BAR;
    } else {
        PG8_STAGE(PG8_SB(0, 0), cB, voffB); PG8_STAGE(PG8_SA(0, 0), cA, voffA); PG8_STAGE(PG8_SB(0, 1), cB + hstep, voffB); PG8_STAGE(PG8_SA(0, 1), cA + hstep, voffA);
        if (wr == 1) PG8_BAR;
        PG8_WAIT_V(4); PG8_BAR;
        PG8_STAGE(PG8_SB(1, 0), cB + kstep, voffB); PG8_STAGE(PG8_SA(1, 0), cA + kstep, voffA); PG8_STAGE(PG8_SB(1, 1), cB + hstep + kstep, voffB);
        PG8_WAIT_V(6); PG8_BAR;
    }
    for (;;) {
        const bool has_next = S.next(ui + 1, nxt);
        const char* nA = has_next ? (const char*)g.A + (size_t)nxt.pm * tstep + (size_t)nxt.kh * K * 2 : cA; const char* nB = has_next ? (const char*)g.Bt + (size_t)nxt.pn * tstep + (size_t)nxt.kh * K * 2 : cB;
        for (int t = 0; t < nt; t += 2) {
            const bool last = (t == nt - 2);
            const char* a1 = cA + (size_t)(t + 1) * kstep;
            const char* a2 = last ? nA : cA + (size_t)(t + 2) * kstep; const char* b2 = last ? nB : cB + (size_t)(t + 2) * kstep;
            const char* a3 = a2 + kstep; const char* b3 = b2 + kstep;
            if constexpr (SP2) {
            PG8_LDB(B0, 0, 0); PG8_LDB(B1, 0, 1); PG8_SCHED; PG8_LDA(At, 0, 0); PG8_STAGE(PG8_SA(1, 1), a1 + hstep, voffA);
            PG8_WAIT_V(8); PG8_WAIT_L(0); PG8_BAR; PG8_MMA(0, 0, At, B0); PG8_MMA(0, 1, At, B1); PG8_BAR; PG8_SCHED;
            PG8_LDA(At, 0, 1); PG8_STAGE(PG8_SB(0, 0), b2, voffB); PG8_STAGE(PG8_SB(0, 1), b2 + hstep, voffB); PG8_STAGE(PG8_SA(0, 0), a2, voffA);
            PG8_WAIT_V(8); PG8_WAIT_L(0); PG8_BAR; PG8_MMA(1, 0, At, B0); PG8_MMA(1, 1, At, B1); PG8_BAR; PG8_SCHED;
            PG8_LDB(B0, 1, 0); PG8_LDB(B1, 1, 1); PG8_SCHED; PG8_LDA(At, 1, 0); PG8_STAGE(PG8_SA(0, 1), a2 + hstep, voffA);
            PG8_WAIT_V(8); PG8_WAIT_L(0); PG8_BAR; PG8_MMA(0, 0, At, B0); PG8_MMA(0, 1, At, B1); PG8_BAR; PG8_SCHED;
            PG8_LDA(At, 1, 1); PG8_STAGE(PG8_SB(1, 0), b3, voffB); PG8_STAGE(PG8_SB(1, 1), b3 + hstep, voffB); PG8_STAGE(PG8_SA(1, 0), a3, voffA);
            PG8_WAIT_V(8); PG8_WAIT_L(0); PG8_BAR; PG8_MMA(1, 0, At, B0); PG8_MMA(1, 1, At, B1); PG8_BAR; PG8_SCHED;
            } else {
            PG8_LDB(B0, 0, 0); PG8_SCHED; PG8_LDA(At, 0, 0); PG8_STAGE(PG8_SA(1, 1), a1 + hstep, voffA);
            PG8_WAIT_L(8); PG8_BAR; PG8_WAIT_L(0); PG8_MMA(0, 0, At, B0); PG8_BAR; PG8_SCHED;
            PG8_LDB(B1, 0, 1); PG8_STAGE(PG8_SB(0, 0), b2, voffB);
            PG8_BAR; PG8_WAIT_L(0); PG8_MMA(0, 1, At, B1); PG8_BAR;
            PG8_LDA(At, 0, 1); PG8_STAGE(PG8_SA(0, 0), a2, voffA);
            PG8_BAR; PG8_WAIT_L(0); PG8_MMA(1, 0, At, B0); PG8_BAR; PG8_SCHED;
            PG8_STAGE(PG8_SB(0, 1), b2 + hstep, voffB);
            PG8_WAIT_V(6); PG8_BAR; PG8_MMA(1, 1, At, B1); PG8_BAR;
            PG8_LDB(B0, 1, 0); PG8_SCHED; PG8_LDA(At, 1, 0); PG8_STAGE(PG8_SA(0, 1), a2 + hstep, voffA);
            PG8_WAIT_L(8); PG8_BAR; PG8_WAIT_L(0); PG8_MMA(0, 0, At, B0); PG8_BAR; PG8_SCHED;
            PG8_LDB(B1, 1, 1); PG8_STAGE(PG8_SB(1, 0), b3, voffB);
            PG8_BAR; PG8_WAIT_L(0); PG8_MMA(0, 1, At, B1); PG8_BAR;
            PG8_LDA(At, 1, 1); PG8_STAGE(PG8_SA(1, 0), a3, voffA);
            PG8_BAR; PG8_WAIT_L(0); PG8_MMA(1, 0, At, B0); PG8_BAR; PG8_SCHED;
            PG8_STAGE(PG8_SB(1, 1), b3 + hstep, voffB);
            PG8_WAIT_V(6); PG8_BAR; PG8_MMA(1, 1, At, B1); PG8_BAR;
            }
        }
        if constexpr (ALIGN_EPI) { if (wr == 0) PG8_BAR; }
        E(acc, cur, wr, wc, fr, fq);
        if (!has_next) break;
#pragma unroll
        for (int a = 0; a < 2; ++a)
#pragma unroll
            for (int b = 0; b < 2; ++b)
#pragma unroll
                for (int m = 0; m < 4; ++m)
#pragma unroll
                    for (int n = 0; n < 2; ++n) acc[a][b][m][n] = (f32x4){0.f, 0.f, 0.f, 0.f};
        cur = nxt; cA = nA; cB = nB; ++ui;
        if constexpr (ALIGN_EPI) { if (wr == 1) PG8_BAR; }
    }
    PG8_WAIT_V(0);
    if constexpr (!ALIGN_EPI) { if (wr == 0) PG8_BAR; }
    PG8_BAR;
#undef PG8_SA
#undef PG8_SB
#undef PG8_STAGE
#undef PG8_LDA
#undef PG8_LDB
#undef PG8_MMA
#undef PG8_WAIT_V
#undef PG8_WAIT_L
#undef PG8_BAR
#undef PG8_SCHED
}
}

struct Args {
    const float* x; const float* c; const float* w_ada; const float* b_ada; const float* norm_g; const float* w_in;
    const float* lb_logits; const float* hgrn_g; const float* ret_g; const float* conv_w; const float* conv_b;
    const float* dt_bias; const float* a_log; const float* dskip; const float* ssm_g; const float* w_gk2; const float* b_gk2;
    const float* gla_g; const float* w_out; const float* final_g;
    float* out; unsigned char* ws;
};

__device__ __forceinline__ void transpose_cvt(const float* __restrict__ src, int K, int N, bf16_t* __restrict__ dst, int Npad, LAS unsigned char* lds, int gid, int gstride, bool perm) {
    LAS float* T = (LAS float*)lds;
    const int tid = opaque_tid(), ntk = K / 64, ntn = Npad / 256;
    for (int tile = gid; tile < ntk * ntn; tile += gstride) {
        const int tk = tile % ntk, tn = tile / ntk;
        float v[32];
#pragma unroll
        for (int i = 0; i < 32; ++i) { const int kk = (tid >> 8) + 2 * i, nn = tid & 255, n = tn * 256 + nn;
            const int ns = !perm ? n : (n < 5632) ? n : (n < 7168) ? n + 8 : (n < 7176) ? n - 7168 + 5632 : n;
            v[i] = (n < N) ? src[(size_t)(tk * 64 + kk) * N + ns] : 0.f; }
#pragma unroll
        for (int i = 0; i < 32; ++i) { const int kk = (tid >> 8) + 2 * i, nn = tid & 255; T[kk * 257 + nn] = v[i]; }
        __syncthreads();
#pragma unroll
        for (int i = 0; i < 16; ++i) { const int nn = (tid >> 5) + 16 * i, kk = (tid & 31) * 2;
            *(unsigned*)(dst + (size_t)(tn * 256 + nn) * K + tk * 64 + kk) = pk2(T[kk * 257 + nn], T[(kk + 1) * 257 + nn]); }
        __syncthreads();
    }
}

__device__ __forceinline__ void phase_wcvt(const Args& a, LAS unsigned char* lds) {
    const int G = gridDim.x, bid = blockIdx.x;
    unsigned char* ws = a.ws;
    for (int l = 0; l < DEPTH; ++l) {
        transpose_cvt(a.w_in + (size_t)l * DM * NIN, DM, NIN, (bf16_t*)(ws + WS_WIN) + (size_t)l * LDP * DM, LDP, lds, bid, G, true);
        transpose_cvt(a.w_out + (size_t)l * DI * DM, DI, DM, (bf16_t*)(ws + WS_WOUT) + (size_t)l * DM * DI, DM, lds, (bid + 128) % G, G, false);
    }
}
__device__ __forceinline__ void phase_prep(const Args& a, LAS unsigned char* lds) {
    const int tid = opaque_tid(), G = gridDim.x, bid = blockIdx.x;
    unsigned char* ws = a.ws;
    {
        LAS float* R = (LAS float*)lds;
        LAS float* CA = (LAS float*)(lds + 8192);
        float* mod = (float*)(ws + WS_MOD);
        const int jj = tid & 63, ks = tid >> 6;
        if (bid < DEPTH * 48) {
#pragma unroll
            for (int q = 0; q < 8; ++q) CA[tid + NTHR * q] = silu_f(a.c[tid + NTHR * q]);
            __syncthreads();
        }
        for (int item = bid; item < DEPTH * 48; item += G) {
            const int l = item / 48, j = (item % 48) * 64 + jj;
            float s0 = 0.f, s1 = 0.f, s2 = 0.f, s3 = 0.f;
            const float* w = a.w_ada + (size_t)l * DM * 3072 + j;
#pragma unroll 16
            for (int k = ks * 128; k < ks * 128 + 128; ++k) { const float wv = w[(size_t)k * 3072];
                s0 += CA[k] * wv; s1 += CA[DM + k] * wv; s2 += CA[2 * DM + k] * wv; s3 += CA[3 * DM + k] * wv; }
            R[(ks * 4 + 0) * 64 + jj] = s0; R[(ks * 4 + 1) * 64 + jj] = s1; R[(ks * 4 + 2) * 64 + jj] = s2; R[(ks * 4 + 3) * 64 + jj] = s3;
            __syncthreads();
            if (tid < 256) { const int b = tid >> 6; float s = a.b_ada[l * 3072 + j];
#pragma unroll
                for (int q = 0; q < 8; ++q) s += R[(q * 4 + b) * 64 + jj];
                mod[(size_t)(l * 4 + b) * 3072 + j] = s; }
            __syncthreads();
        }
    }
    {
        float2* rope = (float2*)(ws + WS_ROPE);
        for (int i = bid * NTHR + tid; i < 4096 * 64; i += G * NTHR) {
            const int pos = i >> 6, j = i & 63;
            const float invf = powf(10000.f, -(float)(2 * j) / 128.f);
            const float ang = (float)pos * invf;
            const float k = rintf(ang * 0.15915494309189535f);
            float r = fmaf(-k, 6.2831854820251465f, ang); r = fmaf(-k, -1.7484555e-07f, r);
            rope[i] = make_float2(__cosf(r), __sinf(r));
        }
    }
}

template <bool FINAL>
__device__ __forceinline__ void phase_norm(const float* __restrict__ xin  , const bf16_t* __restrict__ slab  ,
                                           const float* __restrict__ gate_prev  , float* xout  ,
                                           const float* __restrict__ g, const float* __restrict__ mod  , int half, bf16_t* __restrict__ hout) {
    const int tid = opaque_tid(), lane = tid & 63, wid = tid >> 6;
    const int gw = blockIdx.x * 8 + wid, nw = gridDim.x * 8;
    f32x4 gg[4], sh[4], sc[4], gp[4];
#pragma unroll
    for (int i = 0; i < 4; ++i) { gg[i] = *(const f32x4*)(g + i * 256 + lane * 4); sh[i] = gg[i]; sc[i] = gg[i]; gp[i] = gg[i]; }
    int curb = -1;
    for (int row = gw; row < HROWS; row += nw) {
        const int b = row >> 12;
        if (b != curb) { curb = b;
#pragma unroll
            for (int i = 0; i < 4; ++i) { const int col = i * 256 + lane * 4;
                if constexpr (!FINAL) { const float* mb = mod + (size_t)(half * 2 + b) * 3072; sh[i] = *(const f32x4*)(mb + col); sc[i] = *(const f32x4*)(mb + 1024 + col); }
                if (slab) gp[i] = *(const f32x4*)(gate_prev + (size_t)b * 3072 + col); } }
        const float* xr = xin + (size_t)row * DM;
        f32x4 v[4]; float ss = 0.f;
#pragma unroll
        for (int i = 0; i < 4; ++i) v[i] = *(const f32x4*)(xr + i * 256 + lane * 4);
        if (slab) {
            u32x2 a0[4], a1[4];
#pragma unroll
            for (int i = 0; i < 4; ++i) { const int col = i * 256 + lane * 4;
                a0[i] = *(const u32x2*)(slab + (size_t)row * DM + col); a1[i] = *(const u32x2*)(slab + (size_t)(HROWS + row) * DM + col); }
#pragma unroll
            for (int i = 0; i < 4; ++i) {
                const f32x4 sa = {__uint_as_float(a0[i].x << 16) + __uint_as_float(a1[i].x << 16), __uint_as_float(a0[i].x & 0xffff0000u) + __uint_as_float(a1[i].x & 0xffff0000u),
                                  __uint_as_float(a0[i].y << 16) + __uint_as_float(a1[i].y << 16), __uint_as_float(a0[i].y & 0xffff0000u) + __uint_as_float(a1[i].y & 0xffff0000u)};
                v[i] = v[i] + gp[i] * sa; }
        }
        if (!FINAL && xout) {
#pragma unroll
            for (int i = 0; i < 4; ++i) *(f32x4*)(xout + (size_t)row * DM + i * 256 + lane * 4) = v[i];
        }
#pragma unroll
        for (int i = 0; i < 4; ++i) ss += v[i][0] * v[i][0] + v[i][1] * v[i][1] + v[i][2] * v[i][2] + v[i][3] * v[i][3];
#pragma unroll
        for (int o = 32; o > 0; o >>= 1) ss += __shfl_xor(ss, o);
        const float rinv = rsqrtf(ss * (1.f / DM) + EPS);
        if constexpr (FINAL) {
#pragma unroll
            for (int i = 0; i < 4; ++i) { const int col = i * 256 + lane * 4;
                *(f32x4*)(xout + (size_t)row * DM + col) = v[i] * rinv * gg[i]; }
        } else {
#pragma unroll
            for (int i = 0; i < 4; ++i) { const int col = i * 256 + lane * 4;
                float o0 = v[i][0] * rinv * gg[i][0] * (1.f + sc[i][0]) + sh[i][0], o1 = v[i][1] * rinv * gg[i][1] * (1.f + sc[i][1]) + sh[i][1];
                float o2 = v[i][2] * rinv * gg[i][2] * (1.f + sc[i][2]) + sh[i][2], o3 = v[i][3] * rinv * gg[i][3] * (1.f + sc[i][3]) + sh[i][3];
                u32x2 w; w.x = pk2(o0, o1); w.y = pk2(o2, o3);
                *(u32x2*)(hout + (size_t)row * DM + col) = w; }
        }
    }
}

struct MixP {
    const bf16_t* proj; bf16_t* st; float* dec; bf16_t* y; const float2* rope;
    const float* lbl; const float* hgrn_g; const float* ret_g; const float* conv_w; const float* conv_b; const float* dt_bias; const float* a_log;
    const float* dskip; const float* ssm_g; const float* w2; const float* b2; const float* gla_g; int layer;
};

__device__ __forceinline__ bf16x8 frag(LAS unsigned char* lds, int off, int ld, int r0, int ks, int lane) {
    return *(const LAS bf16x8*)(lds + off + (((r0 + (lane & 31)) * ld + 16 * ks + 8 * (lane >> 5)) << 1));
}
__device__ __forceinline__ int rowmap(int r, int lane) { return (r & 3) + 8 * (r >> 2) + 4 * (lane >> 5); }

__device__ __forceinline__ void conv16(LAS unsigned char* lds, int off, int ncols, int col, const float* cw, int seg, float (&out)[16]) {
    const LAS bf16_t* rp = (const LAS bf16_t*)(lds + off) + seg * 16 * ncols + col;
    float u[19];
#pragma unroll
    for (int k = 0; k < 19; ++k) u[k] = bf2f(rp[k * ncols]);
#pragma unroll
    for (int i = 0; i < 16; ++i) out[i] = silu_f(cw[4] + cw[0] * u[i] + cw[1] * u[i + 1] + cw[2] * u[i + 2] + cw[3] * u[i + 3]);
}
__device__ __forceinline__ void conv_w_load(const MixP& p, int chan, float* cw) {
    cw[0] = p.conv_w[chan]; cw[1] = p.conv_w[1024 + chan]; cw[2] = p.conv_w[2048 + chan]; cw[3] = p.conv_w[3072 + chan]; cw[4] = p.conv_b[chan];
}
template <int NCOLS, int NROWS> struct Stg { static constexpr int VPR = NCOLS / 8, NV = NROWS * VPR, NIT = (NV + NTHR - 1) / NTHR; };
template <int NCOLS, int NROWS>
__device__ __forceinline__ void stg_load(const bf16_t* proj, int grow0, int col0, int tid, int zrows, u32x4* r) {
    using S = Stg<NCOLS, NROWS>;
#pragma unroll
    for (int j = 0; j < S::NIT; ++j) { const int vi = tid + NTHR * j, row = vi / S::VPR, cv = vi % S::VPR;
        const bool ok = (vi < S::NV) && (row >= zrows);
        r[j] = ok ? *(const u32x4*)(proj + pidx(grow0 + row, col0 + cv * 8)) : (u32x4){0u, 0u, 0u, 0u}; }
}
template <int NCOLS, int NROWS>
__device__ __forceinline__ void stg_store(LAS unsigned char* lds, int off, int tid, const u32x4* r) {
    using S = Stg<NCOLS, NROWS>;
#pragma unroll
    for (int j = 0; j < S::NIT; ++j) { const int vi = tid + NTHR * j; if (vi < S::NV) *(LAS u32x4*)(lds + off + vi * 16) = r[j]; }
}
__device__ __forceinline__ void store16(LAS unsigned char* lds, int byteoff, const float (&v)[16]) {
    u32x4 a, b; a.x = pk2(v[0], v[1]); a.y = pk2(v[2], v[3]); a.z = pk2(v[4], v[5]); a.w = pk2(v[6], v[7]);
    b.x = pk2(v[8], v[9]); b.y = pk2(v[10], v[11]); b.z = pk2(v[12], v[13]); b.w = pk2(v[14], v[15]);
    *(LAS u32x4*)(lds + byteoff) = a; *(LAS u32x4*)(lds + byteoff + 16) = b;
}
__device__ __forceinline__ void store8(LAS unsigned char* lds, int byteoff, const float (&v)[8]) {
    u32x4 a; a.x = pk2(v[0], v[1]); a.y = pk2(v[2], v[3]); a.z = pk2(v[4], v[5]); a.w = pk2(v[6], v[7]);
    *(LAS u32x4*)(lds + byteoff) = a;
}

constexpr int NUNITS = 128 * 14;
struct Pref { u32x4 raw[11]; u32x4 st[8]; float aux[16]; };
template <int BR, int PASS>
__device__ __forceinline__ void load_A(const MixP& p, int bc, int hu, int tid, Pref& pf) {
    const bf16_t* P = p.proj; const int g0 = bc * 64;
    if constexpr (BR == 0) { stg_load<128, 64>(P, g0, C_AF + hu * 128, tid, 0, pf.raw + 0); stg_load<128, 64>(P, g0, C_AI + hu * 128, tid, 0, pf.raw + 2);
        if constexpr (PASS == 3) stg_load<128, 64>(P, g0, C_AQ + hu * 128, tid, 0, pf.raw + 4); }
    if constexpr (BR == 1) { stg_load<128, 64>(P, g0, C_RK + hu * 128, tid, 0, pf.raw + 0); stg_load<128, 64>(P, g0, C_RV + hu * 128, tid, 0, pf.raw + 2);
        if constexpr (PASS == 3) stg_load<128, 64>(P, g0, C_RQ + hu * 128, tid, 0, pf.raw + 4); }
    if constexpr (BR == 2) { const int zr = ((bc & 63) == 0) ? 3 : 0;
        stg_load<128, 67>(P, g0 - 3, C_XBC + 512 + hu * 128, tid, zr, pf.raw + 0); stg_load<256, 67>(P, g0 - 3, C_XBC + hu * 256, tid, zr, pf.raw + 3);
        if constexpr (PASS == 3) stg_load<128, 67>(P, g0 - 3, C_XBC + 768 + hu * 128, tid, zr, pf.raw + 8); }
    if constexpr (BR == 3) { stg_load<64, 64>(P, g0, C_GK + hu * 64, tid, 0, pf.raw + 0); stg_load<128, 64>(P, g0, C_GV + hu * 128, tid, 0, pf.raw + 1); stg_load<16, 64>(P, g0, C_LR, tid, 0, pf.raw + 3);
        if constexpr (PASS == 3) stg_load<64, 64>(P, g0, C_GQ + hu * 64, tid, 0, pf.raw + 4); }
}
template <int BR, int PASS>
__device__ __forceinline__ void load_B(const MixP& p, int bc, int hu, int tid, Pref& pf) {
    if constexpr (PASS == 3) {
        constexpr int DK = (BR == 3) ? 64 : 128, DV = (BR == 2) ? 256 : 128, NV = DV * DK / 8 / NTHR;
        const int st_off = (BR == 0) ? hu * 16384 : (BR == 1) ? 65536 + hu * 16384 : (BR == 2) ? 131072 + hu * 32768 : 196608 + hu * 8192;
        const bf16_t* stg = p.st + (size_t)bc * ST_PER_BC + st_off;
#pragma unroll
        for (int k = 0; k < NV; ++k) pf.st[k] = *(const u32x4*)(stg + (size_t)(tid + NTHR * k) * 8);
    }
    if constexpr (BR == 1) { const int j = tid & 63, seg = tid >> 6, chunk = bc & 63;
#pragma unroll
        for (int i = 0; i < 8; ++i) { const float2 c = p.rope[(chunk * 64 + seg * 8 + i) * 64 + j]; pf.aux[2 * i] = c.x; pf.aux[2 * i + 1] = c.y; } }
    if constexpr (BR == 2) { if (tid < 64) {
#pragma unroll
            for (int hh = 0; hh < 4; ++hh) pf.aux[hh] = bf2f(p.proj[pidx(bc * 64 + tid, C_DT + hu * 4 + hh)]); } }
    if constexpr (BR == 3) { const int cc = hu * 64 + (tid & 63);
#pragma unroll
        for (int r = 0; r < 16; ++r) pf.aux[r] = p.w2[r * 256 + cc]; }
}
template <int PASS>
__device__ __forceinline__ void load_A_any(const MixP& p, int i, int tid, Pref& pf) {
    const int bc = i / 14, u = i % 14;
    if (u < 4) load_A<0, PASS>(p, bc, u, tid, pf); else if (u < 8) load_A<1, PASS>(p, bc, u - 4, tid, pf);
    else if (u < 10) load_A<2, PASS>(p, bc, u - 8, tid, pf); else load_A<3, PASS>(p, bc, u - 10, tid, pf);
}
template <int PASS>
__device__ __forceinline__ void load_B_any(const MixP& p, int i, int tid, Pref& pf) {
    const int bc = i / 14, u = i % 14;
    if (u < 4) load_B<0, PASS>(p, bc, u, tid, pf); else if (u < 8) load_B<1, PASS>(p, bc, u - 4, tid, pf);
    else if (u < 10) load_B<2, PASS>(p, bc, u - 8, tid, pf); else load_B<3, PASS>(p, bc, u - 10, tid, pf);
}

template <int BR, int PASS>
__device__ __forceinline__ void mixer_unit(const MixP& p, LAS unsigned char* lds, int bc, int hu  ) {
    constexpr int DK = (BR == 3) ? 64 : 128, LDK = DK + 8, NH = (BR == 2) ? 4 : 1, DV = (BR == 2) ? 256 : 128, NT = DV / 128;
    constexpr bool VEC = (BR == 0 || BR == 3);
    const int tid = opaque_tid(), lane = tid & 63, wid = __builtin_amdgcn_readfirstlane(tid >> 6);
    const int chunk = bc & 63;
    const bf16_t* P = p.proj;
    LAS float* SM = (LAS float*)(lds + L_SM);
    LAS bf16_t* QI = (LAS bf16_t*)(lds + L_QI); LAS bf16_t* KI = (LAS bf16_t*)(lds + L_KI); LAS bf16_t* VT = (LAS bf16_t*)(lds + L_VT);
    const int st_off = (BR == 0) ? hu * 16384 : (BR == 1) ? 65536 + hu * 16384 : (BR == 2) ? 131072 + hu * 32768 : 196608 + hu * 8192;
    bf16_t* stg = p.st + (size_t)bc * ST_PER_BC + st_off;
    Pref pf;
    load_A<BR, PASS>(p, bc, hu, tid, pf);
    load_B<BR, PASS>(p, bc, hu, tid, pf);
    constexpr int NTG = (PASS == 3) ? NT : 1;
    const int gcol = (BR == 0) ? C_AG + hu * 128 : (BR == 1) ? C_RG + hu * 128 : (BR == 2) ? C_MZ + hu * 256 : C_GG + hu * 128;
    const float* gain = (BR == 0) ? p.hgrn_g + hu * 128 : (BR == 1) ? p.ret_g + hu * 128 : (BR == 2) ? p.ssm_g + hu * 256 : p.gla_g + hu * 128;
    bf16_t gt[NTG][16]; float gnv[NTG], dskv[NTG];
    float lb = 0.f, bb = 0.f, cwb[5], cwc[5], cwx[5], dtb[4], alg[4];
    if constexpr (BR == 0) { if (p.layer == 1) { const int cc = hu * 128 + (tid & 127); lb = 1.f / (1.f + __expf(p.lbl[cc] - p.lbl[512 + cc])); } }
    if constexpr (BR == 3) bb = p.b2[hu * 64 + (tid & 63)];
    if constexpr (BR == 2) { conv_w_load(p, 512 + hu * 128 + (tid & 127), cwb); if constexpr (PASS == 3) conv_w_load(p, 768 + hu * 128 + (tid & 127), cwc); conv_w_load(p, hu * 256 + (tid & 255), cwx);
#pragma unroll
        for (int hh = 0; hh < 4; ++hh) { dtb[hh] = p.dt_bias[hu * 4 + hh]; alg[hh] = p.a_log[hu * 4 + hh]; } }
    __builtin_amdgcn_sched_barrier(0);

    for (int urep = 0; urep < REP_UPREP; ++urep) {
    if constexpr (BR == 0) {
        constexpr int RQ = L_BIG, RF = (PASS == 3) ? L_BIG + 16384 : L_QI, RV = (PASS == 3) ? L_BIG + 32768 : L_QI + 16384;
        stg_store<128, 64>(lds, RF, tid, pf.raw + 0); stg_store<128, 64>(lds, RV, tid, pf.raw + 2);
        if constexpr (PASS == 3) stg_store<128, 64>(lds, RQ, tid, pf.raw + 4);
        __builtin_amdgcn_sched_barrier(0);
        const int d = tid & 127, seg = tid >> 7;
        __syncthreads();
        const LAS bf16_t* rF = (const LAS bf16_t*)(lds + RF) + seg * 16 * 128 + d;
        const LAS bf16_t* rQ = (const LAS bf16_t*)(lds + RQ) + seg * 16 * 128 + d;
        const LAS bf16_t* rV = (const LAS bf16_t*)(lds + RV) + seg * 16 * 128 + d;
        float cs[16], kk[16]; float run = 0.f;
#pragma unroll
        for (int i = 0; i < 16; ++i) { const float av = fmaxf(bf2f(rF[i * 128]), -60.f); const float e = __expf(-av), sg = __builtin_amdgcn_rcpf(1.f + e);
            const float f = lb + (1.f - lb) * sg; run += __logf(f); cs[i] = run; kk[i] = (1.f - lb) * e * sg; }
        SM[SM_SEG + seg * 128 + d] = run;
        __syncthreads();
        const float t0 = SM[SM_SEG + d], t1 = SM[SM_SEG + 128 + d], t2 = SM[SM_SEG + 256 + d], t3 = SM[SM_SEG + 384 + d];
        const float off = (seg == 0) ? 0.f : (seg == 1) ? t0 : (seg == 2) ? t0 + t1 : t0 + t1 + t2;
        const float ref = t0 + t1, clast = ref + t2 + t3;
        if (seg == 0) { SM[SM_REF + d] = ref; SM[SM_CLAST + d] = clast; SM[SM_RSS + d] = (PASS == 3) ? __expf(ref) : __expf(clast - ref); }
        float kv[16];
#pragma unroll
        for (int i = 0; i < 16; ++i) { const float c = off + cs[i]; kv[i] = kk[i] * __expf(fminf(ref - c, 80.f));
            if constexpr (PASS == 3) { KI[(seg * 16 + i) * LDK + d] = f2bf(kv[i]);
                const float q = bf2f(rQ[i * 128]); QI[(seg * 16 + i) * LDK + d] = f2bf(silu_f(q) * __expf(fminf(c - ref, 80.f))); } }
        if constexpr (PASS == 1) store16(lds, L_BIG + (d * 72 + seg * 16) * 2, kv);
        unsigned vv[16];
#pragma unroll
        for (int i = 0; i < 16; ++i) vv[i] = rV[i * 128];
        u32x4 a, b; a.x = vv[0] | (vv[1] << 16); a.y = vv[2] | (vv[3] << 16); a.z = vv[4] | (vv[5] << 16); a.w = vv[6] | (vv[7] << 16);
        b.x = vv[8] | (vv[9] << 16); b.y = vv[10] | (vv[11] << 16); b.z = vv[12] | (vv[13] << 16); b.w = vv[14] | (vv[15] << 16);
        *(LAS u32x4*)(lds + L_VT + (d * 72 + seg * 16) * 2) = a; *(LAS u32x4*)(lds + L_VT + (d * 72 + seg * 16) * 2 + 16) = b;
    }
    if constexpr (BR == 1) {
        constexpr int RQ = L_BIG, RK = (PASS == 3) ? L_BIG + 16384 : L_QI, RV = (PASS == 3) ? L_BIG + 32768 : L_QI + 16384;
        const int j = tid & 63, seg = tid >> 6;
        float2 cssn[8];
#pragma unroll
        for (int i = 0; i < 8; ++i) cssn[i] = make_float2(pf.aux[2 * i], pf.aux[2 * i + 1]);
        stg_store<128, 64>(lds, RK, tid, pf.raw + 0); stg_store<128, 64>(lds, RV, tid, pf.raw + 2);
        if constexpr (PASS == 3) stg_store<128, 64>(lds, RQ, tid, pf.raw + 4);
        __builtin_amdgcn_sched_barrier(0);
        const float lg = log1pf(-exp2f(-(5.f + (float)hu)));
        if (tid < 64) { SM[SM_CUM + tid] = (float)(tid + 1) * lg; SM[SM_DT + tid] = 1.f; }
        __syncthreads();
        float k1[8], k2[8];
#pragma unroll
        for (int i = 0; i < 8; ++i) { const int t = seg * 8 + i;
            const LAS bf16_t* rk = (const LAS bf16_t*)(lds + RK) + t * 128 + j;
            const float ka = bf2f(rk[0]) * 0.08838834764831845f, kb = bf2f(rk[64]) * 0.08838834764831845f;
            k1[i] = ka * cssn[i].x - kb * cssn[i].y; k2[i] = ka * cssn[i].y + kb * cssn[i].x;
            if constexpr (PASS == 3) { const LAS bf16_t* rq = (const LAS bf16_t*)(lds + RQ) + t * 128 + j;
                const float qa = bf2f(rq[0]), qb = bf2f(rq[64]);
                QI[t * LDK + j] = f2bf(qa * cssn[i].x - qb * cssn[i].y); QI[t * LDK + j + 64] = f2bf(qa * cssn[i].y + qb * cssn[i].x);
                KI[t * LDK + j] = f2bf(k1[i]); KI[t * LDK + j + 64] = f2bf(k2[i]); } }
        if constexpr (PASS == 1) { store8(lds, L_BIG + (j * 72 + seg * 8) * 2, k1); store8(lds, L_BIG + ((j + 64) * 72 + seg * 8) * 2, k2); }
        const int v = tid & 127, s4 = tid >> 7; float vv[16];
#pragma unroll
        for (int i = 0; i < 16; ++i) { const int s = s4 * 16 + i; float x = bf2f(((const LAS bf16_t*)(lds + RV))[s * 128 + v]);
            if constexpr (PASS == 1) x *= __expf((float)(63 - s) * lg);
            vv[i] = x; }
        store16(lds, L_VT + (v * 72 + s4 * 16) * 2, vv);
    }
    if constexpr (BR == 2) {
        constexpr int RB = (PASS == 3) ? L_BIG : L_QI, RC = L_BIG + 17152, RX = (PASS == 3) ? L_BIG + 34304 : L_BIG + 18432;
        float dtr[4];
#pragma unroll
        for (int hh = 0; hh < 4; ++hh) dtr[hh] = pf.aux[hh];
        stg_store<128, 67>(lds, RB, tid, pf.raw + 0); stg_store<256, 67>(lds, RX, tid, pf.raw + 3);
        if constexpr (PASS == 3) stg_store<128, 67>(lds, RC, tid, pf.raw + 8);
        __builtin_amdgcn_sched_barrier(0);
        if (tid < 64) {
#pragma unroll
            for (int hh = 0; hh < 4; ++hh) {
                const float dt = softplus_f(dtr[hh] + dtb[hh]);
                float la = -dt * __expf(alg[hh]);
#pragma unroll
                for (int o = 1; o < 64; o <<= 1) { const float yv = __shfl_up(la, o); if (tid >= o) la += yv; }
                SM[SM_CUM + hh * 64 + tid] = la; SM[SM_DT + hh * 64 + tid] = dt; }
        }
        __syncthreads();
        { const int n = tid & 127, seg = tid >> 7; float o[16];
          conv16(lds, RB, 128, n, cwb, seg, o);
          if constexpr (PASS == 3) {
#pragma unroll
              for (int i = 0; i < 16; ++i) KI[(seg * 16 + i) * LDK + n] = f2bf(o[i]);
              conv16(lds, RC, 128, n, cwc, seg, o);
#pragma unroll
              for (int i = 0; i < 16; ++i) QI[(seg * 16 + i) * LDK + n] = f2bf(o[i]);
          } else store16(lds, L_BIG + (n * 72 + seg * 16) * 2, o);
        }
        { const int v = tid & 255, s2 = tid >> 8, hh = v >> 6;
#pragma unroll
          for (int r = 0; r < 2; ++r) { const int seg = s2 * 2 + r; float o[16];
              conv16(lds, RX, 256, v, cwx, seg, o);
              if constexpr (PASS == 1) { const float cl = SM[SM_CUM + hh * 64 + 63];
#pragma unroll
                  for (int i = 0; i < 16; ++i) { const int s = seg * 16 + i; o[i] *= __expf(cl - SM[SM_CUM + hh * 64 + s]) * SM[SM_DT + hh * 64 + s]; } }
              store16(lds, L_VT + (v * 72 + seg * 16) * 2, o); }
        }
    }
    if constexpr (BR == 3) {
        constexpr int RQ = L_BIG, RK = (PASS == 3) ? L_BIG + 8192 : L_QI, RV = (PASS == 3) ? L_BIG + 16384 : L_QI + 8192, RL = (PASS == 3) ? L_BIG + 32768 : L_QI + 24576;
        const int d = tid & 63, seg = tid >> 6, cc = hu * 64 + d;
        float w2r[16];
#pragma unroll
        for (int r = 0; r < 16; ++r) w2r[r] = pf.aux[r];
        stg_store<64, 64>(lds, RK, tid, pf.raw + 0); stg_store<128, 64>(lds, RV, tid, pf.raw + 1); stg_store<16, 64>(lds, RL, tid, pf.raw + 3);
        if constexpr (PASS == 3) stg_store<64, 64>(lds, RQ, tid, pf.raw + 4);
        __builtin_amdgcn_sched_barrier(0);
        __syncthreads();
        float cs[8]; float run = 0.f;
#pragma unroll
        for (int i = 0; i < 8; ++i) { const int t = seg * 8 + i; const LAS bf16x8* lp = (const LAS bf16x8*)(lds + RL + t * 32);
            const bf16x8 l0 = lp[0], l1 = lp[1]; float gk = bb;
#pragma unroll
            for (int r = 0; r < 8; ++r) { gk += w2r[r] * bf2f((bf16_t)l0[r]); gk += w2r[8 + r] * bf2f((bf16_t)l1[r]); }
            run += logsig_f(gk) * (1.f / 16.f); cs[i] = run; }
        SM[SM_SEG + seg * 64 + d] = run;
        __syncthreads();
        float off = 0.f, ref = 0.f, clast = 0.f;
#pragma unroll
        for (int s = 0; s < 8; ++s) { const float tv = SM[SM_SEG + s * 64 + d]; if (s < seg) off += tv; if (s < 4) ref += tv; clast += tv; }
        if (seg == 0) { SM[SM_REF + d] = ref; SM[SM_CLAST + d] = clast; SM[SM_RSS + d] = (PASS == 3) ? __expf(ref) : __expf(clast - ref); }
        float kv[8];
#pragma unroll
        for (int i = 0; i < 8; ++i) { const int t = seg * 8 + i; const float c = off + cs[i];
            kv[i] = bf2f(((const LAS bf16_t*)(lds + RK))[t * 64 + d]) * __expf(fminf(ref - c, 80.f));
            if constexpr (PASS == 3) { KI[t * LDK + d] = f2bf(kv[i]); QI[t * LDK + d] = f2bf(bf2f(((const LAS bf16_t*)(lds + RQ))[t * 64 + d]) * 0.125f * __expf(fminf(c - ref, 80.f))); } }
        if constexpr (PASS == 1) store8(lds, L_BIG + (d * 72 + seg * 8) * 2, kv);
        const int v = tid & 127, s4 = tid >> 7; unsigned vv[16];
#pragma unroll
        for (int i = 0; i < 16; ++i) vv[i] = ((const LAS bf16_t*)(lds + RV))[(s4 * 16 + i) * 128 + v];
        u32x4 a, b; a.x = vv[0] | (vv[1] << 16); a.y = vv[2] | (vv[3] << 16); a.z = vv[4] | (vv[5] << 16); a.w = vv[6] | (vv[7] << 16);
        b.x = vv[8] | (vv[9] << 16); b.y = vv[10] | (vv[11] << 16); b.z = vv[12] | (vv[13] << 16); b.w = vv[14] | (vv[15] << 16);
        *(LAS u32x4*)(lds + L_VT + (v * 72 + s4 * 16) * 2) = a; *(LAS u32x4*)(lds + L_VT + (v * 72 + s4 * 16) * 2 + 16) = b;
    }
    __syncthreads();
    }
    for (int urep = 0; urep < REP_UCORE; ++urep) {
    if constexpr (PASS == 1) {
        constexpr int NTN = DV / 32, NTILES = (DK / 32) * NTN, NTL = NTILES / 8;
        f32x16 hacc[NTL];
#pragma unroll
        for (int i = 0; i < NTL; ++i) {
            const int ti = wid + 8 * i, tm = ti / NTN, tn = ti % NTN;
#pragma unroll
            for (int r = 0; r < 16; ++r) hacc[i][r] = 0.f;
#pragma unroll
            for (int ks = 0; ks < 4; ++ks) hacc[i] = __builtin_amdgcn_mfma_f32_32x32x16_bf16(frag(lds, L_BIG, 72, tm * 32, ks, lane), frag(lds, L_VT, 72, tn * 32, ks, lane), hacc[i], 0, 0, 0);
            if constexpr (VEC) {
#pragma unroll
                for (int r = 0; r < 16; ++r) { const int d = tm * 32 + rowmap(r, lane); hacc[i][r] *= SM[SM_RSS + d]; }
            }
        }
        float decv = 0.f;
        if constexpr (BR == 0) { if (tid < 128) decv = __expf(SM[SM_CLAST + tid]); }
        if constexpr (BR == 3) { if (tid < 64) decv = __expf(SM[SM_CLAST + tid]); }
        if constexpr (BR == 2) { if (tid < 4) decv = __expf(SM[SM_CUM + tid * 64 + 63]); }
        __syncthreads();
        constexpr int LDH = DK + 8, H_OFF = (BR == 2) ? L_BIG : L_VT;
#pragma unroll
        for (int i = 0; i < NTL; ++i) {
            const int ti = wid + 8 * i, tm = ti / NTN, tn = ti % NTN;
            const int v = tn * 32 + (lane & 31);
#pragma unroll
            for (int rg = 0; rg < 4; ++rg) { const int d0 = tm * 32 + 8 * rg + 4 * (lane >> 5);
                u32x2 w; w.x = pk2(hacc[i][rg * 4 + 0], hacc[i][rg * 4 + 1]); w.y = pk2(hacc[i][rg * 4 + 2], hacc[i][rg * 4 + 3]);
                *(LAS u32x2*)(lds + H_OFF + (v * LDH + d0) * 2) = w; }
        }
        __syncthreads();
#pragma unroll
        for (int k = 0; k < DV * DK / 8 / NTHR; ++k) { const int vi = tid + NTHR * k, v = vi / (DK / 8), c = vi % (DK / 8);
            const u32x4 w = *(const LAS u32x4*)(lds + H_OFF + (v * LDH + c * 8) * 2);
            *(u32x4*)(stg + (size_t)vi * 8) = w; }
        float* dec = p.dec + (size_t)bc * 1024;
        if constexpr (BR == 0) { if (tid < 128) dec[hu * 128 + tid] = decv; }
        if constexpr (BR == 3) { if (tid < 64) dec[512 + hu * 64 + tid] = decv; }
        if constexpr (BR == 2) { if (tid < 4) dec[768 + hu * 4 + tid] = decv; }
    } else {
        constexpr int NCT = DV / 32;
    if constexpr (PASS == 3) {
#pragma unroll
            for (int nt = 0; nt < NT; ++nt) { const int ct = (wid & 3) + 4 * nt;
                gnv[nt] = gain[ct * 32 + (lane & 31)]; dskv[nt] = (BR == 2) ? p.dskip[hu * 4 + (ct >> 1)] : 0.f;
#pragma unroll
                for (int r = 0; r < 16; ++r) gt[nt][r] = P[pidx(bc * 64 + (wid >> 2) * 32 + rowmap(r, lane), gcol + ct * 32 + (lane & 31))]; }
        }
        __builtin_amdgcn_sched_barrier(0);
        {
            constexpr int NVEC = DV * DK / 8, VPR = DK / 8;
#pragma unroll
            for (int k = 0; k < NVEC / NTHR; ++k) { const int vi = tid + NTHR * k; const int v = vi / VPR, d0 = (vi % VPR) * 8;
                u32x4 raw = pf.st[k];
                if constexpr (VEC) { unsigned w[4] = {raw.x, raw.y, raw.z, raw.w};
#pragma unroll
                    for (int q = 0; q < 4; ++q) { const float lo = __uint_as_float(w[q] << 16) * SM[SM_RSS + d0 + 2 * q], hi = __uint_as_float(w[q] & 0xffff0000u) * SM[SM_RSS + d0 + 2 * q + 1];
                        w[q] = pk2(lo, hi); }
                    raw.x = w[0]; raw.y = w[1]; raw.z = w[2]; raw.w = w[3]; }
                *(LAS u32x4*)(lds + L_BIG + (v * LDK + d0) * 2) = raw; }
        }
        __builtin_amdgcn_sched_barrier(0);
        __syncthreads();
        const int tm = wid >> 2, tnb = wid & 3;
        f32x16 acc[NT];
#pragma unroll
        for (int nt = 0; nt < NT; ++nt)
#pragma unroll
            for (int r = 0; r < 16; ++r) acc[nt][r] = 0.f;
#pragma unroll
        for (int ks = 0; ks < DK / 16; ++ks) { const bf16x8 af = frag(lds, L_QI, LDK, tm * 32, ks, lane);
#pragma unroll
            for (int nt = 0; nt < NT; ++nt) acc[nt] = __builtin_amdgcn_mfma_f32_32x32x16_bf16(af, frag(lds, L_BIG, LDK, (tnb + 4 * nt) * 32, ks, lane), acc[nt], 0, 0, 0); }
        if constexpr (!VEC) {
#pragma unroll
            for (int nt = 0; nt < NT; ++nt) { const int hh = (NH == 1) ? 0 : ((tnb + 4 * nt) >> 1);
#pragma unroll
                for (int r = 0; r < 16; ++r) acc[nt][r] *= __expf(SM[SM_CUM + hh * 64 + tm * 32 + rowmap(r, lane)]); }
        }
        constexpr int P_OFF = (NH == 1) ? L_BIG + 34816 : L_BIG;
        f32x16 sc;
#pragma unroll
        for (int r = 0; r < 16; ++r) sc[r] = 0.f;
        const int w4 = wid & 3, stm = w4 >> 1, stn = w4 & 1, whalf = wid >> 2;
#pragma unroll
        for (int ks = 0; ks < DK / 16; ++ks) sc = __builtin_amdgcn_mfma_f32_32x32x16_bf16(frag(lds, L_QI, LDK, stm * 32, ks, lane), frag(lds, L_KI, LDK, stn * 32, ks, lane), sc, 0, 0, 0);
        if constexpr (NH != 1) __syncthreads();
        {
            const int s = stn * 32 + (lane & 31);
            if constexpr (NH == 1) {
                float cums = 0.f, dts = 1.f;
                if constexpr (!VEC) { cums = SM[SM_CUM + s]; dts = SM[SM_DT + s]; }
#pragma unroll
                for (int r8 = 0; r8 < 8; ++r8) { const int rlo = r8, rhi = r8 + 8; const int r = whalf ? rhi : rlo; const int t = stm * 32 + (whalf ? rowmap(rhi, lane) : rowmap(rlo, lane));
                    float val = whalf ? sc[rhi] : sc[rlo]; (void)r;
                    if constexpr (!VEC) { const float ex = (s <= t) ? SM[SM_CUM + t] - cums : 0.f; val *= __expf(ex) * dts; }
                    val = (s <= t) ? val : 0.f;
                    *(LAS bf16_t*)(lds + P_OFF + (t * 72 + s) * 2) = f2bf(val); }
            } else {
#pragma unroll
                for (int h2 = 0; h2 < NH / 2; ++h2) { const int hh = whalf * (NH / 2) + h2;
                    const float cums = SM[SM_CUM + hh * 64 + s], dts = SM[SM_DT + hh * 64 + s];
#pragma unroll
                    for (int r = 0; r < 16; ++r) { const int t = stm * 32 + rowmap(r, lane);
                        float val = sc[r];
                        const float ex = (s <= t) ? SM[SM_CUM + hh * 64 + t] - cums : 0.f; val *= __expf(ex) * dts;
                        val = (s <= t) ? val : 0.f;
                        *(LAS bf16_t*)(lds + P_OFF + ((hh * 64 + t) * 72 + s) * 2) = f2bf(val); } }
            }
        }
        __syncthreads();
#pragma unroll
        for (int nt = 0; nt < NT; ++nt) { const int hh = (NH == 1) ? 0 : ((tnb + 4 * nt) >> 1);
#pragma unroll
            for (int ks = 0; ks < 4; ++ks) acc[nt] = __builtin_amdgcn_mfma_f32_32x32x16_bf16(frag(lds, P_OFF + hh * 9216, 72, tm * 32, ks, lane), frag(lds, L_VT, 72, (tnb + 4 * nt) * 32, ks, lane), acc[nt], 0, 0, 0); }
        const int ycol = (BR == 0) ? hu * 128 : (BR == 1) ? 512 + hu * 128 : (BR == 2) ? 1024 + hu * 256 : 1536 + hu * 128;
#pragma unroll
        for (int nt = 0; nt < NT; ++nt) { const int ct = tnb + 4 * nt, v = ct * 32 + (lane & 31);
            const float dsk = dskv[nt];
            float sq[16];
#pragma unroll
            for (int r = 0; r < 16; ++r) { const int t = tm * 32 + rowmap(r, lane);
                float val = acc[nt][r];
                if constexpr (BR == 2) { val = (val + dsk * bf2f(VT[v * 72 + t])) * silu_f(bf2f(gt[nt][r])); acc[nt][r] = val; }
                sq[r] = val * val; }
            const bool b4 = lane & 16, b3 = lane & 8, b2 = lane & 4, b1 = lane & 2;
#pragma unroll
            for (int i = 0; i < 8; ++i) { const float lo = sq[i], hi = sq[i + 8]; sq[i] = (b4 ? hi : lo) + __shfl_xor(b4 ? lo : hi, 16); }
#pragma unroll
            for (int i = 0; i < 4; ++i) { const float lo = sq[i], hi = sq[i + 4]; sq[i] = (b3 ? hi : lo) + __shfl_xor(b3 ? lo : hi, 8); }
#pragma unroll
            for (int i = 0; i < 2; ++i) { const float lo = sq[i], hi = sq[i + 2]; sq[i] = (b2 ? hi : lo) + __shfl_xor(b2 ? lo : hi, 4); }
            { const float lo = sq[0], hi = sq[1]; sq[0] = (b1 ? hi : lo) + __shfl_xor(b1 ? lo : hi, 2); }
            sq[0] += __shfl_xor(sq[0], 1);
            const int rr = (b4 ? 8 : 0) + (b3 ? 4 : 0) + (b2 ? 2 : 0) + (b1 ? 1 : 0);
            if ((lane & 1) == 0) SM[SM_RSS + ct * 64 + tm * 32 + rowmap(rr, lane)] = sq[0];
        }
        __syncthreads();
        if (tid < 64) { float tot = 0.f;
#pragma unroll
            for (int q = 0; q < NCT; ++q) tot += SM[SM_RSS + q * 64 + tid];
            SM[SM_SEG + tid] = rsqrtf(tot * (1.f / DV) + EPS); }
        __syncthreads();
        float rinv[16];
#pragma unroll
        for (int r = 0; r < 16; ++r) rinv[r] = SM[SM_SEG + tm * 32 + rowmap(r, lane)];
        __syncthreads();
#pragma unroll
        for (int nt = 0; nt < NT; ++nt) { const int ct = tnb + 4 * nt, v = ct * 32 + (lane & 31);
            const float gn = gnv[nt];
#pragma unroll
            for (int r = 0; r < 16; ++r) { const int t = tm * 32 + rowmap(r, lane);
                float o = acc[nt][r] * rinv[r] * gn;
                if constexpr (BR != 2) o *= silu_f(bf2f(gt[nt][r]));
                p.y[(size_t)(bc * 64 + t) * DI + ycol + v] = f2bf(o); }
        }
    }
    }
}

template <int PASS>
__device__ __forceinline__ void phase_mixer(const MixP& p, LAS unsigned char* lds) {
#pragma unroll 1
    for (int i = blockIdx.x; i < NUNITS; i += gridDim.x) {
        const int bc = i / 14, u = i % 14;
        if (u < 4) mixer_unit<0, PASS>(p, lds, bc, u);
        else if (u < 8) mixer_unit<1, PASS>(p, lds, bc, u - 4);
        else if (u < 10) mixer_unit<2, PASS>(p, lds, bc, u - 8);
        else mixer_unit<3, PASS>(p, lds, bc, u - 10);
    }
}

__device__ __forceinline__ void phase_scan(bf16_t* st, const float* dec, LAS unsigned char* lds) {
    constexpr int BPB = ST_PER_BC / 2048;
    LAS float* D = (LAS float*)lds;
    const int tid = opaque_tid();
#pragma unroll 1
    for (int blk = blockIdx.x; blk < 2 * BPB; blk += gridDim.x) {
        const int bl = blk / BPB, eb = (blk % BPB) * 2048, e0 = eb + tid * 4;
        const float* dpb = dec + (size_t)bl * 64 * 1024;
        int mode, dsel = 0;
        if (eb < 65536) { mode = 0; const int dbase = (eb >> 14) * 128;
            for (int k = tid; k < 64 * 32; k += NTHR) { const int c = k >> 5, q = k & 31; *(LAS f32x4*)(D + c * 128 + q * 4) = *(const f32x4*)(dpb + (size_t)c * 1024 + dbase + q * 4); }
            dsel = e0 & 127; }
        else if (eb < 131072) { mode = 1; }
        else if (eb < 196608) { mode = 2; const int r = eb - 131072; const int g = r >> 15;
            const int head = g * 4 + (((r & 32767) >> 7) >> 6);
            if (tid < 64) D[tid] = dpb[(size_t)tid * 1024 + 768 + head]; }
        else { mode = 3; const int r = eb - 196608; const int dbase = 512 + (r >> 13) * 64;
            for (int k = tid; k < 64 * 16; k += NTHR) { const int c = k >> 4, q = k & 15; *(LAS f32x4*)(D + c * 64 + q * 4) = *(const f32x4*)(dpb + (size_t)c * 1024 + dbase + q * 4); }
            dsel = e0 & 63; }
        float cfac = 0.f;
        if (mode == 1) { const int h = (eb - 65536) >> 14; cfac = __expf(64.f * log1pf(-exp2f(-(5.f + (float)h)))); }
        __syncthreads();
        float s0 = 0.f, s1 = 0.f, s2 = 0.f, s3 = 0.f;
        bf16_t* ptr = st + (size_t)bl * 64 * ST_PER_BC + e0;
#pragma unroll 1
        for (int c0 = 0; c0 < 64; c0 += 8) {
            u32x2 hv[8];
#pragma unroll
            for (int j = 0; j < 8; ++j) hv[j] = *(const u32x2*)(ptr + (size_t)(c0 + j) * ST_PER_BC);
            __builtin_amdgcn_sched_barrier(0);
#pragma unroll
            for (int j = 0; j < 8; ++j) {
                f32x4 dv;
                if (mode == 0) dv = *(const LAS f32x4*)(D + (c0 + j) * 128 + dsel);
                else if (mode == 3) dv = *(const LAS f32x4*)(D + (c0 + j) * 64 + dsel);
                else if (mode == 1) dv = (f32x4){cfac, cfac, cfac, cfac};
                else { const float d = D[c0 + j]; dv = (f32x4){d, d, d, d}; }
                u32x2 w; w.x = pk2(s0, s1); w.y = pk2(s2, s3);
                *(u32x2*)(ptr + (size_t)(c0 + j) * ST_PER_BC) = w;
                s0 = s0 * dv[0] + __uint_as_float(hv[j].x << 16); s1 = s1 * dv[1] + __uint_as_float(hv[j].x & 0xffff0000u);
                s2 = s2 * dv[2] + __uint_as_float(hv[j].y << 16); s3 = s3 * dv[3] + __uint_as_float(hv[j].y & 0xffff0000u);
            }
        }
        __syncthreads();
    }
}

#define XB_TMO      128
#define XB_XCNT(j)  (256  + 64 * (j))
#define XB_XSUB(j)  (1280 + 64 * (j))
#define XB_XGEN(j)  (2304 + 64 * (j))
#define XB_TOP      3328
#define XB_TOPGEN   3392
#define XCD_BAR_WORDS 3456
#define XB_SPIN_CAP (1u << 18)
__device__ __forceinline__ unsigned xb_ld(unsigned* p)              { return __hip_atomic_load(p, __ATOMIC_RELAXED, __HIP_MEMORY_SCOPE_AGENT); }
__device__ __forceinline__ unsigned xb_add(unsigned* p, unsigned v) { return __hip_atomic_fetch_add(p, v, __ATOMIC_RELAXED, __HIP_MEMORY_SCOPE_AGENT); }
__device__ __forceinline__ unsigned xb_xcc_id() { return (unsigned)__builtin_amdgcn_s_getreg((3 << 11) | 20) & 0xFu; }
#define XB_SPIN(cond, bar) do { unsigned _sp = 0; while (cond) { __builtin_amdgcn_s_sleep(1); \
    if ((++_sp & 255u) == 0u) { if (xb_ld(&(bar)[XB_TMO])) break; if (_sp > XB_SPIN_CAP) { atomicAdd(&(bar)[XB_TMO], 1u); break; } } } } while (0)
struct XcdBarrier { unsigned* bar; unsigned x; volatile LAS unsigned* st; };
__device__ __forceinline__ XcdBarrier xcd_barrier_post(unsigned* bar, volatile LAS unsigned* st) {
    XcdBarrier b; b.bar = bar; b.x = xb_xcc_id(); b.st = st;
    if (threadIdx.x == 0) (void)xb_add(&bar[XB_XCNT(b.x)], 1u);
    return b;
}
__device__ __forceinline__ void xcd_barrier_complete(unsigned* bar, unsigned x, unsigned& nloc, unsigned& nx) {
    const unsigned G = gridDim.x * gridDim.y * gridDim.z;
    unsigned sum, cnt, mine, sp = 0u;
    for (;;) {
        sum = 0u; cnt = 0u; mine = 0u;
#pragma unroll
        for (unsigned j = 0; j < 16; ++j) { const unsigned c = xb_ld(&bar[XB_XCNT(j)]); sum += c; cnt += (c > 0u) ? 1u : 0u; mine = (j == x) ? c : mine; }
        if (sum == G) break;
        __builtin_amdgcn_s_sleep(1);
        if ((++sp & 255u) == 0u) { if (xb_ld(&bar[XB_TMO])) break; if (sp > XB_SPIN_CAP) { atomicAdd(&bar[XB_TMO], 1u); break; } }
    }
    nloc = mine > 0u ? mine : 1u; nx = cnt > 0u ? cnt : 1u;
}
__device__ __forceinline__ void xcd_barrier(const XcdBarrier& b) {
    asm volatile("s_waitcnt vmcnt(0)" ::: "memory");
    __syncthreads();
    if (threadIdx.x == 0) {
        unsigned* bar = b.bar;
        __builtin_amdgcn_s_waitcnt(0);
        unsigned nloc = b.st[0], nx = b.st[1];
        if (nloc == 0u) { xcd_barrier_complete(bar, b.x, nloc, nx); b.st[0] = nloc; b.st[1] = nx; }
        const unsigned old = xb_add(&bar[XB_XSUB(b.x)], 1u);
        const unsigned gen = old / nloc;
        if (old + 1u == (gen + 1u) * nloc) {
            __builtin_amdgcn_fence(__ATOMIC_RELEASE, "agent");
            asm volatile("s_waitcnt vmcnt(0)" ::: "memory");
            const unsigned og = xb_add(&bar[XB_TOP], 1u);
            const unsigned tg = og / nx;
            if (og + 1u == (tg + 1u) * nx) xb_add(&bar[XB_TOPGEN], 1u);
            else XB_SPIN(xb_ld(&bar[XB_TOPGEN]) == tg, bar);
            __builtin_amdgcn_fence(__ATOMIC_ACQUIRE, "agent");
            xb_add(&bar[XB_XGEN(b.x)], 1u);
            asm volatile("s_waitcnt vmcnt(0)" ::: "memory");
        } else {
            XB_SPIN(xb_ld(&bar[XB_XGEN(b.x)]) == gen, bar);
            __builtin_amdgcn_fence(__ATOMIC_ACQUIRE, "agent");
            asm volatile("s_waitcnt vmcnt(0)" ::: "memory");
        }
    }
    __syncthreads();
}

__global__ void __launch_bounds__(NTHR, 2) fwd_megakernel(Args a) {
    extern __shared__ __attribute__((aligned(16))) unsigned char shm[];
    LAS unsigned char* lds = (LAS unsigned char*)shm;
    cg::grid_group grid = cg::this_grid();
    unsigned char* ws = a.ws;
    const int G = gridDim.x;

    {
        volatile LAS unsigned* stw = (volatile LAS unsigned*)(lds + L_BARST);
        if (threadIdx.x < 2) stw[threadIdx.x] = 0u;
        __syncthreads();
    }
    const XcdBarrier gbar = xcd_barrier_post((unsigned*)(ws + WS_BAR), (volatile LAS unsigned*)(lds + L_BARST));
    for (int rep = 0; rep < REP_PREP; ++rep) { phase_prep(a, lds); if (rep == 0) grid.sync(); else xcd_barrier(gbar); }

    bf16_t* hbuf = (bf16_t*)(ws + WS_HY); bf16_t* ybuf = (bf16_t*)(ws + WS_HY);
    bf16_t* proj = (bf16_t*)(ws + WS_PROJ); bf16_t* st = (bf16_t*)(ws + WS_ST); float* dec = (float*)(ws + WS_DEC);
    const float* mod = (const float*)(ws + WS_MOD);

#pragma unroll 1
    for (int half = 0; half < 2; ++half) {
        const size_t xoff = (size_t)half * HROWS * DM;
#pragma unroll 1
        for (int l = 0; l < DEPTH; ++l) {
            const float* modl = mod + (size_t)l * 4 * 3072;
            bf16_t* slab = (bf16_t*)(ws + WS_PROJ);
            if (l == 0) { phase_norm<false>(a.x + xoff, nullptr, nullptr, nullptr, a.norm_g, modl, half, hbuf); if (half == 0) phase_wcvt(a, lds); }
            else phase_norm<false>(a.x + xoff, slab, mod + (size_t)(half * 2) * 3072 + 2048, a.out + xoff, a.norm_g + l * DM, modl, half, hbuf);
            xcd_barrier(gbar);
            for (int rep = 0; rep < REP_G1; ++rep) {
                pg8::Gemm g{hbuf, (const bf16_t*)(ws + WS_WIN) + (size_t)l * LDP * DM, HROWS, LDP, DM, DM};
                pg8::StaticOrder S; S.init(HROWS, LDP, G, (int)blockIdx.x);
                pg8::EpiProj E{proj, LDP};
                pg8::gemm_phase<pg8::EpiProj, pg8::StaticOrder>(lds, g, S, E);
                xcd_barrier(gbar);
            }
            MixP p;
            p.proj = proj; p.st = st; p.dec = dec; p.y = ybuf; p.rope = (const float2*)(ws + WS_ROPE);
            p.lbl = a.lb_logits; p.hgrn_g = a.hgrn_g + l * 512; p.ret_g = a.ret_g + l * 512; p.conv_w = a.conv_w + l * 4096; p.conv_b = a.conv_b + l * 1024;
            p.dt_bias = a.dt_bias + l * 8; p.a_log = a.a_log + l * 8; p.dskip = a.dskip + l * 8; p.ssm_g = a.ssm_g + l * 512;
            p.w2 = a.w_gk2 + l * 16 * 256; p.b2 = a.b_gk2 + l * 256; p.gla_g = a.gla_g + l * 512; p.layer = l;
            for (int rep = 0; rep < REP_M12; ++rep) { phase_mixer<1>(p, lds); xcd_barrier(gbar); phase_scan(st, dec, lds); xcd_barrier(gbar); }
            for (int rep = 0; rep < REP_M3; ++rep) { phase_mixer<3>(p, lds); xcd_barrier(gbar); }
            for (int rep = 0; rep < REP_G2; ++rep) {
                pg8::Gemm g{ybuf, (const bf16_t*)(ws + WS_WOUT) + (size_t)l * DM * DI, HROWS, DM, DI / 2, DI};
                pg8::SplitOrder S; S.init(HROWS, DM, G, (int)blockIdx.x);
                pg8::EpiSlab E{slab};
                pg8::gemm_phase<pg8::EpiSlab, pg8::SplitOrder>(lds, g, S, E);
                xcd_barrier(gbar);
            }
        }
        phase_norm<true>(a.out + xoff, (const bf16_t*)(ws + WS_PROJ), mod + (size_t)(4 + half * 2) * 3072 + 2048, a.out + xoff, a.final_g, nullptr, half, nullptr);
    }
}

extern "C" void kernel_launch(void* const* d_in, const int* in_sizes, int n_in, void* d_out, int out_size, void* d_ws, size_t ws_size, hipStream_t stream) {
    static int grid = 0;
    if (grid == 0) {
        if (n_in != 20 || ws_size < WS_END) { fprintf(stderr, "kernel_launch: unexpected n_in %d / ws_size %zu (need %zu)\n", n_in, ws_size, (size_t)WS_END); grid = -1; return; }
        int dev = 0, cus = 0, per_cu = 0;
        hipGetDevice(&dev);
        hipDeviceGetAttribute(&cus, hipDeviceAttributeMultiprocessorCount, dev);
        if (hipFuncSetAttribute((const void*)fwd_megakernel, hipFuncAttributeMaxDynamicSharedMemorySize, LDS_BYTES) != hipSuccess) { fprintf(stderr, "kernel_launch: hipFuncSetAttribute failed\n"); grid = -1; return; }
        hipOccupancyMaxActiveBlocksPerMultiprocessor(&per_cu, (const void*)fwd_megakernel, NTHR, LDS_BYTES);
        if (per_cu < 1) { fprintf(stderr, "kernel_launch: occupancy query says %d blocks per CU\n", per_cu); per_cu = 1; }
        (void)hipGetLastError();
        grid = cus * per_cu;
    }
    if (grid < 0) return;
    Args a{};
    const float** f = (const float**)&a;
    for (int i = 0; i < 20; ++i) f[i] = (const float*)d_in[i];
    a.out = (float*)d_out; a.ws = (unsigned char*)d_ws;
    void* args[] = {&a};
    if (hipMemsetAsync((char*)d_ws + WS_BAR, 0, XCD_BAR_WORDS * 4, stream) != hipSuccess) { fprintf(stderr, "kernel_launch: memset of barrier words failed\n"); return; }
    hipError_t e = hipLaunchCooperativeKernel((const void*)fwd_megakernel, dim3(grid), dim3(NTHR), args, LDS_BYTES, stream);
    if (e != hipSuccess) fprintf(stderr, "cooperative launch failed: %s (grid %d)\n", hipGetErrorString(e), grid);
}
```

```cpp
#include <hip/hip_runtime.h>
#include <hip/hip_cooperative_groups.h>
#include <cstdio>
namespace cg = cooperative_groups;

#define LAS __attribute__((address_space(3)))
typedef unsigned short bf16_t;
typedef short bf16x8 __attribute__((ext_vector_type(8)));
typedef float f32x4 __attribute__((ext_vector_type(4)));
typedef float f32x16 __attribute__((ext_vector_type(16)));
typedef unsigned u32x4 __attribute__((ext_vector_type(4)));
typedef unsigned u32x2 __attribute__((ext_vector_type(2)));

#ifndef REP_PREP
#define REP_PREP 1
#endif
#ifndef REP_NORM
#define REP_NORM 1
#endif
#ifndef REP_G1
#define REP_G1 1
#endif
#ifndef REP_M12
#define REP_M12 1
#endif
#ifndef REP_M3
#define REP_M3 1
#endif
#ifndef REP_G2
#define REP_G2 1
#endif
#ifndef REP_UPREP
#define REP_UPREP 1
#endif
#ifndef REP_UCORE
#define REP_UCORE 1
#endif
constexpr int NB = 4, SEQ = 4096, DM = 1024, DEPTH = 2, DI = 2048;
constexpr int NIN = 7192, LDP = 7424;
constexpr int HROWS = 8192;
constexpr int NTHR = 512;
constexpr float EPS = 1e-6f;
constexpr int C_AQ = 0, C_AF = 512, C_AI = 1024, C_AG = 1536, C_RQ = 2048, C_RK = 2560, C_RV = 3072, C_RG = 3584,
              C_MZ = 4096, C_XBC = 4608, C_GQ = 5632, C_GK = 5888, C_GV = 6144, C_GG = 6656, C_DT = 7168, C_LR = 7176;
constexpr int ST_PER_BC = 229376;
constexpr size_t WS_WIN = 0;
constexpr size_t WS_WOUT = WS_WIN + 2ull * LDP * DM * 2;
constexpr size_t WS_MOD = WS_WOUT + 2ull * DM * DI * 2;
constexpr size_t WS_ROPE = WS_MOD + 2ull * 4 * 3072 * 4;
constexpr size_t WS_DEC = WS_ROPE + 4096ull * 64 * 8;
constexpr size_t WS_HY = WS_DEC + 128ull * 1024 * 4;
constexpr size_t WS_PROJ = WS_HY + (size_t)HROWS * DI * 2;
constexpr size_t WS_ST = WS_PROJ + (size_t)HROWS * LDP * 2;
constexpr size_t WS_BAR = WS_ST + 128ull * ST_PER_BC * 2;
constexpr size_t WS_END = WS_BAR + 3456 * 4;
constexpr int L_QI = 0, L_KI = 17408, L_VT = 34816, L_BIG = 71680, L_SM = 141312;
constexpr int SM_CUM = 0, SM_DT = 256, SM_SEG = 512, SM_REF = 1536, SM_CLAST = 1664, SM_RSS = 1792;
constexpr int L_BARST = L_SM + (1792 + 512) * 4;
constexpr int LDS_BYTES = L_BARST + 16;

constexpr int NCG = LDP / 128;
__device__ __forceinline__ size_t pidx(int row, int col) { return ((size_t)((row >> 6) * NCG + (col >> 7)) * 64 + (row & 63)) * 128 + (col & 127); }
__device__ __forceinline__ float bf2f(bf16_t v) { return __uint_as_float(((unsigned)v) << 16); }
__device__ __forceinline__ bf16_t f2bf(float f) { unsigned u = __float_as_uint(f); u += 0x7FFFu + ((u >> 16) & 1u); return (bf16_t)(u >> 16); }
typedef float f32x2_t __attribute__((ext_vector_type(2)));
typedef __bf16 bf16x2_t __attribute__((ext_vector_type(2)));
__device__ __forceinline__ unsigned pk2(float lo, float hi) { f32x2_t v = {lo, hi}; bf16x2_t b = __builtin_convertvector(v, bf16x2_t); return __builtin_bit_cast(unsigned, b); }
__device__ __forceinline__ int opaque_tid() { int t = threadIdx.x; asm volatile("" : "+v"(t)); return t; }
__device__ __forceinline__ float silu_f(float x) { return x * __builtin_amdgcn_rcpf(1.f + __expf(-x)); }
__device__ __forceinline__ float softplus_f(float x) { return fmaxf(x, 0.f) + __logf(1.f + __expf(-fabsf(x))); }
__device__ __forceinline__ float logsig_f(float x) { return fminf(x, 0.f) - __logf(1.f + __expf(-fabsf(x))); }

namespace pg8 {
constexpr int BM = 256, BK = 64, HALF = 128, HTB = HALF * BK * 2, STAGE_BYTES = 8 * HTB, NXCD = 8, WGM = 8;
__device__ __forceinline__ int lds_byte(int r, int c) { const int st = (r >> 4) * 2 + (c >> 5), rr = r & 15, cc = c & 31, ob = rr * 64 + cc * 2; return st * 1024 + (ob ^ (((ob >> 9) & 1) << 5)); }
__device__ __forceinline__ void stage_rc(int b, int& R, int& C) { const int st = b / 1024, sb = b % 1024, swz = sb ^ (((sb >> 9) & 1) << 5); R = (st >> 1) * 16 + swz / 64; C = (st & 1) * 32 + (swz % 64) / 2; }
__device__ __forceinline__ int perm32(int rho) { const int n = rho >> 4, i = rho & 15; return 8 * (i >> 2) + 4 * n + (i & 3); }
struct Unit { int pm, pn, kh; };
struct Gemm { const bf16_t* A; const bf16_t* Bt; int M, N, K, ld; };
struct StaticOrder {
    int nM, nN, nwg, G, c;
    __device__ void init(int M, int N, int G_, int c_) { nM = M / BM; nN = N / BM; nwg = nM * nN; G = G_; c = c_; }
    __device__ bool next(int i, Unit& u) const {
        const long L = (long)i * G + c; if (L >= nwg) return false;
        int wgid = (int)L; { const int q = nwg / NXCD, r = nwg % NXCD, xcd = wgid % NXCD, off = wgid / NXCD; wgid = (xcd < r ? xcd * (q + 1) : r * (q + 1) + (xcd - r) * q) + off; }
        const int nig = WGM * nN, gid = wgid / nig, fm = gid * WGM, gsz = (nM - fm) < WGM ? (nM - fm) : WGM;
        u.pm = fm + ((wgid % nig) % gsz); u.pn = (wgid % nig) / gsz; u.kh = 0; return true;
    }
};
struct SplitOrder {
    StaticOrder so;
    __device__ void init(int M, int N, int G_, int c_) { so.init(M, 2 * N, G_, c_); }
    __device__ bool next(int i, Unit& u) const { if (!so.next(i, u)) return false; u.kh = u.pn & 1; u.pn >>= 1; return true; }
};
struct EpiProj {
    static constexpr bool PERM = true;
    bf16_t* O; int ldc;
    __device__ __forceinline__ void operator()(const f32x4 (&acc)[2][2][4][2], const Unit& u, int wr, int wc, int fr, int fq) const {
        bf16_t* base = O + ((size_t)((u.pm * 4 + wr) * NCG + u.pn * 2) * 64 + fr) * 128 + wc * 32 + 8 * fq;
#pragma unroll
        for (int ai = 0; ai < 2; ++ai)
#pragma unroll
            for (int m = 0; m < 4; ++m)
#pragma unroll
                for (int bj = 0; bj < 2; ++bj) { const f32x4 v0 = acc[ai][bj][m][0], v1 = acc[ai][bj][m][1];
                    u32x4 w; w.x = pk2(v0[0], v0[1]); w.y = pk2(v0[2], v0[3]); w.z = pk2(v1[0], v1[1]); w.w = pk2(v1[2], v1[3]);
                    *(u32x4*)(base + (size_t)ai * (2 * NCG * 8192) + bj * 8192 + m * (16 * 128)) = w; }
    }
};
struct EpiRes {
    static constexpr bool PERM = false;
    const float* xin; float* xout; const float* gate;
    __device__ __forceinline__ void operator()(const f32x4 (&acc)[2][2][4][2], const Unit& u, int wr, int wc, int fr, int fq) const {
        const int row0 = u.pm * BM + wr * 64 + fr, col0 = u.pn * BM + wc * 32 + 4 * fq;
        const float* gp = gate + (size_t)(u.pm >> 4) * 3072 + col0;
        f32x4 gv[2][2];
#pragma unroll
        for (int bj = 0; bj < 2; ++bj)
#pragma unroll
            for (int n = 0; n < 2; ++n) gv[bj][n] = *(const f32x4*)(gp + bj * HALF + n * 16);
#pragma unroll
        for (int am = 0; am < 4; ++am) {
            const int ai = am >> 1, m0 = (am & 1) * 2;
            f32x4 xi[2][2][2];
#pragma unroll
            for (int m = 0; m < 2; ++m)
#pragma unroll
                for (int bj = 0; bj < 2; ++bj)
#pragma unroll
                    for (int n = 0; n < 2; ++n) xi[m][bj][n] = *(const f32x4*)(xin + (size_t)(row0 + ai * HALF + (m0 + m) * 16) * DM + col0 + bj * HALF + n * 16);
            __builtin_amdgcn_sched_barrier(0);
#pragma unroll
            for (int m = 0; m < 2; ++m)
#pragma unroll
                for (int bj = 0; bj < 2; ++bj)
#pragma unroll
                    for (int n = 0; n < 2; ++n) *(f32x4*)(xout + (size_t)(row0 + ai * HALF + (m0 + m) * 16) * DM + col0 + bj * HALF + n * 16) = xi[m][bj][n] + gv[bj][n] * acc[ai][bj][m0 + m][n];
        }
    }
};

struct EpiSlab {
    static constexpr bool PERM = true;
    bf16_t* slab;
    __device__ __forceinline__ void operator()(const f32x4 (&acc)[2][2][4][2], const Unit& u, int wr, int wc, int fr, int fq) const {
        const int row0 = u.pm * BM + wr * 64 + fr, col0 = u.pn * BM + wc * 32 + 8 * fq;
        bf16_t* base = slab + (size_t)u.kh * HROWS * DM;
#pragma unroll
        for (int ai = 0; ai < 2; ++ai)
#pragma unroll
            for (int m = 0; m < 4; ++m) { bf16_t* rowp = base + (size_t)(row0 + ai * HALF + m * 16) * DM + col0;
#pragma unroll
                for (int bj = 0; bj < 2; ++bj) { const f32x4 v0 = acc[ai][bj][m][0], v1 = acc[ai][bj][m][1];
                    u32x4 w; w.x = pk2(v0[0], v0[1]); w.y = pk2(v0[2], v0[3]); w.z = pk2(v1[0], v1[1]); w.w = pk2(v1[2], v1[3]);
                    *(u32x4*)(rowp + bj * HALF) = w; } }
    }
};

template <class Epi, class Sched, bool ALIGN_EPI = true, bool SP2 = true>
__device__ __forceinline__ void gemm_phase(LAS unsigned char* lds, const Gemm g, const Sched& S, const Epi& E) {
    const int tid = opaque_tid(), wid = __builtin_amdgcn_readfirstlane(tid >> 6), lane = tid & 63, wr = wid >> 2, wc = wid & 3, fr = lane & 15, fq = lane >> 4;
    const int K = g.K, nt = K / BK, ld = g.ld;
    unsigned voffA[2], voffB[2];
#pragma unroll
    for (int i = 0; i < 2; ++i) { int R, C; stage_rc(tid * 16 + i * 8192, R, C); const int Rb = Epi::PERM ? ((R & ~31) + perm32(R & 31)) : R;
        voffA[i] = (unsigned)(R * ld + C) * 2u; voffB[i] = (unsigned)(Rb * ld + C) * 2u; }
    const size_t kstep = (size_t)(BK * 2);
    const size_t hstep = (size_t)HALF * ld * 2;
    const size_t tstep = 2 * hstep;
    const unsigned ldsw = (unsigned)wid * 1024u;
    const int aoff = lds_byte(wr * 64 + fr, fq * 8), boff = lds_byte(wc * 32 + fr, fq * 8);
#define PG8_SA(b, h) (((b) * 2 + (h)) * HTB)
#define PG8_SB(b, h) ((4 + (b) * 2 + (h)) * HTB)
#define PG8_STAGE(bufoff, gbase, voff) do { _Pragma("unroll") for (int _i = 0; _i < 2; ++_i) \
        __builtin_amdgcn_global_load_lds((const unsigned*)((const char*)(gbase) + (voff)[_i]), (LAS unsigned*)(lds + (bufoff) + ldsw + _i * 8192), 16, 0, 0); } while (0)
#define PG8_LDA(dst, b, h) do { _Pragma("unroll") for (int m = 0; m < 4; ++m) _Pragma("unroll") for (int k = 0; k < 2; ++k) dst[m][k] = *(const LAS bf16x8*)(lds + PG8_SA(b, h) + aoff + m * 2048 + k * 1024); } while (0)
#define PG8_LDB(dst, b, h) do { _Pragma("unroll") for (int n = 0; n < 2; ++n) _Pragma("unroll") for (int k = 0; k < 2; ++k) dst[n][k] = *(const LAS bf16x8*)(lds + PG8_SB(b, h) + boff + n * 2048 + k * 1024); } while (0)
#define PG8_MMA(ai, bj, At, Bt) do { __builtin_amdgcn_s_setprio(1); _Pragma("unroll") for (int m = 0; m < 4; ++m) _Pragma("unroll") for (int n = 0; n < 2; ++n) _Pragma("unroll") for (int k = 0; k < 2; ++k) \
        acc[ai][bj][m][n] = __builtin_amdgcn_mfma_f32_16x16x32_bf16(Bt[n][k], At[m][k], acc[ai][bj][m][n], 0, 0, 0); __builtin_amdgcn_s_setprio(0); } while (0)
#define PG8_WAIT_V(n) asm volatile("s_waitcnt vmcnt(" #n ")" ::: "memory")
#define PG8_WAIT_L(n) asm volatile("s_waitcnt lgkmcnt(" #n ")" ::: "memory")
#define PG8_BAR __builtin_amdgcn_s_barrier()
#define PG8_SCHED __builtin_amdgcn_sched_barrier(0)
    Unit cur, nxt; int ui = 0;
    if (!S.next(0, cur)) return;
    f32x4 acc[2][2][4][2];
#pragma unroll
    for (int a = 0; a < 2; ++a)
#pragma unroll
        for (int b = 0; b < 2; ++b)
#pragma unroll
            for (int m = 0; m < 4; ++m)
#pragma unroll
                for (int n = 0; n < 2; ++n) acc[a][b][m][n] = (f32x4){0.f, 0.f, 0.f, 0.f};
    bf16x8 At[4][2], B0[2][2], B1[2][2];
    const char* cA = (const char*)g.A + (size_t)cur.pm * tstep + (size_t)cur.kh * K * 2; const char* cB = (const char*)g.Bt + (size_t)cur.pn * tstep + (size_t)cur.kh * K * 2;
    if constexpr (SP2) {
        PG8_STAGE(PG8_SB(0, 0), cB, voffB); PG8_STAGE(PG8_SB(0, 1), cB + hstep, voffB); PG8_STAGE(PG8_SA(0, 0), cA, voffA); PG8_STAGE(PG8_SA(0, 1), cA + hstep, voffA);
        if (wr == 1) PG8_BAR;
        PG8_WAIT_V(2); PG8_BAR;
        PG8_STAGE(PG8_SB(1, 0), cB + kstep, voffB); PG8_STAGE(PG8_SA(1, 0), cA + kstep, voffA); PG8_STAGE(PG8_SB(1, 1), cB + hstep + kstep, voffB);
        PG8_WAIT_V(6); PG8_BAR;
    } else {
        PG8_STAGE(PG8_SB(0, 0), cB, voffB); PG8_STAGE(PG8_SA(0, 0), cA, voffA); PG8_STAGE(PG8_SB(0, 1), cB + hstep, voffB); PG8_STAGE(PG8_SA(0, 1), cA + hstep, voffA);
        if (wr == 1) PG8_BAR;
        PG8_WAIT_V(4); PG8_BAR;
        PG8_STAGE(PG8_SB(1, 0), cB + kstep, voffB); PG8_STAGE(PG8_SA(1, 0), cA + kstep, voffA); PG8_STAGE(PG8_SB(1, 1), cB + hstep + kstep, voffB);
        PG8_WAIT_V(6); PG8_BAR;
    }
    for (;;) {
        const bool has_next = S.next(ui + 1, nxt);
        const char* nA = has_next ? (const char*)g.A + (size_t)nxt.pm * tstep + (size_t)nxt.kh * K * 2 : cA; const char* nB = has_next ? (const char*)g.Bt + (size_t)nxt.pn * tstep + (size_t)nxt.kh * K * 2 : cB;
        for (int t = 0; t < nt; t += 2) {
            const bool last = (t == nt - 2);
            const char* a1 = cA + (size_t)(t + 1) * kstep;
            const char* a2 = last ? nA : cA + (size_t)(t + 2) * kstep; const char* b2 = last ? nB : cB + (size_t)(t + 2) * kstep;
            const char* a3 = a2 + kstep; const char* b3 = b2 + kstep;
            if constexpr (SP2) {
            PG8_LDB(B0, 0, 0); PG8_LDB(B1, 0, 1); PG8_SCHED; PG8_LDA(At, 0, 0); PG8_STAGE(PG8_SA(1, 1), a1 + hstep, voffA);
            PG8_WAIT_V(8); PG8_WAIT_L(0); PG8_BAR; PG8_MMA(0, 0, At, B0); PG8_MMA(0, 1, At, B1); PG8_BAR; PG8_SCHED;
            PG8_LDA(At, 0, 1); PG8_STAGE(PG8_SB(0, 0), b2, voffB); PG8_STAGE(PG8_SB(0, 1), b2 + hstep, voffB); PG8_STAGE(PG8_SA(0, 0), a2, voffA);
            PG8_WAIT_V(8); PG8_WAIT_L(0); PG8_BAR; PG8_MMA(1, 0, At, B0); PG8_MMA(1, 1, At, B1); PG8_BAR; PG8_SCHED;
            PG8_LDB(B0, 1, 0); PG8_LDB(B1, 1, 1); PG8_SCHED; PG8_LDA(At, 1, 0); PG8_STAGE(PG8_SA(0, 1), a2 + hstep, voffA);
            PG8_WAIT_V(8); PG8_WAIT_L(0); PG8_BAR; PG8_MMA(0, 0, At, B0); PG8_MMA(0, 1, At, B1); PG8_BAR; PG8_SCHED;
            PG8_LDA(At, 1, 1); PG8_STAGE(PG8_SB(1, 0), b3, voffB); PG8_STAGE(PG8_SB(1, 1), b3 + hstep, voffB); PG8_STAGE(PG8_SA(1, 0), a3, voffA);
            PG8_WAIT_V(8); PG8_WAIT_L(0); PG8_BAR; PG8_MMA(1, 0, At, B0); PG8_MMA(1, 1, At, B1); PG8_BAR; PG8_SCHED;
            } else {
            PG8_LDB(B0, 0, 0); PG8_SCHED; PG8_LDA(At, 0, 0); PG8_STAGE(PG8_SA(1, 1), a1 + hstep, voffA);
            PG8_WAIT_L(8); PG8_BAR; PG8_WAIT_L(0); PG8_MMA(0, 0, At, B0); PG8_BAR; PG8_SCHED;
            PG8_LDB(B1, 0, 1); PG8_STAGE(PG8_SB(0, 0), b2, voffB);
            PG8_BAR; PG8_WAIT_L(0); PG8_MMA(0, 1, At, B1); PG8_BAR;
            PG8_LDA(At, 0, 1); PG8_STAGE(PG8_SA(0, 0), a2, voffA);
            PG8_BAR; PG8_WAIT_L(0); PG8_MMA(1, 0, At, B0); PG8_BAR; PG8_SCHED;
            PG8_STAGE(PG8_SB(0, 1), b2 + hstep, voffB);
            PG8_WAIT_V(6); PG8_BAR; PG8_MMA(1, 1, At, B1); PG8_BAR;
            PG8_LDB(B0, 1, 0); PG8_SCHED; PG8_LDA(At, 1, 0); PG8_STAGE(PG8_SA(0, 1), a2 + hstep, voffA);
            PG8_WAIT_L(8); PG8_BAR; PG8_WAIT_L(0); PG8_MMA(0, 0, At, B0); PG8_BAR; PG8_SCHED;
            PG8_LDB(B1, 1, 1); PG8_STAGE(PG8_SB(1, 0), b3, voffB);
            PG8_BAR; PG8_WAIT_L(0); PG8_MMA(0, 1, At, B1); PG8_BAR;
            PG8_LDA(At, 1, 1); PG8_STAGE(PG8_SA(1, 0), a3, voffA);
            PG8_BAR; PG8_WAIT_L(0); PG8_MMA(1, 0, At, B0); PG8_BAR; PG8_SCHED;
            PG8_STAGE(PG8_SB(1, 1), b3 + hstep, voffB);
            PG8_WAIT_V(6); PG8_BAR; PG8_MMA(1, 1, At, B1); PG8_BAR;
            }
        }
        if constexpr (ALIGN_EPI) { if (wr == 0) PG8_BAR; }
        E(acc, cur, wr, wc, fr, fq);
        if (!has_next) break;
#pragma unroll
        for (int a = 0; a < 2; ++a)
#pragma unroll
            for (int b = 0; b < 2; ++b)
#pragma unroll
                for (int m = 0; m < 4; ++m)
#pragma unroll
                    for (int n = 0; n < 2; ++n) acc[a][b][m][n] = (f32x4){0.f, 0.f, 0.f, 0.f};
        cur = nxt; cA = nA; cB = nB; ++ui;
        if constexpr (ALIGN_EPI) { if (wr == 1) PG8_BAR; }
    }
    PG8_WAIT_V(0);
    if constexpr (!ALIGN_EPI) { if (wr == 0) PG8_BAR; }
    PG8_BAR;
#undef PG8_SA
#undef PG8_SB
#undef PG8_STAGE
#undef PG8_LDA
#undef PG8_LDB
#undef PG8_MMA
#undef PG8_WAIT_V
#undef PG8_WAIT_L
#undef PG8_BAR
#undef PG8_SCHED
}
}

struct Args {
    const float* x; const float* c; const float* w_ada; const float* b_ada; const float* norm_g; const float* w_in;
    const float* lb_logits; const float* hgrn_g; const float* ret_g; const float* conv_w; const float* conv_b;
    const float* dt_bias; const float* a_log; const float* dskip; const float* ssm_g; const float* w_gk2; const float* b_gk2;
    const float* gla_g; const float* w_out; const float* final_g;
    float* out; unsigned char* ws;
};

__device__ __forceinline__ void transpose_cvt(const float* __restrict__ src, int K, int N, bf16_t* __restrict__ dst, int Npad, LAS unsigned char* lds, int gid, int gstride, bool perm) {
    LAS float* T = (LAS float*)lds;
    const int tid = opaque_tid(), ntk = K / 64, ntn = Npad / 256;
    for (int tile = gid; tile < ntk * ntn; tile += gstride) {
        const int tk = tile % ntk, tn = tile / ntk;
        float v[32];
#pragma unroll
        for (int i = 0; i < 32; ++i) { const int kk = (tid >> 8) + 2 * i, nn = tid & 255, n = tn * 256 + nn;
            const int ns = !perm ? n : (n < 5632) ? n : (n < 7168) ? n + 8 : (n < 7176) ? n - 7168 + 5632 : n;
            v[i] = (n < N) ? src[(size_t)(tk * 64 + kk) * N + ns] : 0.f; }
#pragma unroll
        for (int i = 0; i < 32; ++i) { const int kk = (tid >> 8) + 2 * i, nn = tid & 255; T[kk * 257 + nn] = v[i]; }
        __syncthreads();
#pragma unroll
        for (int i = 0; i < 16; ++i) { const int nn = (tid >> 5) + 16 * i, kk = (tid & 31) * 2;
            *(unsigned*)(dst + (size_t)(tn * 256 + nn) * K + tk * 64 + kk) = pk2(T[kk * 257 + nn], T[(kk + 1) * 257 + nn]); }
        __syncthreads();
    }
}

__device__ __forceinline__ void phase_wcvt(const Args& a, LAS unsigned char* lds) {
    const int G = gridDim.x, bid = blockIdx.x;
    unsigned char* ws = a.ws;
    for (int l = 0; l < DEPTH; ++l) {
        transpose_cvt(a.w_in + (size_t)l * DM * NIN, DM, NIN, (bf16_t*)(ws + WS_WIN) + (size_t)l * LDP * DM, LDP, lds, bid, G, true);
        transpose_cvt(a.w_out + (size_t)l * DI * DM, DI, DM, (bf16_t*)(ws + WS_WOUT) + (size_t)l * DM * DI, DM, lds, (bid + 128) % G, G, false);
    }
}
__device__ __forceinline__ void phase_prep(const Args& a, LAS unsigned char* lds) {
    const int tid = opaque_tid(), G = gridDim.x, bid = blockIdx.x;
    unsigned char* ws = a.ws;
    {
        LAS float* R = (LAS float*)lds;
        LAS float* CA = (LAS float*)(lds + 8192);
        float* mod = (float*)(ws + WS_MOD);
        const int jj = tid & 63, ks = tid >> 6;
        if (bid < DEPTH * 48) {
#pragma unroll
            for (int q = 0; q < 8; ++q) CA[tid + NTHR * q] = silu_f(a.c[tid + NTHR * q]);
            __syncthreads();
        }
        for (int item = bid; item < DEPTH * 48; item += G) {
            const int l = item / 48, j = (item % 48) * 64 + jj;
            float s0 = 0.f, s1 = 0.f, s2 = 0.f, s3 = 0.f;
            const float* w = a.w_ada + (size_t)l * DM * 3072 + j;
#pragma unroll 16
            for (int k = ks * 128; k < ks * 128 + 128; ++k) { const float wv = w[(size_t)k * 3072];
                s0 += CA[k] * wv; s1 += CA[DM + k] * wv; s2 += CA[2 * DM + k] * wv; s3 += CA[3 * DM + k] * wv; }
            R[(ks * 4 + 0) * 64 + jj] = s0; R[(ks * 4 + 1) * 64 + jj] = s1; R[(ks * 4 + 2) * 64 + jj] = s2; R[(ks * 4 + 3) * 64 + jj] = s3;
            __syncthreads();
            if (tid < 256) { const int b = tid >> 6; float s = a.b_ada[l * 3072 + j];
#pragma unroll
                for (int q = 0; q < 8; ++q) s += R[(q * 4 + b) * 64 + jj];
                mod[(size_t)(l * 4 + b) * 3072 + j] = s; }
            __syncthreads();
        }
    }
    {
        float2* rope = (float2*)(ws + WS_ROPE);
        for (int i = bid * NTHR + tid; i < 4096 * 64; i += G * NTHR) {
            const int pos = i >> 6, j = i & 63;
            const float invf = powf(10000.f, -(float)(2 * j) / 128.f);
            const float ang = (float)pos * invf;
            const float k = rintf(ang * 0.15915494309189535f);
            float r = fmaf(-k, 6.2831854820251465f, ang); r = fmaf(-k, -1.7484555e-07f, r);
            rope[i] = make_float2(__cosf(r), __sinf(r));
        }
    }
}

template <bool FINAL>
__device__ __forceinline__ void phase_norm(const float* __restrict__ xin  , const bf16_t* __restrict__ slab  ,
                                           const float* __restrict__ gate_prev  , float* xout  ,
                                           const float* __restrict__ g, const float* __restrict__ mod  , int half, bf16_t* __restrict__ hout) {
    const int tid = opaque_tid(), lane = tid & 63, wid = tid >> 6;
    const int gw = blockIdx.x * 8 + wid, nw = gridDim.x * 8;
    f32x4 gg[4], sh[4], sc[4], gp[4];
#pragma unroll
    for (int i = 0; i < 4; ++i) { gg[i] = *(const f32x4*)(g + i * 256 + lane * 4); sh[i] = gg[i]; sc[i] = gg[i]; gp[i] = gg[i]; }
    int curb = -1;
    for (int row = gw; row < HROWS; row += nw) {
        const int b = row >> 12;
        if (b != curb) { curb = b;
#pragma unroll
            for (int i = 0; i < 4; ++i) { const int col = i * 256 + lane * 4;
                if constexpr (!FINAL) { const float* mb = mod + (size_t)(half * 2 + b) * 3072; sh[i] = *(const f32x4*)(mb + col); sc[i] = *(const f32x4*)(mb + 1024 + col); }
                if (slab) gp[i] = *(const f32x4*)(gate_prev + (size_t)b * 3072 + col); } }
        const float* xr = xin + (size_t)row * DM;
        f32x4 v[4]; float ss = 0.f;
#pragma unroll
        for (int i = 0; i < 4; ++i) v[i] = *(const f32x4*)(xr + i * 256 + lane * 4);
        if (slab) {
            u32x2 a0[4], a1[4];
#pragma unroll
            for (int i = 0; i < 4; ++i) { const int col = i * 256 + lane * 4;
                a0[i] = *(const u32x2*)(slab + (size_t)row * DM + col); a1[i] = *(const u32x2*)(slab + (size_t)(HROWS + row) * DM + col); }
#pragma unroll
            for (int i = 0; i < 4; ++i) {
                const f32x4 sa = {__uint_as_float(a0[i].x << 16) + __uint_as_float(a1[i].x << 16), __uint_as_float(a0[i].x & 0xffff0000u) + __uint_as_float(a1[i].x & 0xffff0000u),
                                  __uint_as_float(a0[i].y << 16) + __uint_as_float(a1[i].y << 16), __uint_as_float(a0[i].y & 0xffff0000u) + __uint_as_float(a1[i].y & 0xffff0000u)};
                v[i] = v[i] + gp[i] * sa; }
        }
        if (!FINAL && xout) {
#pragma unroll
            for (int i = 0; i < 4; ++i) *(f32x4*)(xout + (size_t)row * DM + i * 256 + lane * 4) = v[i];
        }
#pragma unroll
        for (int i = 0; i < 4; ++i) ss += v[i][0] * v[i][0] + v[i][1] * v[i][1] + v[i][2] * v[i][2] + v[i][3] * v[i][3];
#pragma unroll
        for (int o = 32; o > 0; o >>= 1) ss += __shfl_xor(ss, o);
        const float rinv = rsqrtf(ss * (1.f / DM) + EPS);
        if constexpr (FINAL) {
#pragma unroll
            for (int i = 0; i < 4; ++i) { const int col = i * 256 + lane * 4;
                *(f32x4*)(xout + (size_t)row * DM + col) = v[i] * rinv * gg[i]; }
        } else {
#pragma unroll
            for (int i = 0; i < 4; ++i) { const int col = i * 256 + lane * 4;
                float o0 = v[i][0] * rinv * gg[i][0] * (1.f + sc[i][0]) + sh[i][0], o1 = v[i][1] * rinv * gg[i][1] * (1.f + sc[i][1]) + sh[i][1];
                float o2 = v[i][2] * rinv * gg[i][2] * (1.f + sc[i][2]) + sh[i][2], o3 = v[i][3] * rinv * gg[i][3] * (1.f + sc[i][3]) + sh[i][3];
                u32x2 w; w.x = pk2(o0, o1); w.y = pk2(o2, o3);
                *(u32x2*)(hout + (size_t)row * DM + col) = w; }
        }
    }
}

struct MixP {
    const bf16_t* proj; bf16_t* st; float* dec; bf16_t* y; const float2* rope;
    const float* lbl; const float* hgrn_g; const float* ret_g; const float* conv_w; const float* conv_b; const float* dt_bias; const float* a_log;
    const float* dskip; const float* ssm_g; const float* w2; const float* b2; const float* gla_g; int layer;
};

__device__ __forceinline__ bf16x8 frag(LAS unsigned char* lds, int off, int ld, int r0, int ks, int lane) {
    return *(const LAS bf16x8*)(lds + off + (((r0 + (lane & 31)) * ld + 16 * ks + 8 * (lane >> 5)) << 1));
}
__device__ __forceinline__ int rowmap(int r, int lane) { return (r & 3) + 8 * (r >> 2) + 4 * (lane >> 5); }

__device__ __forceinline__ void conv16(LAS unsigned char* lds, int off, int ncols, int col, const float* cw, int seg, float (&out)[16]) {
    const LAS bf16_t* rp = (const LAS bf16_t*)(lds + off) + seg * 16 * ncols + col;
    float u[19];
#pragma unroll
    for (int k = 0; k < 19; ++k) u[k] = bf2f(rp[k * ncols]);
#pragma unroll
    for (int i = 0; i < 16; ++i) out[i] = silu_f(cw[4] + cw[0] * u[i] + cw[1] * u[i + 1] + cw[2] * u[i + 2] + cw[3] * u[i + 3]);
}
__device__ __forceinline__ void conv_w_load(const MixP& p, int chan, float* cw) {
    cw[0] = p.conv_w[chan]; cw[1] = p.conv_w[1024 + chan]; cw[2] = p.conv_w[2048 + chan]; cw[3] = p.conv_w[3072 + chan]; cw[4] = p.conv_b[chan];
}
template <int NCOLS, int NROWS> struct Stg { static constexpr int VPR = NCOLS / 8, NV = NROWS * VPR, NIT = (NV + NTHR - 1) / NTHR; };
template <int NCOLS, int NROWS>
__device__ __forceinline__ void stg_load(const bf16_t* proj, int grow0, int col0, int tid, int zrows, u32x4* r) {
    using S = Stg<NCOLS, NROWS>;
#pragma unroll
    for (int j = 0; j < S::NIT; ++j) { const int vi = tid + NTHR * j, row = vi / S::VPR, cv = vi % S::VPR;
        const bool ok = (vi < S::NV) && (row >= zrows);
        r[j] = ok ? *(const u32x4*)(proj + pidx(grow0 + row, col0 + cv * 8)) : (u32x4){0u, 0u, 0u, 0u}; }
}
template <int NCOLS, int NROWS>
__device__ __forceinline__ void stg_store(LAS unsigned char* lds, int off, int tid, const u32x4* r) {
    using S = Stg<NCOLS, NROWS>;
#pragma unroll
    for (int j = 0; j < S::NIT; ++j) { const int vi = tid + NTHR * j; if (vi < S::NV) *(LAS u32x4*)(lds + off + vi * 16) = r[j]; }
}
__device__ __forceinline__ void store16(LAS unsigned char* lds, int byteoff, const float (&v)[16]) {
    u32x4 a, b; a.x = pk2(v[0], v[1]); a.y = pk2(v[2], v[3]); a.z = pk2(v[4], v[5]); a.w = pk2(v[6], v[7]);
    b.x = pk2(v[8], v[9]); b.y = pk2(v[10], v[11]); b.z = pk2(v[12], v[13]); b.w = pk2(v[14], v[15]);
    *(LAS u32x4*)(lds + byteoff) = a; *(LAS u32x4*)(lds + byteoff + 16) = b;
}
__device__ __forceinline__ void store8(LAS unsigned char* lds, int byteoff, const float (&v)[8]) {
    u32x4 a; a.x = pk2(v[0], v[1]); a.y = pk2(v[2], v[3]); a.z = pk2(v[4], v[5]); a.w = pk2(v[6], v[7]);
    *(LAS u32x4*)(lds + byteoff) = a;
}

constexpr int NUNITS = 128 * 14;
struct Pref { u32x4 raw[11]; u32x4 st[8]; float aux[16]; };
template <int BR, int PASS>
__device__ __forceinline__ void load_A(const MixP& p, int bc, int hu, int tid, Pref& pf) {
    const bf16_t* P = p.proj; const int g0 = bc * 64;
    if constexpr (BR == 0) { stg_load<128, 64>(P, g0, C_AF + hu * 128, tid, 0, pf.raw + 0); stg_load<128, 64>(P, g0, C_AI + hu * 128, tid, 0, pf.raw + 2);
        if constexpr (PASS == 3) stg_load<128, 64>(P, g0, C_AQ + hu * 128, tid, 0, pf.raw + 4); }
    if constexpr (BR == 1) { stg_load<128, 64>(P, g0, C_RK + hu * 128, tid, 0, pf.raw + 0); stg_load<128, 64>(P, g0, C_RV + hu * 128, tid, 0, pf.raw + 2);
        if constexpr (PASS == 3) stg_load<128, 64>(P, g0, C_RQ + hu * 128, tid, 0, pf.raw + 4); }
    if constexpr (BR == 2) { const int zr = ((bc & 63) == 0) ? 3 : 0;
        stg_load<128, 67>(P, g0 - 3, C_XBC + 512 + hu * 128, tid, zr, pf.raw + 0); stg_load<256, 67>(P, g0 - 3, C_XBC + hu * 256, tid, zr, pf.raw + 3);
        if constexpr (PASS == 3) stg_load<128, 67>(P, g0 - 3, C_XBC + 768 + hu * 128, tid, zr, pf.raw + 8); }
    if constexpr (BR == 3) { stg_load<64, 64>(P, g0, C_GK + hu * 64, tid, 0, pf.raw + 0); stg_load<128, 64>(P, g0, C_GV + hu * 128, tid, 0, pf.raw + 1); stg_load<16, 64>(P, g0, C_LR, tid, 0, pf.raw + 3);
        if constexpr (PASS == 3) stg_load<64, 64>(P, g0, C_GQ + hu * 64, tid, 0, pf.raw + 4); }
}
template <int BR, int PASS>
__device__ __forceinline__ void load_B(const MixP& p, int bc, int hu, int tid, Pref& pf) {
    if constexpr (PASS == 3) {
        constexpr int DK = (BR == 3) ? 64 : 128, DV = (BR == 2) ? 256 : 128, NV = DV * DK / 8 / NTHR;
        const int st_off = (BR == 0) ? hu * 16384 : (BR == 1) ? 65536 + hu * 16384 : (BR == 2) ? 131072 + hu * 32768 : 196608 + hu * 8192;
        const bf16_t* stg = p.st + (size_t)bc * ST_PER_BC + st_off;
#pragma unroll
        for (int k = 0; k < NV; ++k) pf.st[k] = *(const u32x4*)(stg + (size_t)(tid + NTHR * k) * 8);
    }
    if constexpr (BR == 1) { const int j = tid & 63, seg = tid >> 6, chunk = bc & 63;
#pragma unroll
        for (int i = 0; i < 8; ++i) { const float2 c = p.rope[(chunk * 64 + seg * 8 + i) * 64 + j]; pf.aux[2 * i] = c.x; pf.aux[2 * i + 1] = c.y; } }
    if constexpr (BR == 2) { if (tid < 64) {
#pragma unroll
            for (int hh = 0; hh < 4; ++hh) pf.aux[hh] = bf2f(p.proj[pidx(bc * 64 + tid, C_DT + hu * 4 + hh)]); } }
    if constexpr (BR == 3) { const int cc = hu * 64 + (tid & 63);
#pragma unroll
        for (int r = 0; r < 16; ++r) pf.aux[r] = p.w2[r * 256 + cc]; }
}
template <int PASS>
__device__ __forceinline__ void load_A_any(const MixP& p, int i, int tid, Pref& pf) {
    const int bc = i / 14, u = i % 14;
    if (u < 4) load_A<0, PASS>(p, bc, u, tid, pf); else if (u < 8) load_A<1, PASS>(p, bc, u - 4, tid, pf);
    else if (u < 10) load_A<2, PASS>(p, bc, u - 8, tid, pf); else load_A<3, PASS>(p, bc, u - 10, tid, pf);
}
template <int PASS>
__device__ __forceinline__ void load_B_any(const MixP& p, int i, int tid, Pref& pf) {
    const int bc = i / 14, u = i % 14;
    if (u < 4) load_B<0, PASS>(p, bc, u, tid, pf); else if (u < 8) load_B<1, PASS>(p, bc, u - 4, tid, pf);
    else if (u < 10) load_B<2, PASS>(p, bc, u - 8, tid, pf); else load_B<3, PASS>(p, bc, u - 10, tid, pf);
}

template <int BR, int PASS>
__device__ __forceinline__ void mixer_unit(const MixP& p, LAS unsigned char* lds, int bc, int hu  ) {
    constexpr int DK = (BR == 3) ? 64 : 128, LDK = DK + 8, NH = (BR == 2) ? 4 : 1, DV = (BR == 2) ? 256 : 128, NT = DV / 128;
    constexpr bool VEC = (BR == 0 || BR == 3);
    const int tid = opaque_tid(), lane = tid & 63, wid = __builtin_amdgcn_readfirstlane(tid >> 6);
    const int chunk = bc & 63;
    const bf16_t* P = p.proj;
    LAS float* SM = (LAS float*)(lds + L_SM);
    LAS bf16_t* QI = (LAS bf16_t*)(lds + L_QI); LAS bf16_t* KI = (LAS bf16_t*)(lds + L_KI); LAS bf16_t* VT = (LAS bf16_t*)(lds + L_VT);
    const int st_off = (BR == 0) ? hu * 16384 : (BR == 1) ? 65536 + hu * 16384 : (BR == 2) ? 131072 + hu * 32768 : 196608 + hu * 8192;
    bf16_t* stg = p.st + (size_t)bc * ST_PER_BC + st_off;
    Pref pf;
    load_A<BR, PASS>(p, bc, hu, tid, pf);
    load_B<BR, PASS>(p, bc, hu, tid, pf);
    constexpr int NTG = (PASS == 3) ? NT : 1;
    const int gcol = (BR == 0) ? C_AG + hu * 128 : (BR == 1) ? C_RG + hu * 128 : (BR == 2) ? C_MZ + hu * 256 : C_GG + hu * 128;
    const float* gain = (BR == 0) ? p.hgrn_g + hu * 128 : (BR == 1) ? p.ret_g + hu * 128 : (BR == 2) ? p.ssm_g + hu * 256 : p.gla_g + hu * 128;
    bf16_t gt[NTG][16]; float gnv[NTG], dskv[NTG];
    float lb = 0.f, bb = 0.f, cwb[5], cwc[5], cwx[5], dtb[4], alg[4];
    if constexpr (BR == 0) { if (p.layer == 1) { const int cc = hu * 128 + (tid & 127); lb = 1.f / (1.f + __expf(p.lbl[cc] - p.lbl[512 + cc])); } }
    if constexpr (BR == 3) bb = p.b2[hu * 64 + (tid & 63)];
    if constexpr (BR == 2) { conv_w_load(p, 512 + hu * 128 + (tid & 127), cwb); if constexpr (PASS == 3) conv_w_load(p, 768 + hu * 128 + (tid & 127), cwc); conv_w_load(p, hu * 256 + (tid & 255), cwx);
#pragma unroll
        for (int hh = 0; hh < 4; ++hh) { dtb[hh] = p.dt_bias[hu * 4 + hh]; alg[hh] = p.a_log[hu * 4 + hh]; } }
    __builtin_amdgcn_sched_barrier(0);

    for (int urep = 0; urep < REP_UPREP; ++urep) {
    if constexpr (BR == 0) {
        constexpr int RQ = L_BIG, RF = (PASS == 3) ? L_BIG + 16384 : L_QI, RV = (PASS == 3) ? L_BIG + 32768 : L_QI + 16384;
        stg_store<128, 64>(lds, RF, tid, pf.raw + 0); stg_store<128, 64>(lds, RV, tid, pf.raw + 2);
        if constexpr (PASS == 3) stg_store<128, 64>(lds, RQ, tid, pf.raw + 4);
        __builtin_amdgcn_sched_barrier(0);
        const int d = tid & 127, seg = tid >> 7;
        __syncthreads();
        const LAS bf16_t* rF = (const LAS bf16_t*)(lds + RF) + seg * 16 * 128 + d;
        const LAS bf16_t* rQ = (const LAS bf16_t*)(lds + RQ) + seg * 16 * 128 + d;
        const LAS bf16_t* rV = (const LAS bf16_t*)(lds + RV) + seg * 16 * 128 + d;
        float cs[16], kk[16]; float run = 0.f;
#pragma unroll
        for (int i = 0; i < 16; ++i) { const float av = fmaxf(bf2f(rF[i * 128]), -60.f); const float e = __expf(-av), sg = __builtin_amdgcn_rcpf(1.f + e);
            const float f = lb + (1.f - lb) * sg; run += __logf(f); cs[i] = run; kk[i] = (1.f - lb) * e * sg; }
        SM[SM_SEG + seg * 128 + d] = run;
        __syncthreads();
        const float t0 = SM[SM_SEG + d], t1 = SM[SM_SEG + 128 + d], t2 = SM[SM_SEG + 256 + d], t3 = SM[SM_SEG + 384 + d];
        const float off = (seg == 0) ? 0.f : (seg == 1) ? t0 : (seg == 2) ? t0 + t1 : t0 + t1 + t2;
        const float ref = t0 + t1, clast = ref + t2 + t3;
        if (seg == 0) { SM[SM_REF + d] = ref; SM[SM_CLAST + d] = clast; SM[SM_RSS + d] = (PASS == 3) ? __expf(ref) : __expf(clast - ref); }
        float kv[16];
#pragma unroll
        for (int i = 0; i < 16; ++i) { const float c = off + cs[i]; kv[i] = kk[i] * __expf(fminf(ref - c, 80.f));
            if constexpr (PASS == 3) { KI[(seg * 16 + i) * LDK + d] = f2bf(kv[i]);
                const float q = bf2f(rQ[i * 128]); QI[(seg * 16 + i) * LDK + d] = f2bf(silu_f(q) * __expf(fminf(c - ref, 80.f))); } }
        if constexpr (PASS == 1) store16(lds, L_BIG + (d * 72 + seg * 16) * 2, kv);
        unsigned vv[16];
#pragma unroll
        for (int i = 0; i < 16; ++i) vv[i] = rV[i * 128];
        u32x4 a, b; a.x = vv[0] | (vv[1] << 16); a.y = vv[2] | (vv[3] << 16); a.z = vv[4] | (vv[5] << 16); a.w = vv[6] | (vv[7] << 16);
        b.x = vv[8] | (vv[9] << 16); b.y = vv[10] | (vv[11] << 16); b.z = vv[12] | (vv[13] << 16); b.w = vv[14] | (vv[15] << 16);
        *(LAS u32x4*)(lds + L_VT + (d * 72 + seg * 16) * 2) = a; *(LAS u32x4*)(lds + L_VT + (d * 72 + seg * 16) * 2 + 16) = b;
    }
    if constexpr (BR == 1) {
        constexpr int RQ = L_BIG, RK = (PASS == 3) ? L_BIG + 16384 : L_QI, RV = (PASS == 3) ? L_BIG + 32768 : L_QI + 16384;
        const int j = tid & 63, seg = tid >> 6;
        float2 cssn[8];
#pragma unroll
        for (int i = 0; i < 8; ++i) cssn[i] = make_float2(pf.aux[2 * i], pf.aux[2 * i + 1]);
        stg_store<128, 64>(lds, RK, tid, pf.raw + 0); stg_store<128, 64>(lds, RV, tid, pf.raw + 2);
        if constexpr (PASS == 3) stg_store<128, 64>(lds, RQ, tid, pf.raw + 4);
        __builtin_amdgcn_sched_barrier(0);
        const float lg = log1pf(-exp2f(-(5.f + (float)hu)));
        if (tid < 64) { SM[SM_CUM + tid] = (float)(tid + 1) * lg; SM[SM_DT + tid] = 1.f; }
        __syncthreads();
        float k1[8], k2[8];
#pragma unroll
        for (int i = 0; i < 8; ++i) { const int t = seg * 8 + i;
            const LAS bf16_t* rk = (const LAS bf16_t*)(lds + RK) + t * 128 + j;
            const float ka = bf2f(rk[0]) * 0.08838834764831845f, kb = bf2f(rk[64]) * 0.08838834764831845f;
            k1[i] = ka * cssn[i].x - kb * cssn[i].y; k2[i] = ka * cssn[i].y + kb * cssn[i].x;
            if constexpr (PASS == 3) { const LAS bf16_t* rq = (const LAS bf16_t*)(lds + RQ) + t * 128 + j;
                const float qa = bf2f(rq[0]), qb = bf2f(rq[64]);
                QI[t * LDK + j] = f2bf(qa * cssn[i].x - qb * cssn[i].y); QI[t * LDK + j + 64] = f2bf(qa * cssn[i].y + qb * cssn[i].x);
                KI[t * LDK + j] = f2bf(k1[i]); KI[t * LDK + j + 64] = f2bf(k2[i]); } }
        if constexpr (PASS == 1) { store8(lds, L_BIG + (j * 72 + seg * 8) * 2, k1); store8(lds, L_BIG + ((j + 64) * 72 + seg * 8) * 2, k2); }
        const int v = tid & 127, s4 = tid >> 7; float vv[16];
#pragma unroll
        for (int i = 0; i < 16; ++i) { const int s = s4 * 16 + i; float x = bf2f(((const LAS bf16_t*)(lds + RV))[s * 128 + v]);
            if constexpr (PASS == 1) x *= __expf((float)(63 - s) * lg);
            vv[i] = x; }
        store16(lds, L_VT + (v * 72 + s4 * 16) * 2, vv);
    }
    if constexpr (BR == 2) {
        constexpr int RB = (PASS == 3) ? L_BIG : L_QI, RC = L_BIG + 17152, RX = (PASS == 3) ? L_BIG + 34304 : L_BIG + 18432;
        float dtr[4];
#pragma unroll
        for (int hh = 0; hh < 4; ++hh) dtr[hh] = pf.aux[hh];
        stg_store<128, 67>(lds, RB, tid, pf.raw + 0); stg_store<256, 67>(lds, RX, tid, pf.raw + 3);
        if constexpr (PASS == 3) stg_store<128, 67>(lds, RC, tid, pf.raw + 8);
        __builtin_amdgcn_sched_barrier(0);
        if (tid < 64) {
#pragma unroll
            for (int hh = 0; hh < 4; ++hh) {
                const float dt = softplus_f(dtr[hh] + dtb[hh]);
                float la = -dt * __expf(alg[hh]);
#pragma unroll
                for (int o = 1; o < 64; o <<= 1) { const float yv = __shfl_up(la, o); if (tid >= o) la += yv; }
                SM[SM_CUM + hh * 64 + tid] = la; SM[SM_DT + hh * 64 + tid] = dt; }
        }
        __syncthreads();
        { const int n = tid & 127, seg = tid >> 7; float o[16];
          conv16(lds, RB, 128, n, cwb, seg, o);
          if constexpr (PASS == 3) {
#pragma unroll
              for (int i = 0; i < 16; ++i) KI[(seg * 16 + i) * LDK + n] = f2bf(o[i]);
              conv16(lds, RC, 128, n, cwc, seg, o);
#pragma unroll
              for (int i = 0; i < 16; ++i) QI[(seg * 16 + i) * LDK + n] = f2bf(o[i]);
          } else store16(lds, L_BIG + (n * 72 + seg * 16) * 2, o);
        }
        { const int v = tid & 255, s2 = tid >> 8, hh = v >> 6;
#pragma unroll
          for (int r = 0; r < 2; ++r) { const int seg = s2 * 2 + r; float o[16];
              conv16(lds, RX, 256, v, cwx, seg, o);
              if constexpr (PASS == 1) { const float cl = SM[SM_CUM + hh * 64 + 63];
#pragma unroll
                  for (int i = 0; i < 16; ++i) { const int s = seg * 16 + i; o[i] *= __expf(cl - SM[SM_CUM + hh * 64 + s]) * SM[SM_DT + hh * 64 + s]; } }
              store16(lds, L_VT + (v * 72 + seg * 16) * 2, o); }
        }
    }
    if constexpr (BR == 3) {
        constexpr int RQ = L_BIG, RK = (PASS == 3) ? L_BIG + 8192 : L_QI, RV = (PASS == 3) ? L_BIG + 16384 : L_QI + 8192, RL = (PASS == 3) ? L_BIG + 32768 : L_QI + 24576;
        const int d = tid & 63, seg = tid >> 6, cc = hu * 64 + d;
        float w2r[16];
#pragma unroll
        for (int r = 0; r < 16; ++r) w2r[r] = pf.aux[r];
        stg_store<64, 64>(lds, RK, tid, pf.raw + 0); stg_store<128, 64>(lds, RV, tid, pf.raw + 1); stg_store<16, 64>(lds, RL, tid, pf.raw + 3);
        if constexpr (PASS == 3) stg_store<64, 64>(lds, RQ, tid, pf.raw + 4);
        __builtin_amdgcn_sched_barrier(0);
        __syncthreads();
        float cs[8]; float run = 0.f;
#pragma unroll
        for (int i = 0; i < 8; ++i) { const int t = seg * 8 + i; const LAS bf16x8* lp = (const LAS bf16x8*)(lds + RL + t * 32);
            const bf16x8 l0 = lp[0], l1 = lp[1]; float gk = bb;
#pragma unroll
            for (int r = 0; r < 8; ++r) { gk += w2r[r] * bf2f((bf16_t)l0[r]); gk += w2r[8 + r] * bf2f((bf16_t)l1[r]); }
            run += logsig_f(gk) * (1.f / 16.f); cs[i] = run; }
        SM[SM_SEG + seg * 64 + d] = run;
        __syncthreads();
        float off = 0.f, ref = 0.f, clast = 0.f;
#pragma unroll
        for (int s = 0; s < 8; ++s) { const float tv = SM[SM_SEG + s * 64 + d]; if (s < seg) off += tv; if (s < 4) ref += tv; clast += tv; }
        if (seg == 0) { SM[SM_REF + d] = ref; SM[SM_CLAST + d] = clast; SM[SM_RSS + d] = (PASS == 3) ? __expf(ref) : __expf(clast - ref); }
        float kv[8];
#pragma unroll
        for (int i = 0; i < 8; ++i) { const int t = seg * 8 + i; const float c = off + cs[i];
            kv[i] = bf2f(((const LAS bf16_t*)(lds + RK))[t * 64 + d]) * __expf(fminf(ref - c, 80.f));
            if constexpr (PASS == 3) { KI[t * LDK + d] = f2bf(kv[i]); QI[t * LDK + d] = f2bf(bf2f(((const LAS bf16_t*)(lds + RQ))[t * 64 + d]) * 0.125f * __expf(fminf(c - ref, 80.f))); } }
        if constexpr (PASS == 1) store8(lds, L_BIG + (d * 72 + seg * 8) * 2, kv);
        const int v = tid & 127, s4 = tid >> 7; unsigned vv[16];
#pragma unroll
        for (int i = 0; i < 16; ++i) vv[i] = ((const LAS bf16_t*)(lds + RV))[(s4 * 16 + i) * 128 + v];
        u32x4 a, b; a.x = vv[0] | (vv[1] << 16); a.y = vv[2] | (vv[3] << 16); a.z = vv[4] | (vv[5] << 16); a.w = vv[6] | (vv[7] << 16);
        b.x = vv[8] | (vv[9] << 16); b.y = vv[10] | (vv[11] << 16); b.z = vv[12] | (vv[13] << 16); b.w = vv[14] | (vv[15] << 16);
        *(LAS u32x4*)(lds + L_VT + (v * 72 + s4 * 16) * 2) = a; *(LAS u32x4*)(lds + L_VT + (v * 72 + s4 * 16) * 2 + 16) = b;
    }
    __syncthreads();
    }
    for (int urep = 0; urep < REP_UCORE; ++urep) {
    if constexpr (PASS == 1) {
        constexpr int NTN = DV / 32, NTILES = (DK / 32) * NTN, NTL = NTILES / 8;
        f32x16 hacc[NTL];
#pragma unroll
        for (int i = 0; i < NTL; ++i) {
            const int ti = wid + 8 * i, tm = ti / NTN, tn = ti % NTN;
#pragma unroll
            for (int r = 0; r < 16; ++r) hacc[i][r] = 0.f;
#pragma unroll
            for (int ks = 0; ks < 4; ++ks) hacc[i] = __builtin_amdgcn_mfma_f32_32x32x16_bf16(frag(lds, L_BIG, 72, tm * 32, ks, lane), frag(lds, L_VT, 72, tn * 32, ks, lane), hacc[i], 0, 0, 0);
            if constexpr (VEC) {
#pragma unroll
                for (int r = 0; r < 16; ++r) { const int d = tm * 32 + rowmap(r, lane); hacc[i][r] *= SM[SM_RSS + d]; }
            }
        }
        float decv = 0.f;
        if constexpr (BR == 0) { if (tid < 128) decv = __expf(SM[SM_CLAST + tid]); }
        if constexpr (BR == 3) { if (tid < 64) decv = __expf(SM[SM_CLAST + tid]); }
        if constexpr (BR == 2) { if (tid < 4) decv = __expf(SM[SM_CUM + tid * 64 + 63]); }
        __syncthreads();
        constexpr int LDH = DK + 8, H_OFF = (BR == 2) ? L_BIG : L_VT;
#pragma unroll
        for (int i = 0; i < NTL; ++i) {
            const int ti = wid + 8 * i, tm = ti / NTN, tn = ti % NTN;
            const int v = tn * 32 + (lane & 31);
#pragma unroll
            for (int rg = 0; rg < 4; ++rg) { const int d0 = tm * 32 + 8 * rg + 4 * (lane >> 5);
                u32x2 w; w.x = pk2(hacc[i][rg * 4 + 0], hacc[i][rg * 4 + 1]); w.y = pk2(hacc[i][rg * 4 + 2], hacc[i][rg * 4 + 3]);
                *(LAS u32x2*)(lds + H_OFF + (v * LDH + d0) * 2) = w; }
        }
        __syncthreads();
#pragma unroll
        for (int k = 0; k < DV * DK / 8 / NTHR; ++k) { const int vi = tid + NTHR * k, v = vi / (DK / 8), c = vi % (DK / 8);
            const u32x4 w = *(const LAS u32x4*)(lds + H_OFF + (v * LDH + c * 8) * 2);
            *(u32x4*)(stg + (size_t)vi * 8) = w; }
        float* dec = p.dec + (size_t)bc * 1024;
        if constexpr (BR == 0) { if (tid < 128) dec[hu * 128 + tid] = decv; }
        if constexpr (BR == 3) { if (tid < 64) dec[512 + hu * 64 + tid] = decv; }
        if constexpr (BR == 2) { if (tid < 4) dec[768 + hu * 4 + tid] = decv; }
    } else {
        constexpr int NCT = DV / 32;
    if constexpr (PASS == 3) {
#pragma unroll
            for (int nt = 0; nt < NT; ++nt) { const int ct = (wid & 3) + 4 * nt;
                gnv[nt] = gain[ct * 32 + (lane & 31)]; dskv[nt] = (BR == 2) ? p.dskip[hu * 4 + (ct >> 1)] : 0.f;
#pragma unroll
                for (int r = 0; r < 16; ++r) gt[nt][r] = P[pidx(bc * 64 + (wid >> 2) * 32 + rowmap(r, lane), gcol + ct * 32 + (lane & 31))]; }
        }
        __builtin_amdgcn_sched_barrier(0);
        {
            constexpr int NVEC = DV * DK / 8, VPR = DK / 8;
#pragma unroll
            for (int k = 0; k < NVEC / NTHR; ++k) { const int vi = tid + NTHR * k; const int v = vi / VPR, d0 = (vi % VPR) * 8;
                u32x4 raw = pf.st[k];
                if constexpr (VEC) { unsigned w[4] = {raw.x, raw.y, raw.z, raw.w};
#pragma unroll
                    for (int q = 0; q < 4; ++q) { const float lo = __uint_as_float(w[q] << 16) * SM[SM_RSS + d0 + 2 * q], hi = __uint_as_float(w[q] & 0xffff0000u) * SM[SM_RSS + d0 + 2 * q + 1];
                        w[q] = pk2(lo, hi); }
                    raw.x = w[0]; raw.y = w[1]; raw.z = w[2]; raw.w = w[3]; }
                *(LAS u32x4*)(lds + L_BIG + (v * LDK + d0) * 2) = raw; }
        }
        __builtin_amdgcn_sched_barrier(0);
        __syncthreads();
        const int tm = wid >> 2, tnb = wid & 3;
        f32x16 acc[NT];
#pragma unroll
        for (int nt = 0; nt < NT; ++nt)
#pragma unroll
            for (int r = 0; r < 16; ++r) acc[nt][r] = 0.f;
#pragma unroll
        for (int ks = 0; ks < DK / 16; ++ks) { const bf16x8 af = frag(lds, L_QI, LDK, tm * 32, ks, lane);
#pragma unroll
            for (int nt = 0; nt < NT; ++nt) acc[nt] = __builtin_amdgcn_mfma_f32_32x32x16_bf16(af, frag(lds, L_BIG, LDK, (tnb + 4 * nt) * 32, ks, lane), acc[nt], 0, 0, 0); }
        if constexpr (!VEC) {
#pragma unroll
            for (int nt = 0; nt < NT; ++nt) { const int hh = (NH == 1) ? 0 : ((tnb + 4 * nt) >> 1);
#pragma unroll
                for (int r = 0; r < 16; ++r) acc[nt][r] *= __expf(SM[SM_CUM + hh * 64 + tm * 32 + rowmap(r, lane)]); }
        }
        constexpr int P_OFF = (NH == 1) ? L_BIG + 34816 : L_BIG;
        f32x16 sc;
#pragma unroll
        for (int r = 0; r < 16; ++r) sc[r] = 0.f;
        const int w4 = wid & 3, stm = w4 >> 1, stn = w4 & 1, whalf = wid >> 2;
#pragma unroll
        for (int ks = 0; ks < DK / 16; ++ks) sc = __builtin_amdgcn_mfma_f32_32x32x16_bf16(frag(lds, L_QI, LDK, stm * 32, ks, lane), frag(lds, L_KI, LDK, stn * 32, ks, lane), sc, 0, 0, 0);
        if constexpr (NH != 1) __syncthreads();
        {
            const int s = stn * 32 + (lane & 31);
            if constexpr (NH == 1) {
                float cums = 0.f, dts = 1.f;
                if constexpr (!VEC) { cums = SM[SM_CUM + s]; dts = SM[SM_DT + s]; }
#pragma unroll
                for (int r8 = 0; r8 < 8; ++r8) { const int rlo = r8, rhi = r8 + 8; const int r = whalf ? rhi : rlo; const int t = stm * 32 + (whalf ? rowmap(rhi, lane) : rowmap(rlo, lane));
                    float val = whalf ? sc[rhi] : sc[rlo]; (void)r;
                    if constexpr (!VEC) { const float ex = (s <= t) ? SM[SM_CUM + t] - cums : 0.f; val *= __expf(ex) * dts; }
                    val = (s <= t) ? val : 0.f;
                    *(LAS bf16_t*)(lds + P_OFF + (t * 72 + s) * 2) = f2bf(val); }
            } else {
#pragma unroll
                for (int h2 = 0; h2 < NH / 2; ++h2) { const int hh = whalf * (NH / 2) + h2;
                    const float cums = SM[SM_CUM + hh * 64 + s], dts = SM[SM_DT + hh * 64 + s];
#pragma unroll
                    for (int r = 0; r < 16; ++r) { const int t = stm * 32 + rowmap(r, lane);
                        float val = sc[r];
                        const float ex = (s <= t) ? SM[SM_CUM + hh * 64 + t] - cums : 0.f; val *= __expf(ex) * dts;
                        val = (s <= t) ? val : 0.f;
                        *(LAS bf16_t*)(lds + P_OFF + ((hh * 64 + t) * 72 + s) * 2) = f2bf(val); } }
            }
        }
        __syncthreads();
#pragma unroll
        for (int nt = 0; nt < NT; ++nt) { const int hh = (NH == 1) ? 0 : ((tnb + 4 * nt) >> 1);
#pragma unroll
            for (int ks = 0; ks < 4; ++ks) acc[nt] = __builtin_amdgcn_mfma_f32_32x32x16_bf16(frag(lds, P_OFF + hh * 9216, 72, tm * 32, ks, lane), frag(lds, L_VT, 72, (tnb + 4 * nt) * 32, ks, lane), acc[nt], 0, 0, 0); }
        const int ycol = (BR == 0) ? hu * 128 : (BR == 1) ? 512 + hu * 128 : (BR == 2) ? 1024 + hu * 256 : 1536 + hu * 128;
#pragma unroll
        for (int nt = 0; nt < NT; ++nt) { const int ct = tnb + 4 * nt, v = ct * 32 + (lane & 31);
            const float dsk = dskv[nt];
            float sq[16];
#pragma unroll
            for (int r = 0; r < 16; ++r) { const int t = tm * 32 + rowmap(r, lane);
                float val = acc[nt][r];
                if constexpr (BR == 2) { val = (val + dsk * bf2f(VT[v * 72 + t])) * silu_f(bf2f(gt[nt][r])); acc[nt][r] = val; }
                sq[r] = val * val; }
            const bool b4 = lane & 16, b3 = lane & 8, b2 = lane & 4, b1 = lane & 2;
#pragma unroll
            for (int i = 0; i < 8; ++i) { const float lo = sq[i], hi = sq[i + 8]; sq[i] = (b4 ? hi : lo) + __shfl_xor(b4 ? lo : hi, 16); }
#pragma unroll
            for (int i = 0; i < 4; ++i) { const float lo = sq[i], hi = sq[i + 4]; sq[i] = (b3 ? hi : lo) + __shfl_xor(b3 ? lo : hi, 8); }
#pragma unroll
            for (int i = 0; i < 2; ++i) { const float lo = sq[i], hi = sq[i + 2]; sq[i] = (b2 ? hi : lo) + __shfl_xor(b2 ? lo : hi, 4); }
            { const float lo = sq[0], hi = sq[1]; sq[0] = (b1 ? hi : lo) + __shfl_xor(b1 ? lo : hi, 2); }
            sq[0] += __shfl_xor(sq[0], 1);
            const int rr = (b4 ? 8 : 0) + (b3 ? 4 : 0) + (b2 ? 2 : 0) + (b1 ? 1 : 0);
            if ((lane & 1) == 0) SM[SM_RSS + ct * 64 + tm * 32 + rowmap(rr, lane)] = sq[0];
        }
        __syncthreads();
        if (tid < 64) { float tot = 0.f;
#pragma unroll
            for (int q = 0; q < NCT; ++q) tot += SM[SM_RSS + q * 64 + tid];
            SM[SM_SEG + tid] = rsqrtf(tot * (1.f / DV) + EPS); }
        __syncthreads();
        float rinv[16];
#pragma unroll
        for (int r = 0; r < 16; ++r) rinv[r] = SM[SM_SEG + tm * 32 + rowmap(r, lane)];
        __syncthreads();
#pragma unroll
        for (int nt = 0; nt < NT; ++nt) { const int ct = tnb + 4 * nt, v = ct * 32 + (lane & 31);
            const float gn = gnv[nt];
#pragma unroll
            for (int r = 0; r < 16; ++r) { const int t = tm * 32 + rowmap(r, lane);
                float o = acc[nt][r] * rinv[r] * gn;
                if constexpr (BR != 2) o *= silu_f(bf2f(gt[nt][r]));
                p.y[(size_t)(bc * 64 + t) * DI + ycol + v] = f2bf(o); }
        }
    }
    }
}

template <int PASS>
__device__ __forceinline__ void phase_mixer(const MixP& p, LAS unsigned char* lds) {
#pragma unroll 1
    for (int i = blockIdx.x; i < NUNITS; i += gridDim.x) {
        const int bc = i / 14, u = i % 14;
        if (u < 4) mixer_unit<0, PASS>(p, lds, bc, u);
        else if (u < 8) mixer_unit<1, PASS>(p, lds, bc, u - 4);
        else if (u < 10) mixer_unit<2, PASS>(p, lds, bc, u - 8);
        else mixer_unit<3, PASS>(p, lds, bc, u - 10);
    }
}

__device__ __forceinline__ void phase_scan(bf16_t* st, const float* dec, LAS unsigned char* lds) {
    constexpr int BPB = ST_PER_BC / 2048;
    LAS float* D = (LAS float*)lds;
    const int tid = opaque_tid();
#pragma unroll 1
    for (int blk = blockIdx.x; blk < 2 * BPB; blk += gridDim.x) {
        const int bl = blk / BPB, eb = (blk % BPB) * 2048, e0 = eb + tid * 4;
        const float* dpb = dec + (size_t)bl * 64 * 1024;
        int mode, dsel = 0;
        if (eb < 65536) { mode = 0; const int dbase = (eb >> 14) * 128;
            for (int k = tid; k < 64 * 32; k += NTHR) { const int c = k >> 5, q = k & 31; *(LAS f32x4*)(D + c * 128 + q * 4) = *(const f32x4*)(dpb + (size_t)c * 1024 + dbase + q * 4); }
            dsel = e0 & 127; }
        else if (eb < 131072) { mode = 1; }
        else if (eb < 196608) { mode = 2; const int r = eb - 131072; const int g = r >> 15;
            const int head = g * 4 + (((r & 32767) >> 7) >> 6);
            if (tid < 64) D[tid] = dpb[(size_t)tid * 1024 + 768 + head]; }
        else { mode = 3; const int r = eb - 196608; const int dbase = 512 + (r >> 13) * 64;
            for (int k = tid; k < 64 * 16; k += NTHR) { const int c = k >> 4, q = k & 15; *(LAS f32x4*)(D + c * 64 + q * 4) = *(const f32x4*)(dpb + (size_t)c * 1024 + dbase + q * 4); }
            dsel = e0 & 63; }
        float cfac = 0.f;
        if (mode == 1) { const int h = (eb - 65536) >> 14; cfac = __expf(64.f * log1pf(-exp2f(-(5.f + (float)h)))); }
        __syncthreads();
        float s0 = 0.f, s1 = 0.f, s2 = 0.f, s3 = 0.f;
        bf16_t* ptr = st + (size_t)bl * 64 * ST_PER_BC + e0;
#pragma unroll 1
        for (int c0 = 0; c0 < 64; c0 += 8) {
            u32x2 hv[8];
#pragma unroll
            for (int j = 0; j < 8; ++j) hv[j] = *(const u32x2*)(ptr + (size_t)(c0 + j) * ST_PER_BC);
            __builtin_amdgcn_sched_barrier(0);
#pragma unroll
            for (int j = 0; j < 8; ++j) {
                f32x4 dv;
                if (mode == 0) dv = *(const LAS f32x4*)(D + (c0 + j) * 128 + dsel);
                else if (mode == 3) dv = *(const LAS f32x4*)(D + (c0 + j) * 64 + dsel);
                else if (mode == 1) dv = (f32x4){cfac, cfac, cfac, cfac};
                else { const float d = D[c0 + j]; dv = (f32x4){d, d, d, d}; }
                u32x2 w; w.x = pk2(s0, s1); w.y = pk2(s2, s3);
                *(u32x2*)(ptr + (size_t)(c0 + j) * ST_PER_BC) = w;
                s0 = s0 * dv[0] + __uint_as_float(hv[j].x << 16); s1 = s1 * dv[1] + __uint_as_float(hv[j].x & 0xffff0000u);
                s2 = s2 * dv[2] + __uint_as_float(hv[j].y << 16); s3 = s3 * dv[3] + __uint_as_float(hv[j].y & 0xffff0000u);
            }
        }
        __syncthreads();
    }
}

#define XB_TMO      128
#define XB_XCNT(j)  (256  + 64 * (j))
#define XB_XSUB(j)  (1280 + 64 * (j))
#define XB_XGEN(j)  (2304 + 64 * (j))
#define XB_TOP      3328
#define XB_TOPGEN   3392
#define XCD_BAR_WORDS 3456
#define XB_SPIN_CAP (1u << 18)
__device__ __forceinline__ unsigned xb_ld(unsigned* p)              { return __hip_atomic_load(p, __ATOMIC_RELAXED, __HIP_MEMORY_SCOPE_AGENT); }
__device__ __forceinline__ unsigned xb_add(unsigned* p, unsigned v) { return __hip_atomic_fetch_add(p, v, __ATOMIC_RELAXED, __HIP_MEMORY_SCOPE_AGENT); }
__device__ __forceinline__ unsigned xb_xcc_id() { return (unsigned)__builtin_amdgcn_s_getreg((3 << 11) | 20) & 0xFu; }
#define XB_SPIN(cond, bar) do { unsigned _sp = 0; while (cond) { __builtin_amdgcn_s_sleep(1); \
    if ((++_sp & 255u) == 0u) { if (xb_ld(&(bar)[XB_TMO])) break; if (_sp > XB_SPIN_CAP) { atomicAdd(&(bar)[XB_TMO], 1u); break; } } } } while (0)
struct XcdBarrier { unsigned* bar; unsigned x; volatile LAS unsigned* st; };
__device__ __forceinline__ XcdBarrier xcd_barrier_post(unsigned* bar, volatile LAS unsigned* st) {
    XcdBarrier b; b.bar = bar; b.x = xb_xcc_id(); b.st = st;
    if (threadIdx.x == 0) (void)xb_add(&bar[XB_XCNT(b.x)], 1u);
    return b;
}
__device__ __forceinline__ void xcd_barrier_complete(unsigned* bar, unsigned x, unsigned& nloc, unsigned& nx) {
    const unsigned G = gridDim.x * gridDim.y * gridDim.z;
    unsigned sum, cnt, mine, sp = 0u;
    for (;;) {
        sum = 0u; cnt = 0u; mine = 0u;
#pragma unroll
        for (unsigned j = 0; j < 16; ++j) { const unsigned c = xb_ld(&bar[XB_XCNT(j)]); sum += c; cnt += (c > 0u) ? 1u : 0u; mine = (j == x) ? c : mine; }
        if (sum == G) break;
        __builtin_amdgcn_s_sleep(1);
        if ((++sp & 255u) == 0u) { if (xb_ld(&bar[XB_TMO])) break; if (sp > XB_SPIN_CAP) { atomicAdd(&bar[XB_TMO], 1u); break; } }
    }
    nloc = mine > 0u ? mine : 1u; nx = cnt > 0u ? cnt : 1u;
}
__device__ __forceinline__ void xcd_barrier(const XcdBarrier& b) {
    asm volatile("s_waitcnt vmcnt(0)" ::: "memory");
    __syncthreads();
    if (threadIdx.x == 0) {
        unsigned* bar = b.bar;
        __builtin_amdgcn_s_waitcnt(0);
        unsigned nloc = b.st[0], nx = b.st[1];
        if (nloc == 0u) { xcd_barrier_complete(bar, b.x, nloc, nx); b.st[0] = nloc; b.st[1] = nx; }
        const unsigned old = xb_add(&bar[XB_XSUB(b.x)], 1u);
        const unsigned gen = old / nloc;
        if (old + 1u == (gen + 1u) * nloc) {
            __builtin_amdgcn_fence(__ATOMIC_RELEASE, "agent");
            asm volatile("s_waitcnt vmcnt(0)" ::: "memory");
            const unsigned og = xb_add(&bar[XB_TOP], 1u);
            const unsigned tg = og / nx;
            if (og + 1u == (tg + 1u) * nx) xb_add(&bar[XB_TOPGEN], 1u);
            else XB_SPIN(xb_ld(&bar[XB_TOPGEN]) == tg, bar);
            __builtin_amdgcn_fence(__ATOMIC_ACQUIRE, "agent");
            xb_add(&bar[XB_XGEN(b.x)], 1u);
            asm volatile("s_waitcnt vmcnt(0)" ::: "memory");
        } else {
            XB_SPIN(xb_ld(&bar[XB_XGEN(b.x)]) == gen, bar);
            __builtin_amdgcn_fence(__ATOMIC_ACQUIRE, "agent");
            asm volatile("s_waitcnt vmcnt(0)" ::: "memory");
        }
    }
    __syncthreads();
}

__global__ void __launch_bounds__(NTHR, 2) fwd_megakernel(Args a) {
    extern __shared__ __attribute__((aligned(16))) unsigned char shm[];
    LAS unsigned char* lds = (LAS unsigned char*)shm;
    cg::grid_group grid = cg::this_grid();
    unsigned char* ws = a.ws;
    const int G = gridDim.x;

    {
        volatile LAS unsigned* stw = (volatile LAS unsigned*)(lds + L_BARST);
        if (threadIdx.x < 2) stw[threadIdx.x] = 0u;
        __syncthreads();
    }
    const XcdBarrier gbar = xcd_barrier_post((unsigned*)(ws + WS_BAR), (volatile LAS unsigned*)(lds + L_BARST));
    if (a.ws == nullptr) grid.sync();
    for (int rep = 0; rep < REP_PREP; ++rep) { phase_prep(a, lds); xcd_barrier(gbar); }

    bf16_t* hbuf = (bf16_t*)(ws + WS_HY); bf16_t* ybuf = (bf16_t*)(ws + WS_HY);
    bf16_t* proj = (bf16_t*)(ws + WS_PROJ); bf16_t* st = (bf16_t*)(ws + WS_ST); float* dec = (float*)(ws + WS_DEC);
    const float* mod = (const float*)(ws + WS_MOD);

#pragma unroll 1
    for (int half = 0; half < 2; ++half) {
        const size_t xoff = (size_t)half * HROWS * DM;
#pragma unroll 1
        for (int l = 0; l < DEPTH; ++l) {
            const float* modl = mod + (size_t)l * 4 * 3072;
            bf16_t* slab = (bf16_t*)(ws + WS_PROJ);
            if (l == 0) { phase_norm<false>(a.x + xoff, nullptr, nullptr, nullptr, a.norm_g, modl, half, hbuf); if (half == 0) phase_wcvt(a, lds); }
            else phase_norm<false>(a.x + xoff, slab, mod + (size_t)(half * 2) * 3072 + 2048, a.out + xoff, a.norm_g + l * DM, modl, half, hbuf);
            xcd_barrier(gbar);
            for (int rep = 0; rep < REP_G1; ++rep) {
                pg8::Gemm g{hbuf, (const bf16_t*)(ws + WS_WIN) + (size_t)l * LDP * DM, HROWS, LDP, DM, DM};
                pg8::StaticOrder S; S.init(HROWS, LDP, G, (int)blockIdx.x);
                pg8::EpiProj E{proj, LDP};
                pg8::gemm_phase<pg8::EpiProj, pg8::StaticOrder>(lds, g, S, E);
                xcd_barrier(gbar);
            }
            MixP p;
            p.proj = proj; p.st = st; p.dec = dec; p.y = ybuf; p.rope = (const float2*)(ws + WS_ROPE);
            p.lbl = a.lb_logits; p.hgrn_g = a.hgrn_g + l * 512; p.ret_g = a.ret_g + l * 512; p.conv_w = a.conv_w + l * 4096; p.conv_b = a.conv_b + l * 1024;
            p.dt_bias = a.dt_bias + l * 8; p.a_log = a.a_log + l * 8; p.dskip = a.dskip + l * 8; p.ssm_g = a.ssm_g + l * 512;
            p.w2 = a.w_gk2 + l * 16 * 256; p.b2 = a.b_gk2 + l * 256; p.gla_g = a.gla_g + l * 512; p.layer = l;
            for (int rep = 0; rep < REP_M12; ++rep) { phase_mixer<1>(p, lds); xcd_barrier(gbar); phase_scan(st, dec, lds); xcd_barrier(gbar); }
            for (int rep = 0; rep < REP_M3; ++rep) { phase_mixer<3>(p, lds); xcd_barrier(gbar); }
            for (int rep = 0; rep < REP_G2; ++rep) {
                pg8::Gemm g{ybuf, (const bf16_t*)(ws + WS_WOUT) + (size_t)l * DM * DI, HROWS, DM, DI / 2, DI};
                pg8::SplitOrder S; S.init(HROWS, DM, G, (int)blockIdx.x);
                pg8::EpiSlab E{slab};
                pg8::gemm_phase<pg8::EpiSlab, pg8::SplitOrder>(lds, g, S, E);
                xcd_barrier(gbar);
            }
        }
        phase_norm<true>(a.out + xoff, (const bf16_t*)(ws + WS_PROJ), mod + (size_t)(4 + half * 2) * 3072 + 2048, a.out + xoff, a.final_g, nullptr, half, nullptr);
    }
}

extern "C" void kernel_launch(void* const* d_in, const int* in_sizes, int n_in, void* d_out, int out_size, void* d_ws, size_t ws_size, hipStream_t stream) {
    static int grid = 0;
    if (grid == 0) {
        if (n_in != 20 || ws_size < WS_END) { fprintf(stderr, "kernel_launch: unexpected n_in %d / ws_size %zu (need %zu)\n", n_in, ws_size, (size_t)WS_END); grid = -1; return; }
        int dev = 0, cus = 0, per_cu = 0;
        hipGetDevice(&dev);
        hipDeviceGetAttribute(&cus, hipDeviceAttributeMultiprocessorCount, dev);
        if (hipFuncSetAttribute((const void*)fwd_megakernel, hipFuncAttributeMaxDynamicSharedMemorySize, LDS_BYTES) != hipSuccess) { fprintf(stderr, "kernel_launch: hipFuncSetAttribute failed\n"); grid = -1; return; }
        hipOccupancyMaxActiveBlocksPerMultiprocessor(&per_cu, (const void*)fwd_megakernel, NTHR, LDS_BYTES);
        if (per_cu < 1) { fprintf(stderr, "kernel_launch: occupancy query says %d blocks per CU\n", per_cu); per_cu = 1; }
        (void)hipGetLastError();
        grid = cus * per_cu;
    }
    if (grid < 0) return;
    Args a{};
    const float** f = (const float**)&a;
    for (int i = 0; i < 20; ++i) f[i] = (const float*)d_in[i];
    a.out = (float*)d_out; a.ws = (unsigned char*)d_ws;
    void* args[] = {&a};
    if (hipMemsetAsync((char*)d_ws + WS_BAR, 0, XCD_BAR_WORDS * 4, stream) != hipSuccess) { fprintf(stderr, "kernel_launch: memset of barrier words failed\n"); return; }
    hipError_t e = hipLaunchCooperativeKernel((const void*)fwd_megakernel, dim3(grid), dim3(NTHR), args, LDS_BYTES, stream);
    if (e != hipSuccess) fprintf(stderr, "cooperative launch failed: %s (grid %d)\n", hipGetErrorString(e), grid);
}
```
